# Optimizing an MI355X kernel written in HIP

```python
import math
import jax
import jax.numpy as jnp
from jax import lax
import numpy as np

D_MODEL = 2048
BATCH = 1
SEQ = 16384
DEPTH = 1

DIFF_WIDTH = D_MODEL // 2
SB_WIDTH = D_MODEL - DIFF_WIDTH
DIFF_QK_DIM = 64
DIFF_V_DIM = 2 * DIFF_QK_DIM
DIFF_HEADS = DIFF_WIDTH // DIFF_V_DIM
SB_HEAD_DIM = 128
SB_HEADS = SB_WIDTH // SB_HEAD_DIM
D_FF = 4 * D_MODEL
ROPE_THETA = 500000.0
ROPE_FRACTION_DEN = 4
BLOCK_Q = 128
NORM_EPS = 1e-6
NEG_INF = -1e30
PROJ_SPLITS = (
    2 * DIFF_HEADS * DIFF_QK_DIM,
    2 * DIFF_HEADS * DIFF_QK_DIM,
    DIFF_HEADS * DIFF_V_DIM,
    SB_HEADS * SB_HEAD_DIM,
    SB_HEADS * SB_HEAD_DIM,
    SB_HEADS * SB_HEAD_DIM,
)
PROJ_WIDTH = sum(PROJ_SPLITS)

kernel_name = "hymba_diff_stickbreaking_hybrid"


def rmsnorm(x, g):
    xf = x.astype(jnp.float32)
    y = xf * lax.rsqrt(jnp.mean(jnp.square(xf), axis=-1, keepdims=True) + NORM_EPS)
    return (y * g.astype(jnp.float32)).astype(x.dtype)


def partial_rotary(x, pos):
    d = x.shape[-1]
    rot = d // ROPE_FRACTION_DEN
    half = rot // 2
    inv_freq = ROPE_THETA ** (-jnp.arange(0, rot, 2, dtype=jnp.float32) / rot)
    ang = pos.astype(jnp.float32)[:, None] * inv_freq[None, :]
    cos = jnp.cos(ang)[None, :, None, :]
    sin = jnp.sin(ang)[None, :, None, :]
    xr = x[..., :rot].astype(jnp.float32)
    x1, x2 = xr[..., :half], xr[..., half:]
    rotated = jnp.concatenate([x1 * cos - x2 * sin, x2 * cos + x1 * sin], axis=-1)
    return jnp.concatenate([rotated.astype(x.dtype), x[..., rot:]], axis=-1)


def to_blocks(a):
    b, s = a.shape[0], a.shape[1]
    return jnp.swapaxes(a.reshape(b, s // BLOCK_Q, BLOCK_Q, *a.shape[2:]), 0, 1)


def from_blocks(a):
    a = jnp.swapaxes(a, 0, 1)
    return a.reshape(a.shape[0], a.shape[1] * a.shape[2], *a.shape[3:])


def differential_attention(q1, q2, k1, k2, v, lam):
    s_len = q1.shape[1]
    key_pos = jnp.arange(s_len)
    scale = DIFF_QK_DIM ** -0.5

    def block(args):
        qb1, qb2, qpos = args
        causal = key_pos[None, :] <= qpos[:, None]

        def probs(qb, k):
            sc = jnp.einsum("bqhd,bkhd->bhqk", qb, k,
                            preferred_element_type=jnp.float32) * scale
            return jax.nn.softmax(jnp.where(causal, sc, NEG_INF), axis=-1)

        w = probs(qb1, k1) - lam * probs(qb2, k2)
        return jnp.einsum("bhqk,bkhd->bqhd", w.astype(v.dtype), v)

    qpos = jnp.arange(s_len).reshape(-1, BLOCK_Q)
    out = lax.map(block, (to_blocks(q1), to_blocks(q2), qpos))
    return from_blocks(out)


def stick_breaking_attention(q, k, v):
    s_len = q.shape[1]
    key_pos = jnp.arange(s_len)
    scale = SB_HEAD_DIM ** -0.5

    def block(args):
        qb, qpos = args
        strict = key_pos[None, :] < qpos[:, None]
        z = jnp.einsum("bqhd,bkhd->bhqk", qb, k,
                       preferred_element_type=jnp.float32) * scale
        log_beta = jax.nn.log_sigmoid(z)
        log_one_minus = jnp.where(strict, jax.nn.log_sigmoid(-z), 0.0)
        log_stick = lax.cumsum(log_one_minus, axis=3, reverse=True) - log_one_minus
        a = jnp.where(strict, jnp.exp(log_beta + log_stick), 0.0)
        return jnp.einsum("bhqk,bkhd->bqhd", a.astype(v.dtype), v)

    qpos = jnp.arange(s_len).reshape(-1, BLOCK_Q)
    out = lax.map(block, (to_blocks(q), qpos))
    return from_blocks(out)


def setup_inputs(seed: int = 0) -> dict:
    key = jax.random.key(seed)
    ks = jax.random.split(key, 16)
    f32 = jnp.float32

    def normal(k, shape, scale):
        return jax.random.normal(k, shape, f32) * scale

    return {
        "x": normal(ks[0], (BATCH, SEQ, D_MODEL), 1.0),
        "ln1": 1.0 + normal(ks[1], (DEPTH, D_MODEL), 0.02),
        "w_in": normal(ks[2], (DEPTH, D_MODEL, PROJ_WIDTH), D_MODEL ** -0.5),
        "lambda_q1": normal(ks[3], (DEPTH, DIFF_QK_DIM), 0.1),
        "lambda_k1": normal(ks[4], (DEPTH, DIFF_QK_DIM), 0.1),
        "lambda_q2": normal(ks[5], (DEPTH, DIFF_QK_DIM), 0.1),
        "lambda_k2": normal(ks[6], (DEPTH, DIFF_QK_DIM), 0.1),
        "diff_head_norm": 1.0 + normal(ks[7], (DEPTH, DIFF_V_DIM), 0.02),
        "sb_head_norm": 1.0 + normal(ks[8], (DEPTH, SB_HEAD_DIM), 0.02),
        "w_out": normal(ks[9], (DEPTH, DIFF_WIDTH + SB_WIDTH, D_MODEL), (DIFF_WIDTH + SB_WIDTH) ** -0.5),
        "ln2": 1.0 + normal(ks[10], (DEPTH, D_MODEL), 0.02),
        "w_mlp_in": normal(ks[11], (DEPTH, D_MODEL, D_FF), D_MODEL ** -0.5),
        "w_mlp_out": normal(ks[12], (DEPTH, D_FF, D_MODEL), 0.2 * D_FF ** -0.5),
        "ln_f": 1.0 + normal(ks[13], (D_MODEL,), 0.02),
    }


def reference(x, ln1, w_in, lambda_q1, lambda_k1, lambda_q2, lambda_k2,
              diff_head_norm, sb_head_norm, w_out, ln2, w_mlp_in, w_mlp_out, ln_f):
    b, s_len, _ = x.shape
    pos = jnp.arange(s_len)
    split_points = list(np.cumsum(PROJ_SPLITS)[:-1])
    for l in range(DEPTH):
        lam_init = 0.8 - 0.6 * math.exp(-0.3 * l)

        h = rmsnorm(x, ln1[l])
        proj = h @ w_in[l]
        dq, dk, dv, sq, sk, sv = jnp.split(proj, split_points, axis=-1)

        dq = dq.reshape(b, s_len, DIFF_HEADS, 2, DIFF_QK_DIM)
        dk = dk.reshape(b, s_len, DIFF_HEADS, 2, DIFF_QK_DIM)
        q1 = partial_rotary(dq[..., 0, :], pos)
        q2 = partial_rotary(dq[..., 1, :], pos)
        k1 = partial_rotary(dk[..., 0, :], pos)
        k2 = partial_rotary(dk[..., 1, :], pos)
        dv = dv.reshape(b, s_len, DIFF_HEADS, DIFF_V_DIM)
        lam = (jnp.exp(jnp.sum(lambda_q1[l].astype(jnp.float32) * lambda_k1[l].astype(jnp.float32)))
               - jnp.exp(jnp.sum(lambda_q2[l].astype(jnp.float32) * lambda_k2[l].astype(jnp.float32)))
               + lam_init)
        diff_out = differential_attention(q1, q2, k1, k2, dv, lam)
        diff_out = rmsnorm(diff_out, diff_head_norm[l]) * (1.0 - lam_init)

        sq = sq.reshape(b, s_len, SB_HEADS, SB_HEAD_DIM)
        sk = sk.reshape(b, s_len, SB_HEADS, SB_HEAD_DIM)
        sv = sv.reshape(b, s_len, SB_HEADS, SB_HEAD_DIM)
        sb_out = rmsnorm(stick_breaking_attention(sq, sk, sv), sb_head_norm[l])

        mixed = jnp.concatenate([diff_out.reshape(b, s_len, DIFF_WIDTH),
                                 sb_out.reshape(b, s_len, SB_WIDTH)], axis=-1)
        x = x + mixed @ w_out[l]

        h = rmsnorm(x, ln2[l])
        x = x + jnp.square(jax.nn.relu(h @ w_mlp_in[l])) @ w_mlp_out[l]
    return rmsnorm(x, ln_f)
```

```cpp
#include <hip/hip_runtime.h>
#include <hip/hip_cooperative_groups.h>
#include <cstdio>
#include <cstdint>
#include <cmath>
namespace cg = cooperative_groups;
namespace pg8 {
#define PG8_LAS __attribute__((address_space(3)))
typedef unsigned short bf16_t;
typedef short bf16x8 __attribute__((ext_vector_type(8)));
typedef float f32x4 __attribute__((ext_vector_type(4)));
typedef unsigned u32x4 __attribute__((ext_vector_type(4)));
constexpr int BM = 256, BK = 64, HALF = 128, HTB = HALF * BK * 2  , STAGE_BYTES = 8 * HTB, NXCD = 8, WGM = 8;

__host__ __device__ __forceinline__ int lds_byte(int r, int c) { const int st = (r >> 4) * 2 + (c >> 5), rr = r & 15, cc = c & 31, ob = rr * 64 + cc * 2; return st * 1024 + (ob ^ (((ob >> 9) & 1) << 5)); }
__host__ __device__ __forceinline__ void stage_rc(int b, int& R, int& C) { const int st = b / 1024, sb = b % 1024, swz = sb ^ (((sb >> 9) & 1) << 5); R = (st >> 1) * 16 + swz / 64; C = (st & 1) * 32 + (swz % 64) / 2; }
__host__ __device__ __forceinline__ int perm32(int rho) { const int n = rho >> 4, i = rho & 15; return 8 * (i >> 2) + 4 * n + (i & 3); }

struct Unit { int pm, pn; };
struct Gemm { const bf16_t* A; const bf16_t* Bt; int M, N, K; };

struct StaticOrder {
    int nM, nN, nwg, G, c;
    __host__ __device__ void init(int M, int N, int G_, int c_) { nM = M / BM; nN = N / BM; nwg = nM * nN; G = G_; c = c_; }
    __host__ __device__ bool next(int i, Unit& u) const {
        const long L = (long)i * G + c; if (L >= nwg) return false;
        int wgid = (int)L; { const int q = nwg / NXCD, r = nwg % NXCD, xcd = wgid % NXCD, off = wgid / NXCD; wgid = (xcd < r ? xcd * (q + 1) : r * (q + 1) + (xcd - r) * q) + off; }
        const int nig = WGM * nN, gid = wgid / nig, fm = gid * WGM, gsz = (nM - fm) < WGM ? (nM - fm) : WGM;
        u.pm = fm + ((wgid % nig) % gsz); u.pn = (wgid % nig) / gsz; return true;
    }
    __device__ __forceinline__ void a_ready(const Unit&) const {}
    __device__ __forceinline__ void done(const Unit&) const {}
};

__device__ __forceinline__ unsigned cvt_pk_bf16(float lo, float hi) { unsigned r; asm volatile("v_cvt_pk_bf16_f32 %0, %1, %2" : "=v"(r) : "v"(lo), "v"(hi)); return r; }
template <class Epi, class Sched, bool ALIGN_EPI = false, bool SP2 = false>
__device__ __forceinline__ void gemm_phase(PG8_LAS unsigned char* lds, const Gemm g, const Sched& S, const Epi& E, int wave_id) {
    int tid_ = wave_id * 64 + (int)__builtin_amdgcn_mbcnt_hi(~0u, __builtin_amdgcn_mbcnt_lo(~0u, 0u)); asm volatile("" : "+v"(tid_));
    const int tid = tid_, wid = __builtin_amdgcn_readfirstlane(tid >> 6), lane = tid & 63, wr = wid >> 2, wc = wid & 3, fr = lane & 15, fq = lane >> 4;
    const int K = g.K, nt = K / BK;
    unsigned voffA[2], voffB[2];
#pragma unroll
    for (int i = 0; i < 2; ++i) { int R, C; stage_rc(tid * 16 + i * 8192, R, C); const int Rb = Epi::PERM ? ((R & ~31) + perm32(R & 31)) : R;
        voffA[i] = (unsigned)(R * K + C) * 2u; voffB[i] = (unsigned)(Rb * K + C) * 2u; }
    const size_t kstep = (size_t)(BK * 2);
    const size_t hstep = (size_t)HALF * K * 2;
    const size_t tstep = 2 * hstep;
    const unsigned ldsw = (unsigned)wid * 1024u;
    const int aoff = lds_byte(wr * 64 + fr, fq * 8), boff = lds_byte(wc * 32 + fr, fq * 8);
#define PG8_SA(b, h) (((b) * 2 + (h)) * HTB)
#define PG8_SB(b, h) ((4 + (b) * 2 + (h)) * HTB)
#define PG8_STAGE(bufoff, gbase, voff) do { _Pragma("unroll") for (int _i = 0; _i < 2; ++_i) \
        __builtin_amdgcn_global_load_lds((const unsigned*)((const char*)(gbase) + (voff)[_i]), (PG8_LAS unsigned*)(lds + (bufoff) + ldsw + _i * 8192), 16, 0, 0); } while (0)
#define PG8_LDA(dst, b, h) do { _Pragma("unroll") for (int m = 0; m < 4; ++m) _Pragma("unroll") for (int k = 0; k < 2; ++k) dst[m][k] = *(const PG8_LAS bf16x8*)(lds + PG8_SA(b, h) + aoff + m * 2048 + k * 1024); } while (0)
#define PG8_LDB(dst, b, h) do { _Pragma("unroll") for (int n = 0; n < 2; ++n) _Pragma("unroll") for (int k = 0; k < 2; ++k) dst[n][k] = *(const PG8_LAS bf16x8*)(lds + PG8_SB(b, h) + boff + n * 2048 + k * 1024); } while (0)
#define PG8_MMA(ai, bj, At, Bt) do { __builtin_amdgcn_s_setprio(1); _Pragma("unroll") for (int m = 0; m < 4; ++m) _Pragma("unroll") for (int n = 0; n < 2; ++n) _Pragma("unroll") for (int k = 0; k < 2; ++k) \
        acc[ai][bj][m][n] = __builtin_amdgcn_mfma_f32_16x16x32_bf16(Bt[n][k], At[m][k], acc[ai][bj][m][n], 0, 0, 0); __builtin_amdgcn_s_setprio(0); } while (0)
#define PG8_WAIT_V(n) asm volatile("s_waitcnt vmcnt(" #n ")" ::: "memory")
#define PG8_WAIT_L(n) asm volatile("s_waitcnt lgkmcnt(" #n ")" ::: "memory")
#define PG8_BAR __builtin_amdgcn_s_barrier()
#define PG8_SCHED __builtin_amdgcn_sched_barrier(0)
    Unit cur, nxt; int ui = 0;
    if (!S.next(0, cur)) return;
    f32x4 acc[2][2][4][2];
#pragma unroll
    for (int a = 0; a < 2; ++a)
#pragma unroll
        for (int b = 0; b < 2; ++b)
#pragma unroll
            for (int m = 0; m < 4; ++m)
#pragma unroll
                for (int n = 0; n < 2; ++n) acc[a][b][m][n] = (f32x4){0.f, 0.f, 0.f, 0.f};
    bf16x8 At[4][2], B0[2][2], B1[2][2];
    const char* cA = (const char*)g.A + (size_t)cur.pm * tstep; const char* cB = (const char*)g.Bt + (size_t)cur.pn * tstep;
    S.a_ready(cur);
    if constexpr (SP2) {
        PG8_STAGE(PG8_SB(0, 0), cB, voffB); PG8_STAGE(PG8_SB(0, 1), cB + hstep, voffB); PG8_STAGE(PG8_SA(0, 0), cA, voffA); PG8_STAGE(PG8_SA(0, 1), cA + hstep, voffA);
        if (wr == 1) PG8_BAR;
        PG8_WAIT_V(2); PG8_BAR;
        PG8_STAGE(PG8_SB(1, 0), cB + kstep, voffB); PG8_STAGE(PG8_SA(1, 0), cA + kstep, voffA); PG8_STAGE(PG8_SB(1, 1), cB + hstep + kstep, voffB);
        PG8_WAIT_V(6); PG8_BAR;
    } else {
        PG8_STAGE(PG8_SB(0, 0), cB, voffB); PG8_STAGE(PG8_SA(0, 0), cA, voffA); PG8_STAGE(PG8_SB(0, 1), cB + hstep, voffB); PG8_STAGE(PG8_SA(0, 1), cA + hstep, voffA);
        if (wr == 1) PG8_BAR;
        PG8_WAIT_V(4); PG8_BAR;
        PG8_STAGE(PG8_SB(1, 0), cB + kstep, voffB); PG8_STAGE(PG8_SA(1, 0), cA + kstep, voffA); PG8_STAGE(PG8_SB(1, 1), cB + hstep + kstep, voffB);
        PG8_WAIT_V(6); PG8_BAR;
    }
    for (;;) {
        const bool has_next = S.next(ui + 1, nxt);
        const char* nA = has_next ? (const char*)g.A + (size_t)nxt.pm * tstep : cA; const char* nB = has_next ? (const char*)g.Bt + (size_t)nxt.pn * tstep : cB;
        for (int t = 0; t < nt; t += 2) {
            const bool last = (t == nt - 2);
            const char* a1 = cA + (size_t)(t + 1) * kstep;
            const char* a2 = last ? nA : cA + (size_t)(t + 2) * kstep; const char* b2 = last ? nB : cB + (size_t)(t + 2) * kstep;
            const char* a3 = a2 + kstep; const char* b3 = b2 + kstep;
            if (last && has_next) S.a_ready(nxt);
            if constexpr (SP2) {
            PG8_LDB(B0, 0, 0); PG8_LDB(B1, 0, 1); PG8_SCHED; PG8_LDA(At, 0, 0); PG8_STAGE(PG8_SA(1, 1), a1 + hstep, voffA);
            PG8_WAIT_V(8); PG8_WAIT_L(0); PG8_BAR; PG8_MMA(0, 0, At, B0); PG8_MMA(0, 1, At, B1); PG8_BAR; PG8_SCHED;
            PG8_LDA(At, 0, 1); PG8_STAGE(PG8_SB(0, 0), b2, voffB); PG8_STAGE(PG8_SB(0, 1), b2 + hstep, voffB); PG8_STAGE(PG8_SA(0, 0), a2, voffA);
            PG8_WAIT_V(8); PG8_WAIT_L(0); PG8_BAR; PG8_MMA(1, 0, At, B0); PG8_MMA(1, 1, At, B1); PG8_BAR; PG8_SCHED;
            PG8_LDB(B0, 1, 0); PG8_LDB(B1, 1, 1); PG8_SCHED; PG8_LDA(At, 1, 0); PG8_STAGE(PG8_SA(0, 1), a2 + hstep, voffA);
            PG8_WAIT_V(8); PG8_WAIT_L(0); PG8_BAR; PG8_MMA(0, 0, At, B0); PG8_MMA(0, 1, At, B1); PG8_BAR; PG8_SCHED;
            PG8_LDA(At, 1, 1); PG8_STAGE(PG8_SB(1, 0), b3, voffB); PG8_STAGE(PG8_SB(1, 1), b3 + hstep, voffB); PG8_STAGE(PG8_SA(1, 0), a3, voffA);
            PG8_WAIT_V(8); PG8_WAIT_L(0); PG8_BAR; PG8_MMA(1, 0, At, B0); PG8_MMA(1, 1, At, B1); PG8_BAR; PG8_SCHED;
            } else {
            PG8_LDB(B0, 0, 0); PG8_SCHED; PG8_LDA(At, 0, 0); PG8_STAGE(PG8_SA(1, 1), a1 + hstep, voffA);
            PG8_WAIT_L(8); PG8_BAR; PG8_WAIT_L(0); PG8_MMA(0, 0, At, B0); PG8_BAR; PG8_SCHED;
            PG8_LDB(B1, 0, 1); PG8_STAGE(PG8_SB(0, 0), b2, voffB);
            PG8_BAR; PG8_WAIT_L(0); PG8_MMA(0, 1, At, B1); PG8_BAR;
            PG8_LDA(At, 0, 1); PG8_STAGE(PG8_SA(0, 0), a2, voffA);
            PG8_BAR; PG8_WAIT_L(0); PG8_MMA(1, 0, At, B0); PG8_BAR; PG8_SCHED;
            PG8_STAGE(PG8_SB(0, 1), b2 + hstep, voffB);
            PG8_WAIT_V(6); PG8_BAR; PG8_MMA(1, 1, At, B1); PG8_BAR;
            PG8_LDB(B0, 1, 0); PG8_SCHED; PG8_LDA(At, 1, 0); PG8_STAGE(PG8_SA(0, 1), a2 + hstep, voffA);
            PG8_WAIT_L(8); PG8_BAR; PG8_WAIT_L(0); PG8_MMA(0, 0, At, B0); PG8_BAR; PG8_SCHED;
            PG8_LDB(B1, 1, 1); PG8_STAGE(PG8_SB(1, 0), b3, voffB);
            PG8_BAR; PG8_WAIT_L(0); PG8_MMA(0, 1, At, B1); PG8_BAR;
            PG8_LDA(At, 1, 1); PG8_STAGE(PG8_SA(1, 0), a3, voffA);
            PG8_BAR; PG8_WAIT_L(0); PG8_MMA(1, 0, At, B0); PG8_BAR; PG8_SCHED;
            PG8_STAGE(PG8_SB(1, 1), b3 + hstep, voffB);
            PG8_WAIT_V(6); PG8_BAR; PG8_MMA(1, 1, At, B1); PG8_BAR;
            }
        }
        if constexpr (ALIGN_EPI) { if (wr == 0) PG8_BAR; }
        if constexpr (!Epi::AFTER_DRAIN) { E(acc, cur, wr, wc, fr, fq); S.done(cur); }
        if (!has_next) break;
#pragma unroll
        for (int a = 0; a < 2; ++a)
#pragma unroll
            for (int b = 0; b < 2; ++b)
#pragma unroll
                for (int m = 0; m < 4; ++m)
#pragma unroll
                    for (int n = 0; n < 2; ++n) acc[a][b][m][n] = (f32x4){0.f, 0.f, 0.f, 0.f};
        cur = nxt; cA = nA; cB = nB; ++ui;
        if constexpr (ALIGN_EPI) { if (wr == 1) PG8_BAR; }
    }
    PG8_WAIT_V(0);
    if constexpr (!ALIGN_EPI) { if (wr == 0) PG8_BAR; }
    PG8_BAR;
    if constexpr (Epi::AFTER_DRAIN) { E.fused(acc, cur, wr, wc, fr, fq, lds, wid, lane); S.done(cur); }
#undef PG8_SA
#undef PG8_SB
#undef PG8_STAGE
#undef PG8_LDA
#undef PG8_LDB
#undef PG8_MMA
#undef PG8_WAIT_V
#undef PG8_WAIT_L
#undef PG8_BAR
#undef PG8_SCHED
}
}
#define GAS __attribute__((address_space(1)))
#define LAS __attribute__((address_space(3)))
typedef unsigned short bf16;
typedef unsigned v4u __attribute__((ext_vector_type(4)));
typedef unsigned v2u __attribute__((ext_vector_type(2)));
typedef float f32x4 __attribute__((ext_vector_type(4)));
typedef float f32x16 __attribute__((ext_vector_type(16)));
typedef short bf16x8 __attribute__((ext_vector_type(8)));
typedef short s16x4 __attribute__((ext_vector_type(4)));
using pg8::Unit; using pg8::cvt_pk_bf16; using pg8::BM; using pg8::HALF;

constexpr int SEQ = 16384, DM = 2048, PW = 6144, FF = 8192, M = SEQ;
constexpr int NWAVES = 8, NTHR = 512;
constexpr float EPS = 1e-6f;
constexpr float C2 = 0.125f * 1.4426950408889634f;
constexpr float SBSCALE = 0.08838834764831845f * 1.4426950408889634f;
constexpr float LAM_INIT = 0.2f;
constexpr int COL_DQ = 0, COL_DK = 1024, COL_DV = 2048, COL_SQ = 3072, COL_SK = 4096, COL_SV = 5120;

constexpr size_t MiB = 1u << 20;
constexpr size_t WS_WIN = 0;
constexpr size_t WS_WOUT = 24 * MiB;
constexpr size_t WS_W1 = 32 * MiB;
constexpr size_t WS_W2 = 64 * MiB;
constexpr size_t WS_CS = 96 * MiB;
constexpr size_t WS_SS1 = 97 * MiB;
constexpr size_t WS_SS2 = 97 * MiB + 65536;
constexpr size_t WS_H = 98 * MiB;
constexpr size_t WS_QKV = 162 * MiB;
constexpr size_t WS_MIX = 354 * MiB;
constexpr size_t WS_U = 162 * MiB;
constexpr size_t WS_CTL = 418 * MiB;
constexpr size_t WS_END = 419 * MiB;

constexpr int RING_BYTES = 131072, LDS_BYTES = 131072 + 1024;

__device__ __forceinline__ unsigned f2bf(float f) { unsigned u = __builtin_bit_cast(unsigned, f); return (u + 0x7fffu + ((u >> 16) & 1u)) >> 16; }
__device__ __forceinline__ unsigned pk2(float lo, float hi) { return f2bf(lo) | (f2bf(hi) << 16); }
__device__ __forceinline__ float wave_sum(float v) {
#pragma unroll
    for (int o = 1; o < 64; o <<= 1) v += __shfl_xor(v, o);
    return v;
}
typedef unsigned u32x2_t __attribute__((ext_vector_type(2)));
__device__ __forceinline__ void swap_x32(float& a, float& b) { asm volatile("s_nop 1\n\tv_permlane32_swap_b32 %0, %1" : "+v"(a), "+v"(b)); }
__device__ __forceinline__ float max_x32(float x) { float a = x, b = x; swap_x32(a, b); return fmaxf(a, b); }
__device__ __forceinline__ float sum_x32(float x) { float a = x, b = x; swap_x32(a, b); return a + b; }
__device__ __forceinline__ float partner_x32(float x, int hi) { float a = x, b = x; swap_x32(a, b); return hi ? a : b; }
#define LDS_WAIT() asm volatile("s_waitcnt lgkmcnt(0)" ::: "memory")
__device__ __forceinline__ int opaque(int v) { asm volatile("" : "+v"(v)); return v; }

struct EpiQKV {
    static constexpr bool PERM = true, AFTER_DRAIN = false;
    bf16* O; const float* cs;
    __device__ __forceinline__ void operator()(const f32x4 (&acc)[2][2][4][2], const Unit& u, int wr, int wc, int fr, int fq) const {
        const int row0 = u.pm * BM + wr * 64 + fr, col0 = u.pn * BM + wc * 32 + 8 * fq;
        float sc = 1.f; if (u.pn < 4) sc = C2; else if (u.pn >= 12 && u.pn < 16) sc = SBSCALE;
        const bool rot = (u.pn < 8) && ((wc & 1) == 0);
        if (rot) {
#pragma unroll
            for (int ai = 0; ai < 2; ++ai) {
                f32x4 cv[4][4];
#pragma unroll
                for (int m = 0; m < 4; ++m) { const f32x4* p = (const f32x4*)(cs + (size_t)(row0 + ai * HALF + m * 16) * 16); cv[m][0] = p[0]; cv[m][1] = p[1]; cv[m][2] = p[2]; cv[m][3] = p[3]; }
#pragma unroll
                for (int m = 0; m < 4; ++m) {
                    const int row = row0 + ai * HALF + m * 16;
                    const f32x4 c0 = cv[m][0], c1 = cv[m][1]; f32x4 s0 = cv[m][2], s1 = cv[m][3]; if (fq == 0) { s0 = -s0; s1 = -s1; }
#pragma unroll
                    for (int bj = 0; bj < 2; ++bj) {
                        f32x4 v0 = acc[ai][bj][m][0] * sc, v1 = acc[ai][bj][m][1] * sc, p0, p1;
#pragma unroll
                        for (int e = 0; e < 4; ++e) { p0[e] = __shfl_xor(v0[e], 16); p1[e] = __shfl_xor(v1[e], 16); }
                        if (fq < 2) { v0 = v0 * c0 + p0 * s0; v1 = v1 * c1 + p1 * s1; }
                        v4u w; w.x = cvt_pk_bf16(v0[0], v0[1]); w.y = cvt_pk_bf16(v0[2], v0[3]); w.z = cvt_pk_bf16(v1[0], v1[1]); w.w = cvt_pk_bf16(v1[2], v1[3]);
                        *(v4u*)(O + (size_t)row * PW + col0 + bj * HALF) = w;
                    }
                }
            }
        } else {
#pragma unroll
            for (int ai = 0; ai < 2; ++ai)
#pragma unroll
                for (int m = 0; m < 4; ++m) {
                    const int row = row0 + ai * HALF + m * 16;
#pragma unroll
                    for (int bj = 0; bj < 2; ++bj) {
                        const f32x4 v0 = acc[ai][bj][m][0] * sc, v1 = acc[ai][bj][m][1] * sc;
                        v4u w; w.x = cvt_pk_bf16(v0[0], v0[1]); w.y = cvt_pk_bf16(v0[2], v0[3]); w.z = cvt_pk_bf16(v1[0], v1[1]); w.w = cvt_pk_bf16(v1[2], v1[3]);
                        *(v4u*)(O + (size_t)row * PW + col0 + bj * HALF) = w;
                    }
                }
        }
    }
};
struct EpiRes {
    static constexpr bool PERM = true, AFTER_DRAIN = false;
    const float* R; float* Y; bf16* Yb; float* ss;
    __device__ __forceinline__ void operator()(const f32x4 (&acc)[2][2][4][2], const Unit& u, int wr, int wc, int fr, int fq) const {
        const int row0 = u.pm * BM + wr * 64 + fr, col0 = u.pn * BM + wc * 32 + 8 * fq;
#pragma unroll
        for (int ai = 0; ai < 2; ++ai) {
            f32x4 rv[4][2][2];
#pragma unroll
            for (int m = 0; m < 4; ++m)
#pragma unroll
                for (int bj = 0; bj < 2; ++bj) { const size_t off = (size_t)(row0 + ai * HALF + m * 16) * DM + col0 + bj * HALF; rv[m][bj][0] = *(const f32x4*)(R + off); rv[m][bj][1] = *(const f32x4*)(R + off + 4); }
            asm volatile("" ::: "memory");
#pragma unroll
            for (int m = 0; m < 4; ++m) {
                const int row = row0 + ai * HALF + m * 16; float s = 0.f;
#pragma unroll
                for (int bj = 0; bj < 2; ++bj) {
                    const size_t off = (size_t)row * DM + col0 + bj * HALF;
                    const f32x4 v0 = acc[ai][bj][m][0] + rv[m][bj][0], v1 = acc[ai][bj][m][1] + rv[m][bj][1];
                    *(f32x4*)(Y + off) = v0; *(f32x4*)(Y + off + 4) = v1;
                    if (Yb) { v4u w; w.x = cvt_pk_bf16(v0[0], v0[1]); w.y = cvt_pk_bf16(v0[2], v0[3]); w.z = cvt_pk_bf16(v1[0], v1[1]); w.w = cvt_pk_bf16(v1[2], v1[3]); *(v4u*)(Yb + off) = w; }
                    s += (v0[0] * v0[0] + v0[1] * v0[1]) + (v0[2] * v0[2] + v0[3] * v0[3]) + (v1[0] * v1[0] + v1[1] * v1[1]) + (v1[2] * v1[2] + v1[3] * v1[3]);
                }
                s += __shfl_xor(s, 16); s += __shfl_xor(s, 32);
                if (fq == 0) atomicAdd(ss + row, s);
            }
        }
    }
};
struct EpiMlpIn {
    static constexpr bool PERM = true, AFTER_DRAIN = false;
    bf16* O; const float* ss;
    __device__ __forceinline__ void operator()(const f32x4 (&acc)[2][2][4][2], const Unit& u, int wr, int wc, int fr, int fq) const {
        const int row0 = u.pm * BM + wr * 64 + fr, col0 = u.pn * BM + wc * 32 + 8 * fq;
        float rs[2][4];
#pragma unroll
        for (int ai = 0; ai < 2; ++ai)
#pragma unroll
            for (int m = 0; m < 4; ++m) rs[ai][m] = __hip_atomic_load(ss + row0 + ai * HALF + m * 16, __ATOMIC_RELAXED, __HIP_MEMORY_SCOPE_AGENT);
        asm volatile("" ::: "memory");
#pragma unroll
        for (int ai = 0; ai < 2; ++ai)
#pragma unroll
            for (int m = 0; m < 4; ++m) {
                const int row = row0 + ai * HALF + m * 16;
                const float rstd = __builtin_amdgcn_rsqf(rs[ai][m] * (1.f / DM) + EPS);
#pragma unroll
                for (int bj = 0; bj < 2; ++bj) {
                    f32x4 v0 = acc[ai][bj][m][0] * rstd, v1 = acc[ai][bj][m][1] * rstd;
#pragma unroll
                    for (int e = 0; e < 4; ++e) { const float a = fmaxf(v0[e], 0.f), b = fmaxf(v1[e], 0.f); v0[e] = a * a; v1[e] = b * b; }
                    v4u w; w.x = cvt_pk_bf16(v0[0], v0[1]); w.y = cvt_pk_bf16(v0[2], v0[3]); w.z = cvt_pk_bf16(v1[0], v1[1]); w.w = cvt_pk_bf16(v1[2], v1[3]);
                    *(v4u*)(O + (size_t)row * FF + col0 + bj * HALF) = w;
                }
            }
    }
};
#define MFMA32(a, b, c) __builtin_amdgcn_mfma_f32_32x32x16_bf16((a), (b), (c), 0, 0, 0)
__device__ __forceinline__ int crow(int r, int hi) { return (r & 3) + 8 * (r >> 2) + 4 * hi; }
typedef short v4i16_t __attribute__((ext_vector_type(4)));
__device__ __forceinline__ s16x4 vtr(LAS const unsigned char* p) { return __builtin_bit_cast(s16x4, __builtin_amdgcn_ds_read_tr16_b64_v4i16((LAS v4i16_t*)p)); }
typedef float f32x2_t __attribute__((ext_vector_type(2)));
typedef __bf16 bf16x2_t __attribute__((ext_vector_type(2)));
__device__ __forceinline__ unsigned cvtpk_s(float lo, float hi) { f32x2_t v = {lo, hi}; bf16x2_t b = __builtin_convertvector(v, bf16x2_t); return __builtin_bit_cast(unsigned, b); }
__device__ __forceinline__ bf16x8 pack8(const f32x16& x, int s) {
    v4u p; p.x = cvtpk_s(x[8 * s], x[8 * s + 1]); p.y = cvtpk_s(x[8 * s + 2], x[8 * s + 3]); p.z = cvtpk_s(x[8 * s + 4], x[8 * s + 5]); p.w = cvtpk_s(x[8 * s + 6], x[8 * s + 7]);
    return __builtin_bit_cast(bf16x8, p);
}

__device__ __forceinline__ void glds16(const void* sbase, unsigned voff, unsigned lds_dst) { unsigned keep;
    asm volatile("s_mov_b32 %0, m0\n\ts_mov_b32 m0, %3\n\ts_nop 0\n\tglobal_load_lds_dwordx4 %1, %2\n\ts_mov_b32 m0, %0" : "=&s"(keep) : "v"(voff), "s"(sbase), "s"(lds_dst) : "memory"); }
template <bool TAIL>
__device__ __forceinline__ void flash_half(f32x16 (&O)[4], f32x16& Sc, f32x16& Sn, float& m_run, float& l_run, bf16x8& mfrag, const bf16x8& onefrag, const bf16x8 (&qf)[4],
                                           LAS const unsigned char* Kn, LAS const unsigned char* Vc, unsigned ka, int kx, unsigned va, int vx, int blk, int hi, int key0, int qrow, int qmin) {
    if (TAIL) {
        const int kb = key0 + 4 * hi;
#pragma unroll
        for (int i = 0; i < 16; ++i) { const int key = kb + (i & 3) + 8 * (i >> 2); if (key > qrow) Sc[i] = -1e30f; }
    }
    float mloc = fmaxf(Sc[0], Sc[1]);
#pragma unroll
    for (int i = 2; i < 16; ++i) mloc = fmaxf(mloc, Sc[i]);
    mloc = max_x32(mloc);
    const bool first = (key0 == 0);
    if (__any(mloc > 8.f) || first) {
        const float m_new = (mloc > 8.f || first) ? __builtin_bit_cast(float, f2bf(m_run + mloc) << 16) : m_run;
        const float delta = m_new - m_run, alpha = __builtin_amdgcn_exp2f(-delta);
        l_run *= alpha;
#pragma unroll
        for (int d = 0; d < 4; ++d)
#pragma unroll
            for (int i = 0; i < 16; ++i) O[d][i] *= alpha;
#pragma unroll
        for (int i = 0; i < 16; ++i) Sc[i] -= delta;
        m_run = m_new;
        mfrag[0] = hi ? (short)0 : (short)(f2bf(-m_new));
    }
#pragma unroll
    for (int i = 0; i < 16; ++i) Sn[i] = 0.f;
    Sn = MFMA32(onefrag, mfrag, Sn);
#pragma unroll
    for (int ks = 0; ks < 4; ++ks) {
        const bf16x8 a0 = *(LAS const bf16x8*)(Kn + ka + (((2 * ks + hi) ^ kx) << 4));
        Sn = MFMA32(a0, qf[ks], Sn);
    }
    float ls = 0.f;
#pragma unroll
    for (int i = 0; i < 16; ++i) { Sc[i] = __builtin_amdgcn_exp2f(Sc[i]); ls += Sc[i]; }
    l_run += ls;
#pragma unroll
    for (int kk = 0; kk < 2; ++kk) {
        if (kk == 1) __builtin_amdgcn_sched_barrier(0);
        const bf16x8 pb = pack8(Sc, kk);
#pragma unroll
        for (int d = 0; d < 4; ++d) {
            LAS const unsigned char* p = Vc + va + kk * 4096 + (((2 * d + blk) ^ vx) << 5);
            const s16x4 lo = vtr(p), hi4 = vtr(p + 2048);
            const bf16x8 a = __builtin_shufflevector(lo, hi4, 0, 1, 2, 3, 4, 5, 6, 7);
            O[d] = MFMA32(a, pb, O[d]);
        }
    }
}

constexpr int DA_V = 49152, KT = 128;
__device__ __forceinline__ void flash_map(f32x16 (&O)[4], LAS unsigned char* lds, const bf16* QKV, int qcol, int kcol, int vcol, int qb, int w, int lane, int tid) {
    const int r32 = lane & 31, hi = lane >> 5;
    const int qmin = qb * 256 + w * 32, qrow = qmin + r32;
    bf16x8 qf[4];
    { const int lq = opaque(lane);
      const bf16* qp = QKV + (size_t)(qmin + (lq & 31)) * PW + qcol + 8 * (lq >> 5);
#pragma unroll
      for (int ks = 0; ks < 4; ++ks) qf[ks] = *(const bf16x8*)(qp + 16 * ks); }
#pragma unroll
    for (int d = 0; d < 4; ++d)
#pragma unroll
        for (int i = 0; i < 16; ++i) O[d][i] = 0.f;
    float m_run = 0.f, l_run = 0.f;
    bf16x8 mfrag = {0, 0, 0, 0, 0, 0, 0, 0}, onefrag = {0, 0, 0, 0, 0, 0, 0, 0}; onefrag[0] = hi ? (short)0 : (short)0x3F80;
    const int nkt = 2 * (qb + 1), nmain = 2 * qb;
    const int krow = tid >> 3, kc = (tid & 7) ^ ((krow >> 1) & 7);
    const unsigned kgo = (unsigned)(krow * PW + kc * 8) * 2u;
    const int vrow = tid >> 4, vpos = tid & 15, vc = ((((vpos >> 1) ^ (2 * (vrow & 3)))) << 1) | (vpos & 1);
    const unsigned vgo = (unsigned)(vrow * PW + vc * 8) * 2u;
    const bf16* kg = QKV + kcol; const bf16* vg = QKV + vcol;
    const unsigned wl = (unsigned)(tid >> 6) * 1024u;
    const size_t tstep = (size_t)KT * PW;
#define DMA16(g, vo, l) glds16((g), (vo), (unsigned)__builtin_amdgcn_readfirstlane((int)(unsigned)(size_t)(l)))
#define DMA_K(t, slot) do { const bf16* g_ = kg + (size_t)(t) * tstep; DMA16(g_, kgo, lds + (slot) + wl); DMA16(g_ + (size_t)64 * PW, kgo, lds + (slot) + 8192 + wl); } while (0)
#define DMA_V(t, b) do { const bf16* g_ = vg + (size_t)(t) * tstep; LAS unsigned char* l_ = lds + DA_V + (b) * 32768 + wl; \
        DMA16(g_, vgo, l_); DMA16(g_ + (size_t)32 * PW, vgo, l_ + 8192); DMA16(g_ + (size_t)64 * PW, vgo, l_ + 16384); DMA16(g_ + (size_t)96 * PW, vgo, l_ + 24576); } while (0)
    const unsigned ka = r32 * 128;
    const int kx = (r32 >> 1) & 7;
    const int q4 = (lane & 15) >> 2, p4 = lane & 3, blk = (lane >> 4) & 1;
    const int vr0 = 4 * hi + q4;
    const unsigned va = DA_V + vr0 * 256 + 8 * p4;
    const int vx = 2 * q4;
    DMA_K(0, 0); DMA_K(1, 16384); DMA_V(0, 0);
    asm volatile("s_waitcnt vmcnt(0) lgkmcnt(0)\n\ts_barrier" ::: "memory");
    f32x16 S0, S1;
#pragma unroll
    for (int i = 0; i < 16; ++i) S0[i] = 0.f;
#pragma unroll
    for (int ks = 0; ks < 4; ++ks) S0 = MFMA32(*(LAS const bf16x8*)(lds + ka + (((2 * ks + hi) ^ kx) << 4)), qf[ks], S0);
    int kb0 = 0, kb1 = 16384, kb2 = 32768;
    for (int kt = 0; kt < nkt; ++kt) {
        const int buf = kt & 1;
        if (kt + 2 < nkt) DMA_K(kt + 2, kb2);
        if (kt + 1 < nkt) DMA_V(kt + 1, buf ^ 1);
        LAS const unsigned char* Kc = lds + kb0; LAS const unsigned char* Vb = lds + buf * 32768;
        if (kt < nmain) {
            flash_half<false>(O, S0, S1, m_run, l_run, mfrag, onefrag, qf, Kc + 4096, Vb, ka, kx, va, vx, blk, hi, kt * KT, qrow, qmin);
            flash_half<false>(O, S1, S0, m_run, l_run, mfrag, onefrag, qf, Kc + 8192, Vb + 8192, ka, kx, va, vx, blk, hi, kt * KT + 32, qrow, qmin);
            flash_half<false>(O, S0, S1, m_run, l_run, mfrag, onefrag, qf, Kc + 12288, Vb + 16384, ka, kx, va, vx, blk, hi, kt * KT + 64, qrow, qmin);
            flash_half<false>(O, S1, S0, m_run, l_run, mfrag, onefrag, qf, lds + kb1, Vb + 24576, ka, kx, va, vx, blk, hi, kt * KT + 96, qrow, qmin);
        } else {
            flash_half<true>(O, S0, S1, m_run, l_run, mfrag, onefrag, qf, Kc + 4096, Vb, ka, kx, va, vx, blk, hi, kt * KT, qrow, qmin);
            flash_half<true>(O, S1, S0, m_run, l_run, mfrag, onefrag, qf, Kc + 8192, Vb + 8192, ka, kx, va, vx, blk, hi, kt * KT + 32, qrow, qmin);
            flash_half<true>(O, S0, S1, m_run, l_run, mfrag, onefrag, qf, Kc + 12288, Vb + 16384, ka, kx, va, vx, blk, hi, kt * KT + 64, qrow, qmin);
            flash_half<true>(O, S1, S0, m_run, l_run, mfrag, onefrag, qf, lds + kb1, Vb + 24576, ka, kx, va, vx, blk, hi, kt * KT + 96, qrow, qmin);
        }
        asm volatile("s_waitcnt vmcnt(0) lgkmcnt(0)\n\ts_barrier" ::: "memory");
        const int t0 = kb0; kb0 = kb1; kb1 = kb2; kb2 = t0;
    }
#undef DMA16
#undef DMA_K
#undef DMA_V
    const float l = sum_x32(l_run), inv = 1.f / l;
#pragma unroll
    for (int d = 0; d < 4; ++d)
#pragma unroll
        for (int i = 0; i < 16; ++i) O[d][i] *= inv;
}

__device__ __forceinline__ void headnorm_store(const f32x16 (&O)[4], const float* g, float post, bf16* MIX, int qrow, int col0, int hi) {
    float ss = 0.f;
#pragma unroll
    for (int d = 0; d < 4; ++d)
#pragma unroll
        for (int i = 0; i < 16; ++i) ss += O[d][i] * O[d][i];
    ss = sum_x32(ss);
    const float rs = __builtin_amdgcn_rsqf(ss * (1.f / 128.f) + EPS) * post;
    f32x4 gvv[4][4];
#pragma unroll
    for (int d = 0; d < 4; ++d)
#pragma unroll
        for (int gq = 0; gq < 4; ++gq) gvv[d][gq] = *(const f32x4*)(g + 32 * d + 8 * gq + 4 * hi);
    asm volatile("" ::: "memory");
#pragma unroll
    for (int d = 0; d < 4; ++d)
#pragma unroll
        for (int gq = 0; gq < 4; ++gq) {
            const int dv = 32 * d + 8 * gq + 4 * hi;
            const f32x4 gv = gvv[d][gq];
            v2u w; w.x = cvtpk_s(O[d][4 * gq] * rs * gv[0], O[d][4 * gq + 1] * rs * gv[1]); w.y = cvtpk_s(O[d][4 * gq + 2] * rs * gv[2], O[d][4 * gq + 3] * rs * gv[3]);
            *(v2u*)(MIX + (size_t)qrow * DM + col0 + dv) = w;
        }
}

__device__ __forceinline__ void diff_unit(LAS unsigned char* lds, const bf16* QKV, bf16* MIX, float* o1s, const float* gd, float lam, int head, int qb, int w, int lane, int tid) {
    f32x16 O[4];
#pragma unroll 1
    for (int j = 0; j < 2; ++j) {
        flash_map(O, lds, QKV, COL_DQ + head * 128 + 64 * j, COL_DK + head * 128 + 64 * j, COL_DV + head * 128, qb, w, lane, tid);
        if (j == 0) {
            f32x4* sc = (f32x4*)(o1s + ((size_t)(blockIdx.x * NWAVES + w) * 64 + opaque(lane)) * 64);
#pragma unroll
            for (int d = 0; d < 4; ++d)
#pragma unroll
                for (int i = 0; i < 4; ++i) sc[d * 4 + i] = (f32x4){O[d][4 * i], O[d][4 * i + 1], O[d][4 * i + 2], O[d][4 * i + 3]};
        }
    }
    lane = opaque(lane);
    const f32x4* sc = (const f32x4*)(o1s + ((size_t)(blockIdx.x * NWAVES + w) * 64 + lane) * 64);
#pragma unroll
    for (int d = 0; d < 4; ++d)
#pragma unroll
        for (int i = 0; i < 4; ++i) { const f32x4 t = sc[d * 4 + i];
#pragma unroll
            for (int e = 0; e < 4; ++e) O[d][4 * i + e] = t[e] - lam * O[d][4 * i + e]; }
    headnorm_store(O, gd, 1.f - LAM_INIT, MIX, qb * 256 + w * 32 + (lane & 31), head * 128, lane >> 5);
}

constexpr float SB_STOP = -44.f * 1.4426950408889634f;
__device__ __forceinline__ void sb_unit(LAS unsigned char* vl, const bf16* QKV, bf16* MIX, const float* gs, int head, int qg, int lane) {
    const int r32 = lane & 31, hi = lane >> 5;
    const int qrow = qg * 32 + r32;
    bf16x8 qf[8];
#pragma unroll
    for (int ks = 0; ks < 8; ++ks) qf[ks] = *(const bf16x8*)(QKV + (size_t)qrow * PW + COL_SQ + head * 128 + 16 * ks + 8 * hi);
    f32x16 O[4];
#pragma unroll
    for (int d = 0; d < 4; ++d)
#pragma unroll
        for (int i = 0; i < 16; ++i) O[d][i] = 0.f;
    float R = 0.f;
    const int q4 = (lane & 15) >> 2, p4 = lane & 3, blk = (lane >> 4) & 1;
    const int vr0 = 4 * hi + q4, vx = vr0 & 7;
    const unsigned va = vr0 * 256 + 8 * p4;
    const bf16* kgp = QKV + (size_t)r32 * PW + COL_SK + head * 128 + 8 * hi;
    const bf16* vgp = QKV + (size_t)(lane >> 4) * PW + COL_SV + head * 128 + (lane & 15) * 8;
    bf16x8 kf[8]; v4u vreg[8];
#pragma unroll
    for (int ks = 0; ks < 8; ++ks) kf[ks] = *(const bf16x8*)(kgp + (size_t)(qg * 32) * PW + 16 * ks);
#pragma unroll
    for (int i = 0; i < 8; ++i) vreg[i] = *(const v4u*)(vgp + (size_t)(qg * 32 + 4 * i) * PW);
    for (int kt = qg; kt >= 0; --kt) {
        const int k0 = kt * 32;
        f32x16 S;
#pragma unroll
        for (int i = 0; i < 16; ++i) S[i] = 0.f;
#pragma unroll
        for (int ks = 0; ks < 8; ++ks) S = MFMA32(kf[ks], qf[ks], S);
        LDS_WAIT();
#pragma unroll
        for (int i = 0; i < 8; ++i) { const int row = 4 * i + (lane >> 4), c = lane & 15; *(LAS v4u*)(vl + row * 256 + (((c >> 1) ^ (row & 7)) << 5) + ((c & 1) << 4)) = vreg[i]; }
        if (kt > 0) {
#pragma unroll
            for (int ks = 0; ks < 8; ++ks) kf[ks] = *(const bf16x8*)(kgp + (size_t)(k0 - 32) * PW + 16 * ks);
#pragma unroll
            for (int i = 0; i < 8; ++i) vreg[i] = *(const v4u*)(vgp + (size_t)(k0 - 32 + 4 * i) * PW);
        }
        float lb[16], lom[16];
#pragma unroll
        for (int i = 0; i < 16; ++i) {
            const int key = k0 + crow(i, hi); const float z = S[i];
            const float sp = __builtin_amdgcn_logf(1.f + __builtin_amdgcn_exp2f(-fabsf(z)));
            lb[i] = fminf(z, 0.f) - sp;
            lom[i] = (key < qrow) ? lb[i] - z : 0.f;
        }
        float gsum[4], pgs[4], after[4];
#pragma unroll
        for (int g = 0; g < 4; ++g) { gsum[g] = (lom[4 * g] + lom[4 * g + 1]) + (lom[4 * g + 2] + lom[4 * g + 3]); pgs[g] = partner_x32(gsum[g], hi); }
        float run = 0.f;
#pragma unroll
        for (int g = 3; g >= 0; --g) { after[g] = run + (hi == 0 ? pgs[g] : 0.f); run += gsum[g] + pgs[g]; }
#pragma unroll
        for (int g = 0; g < 4; ++g) {
            float suf = R + after[g];
#pragma unroll
            for (int e = 3; e >= 0; --e) {
                const int i = 4 * g + e; const int key = k0 + crow(i, hi);
                S[i] = (key < qrow) ? __builtin_amdgcn_exp2f(lb[i] + suf) : 0.f;
                suf += lom[i];
            }
        }
        R += run;
        LDS_WAIT();
#pragma unroll
        for (int kk = 0; kk < 2; ++kk) {
            const bf16x8 pb = pack8(S, kk);
#pragma unroll
            for (int d = 0; d < 4; ++d) {
                LAS const unsigned char* p = vl + va + kk * 4096 + (((2 * d + blk) ^ vx) << 5);
                const s16x4 lo = vtr(p), hi4 = vtr(p + 2048);
                const bf16x8 a = __builtin_shufflevector(lo, hi4, 0, 1, 2, 3, 4, 5, 6, 7);
                O[d] = MFMA32(a, pb, O[d]);
            }
        }
        if (__all(R < SB_STOP)) break;
    }
    LDS_WAIT();
    headnorm_store(O, gs, 1.f, MIX, qrow, 1024 + head * 128, hi);
}
__device__ __forceinline__ void transpose_item(const float* W, int K, int N, bf16* WT, const float* g, LAS float* scr, int item, int lane) {
    const int nblk = N / 32, kb = item / nblk, nb = item % nblk, k0 = 64 * kb, n0 = 32 * nb;
    const int r8 = lane >> 3, c4 = (lane & 7) * 4;
    f32x4 v[8];
#pragma unroll
    for (int i = 0; i < 8; ++i) v[i] = *(const f32x4*)(W + (size_t)(k0 + r8 + 8 * i) * N + n0 + c4);
#pragma unroll
    for (int i = 0; i < 8; ++i) { const int kk = r8 + 8 * i; const float gs = g ? g[k0 + kk] : 1.f;
#pragma unroll
        for (int e = 0; e < 4; ++e) scr[kk * 33 + c4 + e] = v[i][e] * gs; }
    LDS_WAIT();
    const int c = lane & 7;
#pragma unroll
    for (int j = 0; j < 4; ++j) { const int n = (lane >> 3) + 8 * j; const LAS float* sp = scr + (8 * c) * 33 + n;
        v4u o; o.x = pk2(sp[0 * 33], sp[1 * 33]); o.y = pk2(sp[2 * 33], sp[3 * 33]); o.z = pk2(sp[4 * 33], sp[5 * 33]); o.w = pk2(sp[6 * 33], sp[7 * 33]);
        *(v4u*)(WT + (size_t)(n0 + n) * K + k0 + 8 * c) = o; }
    LDS_WAIT();
}

__device__ __forceinline__ void grid_bar(unsigned* ctr, unsigned nblk, int wave_id) {
    asm volatile("s_waitcnt vmcnt(0) lgkmcnt(0)" ::: "memory");
    __syncthreads();
    if (wave_id == 0 && __builtin_amdgcn_mbcnt_hi(~0u, __builtin_amdgcn_mbcnt_lo(~0u, 0u)) == 0) {
        __builtin_amdgcn_fence(__ATOMIC_RELEASE, "agent");
        asm volatile("s_waitcnt vmcnt(0)" ::: "memory");
        __hip_atomic_fetch_add(ctr, 1u, __ATOMIC_RELAXED, __HIP_MEMORY_SCOPE_AGENT);
        while (__hip_atomic_load(ctr, __ATOMIC_RELAXED, __HIP_MEMORY_SCOPE_AGENT) < nblk) __builtin_amdgcn_s_sleep(2);
        __builtin_amdgcn_fence(__ATOMIC_ACQUIRE, "agent");
        asm volatile("s_waitcnt vmcnt(0)" ::: "memory");
    }
    __syncthreads();
}

struct Args { const float* in[14]; float* out; unsigned char* ws; float inv_freq[8]; int ph_lo, ph_hi; };

__global__ void __launch_bounds__(NTHR, 2) hybrid_fwd(Args args) {
    extern __shared__ __attribute__((aligned(16))) unsigned char lds_raw[];
    LAS unsigned char* lds = (LAS unsigned char*)lds_raw;
    cg::grid_group grid = cg::this_grid();
    const int wave = __builtin_amdgcn_readfirstlane((int)threadIdx.x >> 6);
    const int G = gridDim.x, bx = blockIdx.x;
    const int gw = bx * NWAVES + wave, NGW = G * NWAVES;
#define FRESH_IDS const int lane = opaque((int)__builtin_amdgcn_mbcnt_hi(~0u, __builtin_amdgcn_mbcnt_lo(~0u, 0u))), tid = wave * 64 + lane
    unsigned char* ws = args.ws;
    const float* x = args.in[0]; const float* ln1 = args.in[1]; const float* w_in = args.in[2];
    const float* lq1 = args.in[3]; const float* lk1 = args.in[4]; const float* lq2 = args.in[5]; const float* lk2 = args.in[6];
    const float* g_diff = args.in[7]; const float* g_sb = args.in[8]; const float* w_out = args.in[9]; const float* ln2 = args.in[10];
    const float* w1 = args.in[11]; const float* w2 = args.in[12]; const float* ln_f = args.in[13];
    float* out = args.out;
    bf16* Win_t = (bf16*)(ws + WS_WIN); bf16* Wout_t = (bf16*)(ws + WS_WOUT); bf16* W1_t = (bf16*)(ws + WS_W1); bf16* W2_t = (bf16*)(ws + WS_W2);
    float* cs = (float*)(ws + WS_CS); float* ss1 = (float*)(ws + WS_SS1); float* ss2 = (float*)(ws + WS_SS2);
    bf16* Hb = (bf16*)(ws + WS_H); bf16* QKV = (bf16*)(ws + WS_QKV); bf16* MIX = (bf16*)(ws + WS_MIX); bf16* U = (bf16*)(ws + WS_U);
    const int lo = args.ph_lo, hi_ph = args.ph_hi;
#define IN(k) (lo <= (k) && (k) < hi_ph)
#ifndef SKIPMASK
#define SKIPMASK 0
#endif
#define SKIP(k) ((SKIPMASK >> (k)) & 1)
    unsigned* ctl = (unsigned*)(ws + WS_CTL);
#define SEAM(k) do { if (IN(k) && IN((k) + 1)) { if ((k) < 2) grid.sync(); else grid_bar(ctl + 64 * (k), (unsigned)G, wave); } } while (0)

#ifndef REP0
#define REP0 1
#endif
    for (int rep0 = 0; rep0 < REP0; ++rep0)
    if (IN(0) && !SKIP(0)) {
        FRESH_IDS;
        LAS float* scr = (LAS float*)(lds + wave * 16384);
        constexpr int I_IN = (DM / 64) * (PW / 32), I_OUT = (DM / 64) * (DM / 32), I_1 = (DM / 64) * (FF / 32), I_2 = (FF / 64) * (DM / 32);
        constexpr int NITEMS = I_IN + I_OUT + I_1 + I_2;
        for (int it = gw; it < NITEMS; it += NGW) {
            int r = it;
            if (r < I_IN) { transpose_item(w_in, DM, PW, Win_t, nullptr, scr, r, lane); continue; } r -= I_IN;
            if (r < I_OUT) { transpose_item(w_out, DM, DM, Wout_t, nullptr, scr, r, lane); continue; } r -= I_OUT;
            if (r < I_1) { transpose_item(w1, DM, FF, W1_t, ln2, scr, r, lane); continue; } r -= I_1;
            transpose_item(w2, FF, DM, W2_t, nullptr, scr, r, lane);
        }
        for (int m = gw; m < M; m += NGW) {
            const f32x4* xr = (const f32x4*)(x + (size_t)m * DM) + lane; const f32x4* gr = (const f32x4*)ln1 + lane;
            f32x4 v[8], gv[8]; float s = 0.f;
#pragma unroll
            for (int j = 0; j < 8; ++j) { v[j] = xr[64 * j]; gv[j] = gr[64 * j]; }
#pragma unroll
            for (int j = 0; j < 8; ++j) s += (v[j][0] * v[j][0] + v[j][1] * v[j][1]) + (v[j][2] * v[j][2] + v[j][3] * v[j][3]);
            const float rstd = 1.f / sqrtf(wave_sum(s) * (1.f / DM) + EPS);
            v2u* o8 = (v2u*)(Hb + (size_t)m * DM) + lane;
#pragma unroll
            for (int j = 0; j < 8; ++j) { const f32x4 gq = gv[j]; v2u w; w.x = pk2(v[j][0] * rstd * gq[0], v[j][1] * rstd * gq[1]); w.y = pk2(v[j][2] * rstd * gq[2], v[j][3] * rstd * gq[3]); o8[64 * j] = w; }
        }
        for (int e = bx * NTHR + tid; e < SEQ * 8; e += G * NTHR) {
            const int pos = e >> 3, i = e & 7;
            const float ang = (float)pos * args.inv_freq[i];
            const double rev = (double)ang * 0.15915494309189533577; const float fr = (float)(rev - rint(rev));
            cs[pos * 16 + i] = __builtin_amdgcn_cosf(fr); cs[pos * 16 + 8 + i] = __builtin_amdgcn_sinf(fr);
        }
        for (int e = bx * NTHR + tid; e < SEQ; e += G * NTHR) { ss1[e] = 0.f; ss2[e] = 0.f; }
    }
    SEAM(0);
#ifndef REP1
#define REP1 1
#endif
    for (int rep1 = 0; rep1 < REP1; ++rep1)
    if (IN(1) && !SKIP(1)) {
        pg8::Gemm g{Hb, Win_t, M, PW, DM}; pg8::StaticOrder S; S.init(M, PW, G, bx);
        EpiQKV E{QKV, cs};
        pg8::gemm_phase<EpiQKV, pg8::StaticOrder, true, true>(lds, g, S, E, wave);
    }
    SEAM(1);
#ifndef REP2
#define REP2 1
#endif
    for (int rep2 = 0; rep2 < REP2; ++rep2)
    if (IN(2) && !SKIP(2)) {
        FRESH_IDS;
        const float a = lq1[lane] * lk1[lane], b = lq2[lane] * lk2[lane];
        const float lam = __builtin_bit_cast(float, __builtin_amdgcn_readfirstlane(__builtin_bit_cast(int, __expf(wave_sum(a)) - __expf(wave_sum(b)) + LAM_INIT)));
        float* o1s = (float*)(ws + WS_H);
#ifndef NO_DIFF
        for (int u = bx; u < 256; u += G) {
            const int head = u & 7, p = u >> 3;
#pragma unroll 1
            for (int t = 0; t < 2; ++t) diff_unit(lds, QKV, MIX, o1s, g_diff, lam, head, t ? 63 - p : p, wave, lane, tid);
        }
#endif
        __syncthreads();
#ifndef NO_SB
        const int lane_sb = opaque(lane);
#ifndef REPSB
#define REPSB 1
#endif
        for (int repsb = 0; repsb < REPSB; ++repsb)
        for (int wu = gw; wu < 8 * 512; wu += NGW) sb_unit(lds + wave * 8192, QKV, MIX, g_sb, wu & 7, 511 - (wu >> 3), lane_sb);
#endif
        __syncthreads();
    }
    SEAM(2);
    if (IN(3) && !SKIP(3)) {
        pg8::Gemm g{MIX, Wout_t, M, DM, DM}; pg8::StaticOrder S; S.init(M, DM, G, bx);
        EpiRes E{x, out, Hb, ss1};
        pg8::gemm_phase<EpiRes, pg8::StaticOrder, true, true>(lds, g, S, E, wave);
    }
    SEAM(3);
    if (IN(4) && !SKIP(4)) {
        pg8::Gemm g{Hb, W1_t, M, FF, DM}; pg8::StaticOrder S; S.init(M, FF, G, bx);
        EpiMlpIn E{U, ss1};
        pg8::gemm_phase<EpiMlpIn, pg8::StaticOrder, true, true>(lds, g, S, E, wave);
    }
    SEAM(4);
    if (IN(5) && !SKIP(5)) {
        pg8::Gemm g{U, W2_t, M, DM, FF}; pg8::StaticOrder S; S.init(M, DM, G, bx);
        EpiRes E{out, out, nullptr, ss2};
        pg8::gemm_phase<EpiRes, pg8::StaticOrder, true, true>(lds, g, S, E, wave);
    }
    SEAM(5);
    if (IN(6) && !SKIP(6)) {
        FRESH_IDS;
        for (int m = gw; m < M; m += NGW) {
            f32x4* xr = (f32x4*)(out + (size_t)m * DM) + lane; const f32x4* gr = (const f32x4*)ln_f + lane;
            f32x4 v[8], gv[8];
#pragma unroll
            for (int j = 0; j < 8; ++j) { v[j] = xr[64 * j]; gv[j] = gr[64 * j]; }
            const float rstd = 1.f / sqrtf(__hip_atomic_load(ss2 + m, __ATOMIC_RELAXED, __HIP_MEMORY_SCOPE_AGENT) * (1.f / DM) + EPS);
            asm volatile("" ::: "memory");
#pragma unroll
            for (int j = 0; j < 8; ++j) xr[64 * j] = v[j] * rstd * gv[j];
        }
    }
#undef IN
#undef SEAM
}

#ifndef N_LAUNCHES
#define N_LAUNCHES 1
#endif
extern "C" void kernel_launch(void* const* d_in, const int* in_sizes, int n_in, void* d_out, int out_size, void* d_ws, size_t ws_size, hipStream_t stream) {
    static int grid = 0;
    if (grid == 0) {
        if (n_in != 14 || in_sizes[0] != M * DM || out_size != M * DM || ws_size < WS_END) { fprintf(stderr, "kernel_launch: unexpected shapes (n_in %d, in0 %d, out %d, ws %zu)\n", n_in, n_in > 0 ? in_sizes[0] : -1, out_size, ws_size); grid = -1; return; }
        int dev = 0, cus = 0, per_cu = 0;
        (void)hipGetDevice(&dev); (void)hipDeviceGetAttribute(&cus, hipDeviceAttributeMultiprocessorCount, dev);
        if (hipFuncSetAttribute((const void*)hybrid_fwd, hipFuncAttributeMaxDynamicSharedMemorySize, LDS_BYTES) != hipSuccess) { fprintf(stderr, "kernel_launch: hipFuncSetAttribute failed\n"); grid = -1; return; }
        if (hipOccupancyMaxActiveBlocksPerMultiprocessor(&per_cu, (const void*)hybrid_fwd, NTHR, LDS_BYTES) != hipSuccess || per_cu < 1) { fprintf(stderr, "kernel_launch: occupancy query gave %d\n", per_cu); per_cu = 1; }
        (void)hipGetLastError();
        grid = cus * per_cu;
    }
    if (grid < 0) return;
    if (hipMemsetAsync((char*)d_ws + WS_CTL, 0, 4096, stream) != hipSuccess) { fprintf(stderr, "kernel_launch: memset failed\n"); return; }
    Args a{};
    for (int i = 0; i < 14; ++i) a.in[i] = (const float*)d_in[i];
    a.out = (float*)d_out; a.ws = (unsigned char*)d_ws;
    for (int i = 0; i < 8; ++i) a.inv_freq[i] = (float)pow(500000.0, -(double)i / 8.0);
    const int cuts1[2] = {0, 7};
    const int cuts7[8] = {0, 1, 2, 3, 4, 5, 6, 7};
    const int* cuts = (N_LAUNCHES == 1) ? cuts1 : cuts7;
    for (int li = 0; li < N_LAUNCHES; ++li) {
        a.ph_lo = cuts[li]; a.ph_hi = cuts[li + 1];
        void* kargs[] = {&a};
        hipError_t e = hipLaunchCooperativeKernel((const void*)hybrid_fwd, dim3(grid), dim3(NTHR), kargs, LDS_BYTES, stream);
        if (e != hipSuccess) { fprintf(stderr, "kernel_launch: cooperative launch %d failed: %s (grid %d)\n", li, hipGetErrorString(e), grid); break; }
    }
}
```

```cpp
#include <hip/hip_runtime.h>
#include <hip/hip_cooperative_groups.h>
#include <cstdio>
#include <cstdint>
#include <cmath>
namespace cg = cooperative_groups;
namespace pg8 {
#define PG8_LAS __attribute__((address_space(3)))
typedef unsigned short bf16_t;
typedef short bf16x8 __attribute__((ext_vector_type(8)));
typedef float f32x4 __attribute__((ext_vector_type(4)));
typedef unsigned u32x4 __attribute__((ext_vector_type(4)));
constexpr int BM = 256, BK = 64, HALF = 128, HTB = HALF * BK * 2  , STAGE_BYTES = 8 * HTB, NXCD = 8, WGM = 8;

__host__ __device__ __forceinline__ int lds_byte(int r, int c) { const int st = (r >> 4) * 2 + (c >> 5), rr = r & 15, cc = c & 31, ob = rr * 64 + cc * 2; return st * 1024 + (ob ^ (((ob >> 9) & 1) << 5)); }
__host__ __device__ __forceinline__ void stage_rc(int b, int& R, int& C) { const int st = b / 1024, sb = b % 1024, swz = sb ^ (((sb >> 9) & 1) << 5); R = (st >> 1) * 16 + swz / 64; C = (st & 1) * 32 + (swz % 64) / 2; }
__host__ __device__ __forceinline__ int perm32(int rho) { const int n = rho >> 4, i = rho & 15; return 8 * (i >> 2) + 4 * n + (i & 3); }

struct Unit { int pm, pn; };
struct Gemm { const bf16_t* A; const bf16_t* Bt; int M, N, K; };

struct StaticOrder {
    int nM, nN, nwg, G, c;
    __host__ __device__ void init(int M, int N, int G_, int c_) { nM = M / BM; nN = N / BM; nwg = nM * nN; G = G_; c = c_; }
    __host__ __device__ bool next(int i, Unit& u) const {
        const long L = (long)i * G + c; if (L >= nwg) return false;
        int wgid = (int)L; { const int q = nwg / NXCD, r = nwg % NXCD, xcd = wgid % NXCD, off = wgid / NXCD; wgid = (xcd < r ? xcd * (q + 1) : r * (q + 1) + (xcd - r) * q) + off; }
        const int nig = WGM * nN, gid = wgid / nig, fm = gid * WGM, gsz = (nM - fm) < WGM ? (nM - fm) : WGM;
        u.pm = fm + ((wgid % nig) % gsz); u.pn = (wgid % nig) / gsz; return true;
    }
    __device__ __forceinline__ void a_ready(const Unit&) const {}
    __device__ __forceinline__ void done(const Unit&) const {}
};

__device__ __forceinline__ unsigned cvt_pk_bf16(float lo, float hi) { unsigned r; asm volatile("v_cvt_pk_bf16_f32 %0, %1, %2" : "=v"(r) : "v"(lo), "v"(hi)); return r; }
template <class Epi, class Sched, bool ALIGN_EPI = false, bool SP2 = false>
__device__ __forceinline__ void gemm_phase(PG8_LAS unsigned char* lds, const Gemm g, const Sched& S, const Epi& E, int wave_id) {
    int tid_ = wave_id * 64 + (int)__builtin_amdgcn_mbcnt_hi(~0u, __builtin_amdgcn_mbcnt_lo(~0u, 0u)); asm volatile("" : "+v"(tid_));
    const int tid = tid_, wid = __builtin_amdgcn_readfirstlane(tid >> 6), lane = tid & 63, wr = wid >> 2, wc = wid & 3, fr = lane & 15, fq = lane >> 4;
    const int K = g.K, nt = K / BK;
    unsigned voffA[2], voffB[2];
#pragma unroll
    for (int i = 0; i < 2; ++i) { int R, C; stage_rc(tid * 16 + i * 8192, R, C); const int Rb = Epi::PERM ? ((R & ~31) + perm32(R & 31)) : R;
        voffA[i] = (unsigned)(R * K + C) * 2u; voffB[i] = (unsigned)(Rb * K + C) * 2u; }
    const size_t kstep = (size_t)(BK * 2);
    const size_t hstep = (size_t)HALF * K * 2;
    const size_t tstep = 2 * hstep;
    const unsigned ldsw = (unsigned)wid * 1024u;
    const int aoff = lds_byte(wr * 64 + fr, fq * 8), boff = lds_byte(wc * 32 + fr, fq * 8);
#define PG8_SA(b, h) (((b) * 2 + (h)) * HTB)
#define PG8_SB(b, h) ((4 + (b) * 2 + (h)) * HTB)
#define PG8_STAGE(bufoff, gbase, voff) do { _Pragma("unroll") for (int _i = 0; _i < 2; ++_i) \
        __builtin_amdgcn_global_load_lds((const unsigned*)((const char*)(gbase) + (voff)[_i]), (PG8_LAS unsigned*)(lds + (bufoff) + ldsw + _i * 8192), 16, 0, 0); } while (0)
#define PG8_LDA(dst, b, h) do { _Pragma("unroll") for (int m = 0; m < 4; ++m) _Pragma("unroll") for (int k = 0; k < 2; ++k) dst[m][k] = *(const PG8_LAS bf16x8*)(lds + PG8_SA(b, h) + aoff + m * 2048 + k * 1024); } while (0)
#define PG8_LDB(dst, b, h) do { _Pragma("unroll") for (int n = 0; n < 2; ++n) _Pragma("unroll") for (int k = 0; k < 2; ++k) dst[n][k] = *(const PG8_LAS bf16x8*)(lds + PG8_SB(b, h) + boff + n * 2048 + k * 1024); } while (0)
#define PG8_MMA(ai, bj, At, Bt) do { __builtin_amdgcn_s_setprio(1); _Pragma("unroll") for (int m = 0; m < 4; ++m) _Pragma("unroll") for (int n = 0; n < 2; ++n) _Pragma("unroll") for (int k = 0; k < 2; ++k) \
        acc[ai][bj][m][n] = __builtin_amdgcn_mfma_f32_16x16x32_bf16(Bt[n][k], At[m][k], acc[ai][bj][m][n], 0, 0, 0); __builtin_amdgcn_s_setprio(0); } while (0)
#define PG8_WAIT_V(n) asm volatile("s_waitcnt vmcnt(" #n ")" ::: "memory")
#define PG8_WAIT_L(n) asm volatile("s_waitcnt lgkmcnt(" #n ")" ::: "memory")
#define PG8_BAR __builtin_amdgcn_s_barrier()
#define PG8_SCHED __builtin_amdgcn_sched_barrier(0)
    Unit cur, nxt; int ui = 0;
    if (!S.next(0, cur)) return;
    f32x4 acc[2][2][4][2];
#pragma unroll
    for (int a = 0; a < 2; ++a)
#pragma unroll
        for (int b = 0; b < 2; ++b)
#pragma unroll
            for (int m = 0; m < 4; ++m)
#pragma unroll
                for (int n = 0; n < 2; ++n) acc[a][b][m][n] = (f32x4){0.f, 0.f, 0.f, 0.f};
    bf16x8 At[4][2], B0[2][2], B1[2][2];
    const char* cA = (const char*)g.A + (size_t)cur.pm * tstep; const char* cB = (const char*)g.Bt + (size_t)cur.pn * tstep;
    S.a_ready(cur);
    if constexpr (SP2) {
        PG8_STAGE(PG8_SB(0, 0), cB, voffB); PG8_STAGE(PG8_SB(0, 1), cB + hstep, voffB); PG8_STAGE(PG8_SA(0, 0), cA, voffA); PG8_STAGE(PG8_SA(0, 1), cA + hstep, voffA);
        if (wr == 1) PG8_BAR;
        PG8_WAIT_V(2); PG8_BAR;
        PG8_STAGE(PG8_SB(1, 0), cB + kstep, voffB); PG8_STAGE(PG8_SA(1, 0), cA + kstep, voffA); PG8_STAGE(PG8_SB(1, 1), cB + hstep + kstep, voffB);
        PG8_WAIT_V(6); PG8_BAR;
    } else {
        PG8_STAGE(PG8_SB(0, 0), cB, voffB); PG8_STAGE(PG8_SA(0, 0), cA, voffA); PG8_STAGE(PG8_SB(0, 1), cB + hstep, voffB); PG8_STAGE(PG8_SA(0, 1), cA + hstep, voffA);
        if (wr == 1) PG8_BAR;
        PG8_WAIT_V(4); PG8_BAR;
        PG8_STAGE(PG8_SB(1, 0), cB + kstep, voffB); PG8_STAGE(PG8_SA(1, 0), cA + kstep, voffA); PG8_STAGE(PG8_SB(1, 1), cB + hstep + kstep, voffB);
        PG8_WAIT_V(6); PG8_BAR;
    }
    for (;;) {
        const bool has_next = S.next(ui + 1, nxt);
        const char* nA = has_next ? (const char*)g.A + (size_t)nxt.pm * tstep : cA; const char* nB = has_next ? (const char*)g.Bt + (size_t)nxt.pn * tstep : cB;
        for (int t = 0; t < nt; t += 2) {
            const bool last = (t == nt - 2);
            const char* a1 = cA + (size_t)(t + 1) * kstep;
            const char* a2 = last ? nA : cA + (size_t)(t + 2) * kstep; const char* b2 = last ? nB : cB + (size_t)(t + 2) * kstep;
            const char* a3 = a2 + kstep; const char* b3 = b2 + kstep;
            if (last && has_next) S.a_ready(nxt);
            if constexpr (SP2) {
            PG8_LDB(B0, 0, 0); PG8_LDB(B1, 0, 1); PG8_SCHED; PG8_LDA(At, 0, 0); PG8_STAGE(PG8_SA(1, 1), a1 + hstep, voffA);
            PG8_WAIT_V(8); PG8_WAIT_L(0); PG8_BAR; PG8_MMA(0, 0, At, B0); PG8_MMA(0, 1, At, B1); PG8_BAR; PG8_SCHED;
            PG8_LDA(At, 0, 1); PG8_STAGE(PG8_SB(0, 0), b2, voffB); PG8_STAGE(PG8_SB(0, 1), b2 + hstep, voffB); PG8_STAGE(PG8_SA(0, 0), a2, voffA);
            PG8_WAIT_V(8); PG8_WAIT_L(0); PG8_BAR; PG8_MMA(1, 0, At, B0); PG8_MMA(1, 1, At, B1); PG8_BAR; PG8_SCHED;
            PG8_LDB(B0, 1, 0); PG8_LDB(B1, 1, 1); PG8_SCHED; PG8_LDA(At, 1, 0); PG8_STAGE(PG8_SA(0, 1), a2 + hstep, voffA);
            PG8_WAIT_V(8); PG8_WAIT_L(0); PG8_BAR; PG8_MMA(0, 0, At, B0); PG8_MMA(0, 1, At, B1); PG8_BAR; PG8_SCHED;
            PG8_LDA(At, 1, 1); PG8_STAGE(PG8_SB(1, 0), b3, voffB); PG8_STAGE(PG8_SB(1, 1), b3 + hstep, voffB); PG8_STAGE(PG8_SA(1, 0), a3, voffA);
            PG8_WAIT_V(8); PG8_WAIT_L(0); PG8_BAR; PG8_MMA(1, 0, At, B0); PG8_MMA(1, 1, At, B1); PG8_BAR; PG8_SCHED;
            } else {
            PG8_LDB(B0, 0, 0); PG8_SCHED; PG8_LDA(At, 0, 0); PG8_STAGE(PG8_SA(1, 1), a1 + hstep, voffA);
            PG8_WAIT_L(8); PG8_BAR; PG8_WAIT_L(0); PG8_MMA(0, 0, At, B0); PG8_BAR; PG8_SCHED;
            PG8_LDB(B1, 0, 1); PG8_STAGE(PG8_SB(0, 0), b2, voffB);
            PG8_BAR; PG8_WAIT_L(0); PG8_MMA(0, 1, At, B1); PG8_BAR;
            PG8_LDA(At, 0, 1); PG8_STAGE(PG8_SA(0, 0), a2, voffA);
            PG8_BAR; PG8_WAIT_L(0); PG8_MMA(1, 0, At, B0); PG8_BAR; PG8_SCHED;
            PG8_STAGE(PG8_SB(0, 1), b2 + hstep, voffB);
            PG8_WAIT_V(6); PG8_BAR; PG8_MMA(1, 1, At, B1); PG8_BAR;
            PG8_LDB(B0, 1, 0); PG8_SCHED; PG8_LDA(At, 1, 0); PG8_STAGE(PG8_SA(0, 1), a2 + hstep, voffA);
            PG8_WAIT_L(8); PG8_BAR; PG8_WAIT_L(0); PG8_MMA(0, 0, At, B0); PG8_BAR; PG8_SCHED;
            PG8_LDB(B1, 1, 1); PG8_STAGE(PG8_SB(1, 0), b3, voffB);
            PG8_BAR; PG8_WAIT_L(0); PG8_MMA(0, 1, At, B1); PG8_BAR;
            PG8_LDA(At, 1, 1); PG8_STAGE(PG8_SA(1, 0), a3, voffA);
            PG8_BAR; PG8_WAIT_L(0); PG8_MMA(1, 0, At, B0); PG8_BAR; PG8_SCHED;
            PG8_STAGE(PG8_SB(1, 1), b3 + hstep, voffB);
            PG8_WAIT_V(6); PG8_BAR; PG8_MMA(1, 1, At, B1); PG8_BAR;
            }
        }
        if constexpr (ALIGN_EPI) { if (wr == 0) PG8_BAR; }
        if constexpr (!Epi::AFTER_DRAIN) { E(acc, cur, wr, wc, fr, fq); S.done(cur); }
        if (!has_next) break;
#pragma unroll
        for (int a = 0; a < 2; ++a)
#pragma unroll
            for (int b = 0; b < 2; ++b)
#pragma unroll
                for (int m = 0; m < 4; ++m)
#pragma unroll
                    for (int n = 0; n < 2; ++n) acc[a][b][m][n] = (f32x4){0.f, 0.f, 0.f, 0.f};
        cur = nxt; cA = nA; cB = nB; ++ui;
        if constexpr (ALIGN_EPI) { if (wr == 1) PG8_BAR; }
    }
    PG8_WAIT_V(0);
    if constexpr (!ALIGN_EPI) { if (wr == 0) PG8_BAR; }
    PG8_BAR;
    if constexpr (Epi::AFTER_DRAIN) { E.fused(acc, cur, wr, wc, fr, fq, lds, wid, lane); S.done(cur); }
#undef PG8_SA
#undef PG8_SB
#undef PG8_STAGE
#undef PG8_LDA
#undef PG8_LDB
#undef PG8_MMA
#undef PG8_WAIT_V
#undef PG8_WAIT_L
#undef PG8_BAR
#undef PG8_SCHED
}
}
#define GAS __attribute__((address_space(1)))
#define LAS __attribute__((address_space(3)))
typedef unsigned short bf16;
typedef unsigned v4u __attribute__((ext_vector_type(4)));
typedef unsigned v2u __attribute__((ext_vector_type(2)));
typedef float f32x4 __attribute__((ext_vector_type(4)));
typedef float f32x16 __attribute__((ext_vector_type(16)));
typedef short bf16x8 __attribute__((ext_vector_type(8)));
typedef short s16x4 __attribute__((ext_vector_type(4)));
using pg8::Unit; using pg8::cvt_pk_bf16; using pg8::BM; using pg8::HALF;

constexpr int SEQ = 16384, DM = 2048, PW = 6144, FF = 8192, M = SEQ;
constexpr int NWAVES = 8, NTHR = 512;
constexpr float EPS = 1e-6f;
constexpr float C2 = 0.125f * 1.4426950408889634f;
constexpr float SBSCALE = 0.08838834764831845f * 1.4426950408889634f;
constexpr float LAM_INIT = 0.2f;
constexpr int COL_DQ = 0, COL_DK = 1024, COL_DV = 2048, COL_SQ = 3072, COL_SK = 4096, COL_SV = 5120;

constexpr size_t MiB = 1u << 20;
constexpr size_t WS_WIN = 0;
constexpr size_t WS_WOUT = 24 * MiB;
constexpr size_t WS_W1 = 32 * MiB;
constexpr size_t WS_W2 = 64 * MiB;
constexpr size_t WS_CS = 96 * MiB;
constexpr size_t WS_SS1 = 97 * MiB;
constexpr size_t WS_SS2 = 97 * MiB + 65536;
constexpr size_t WS_H = 98 * MiB;
constexpr size_t WS_QKV = 162 * MiB;
constexpr size_t WS_MIX = 354 * MiB;
constexpr size_t WS_U = 162 * MiB;
constexpr size_t WS_CTL = 418 * MiB;
constexpr size_t WS_END = 419 * MiB;

constexpr int RING_BYTES = 131072, LDS_BYTES = 131072 + 1024;

__device__ __forceinline__ unsigned f2bf(float f) { unsigned u = __builtin_bit_cast(unsigned, f); return (u + 0x7fffu + ((u >> 16) & 1u)) >> 16; }
__device__ __forceinline__ unsigned pk2(float lo, float hi) { return f2bf(lo) | (f2bf(hi) << 16); }
__device__ __forceinline__ float wave_sum(float v) {
#pragma unroll
    for (int o = 1; o < 64; o <<= 1) v += __shfl_xor(v, o);
    return v;
}
typedef unsigned u32x2_t __attribute__((ext_vector_type(2)));
__device__ __forceinline__ void swap_x32(float& a, float& b) { asm volatile("s_nop 1\n\tv_permlane32_swap_b32 %0, %1" : "+v"(a), "+v"(b)); }
__device__ __forceinline__ float max_x32(float x) { float a = x, b = x; swap_x32(a, b); return fmaxf(a, b); }
__device__ __forceinline__ float sum_x32(float x) { float a = x, b = x; swap_x32(a, b); return a + b; }
__device__ __forceinline__ float partner_x32(float x, int hi) { float a = x, b = x; swap_x32(a, b); return hi ? a : b; }
#define LDS_WAIT() asm volatile("s_waitcnt lgkmcnt(0)" ::: "memory")
__device__ __forceinline__ int opaque(int v) { asm volatile("" : "+v"(v)); return v; }

struct EpiQKV {
    static constexpr bool PERM = true, AFTER_DRAIN = false;
    bf16* O; const float* cs;
    __device__ __forceinline__ void operator()(const f32x4 (&acc)[2][2][4][2], const Unit& u, int wr, int wc, int fr, int fq) const {
        const int row0 = u.pm * BM + wr * 64 + fr, col0 = u.pn * BM + wc * 32 + 8 * fq;
        float sc = 1.f; if (u.pn < 4) sc = C2; else if (u.pn >= 12 && u.pn < 16) sc = SBSCALE;
        const bool rot = (u.pn < 8) && ((wc & 1) == 0);
        if (rot) {
#pragma unroll
            for (int ai = 0; ai < 2; ++ai) {
                f32x4 cv[4][4];
#pragma unroll
                for (int m = 0; m < 4; ++m) { const f32x4* p = (const f32x4*)(cs + (size_t)(row0 + ai * HALF + m * 16) * 16); cv[m][0] = p[0]; cv[m][1] = p[1]; cv[m][2] = p[2]; cv[m][3] = p[3]; }
#pragma unroll
                for (int m = 0; m < 4; ++m) {
                    const int row = row0 + ai * HALF + m * 16;
                    const f32x4 c0 = cv[m][0], c1 = cv[m][1]; f32x4 s0 = cv[m][2], s1 = cv[m][3]; if (fq == 0) { s0 = -s0; s1 = -s1; }
#pragma unroll
                    for (int bj = 0; bj < 2; ++bj) {
                        f32x4 v0 = acc[ai][bj][m][0] * sc, v1 = acc[ai][bj][m][1] * sc, p0, p1;
#pragma unroll
                        for (int e = 0; e < 4; ++e) { p0[e] = __shfl_xor(v0[e], 16); p1[e] = __shfl_xor(v1[e], 16); }
                        if (fq < 2) { v0 = v0 * c0 + p0 * s0; v1 = v1 * c1 + p1 * s1; }
                        v4u w; w.x = cvt_pk_bf16(v0[0], v0[1]); w.y = cvt_pk_bf16(v0[2], v0[3]); w.z = cvt_pk_bf16(v1[0], v1[1]); w.w = cvt_pk_bf16(v1[2], v1[3]);
                        *(v4u*)(O + (size_t)row * PW + col0 + bj * HALF) = w;
                    }
                }
            }
        } else {
#pragma unroll
            for (int ai = 0; ai < 2; ++ai)
#pragma unroll
                for (int m = 0; m < 4; ++m) {
                    const int row = row0 + ai * HALF + m * 16;
#pragma unroll
                    for (int bj = 0; bj < 2; ++bj) {
                        const f32x4 v0 = acc[ai][bj][m][0] * sc, v1 = acc[ai][bj][m][1] * sc;
                        v4u w; w.x = cvt_pk_bf16(v0[0], v0[1]); w.y = cvt_pk_bf16(v0[2], v0[3]); w.z = cvt_pk_bf16(v1[0], v1[1]); w.w = cvt_pk_bf16(v1[2], v1[3]);
                        *(v4u*)(O + (size_t)row * PW + col0 + bj * HALF) = w;
                    }
                }
        }
    }
};
struct EpiRes {
    static constexpr bool PERM = true, AFTER_DRAIN = false;
    const float* R; float* Y; bf16* Yb; float* ss;
    __device__ __forceinline__ void operator()(const f32x4 (&acc)[2][2][4][2], const Unit& u, int wr, int wc, int fr, int fq) const {
        const int row0 = u.pm * BM + wr * 64 + fr, col0 = u.pn * BM + wc * 32 + 8 * fq;
#pragma unroll
        for (int ai = 0; ai < 2; ++ai) {
            f32x4 rv[4][2][2];
#pragma unroll
            for (int m = 0; m < 4; ++m)
#pragma unroll
                for (int bj = 0; bj < 2; ++bj) { const size_t off = (size_t)(row0 + ai * HALF + m * 16) * DM + col0 + bj * HALF; rv[m][bj][0] = *(const f32x4*)(R + off); rv[m][bj][1] = *(const f32x4*)(R + off + 4); }
            asm volatile("" ::: "memory");
#pragma unroll
            for (int m = 0; m < 4; ++m) {
                const int row = row0 + ai * HALF + m * 16; float s = 0.f;
#pragma unroll
                for (int bj = 0; bj < 2; ++bj) {
                    const size_t off = (size_t)row * DM + col0 + bj * HALF;
                    const f32x4 v0 = acc[ai][bj][m][0] + rv[m][bj][0], v1 = acc[ai][bj][m][1] + rv[m][bj][1];
                    *(f32x4*)(Y + off) = v0; *(f32x4*)(Y + off + 4) = v1;
                    if (Yb) { v4u w; w.x = cvt_pk_bf16(v0[0], v0[1]); w.y = cvt_pk_bf16(v0[2], v0[3]); w.z = cvt_pk_bf16(v1[0], v1[1]); w.w = cvt_pk_bf16(v1[2], v1[3]); *(v4u*)(Yb + off) = w; }
                    s += (v0[0] * v0[0] + v0[1] * v0[1]) + (v0[2] * v0[2] + v0[3] * v0[3]) + (v1[0] * v1[0] + v1[1] * v1[1]) + (v1[2] * v1[2] + v1[3] * v1[3]);
                }
                s += __shfl_xor(s, 16); s += __shfl_xor(s, 32);
                if (fq == 0) atomicAdd(ss + row, s);
            }
        }
    }
};
struct EpiMlpIn {
    static constexpr bool PERM = true, AFTER_DRAIN = false;
    bf16* O; const float* ss;
    __device__ __forceinline__ void operator()(const f32x4 (&acc)[2][2][4][2], const Unit& u, int wr, int wc, int fr, int fq) const {
        const int row0 = u.pm * BM + wr * 64 + fr, col0 = u.pn * BM + wc * 32 + 8 * fq;
        float rs[2][4];
#pragma unroll
        for (int ai = 0; ai < 2; ++ai)
#pragma unroll
            for (int m = 0; m < 4; ++m) rs[ai][m] = __hip_atomic_load(ss + row0 + ai * HALF + m * 16, __ATOMIC_RELAXED, __HIP_MEMORY_SCOPE_AGENT);
        asm volatile("" ::: "memory");
#pragma unroll
        for (int ai = 0; ai < 2; ++ai)
#pragma unroll
            for (int m = 0; m < 4; ++m) {
                const int row = row0 + ai * HALF + m * 16;
                const float rstd = __builtin_amdgcn_rsqf(rs[ai][m] * (1.f / DM) + EPS);
#pragma unroll
                for (int bj = 0; bj < 2; ++bj) {
                    f32x4 v0 = acc[ai][bj][m][0] * rstd, v1 = acc[ai][bj][m][1] * rstd;
#pragma unroll
                    for (int e = 0; e < 4; ++e) { const float a = fmaxf(v0[e], 0.f), b = fmaxf(v1[e], 0.f); v0[e] = a * a; v1[e] = b * b; }
                    v4u w; w.x = cvt_pk_bf16(v0[0], v0[1]); w.y = cvt_pk_bf16(v0[2], v0[3]); w.z = cvt_pk_bf16(v1[0], v1[1]); w.w = cvt_pk_bf16(v1[2], v1[3]);
                    *(v4u*)(O + (size_t)row * FF + col0 + bj * HALF) = w;
                }
            }
    }
};
#define MFMA32(a, b, c) __builtin_amdgcn_mfma_f32_32x32x16_bf16((a), (b), (c), 0, 0, 0)
__device__ __forceinline__ int crow(int r, int hi) { return (r & 3) + 8 * (r >> 2) + 4 * hi; }
typedef short v4i16_t __attribute__((ext_vector_type(4)));
__device__ __forceinline__ s16x4 vtr(LAS const unsigned char* p) { return __builtin_bit_cast(s16x4, __builtin_amdgcn_ds_read_tr16_b64_v4i16((LAS v4i16_t*)p)); }
typedef float f32x2_t __attribute__((ext_vector_type(2)));
typedef __bf16 bf16x2_t __attribute__((ext_vector_type(2)));
__device__ __forceinline__ unsigned cvtpk_s(float lo, float hi) { f32x2_t v = {lo, hi}; bf16x2_t b = __builtin_convertvector(v, bf16x2_t); return __builtin_bit_cast(unsigned, b); }
__device__ __forceinline__ bf16x8 pack8(const f32x16& x, int s) {
    v4u p; p.x = cvtpk_s(x[8 * s], x[8 * s + 1]); p.y = cvtpk_s(x[8 * s + 2], x[8 * s + 3]); p.z = cvtpk_s(x[8 * s + 4], x[8 * s + 5]); p.w = cvtpk_s(x[8 * s + 6], x[8 * s + 7]);
    return __builtin_bit_cast(bf16x8, p);
}

__device__ __forceinline__ void glds16(const void* sbase, unsigned voff, unsigned lds_dst) { unsigned keep;
    asm volatile("s_mov_b32 %0, m0\n\ts_mov_b32 m0, %3\n\ts_nop 0\n\tglobal_load_lds_dwordx4 %1, %2\n\ts_mov_b32 m0, %0" : "=&s"(keep) : "v"(voff), "s"(sbase), "s"(lds_dst) : "memory"); }
template <bool TAIL>
__device__ __forceinline__ void flash_half(f32x16 (&O)[4], f32x16& Sc, f32x16& Sn, float& m_run, float& l_run, bf16x8& mfrag, const bf16x8& onefrag, const bf16x8 (&qf)[4],
                                           LAS const unsigned char* Kn, LAS const unsigned char* Vc, unsigned ka, int kx, unsigned va, int vx, int blk, int hi, int key0, int qrow, int qmin) {
    if (TAIL) {
        const int kb = key0 + 4 * hi;
#pragma unroll
        for (int i = 0; i < 16; ++i) { const int key = kb + (i & 3) + 8 * (i >> 2); if (key > qrow) Sc[i] = -1e30f; }
    }
    float mloc = fmaxf(Sc[0], Sc[1]);
#pragma unroll
    for (int i = 2; i < 16; ++i) mloc = fmaxf(mloc, Sc[i]);
    mloc = max_x32(mloc);
    const bool first = (key0 == 0);
    if (__any(mloc > 8.f) || first) {
        const float m_new = (mloc > 8.f || first) ? __builtin_bit_cast(float, f2bf(m_run + mloc) << 16) : m_run;
        const float delta = m_new - m_run, alpha = __builtin_amdgcn_exp2f(-delta);
        l_run *= alpha;
#pragma unroll
        for (int d = 0; d < 4; ++d)
#pragma unroll
            for (int i = 0; i < 16; ++i) O[d][i] *= alpha;
#pragma unroll
        for (int i = 0; i < 16; ++i) Sc[i] -= delta;
        m_run = m_new;
        mfrag[0] = hi ? (short)0 : (short)(f2bf(-m_new));
    }
#pragma unroll
    for (int i = 0; i < 16; ++i) Sn[i] = 0.f;
    Sn = MFMA32(onefrag, mfrag, Sn);
#pragma unroll
    for (int ks = 0; ks < 4; ++ks) {
        const bf16x8 a0 = *(LAS const bf16x8*)(Kn + ka + (((2 * ks + hi) ^ kx) << 4));
        Sn = MFMA32(a0, qf[ks], Sn);
    }
    float ls = 0.f;
#pragma unroll
    for (int i = 0; i < 16; ++i) { Sc[i] = __builtin_amdgcn_exp2f(Sc[i]); ls += Sc[i]; }
    l_run += ls;
#pragma unroll
    for (int kk = 0; kk < 2; ++kk) {
        if (kk == 1) __builtin_amdgcn_sched_barrier(0);
        const bf16x8 pb = pack8(Sc, kk);
#pragma unroll
        for (int d = 0; d < 4; ++d) {
            LAS const unsigned char* p = Vc + va + kk * 4096 + (((2 * d + blk) ^ vx) << 5);
            const s16x4 lo = vtr(p), hi4 = vtr(p + 2048);
            const bf16x8 a = __builtin_shufflevector(lo, hi4, 0, 1, 2, 3, 4, 5, 6, 7);
            O[d] = MFMA32(a, pb, O[d]);
        }
    }
}

constexpr int DA_V = 49152, KT = 128;
__device__ __forceinline__ void flash_map(f32x16 (&O)[4], LAS unsigned char* lds, const bf16* QKV, int qcol, int kcol, int vcol, int qb, int w, int lane, int tid) {
    const int r32 = lane & 31, hi = lane >> 5;
    const int qmin = qb * 256 + w * 32, qrow = qmin + r32;
    bf16x8 qf[4];
    { const int lq = opaque(lane);
      const bf16* qp = QKV + (size_t)(qmin + (lq & 31)) * PW + qcol + 8 * (lq >> 5);
#pragma unroll
      for (int ks = 0; ks < 4; ++ks) qf[ks] = *(const bf16x8*)(qp + 16 * ks); }
#pragma unroll
    for (int d = 0; d < 4; ++d)
#pragma unroll
        for (int i = 0; i < 16; ++i) O[d][i] = 0.f;
    float m_run = 0.f, l_run = 0.f;
    bf16x8 mfrag = {0, 0, 0, 0, 0, 0, 0, 0}, onefrag = {0, 0, 0, 0, 0, 0, 0, 0}; onefrag[0] = hi ? (short)0 : (short)0x3F80;
    const int nkt = 2 * (qb + 1), nmain = 2 * qb;
    const int krow = tid >> 3, kc = (tid & 7) ^ ((krow >> 1) & 7);
    const unsigned kgo = (unsigned)(krow * PW + kc * 8) * 2u;
    const int vrow = tid >> 4, vpos = tid & 15, vc = ((((vpos >> 1) ^ (2 * (vrow & 3)))) << 1) | (vpos & 1);
    const unsigned vgo = (unsigned)(vrow * PW + vc * 8) * 2u;
    const bf16* kg = QKV + kcol; const bf16* vg = QKV + vcol;
    const unsigned wl = (unsigned)(tid >> 6) * 1024u;
    const size_t tstep = (size_t)KT * PW;
#define DMA16(g, vo, l) glds16((g), (vo), (unsigned)__builtin_amdgcn_readfirstlane((int)(unsigned)(size_t)(l)))
#define DMA_K(t, slot) do { const bf16* g_ = kg + (size_t)(t) * tstep; DMA16(g_, kgo, lds + (slot) + wl); DMA16(g_ + (size_t)64 * PW, kgo, lds + (slot) + 8192 + wl); } while (0)
#define DMA_V(t, b) do { const bf16* g_ = vg + (size_t)(t) * tstep; LAS unsigned char* l_ = lds + DA_V + (b) * 32768 + wl; \
        DMA16(g_, vgo, l_); DMA16(g_ + (size_t)32 * PW, vgo, l_ + 8192); DMA16(g_ + (size_t)64 * PW, vgo, l_ + 16384); DMA16(g_ + (size_t)96 * PW, vgo, l_ + 24576); } while (0)
    const unsigned ka = r32 * 128;
    const int kx = (r32 >> 1) & 7;
    const int q4 = (lane & 15) >> 2, p4 = lane & 3, blk = (lane >> 4) & 1;
    const int vr0 = 4 * hi + q4;
    const unsigned va = DA_V + vr0 * 256 + 8 * p4;
    const int vx = 2 * q4;
    DMA_K(0, 0); DMA_K(1, 16384); DMA_V(0, 0);
    asm volatile("s_waitcnt vmcnt(0) lgkmcnt(0)\n\ts_barrier" ::: "memory");
    f32x16 S0, S1;
#pragma unroll
    for (int i = 0; i < 16; ++i) S0[i] = 0.f;
#pragma unroll
    for (int ks = 0; ks < 4; ++ks) S0 = MFMA32(*(LAS const bf16x8*)(lds + ka + (((2 * ks + hi) ^ kx) << 4)), qf[ks], S0);
    int kb0 = 0, kb1 = 16384, kb2 = 32768;
    for (int kt = 0; kt < nkt; ++kt) {
        const int buf = kt & 1;
        if (kt + 2 < nkt) DMA_K(kt + 2, kb2);
        if (kt + 1 < nkt) DMA_V(kt + 1, buf ^ 1);
        LAS const unsigned char* Kc = lds + kb0; LAS const unsigned char* Vb = lds + buf * 32768;
        if (kt < nmain) {
            flash_half<false>(O, S0, S1, m_run, l_run, mfrag, onefrag, qf, Kc + 4096, Vb, ka, kx, va, vx, blk, hi, kt * KT, qrow, qmin);
            flash_half<false>(O, S1, S0, m_run, l_run, mfrag, onefrag, qf, Kc + 8192, Vb + 8192, ka, kx, va, vx, blk, hi, kt * KT + 32, qrow, qmin);
            flash_half<false>(O, S0, S1, m_run, l_run, mfrag, onefrag, qf, Kc + 12288, Vb + 16384, ka, kx, va, vx, blk, hi, kt * KT + 64, qrow, qmin);
            flash_half<false>(O, S1, S0, m_run, l_run, mfrag, onefrag, qf, lds + kb1, Vb + 24576, ka, kx, va, vx, blk, hi, kt * KT + 96, qrow, qmin);
        } else {
            flash_half<true>(O, S0, S1, m_run, l_run, mfrag, onefrag, qf, Kc + 4096, Vb, ka, kx, va, vx, blk, hi, kt * KT, qrow, qmin);
            flash_half<true>(O, S1, S0, m_run, l_run, mfrag, onefrag, qf, Kc + 8192, Vb + 8192, ka, kx, va, vx, blk, hi, kt * KT + 32, qrow, qmin);
            flash_half<true>(O, S0, S1, m_run, l_run, mfrag, onefrag, qf, Kc + 12288, Vb + 16384, ka, kx, va, vx, blk, hi, kt * KT + 64, qrow, qmin);
            flash_half<true>(O, S1, S0, m_run, l_run, mfrag, onefrag, qf, lds + kb1, Vb + 24576, ka, kx, va, vx, blk, hi, kt * KT + 96, qrow, qmin);
        }
        asm volatile("s_waitcnt vmcnt(0) lgkmcnt(0)\n\ts_barrier" ::: "memory");
        const int t0 = kb0; kb0 = kb1; kb1 = kb2; kb2 = t0;
    }
#undef DMA16
#undef DMA_K
#undef DMA_V
    const float l = sum_x32(l_run), inv = 1.f / l;
#pragma unroll
    for (int d = 0; d < 4; ++d)
#pragma unroll
        for (int i = 0; i < 16; ++i) O[d][i] *= inv;
}

__device__ __forceinline__ void headnorm_store(const f32x16 (&O)[4], const float* g, float post, bf16* MIX, int qrow, int col0, int hi) {
    float ss = 0.f;
#pragma unroll
    for (int d = 0; d < 4; ++d)
#pragma unroll
        for (int i = 0; i < 16; ++i) ss += O[d][i] * O[d][i];
    ss = sum_x32(ss);
    const float rs = __builtin_amdgcn_rsqf(ss * (1.f / 128.f) + EPS) * post;
    f32x4 gvv[4][4];
#pragma unroll
    for (int d = 0; d < 4; ++d)
#pragma unroll
        for (int gq = 0; gq < 4; ++gq) gvv[d][gq] = *(const f32x4*)(g + 32 * d + 8 * gq + 4 * hi);
    asm volatile("" ::: "memory");
#pragma unroll
    for (int d = 0; d < 4; ++d)
#pragma unroll
        for (int gq = 0; gq < 4; ++gq) {
            const int dv = 32 * d + 8 * gq + 4 * hi;
            const f32x4 gv = gvv[d][gq];
            v2u w; w.x = cvtpk_s(O[d][4 * gq] * rs * gv[0], O[d][4 * gq + 1] * rs * gv[1]); w.y = cvtpk_s(O[d][4 * gq + 2] * rs * gv[2], O[d][4 * gq + 3] * rs * gv[3]);
            *(v2u*)(MIX + (size_t)qrow * DM + col0 + dv) = w;
        }
}

__device__ __forceinline__ void diff_unit(LAS unsigned char* lds, const bf16* QKV, bf16* MIX, float* o1s, const float* gd, float lam, int head, int qb, int w, int lane, int tid) {
    f32x16 O[4];
#pragma unroll 1
    for (int j = 0; j < 2; ++j) {
        flash_map(O, lds, QKV, COL_DQ + head * 128 + 64 * j, COL_DK + head * 128 + 64 * j, COL_DV + head * 128, qb, w, lane, tid);
        if (j == 0) {
            f32x4* sc = (f32x4*)(o1s + ((size_t)(blockIdx.x * NWAVES + w) * 64 + opaque(lane)) * 64);
#pragma unroll
            for (int d = 0; d < 4; ++d)
#pragma unroll
                for (int i = 0; i < 4; ++i) sc[d * 4 + i] = (f32x4){O[d][4 * i], O[d][4 * i + 1], O[d][4 * i + 2], O[d][4 * i + 3]};
        }
    }
    lane = opaque(lane);
    const f32x4* sc = (const f32x4*)(o1s + ((size_t)(blockIdx.x * NWAVES + w) * 64 + lane) * 64);
#pragma unroll
    for (int d = 0; d < 4; ++d)
#pragma unroll
        for (int i = 0; i < 4; ++i) { const f32x4 t = sc[d * 4 + i];
#pragma unroll
            for (int e = 0; e < 4; ++e) O[d][4 * i + e] = t[e] - lam * O[d][4 * i + e]; }
    headnorm_store(O, gd, 1.f - LAM_INIT, MIX, qb * 256 + w * 32 + (lane & 31), head * 128, lane >> 5);
}

constexpr float SB_STOP = -44.f * 1.4426950408889634f;
__device__ __forceinline__ void sb_unit(LAS unsigned char* vl, const bf16* QKV, bf16* MIX, const float* gs, int head, int qg, int lane) {
    const int r32 = lane & 31, hi = lane >> 5;
    const int qrow = qg * 32 + r32;
    bf16x8 qf[8];
#pragma unroll
    for (int ks = 0; ks < 8; ++ks) qf[ks] = *(const bf16x8*)(QKV + (size_t)qrow * PW + COL_SQ + head * 128 + 16 * ks + 8 * hi);
    f32x16 O[4];
#pragma unroll
    for (int d = 0; d < 4; ++d)
#pragma unroll
        for (int i = 0; i < 16; ++i) O[d][i] = 0.f;
    float R = 0.f;
    const int q4 = (lane & 15) >> 2, p4 = lane & 3, blk = (lane >> 4) & 1;
    const int vr0 = 4 * hi + q4, vx = vr0 & 7;
    const unsigned va = vr0 * 256 + 8 * p4;
    const bf16* kgp = QKV + (size_t)r32 * PW + COL_SK + head * 128 + 8 * hi;
    const bf16* vgp = QKV + (size_t)(lane >> 4) * PW + COL_SV + head * 128 + (lane & 15) * 8;
    bf16x8 kf[8]; v4u vreg[8];
#pragma unroll
    for (int ks = 0; ks < 8; ++ks) kf[ks] = *(const bf16x8*)(kgp + (size_t)(qg * 32) * PW + 16 * ks);
#pragma unroll
    for (int i = 0; i < 8; ++i) vreg[i] = *(const v4u*)(vgp + (size_t)(qg * 32 + 4 * i) * PW);
    for (int kt = qg; kt >= 0; --kt) {
        const int k0 = kt * 32;
        f32x16 S;
#pragma unroll
        for (int i = 0; i < 16; ++i) S[i] = 0.f;
#pragma unroll
        for (int ks = 0; ks < 8; ++ks) S = MFMA32(kf[ks], qf[ks], S);
        LDS_WAIT();
#pragma unroll
        for (int i = 0; i < 8; ++i) { const int row = 4 * i + (lane >> 4), c = lane & 15; *(LAS v4u*)(vl + row * 256 + (((c >> 1) ^ (row & 7)) << 5) + ((c & 1) << 4)) = vreg[i]; }
        if (kt > 0) {
#pragma unroll
            for (int ks = 0; ks < 8; ++ks) kf[ks] = *(const bf16x8*)(kgp + (size_t)(k0 - 32) * PW + 16 * ks);
#pragma unroll
            for (int i = 0; i < 8; ++i) vreg[i] = *(const v4u*)(vgp + (size_t)(k0 - 32 + 4 * i) * PW);
        }
        float lb[16], lom[16];
#pragma unroll
        for (int i = 0; i < 16; ++i) {
            const int key = k0 + crow(i, hi); const float z = S[i];
            const float sp = __builtin_amdgcn_logf(1.f + __builtin_amdgcn_exp2f(-fabsf(z)));
            lb[i] = fminf(z, 0.f) - sp;
            lom[i] = (key < qrow) ? lb[i] - z : 0.f;
        }
        float gsum[4], pgs[4], after[4];
#pragma unroll
        for (int g = 0; g < 4; ++g) { gsum[g] = (lom[4 * g] + lom[4 * g + 1]) + (lom[4 * g + 2] + lom[4 * g + 3]); pgs[g] = partner_x32(gsum[g], hi); }
        float run = 0.f;
#pragma unroll
        for (int g = 3; g >= 0; --g) { after[g] = run + (hi == 0 ? pgs[g] : 0.f); run += gsum[g] + pgs[g]; }
#pragma unroll
        for (int g = 0; g < 4; ++g) {
            float suf = R + after[g];
#pragma unroll
            for (int e = 3; e >= 0; --e) {
                const int i = 4 * g + e; const int key = k0 + crow(i, hi);
                S[i] = (key < qrow) ? __builtin_amdgcn_exp2f(lb[i] + suf) : 0.f;
                suf += lom[i];
            }
        }
        R += run;
        LDS_WAIT();
#pragma unroll
        for (int kk = 0; kk < 2; ++kk) {
            const bf16x8 pb = pack8(S, kk);
#pragma unroll
            for (int d = 0; d < 4; ++d) {
                LAS const unsigned char* p = vl + va + kk * 4096 + (((2 * d + blk) ^ vx) << 5);
                const s16x4 lo = vtr(p), hi4 = vtr(p + 2048);
                const bf16x8 a = __builtin_shufflevector(lo, hi4, 0, 1, 2, 3, 4, 5, 6, 7);
                O[d] = MFMA32(a, pb, O[d]);
            }
        }
        if (__all(R < SB_STOP)) break;
    }
    LDS_WAIT();
    headnorm_store(O, gs, 1.f, MIX, qrow, 1024 + head * 128, hi);
}
__device__ __forceinline__ void transpose_item(const float* W, int K, int N, bf16* WT, const float* g, LAS float* scr, int item, int lane) {
    const int nblk = N / 32, kb = item / nblk, nb = item % nblk, k0 = 64 * kb, n0 = 32 * nb;
    const int r8 = lane >> 3, c4 = (lane & 7) * 4;
    f32x4 v[8];
#pragma unroll
    for (int i = 0; i < 8; ++i) v[i] = *(const f32x4*)(W + (size_t)(k0 + r8 + 8 * i) * N + n0 + c4);
#pragma unroll
    for (int i = 0; i < 8; ++i) { const int kk = r8 + 8 * i; const float gs = g ? g[k0 + kk] : 1.f;
#pragma unroll
        for (int e = 0; e < 4; ++e) scr[kk * 33 + c4 + e] = v[i][e] * gs; }
    LDS_WAIT();
    const int c = lane & 7;
#pragma unroll
    for (int j = 0; j < 4; ++j) { const int n = (lane >> 3) + 8 * j; const LAS float* sp = scr + (8 * c) * 33 + n;
        v4u o; o.x = pk2(sp[0 * 33], sp[1 * 33]); o.y = pk2(sp[2 * 33], sp[3 * 33]); o.z = pk2(sp[4 * 33], sp[5 * 33]); o.w = pk2(sp[6 * 33], sp[7 * 33]);
        *(v4u*)(WT + (size_t)(n0 + n) * K + k0 + 8 * c) = o; }
    LDS_WAIT();
}

#define XB_TMO      128
#define XB_XCNT(j)  (256  + 64 * (j))
#define XB_XSUB(j)  (1280 + 64 * (j))
#define XB_XGEN(j)  (2304 + 64 * (j))
#define XB_TOP      3328
#define XB_TOPGEN   3392
#define XCD_BAR_WORDS 3456
#define XB_SPIN_CAP (1u << 18)
__device__ __forceinline__ unsigned xb_ld(unsigned* p)              { return __hip_atomic_load(p, __ATOMIC_RELAXED, __HIP_MEMORY_SCOPE_AGENT); }
__device__ __forceinline__ unsigned xb_add(unsigned* p, unsigned v) { return __hip_atomic_fetch_add(p, v, __ATOMIC_RELAXED, __HIP_MEMORY_SCOPE_AGENT); }
__device__ __forceinline__ unsigned xb_xcc_id() { return (unsigned)__builtin_amdgcn_s_getreg((3 << 11) | 20) & 0xFu; }
#define XB_SPIN(cond, bar) do { unsigned _sp = 0; while (cond) { __builtin_amdgcn_s_sleep(1); \
    if ((++_sp & 255u) == 0u) { if (xb_ld(&(bar)[XB_TMO])) break; if (_sp > XB_SPIN_CAP) { atomicAdd(&(bar)[XB_TMO], 1u); break; } } } } while (0)

struct XcdBarrier {
    unsigned* bar; unsigned x;
    volatile LAS unsigned* st;
};

__device__ __forceinline__ XcdBarrier xcd_barrier_post(unsigned* bar, volatile LAS unsigned* st, bool t0) {
    XcdBarrier b; b.bar = bar; b.x = xb_xcc_id(); b.st = st;
    if (t0) (void)xb_add(&bar[XB_XCNT(b.x)], 1u);
    return b;
}
__device__ __forceinline__ void xcd_barrier_complete(unsigned* bar, unsigned x, unsigned& nloc, unsigned& nx) {
    const unsigned G = gridDim.x * gridDim.y * gridDim.z;
    unsigned sum, cnt, mine, sp = 0u;
    for (;;) {
        sum = 0u; cnt = 0u; mine = 0u;
#pragma unroll
        for (unsigned j = 0; j < 16; ++j) { const unsigned c = xb_ld(&bar[XB_XCNT(j)]); sum += c; cnt += (c > 0u) ? 1u : 0u; mine = (j == x) ? c : mine; }
        if (sum == G) break;
        __builtin_amdgcn_s_sleep(1);
        if ((++sp & 255u) == 0u) { if (xb_ld(&bar[XB_TMO])) break; if (sp > XB_SPIN_CAP) { atomicAdd(&bar[XB_TMO], 1u); break; } }
    }
    nloc = mine > 0u ? mine : 1u; nx = cnt > 0u ? cnt : 1u;
}

__device__ __forceinline__ void xcd_barrier(const XcdBarrier& b, bool t0) {
    asm volatile("s_waitcnt vmcnt(0)" ::: "memory");
    __syncthreads();
    if (t0) {
        unsigned* bar = b.bar;
        __builtin_amdgcn_s_waitcnt(0);
        unsigned nloc = b.st[0], nx = b.st[1];
        if (nloc == 0u) { xcd_barrier_complete(bar, b.x, nloc, nx); b.st[0] = nloc; b.st[1] = nx; }
        const unsigned old = xb_add(&bar[XB_XSUB(b.x)], 1u);
        const unsigned gen = old / nloc;
        if (old + 1u == (gen + 1u) * nloc) {
            __builtin_amdgcn_fence(__ATOMIC_RELEASE, "agent");
            asm volatile("s_waitcnt vmcnt(0)" ::: "memory");
            const unsigned og = xb_add(&bar[XB_TOP], 1u);
            const unsigned tg = og / nx;
            if (og + 1u == (tg + 1u) * nx) xb_add(&bar[XB_TOPGEN], 1u);
            else XB_SPIN(xb_ld(&bar[XB_TOPGEN]) == tg, bar);
            __builtin_amdgcn_fence(__ATOMIC_ACQUIRE, "agent");
            xb_add(&bar[XB_XGEN(b.x)], 1u);
            asm volatile("s_waitcnt vmcnt(0)" ::: "memory");
        } else {
            XB_SPIN(xb_ld(&bar[XB_XGEN(b.x)]) == gen, bar);
            __builtin_amdgcn_fence(__ATOMIC_ACQUIRE, "agent");
            asm volatile("s_waitcnt vmcnt(0)" ::: "memory");
        }
    }
    __syncthreads();
}

__device__ __forceinline__ void grid_bar(unsigned* ctr, unsigned nblk, int wave_id) {
    asm volatile("s_waitcnt vmcnt(0) lgkmcnt(0)" ::: "memory");
    __syncthreads();
    if (wave_id == 0 && __builtin_amdgcn_mbcnt_hi(~0u, __builtin_amdgcn_mbcnt_lo(~0u, 0u)) == 0) {
        __builtin_amdgcn_fence(__ATOMIC_RELEASE, "agent");
        asm volatile("s_waitcnt vmcnt(0)" ::: "memory");
        __hip_atomic_fetch_add(ctr, 1u, __ATOMIC_RELAXED, __HIP_MEMORY_SCOPE_AGENT);
        while (__hip_atomic_load(ctr, __ATOMIC_RELAXED, __HIP_MEMORY_SCOPE_AGENT) < nblk) __builtin_amdgcn_s_sleep(2);
        __builtin_amdgcn_fence(__ATOMIC_ACQUIRE, "agent");
        asm volatile("s_waitcnt vmcnt(0)" ::: "memory");
    }
    __syncthreads();
}

struct Args { const float* in[14]; float* out; unsigned char* ws; float inv_freq[8]; int ph_lo, ph_hi; };

__global__ void __launch_bounds__(NTHR, 2) hybrid_fwd(Args args) {
    extern __shared__ __attribute__((aligned(16))) unsigned char lds_raw[];
    LAS unsigned char* lds = (LAS unsigned char*)lds_raw;
    cg::grid_group grid = cg::this_grid();
    const int wave = __builtin_amdgcn_readfirstlane((int)threadIdx.x >> 6);
    const int G = gridDim.x, bx = blockIdx.x;
    const int gw = bx * NWAVES + wave, NGW = G * NWAVES;
#define FRESH_IDS const int lane = opaque((int)__builtin_amdgcn_mbcnt_hi(~0u, __builtin_amdgcn_mbcnt_lo(~0u, 0u))), tid = wave * 64 + lane
    unsigned char* ws = args.ws;
    const float* x = args.in[0]; const float* ln1 = args.in[1]; const float* w_in = args.in[2];
    const float* lq1 = args.in[3]; const float* lk1 = args.in[4]; const float* lq2 = args.in[5]; const float* lk2 = args.in[6];
    const float* g_diff = args.in[7]; const float* g_sb = args.in[8]; const float* w_out = args.in[9]; const float* ln2 = args.in[10];
    const float* w1 = args.in[11]; const float* w2 = args.in[12]; const float* ln_f = args.in[13];
    float* out = args.out;
    bf16* Win_t = (bf16*)(ws + WS_WIN); bf16* Wout_t = (bf16*)(ws + WS_WOUT); bf16* W1_t = (bf16*)(ws + WS_W1); bf16* W2_t = (bf16*)(ws + WS_W2);
    float* cs = (float*)(ws + WS_CS); float* ss1 = (float*)(ws + WS_SS1); float* ss2 = (float*)(ws + WS_SS2);
    bf16* Hb = (bf16*)(ws + WS_H); bf16* QKV = (bf16*)(ws + WS_QKV); bf16* MIX = (bf16*)(ws + WS_MIX); bf16* U = (bf16*)(ws + WS_U);
    const int lo = args.ph_lo, hi_ph = args.ph_hi;
#define IN(k) (lo <= (k) && (k) < hi_ph)
#ifndef SKIPMASK
#define SKIPMASK 0
#endif
#define SKIP(k) ((SKIPMASK >> (k)) & 1)
    unsigned* ctl = (unsigned*)(ws + WS_CTL);
    const bool t0 = (wave == 0) && (__builtin_amdgcn_mbcnt_hi(~0u, __builtin_amdgcn_mbcnt_lo(~0u, 0u)) == 0);
    if (args.ph_lo < 0) grid.sync();
    volatile LAS unsigned* bst = (volatile LAS unsigned*)(lds + RING_BYTES);
    if (t0) { bst[0] = 0u; bst[1] = 0u; }
    __syncthreads();
    XcdBarrier xbar = xcd_barrier_post(ctl + 1024, bst, t0);
#define SEAM(k) do { if (IN(k) && IN((k) + 1)) xcd_barrier(xbar, t0); } while (0)
#ifndef REP0
#define REP0 1
#endif
    for (int rep0 = 0; rep0 < REP0; ++rep0)
    if (IN(0) && !SKIP(0)) {
        FRESH_IDS;
        LAS float* scr = (LAS float*)(lds + wave * 16384);
        constexpr int I_IN = (DM / 64) * (PW / 32), I_OUT = (DM / 64) * (DM / 32), I_1 = (DM / 64) * (FF / 32), I_2 = (FF / 64) * (DM / 32);
        constexpr int NITEMS = I_IN + I_OUT + I_1 + I_2;
        for (int it = gw; it < NITEMS; it += NGW) {
            int r = it;
            if (r < I_IN) { transpose_item(w_in, DM, PW, Win_t, nullptr, scr, r, lane); continue; } r -= I_IN;
            if (r < I_OUT) { transpose_item(w_out, DM, DM, Wout_t, nullptr, scr, r, lane); continue; } r -= I_OUT;
            if (r < I_1) { transpose_item(w1, DM, FF, W1_t, ln2, scr, r, lane); continue; } r -= I_1;
            transpose_item(w2, FF, DM, W2_t, nullptr, scr, r, lane);
        }
        for (int m = gw; m < M; m += NGW) {
            const f32x4* xr = (const f32x4*)(x + (size_t)m * DM) + lane; const f32x4* gr = (const f32x4*)ln1 + lane;
            f32x4 v[8], gv[8]; float s = 0.f;
#pragma unroll
            for (int j = 0; j < 8; ++j) { v[j] = xr[64 * j]; gv[j] = gr[64 * j]; }
#pragma unroll
            for (int j = 0; j < 8; ++j) s += (v[j][0] * v[j][0] + v[j][1] * v[j][1]) + (v[j][2] * v[j][2] + v[j][3] * v[j][3]);
            const float rstd = 1.f / sqrtf(wave_sum(s) * (1.f / DM) + EPS);
            v2u* o8 = (v2u*)(Hb + (size_t)m * DM) + lane;
#pragma unroll
            for (int j = 0; j < 8; ++j) { const f32x4 gq = gv[j]; v2u w; w.x = pk2(v[j][0] * rstd * gq[0], v[j][1] * rstd * gq[1]); w.y = pk2(v[j][2] * rstd * gq[2], v[j][3] * rstd * gq[3]); o8[64 * j] = w; }
        }
        for (int e = bx * NTHR + tid; e < SEQ * 8; e += G * NTHR) {
            const int pos = e >> 3, i = e & 7;
            const float ang = (float)pos * args.inv_freq[i];
            const double rev = (double)ang * 0.15915494309189533577; const float fr = (float)(rev - rint(rev));
            cs[pos * 16 + i] = __builtin_amdgcn_cosf(fr); cs[pos * 16 + 8 + i] = __builtin_amdgcn_sinf(fr);
        }
        for (int e = bx * NTHR + tid; e < SEQ; e += G * NTHR) { ss1[e] = 0.f; ss2[e] = 0.f; }
    }
    SEAM(0);
#ifndef REP1
#define REP1 1
#endif
    for (int rep1 = 0; rep1 < REP1; ++rep1)
    if (IN(1) && !SKIP(1)) {
        pg8::Gemm g{Hb, Win_t, M, PW, DM}; pg8::StaticOrder S; S.init(M, PW, G, bx);
        EpiQKV E{QKV, cs};
        pg8::gemm_phase<EpiQKV, pg8::StaticOrder, true, true>(lds, g, S, E, wave);
    }
    SEAM(1);
#ifndef REP2
#define REP2 1
#endif
    for (int rep2 = 0; rep2 < REP2; ++rep2)
    if (IN(2) && !SKIP(2)) {
        FRESH_IDS;
        const float a = lq1[lane] * lk1[lane], b = lq2[lane] * lk2[lane];
        const float lam = __builtin_bit_cast(float, __builtin_amdgcn_readfirstlane(__builtin_bit_cast(int, __expf(wave_sum(a)) - __expf(wave_sum(b)) + LAM_INIT)));
        float* o1s = (float*)(ws + WS_H);
#ifndef NO_DIFF
        for (int u = bx; u < 256; u += G) {
            const int head = u & 7, p = u >> 3;
#pragma unroll 1
            for (int t = 0; t < 2; ++t) diff_unit(lds, QKV, MIX, o1s, g_diff, lam, head, t ? 63 - p : p, wave, lane, tid);
        }
#endif
        __syncthreads();
#ifndef NO_SB
        const int lane_sb = opaque(lane);
#ifndef REPSB
#define REPSB 1
#endif
        for (int repsb = 0; repsb < REPSB; ++repsb)
        for (int wu = gw; wu < 8 * 512; wu += NGW) sb_unit(lds + wave * 8192, QKV, MIX, g_sb, wu & 7, 511 - (wu >> 3), lane_sb);
#endif
        __syncthreads();
    }
    SEAM(2);
    if (IN(3) && !SKIP(3)) {
        pg8::Gemm g{MIX, Wout_t, M, DM, DM}; pg8::StaticOrder S; S.init(M, DM, G, bx);
        EpiRes E{x, out, Hb, ss1};
        pg8::gemm_phase<EpiRes, pg8::StaticOrder, true, true>(lds, g, S, E, wave);
    }
    SEAM(3);
    if (IN(4) && !SKIP(4)) {
        pg8::Gemm g{Hb, W1_t, M, FF, DM}; pg8::StaticOrder S; S.init(M, FF, G, bx);
        EpiMlpIn E{U, ss1};
        pg8::gemm_phase<EpiMlpIn, pg8::StaticOrder, true, true>(lds, g, S, E, wave);
    }
    SEAM(4);
    if (IN(5) && !SKIP(5)) {
        pg8::Gemm g{U, W2_t, M, DM, FF}; pg8::StaticOrder S; S.init(M, DM, G, bx);
        EpiRes E{out, out, nullptr, ss2};
        pg8::gemm_phase<EpiRes, pg8::StaticOrder, true, true>(lds, g, S, E, wave);
    }
    SEAM(5);
    if (IN(6) && !SKIP(6)) {
        FRESH_IDS;
        for (int m = gw; m < M; m += NGW) {
            f32x4* xr = (f32x4*)(out + (size_t)m * DM) + lane; const f32x4* gr = (const f32x4*)ln_f + lane;
            f32x4 v[8], gv[8];
#pragma unroll
            for (int j = 0; j < 8; ++j) { v[j] = xr[64 * j]; gv[j] = gr[64 * j]; }
            const float rstd = 1.f / sqrtf(__hip_atomic_load(ss2 + m, __ATOMIC_RELAXED, __HIP_MEMORY_SCOPE_AGENT) * (1.f / DM) + EPS);
            asm volatile("" ::: "memory");
#pragma unroll
            for (int j = 0; j < 8; ++j) xr[64 * j] = v[j] * rstd * gv[j];
        }
    }
#ifdef EXTRA_BARS
    for (int e = 0; e < EXTRA_BARS; ++e) grid_bar(ctl + 64 * (8 + e), (unsigned)G, wave);
#endif
#undef IN
#undef SEAM
}

#ifndef N_LAUNCHES
#define N_LAUNCHES 1
#endif
extern "C" void kernel_launch(void* const* d_in, const int* in_sizes, int n_in, void* d_out, int out_size, void* d_ws, size_t ws_size, hipStream_t stream) {
    static int grid = 0;
    if (grid == 0) {
        if (n_in != 14 || in_sizes[0] != M * DM || out_size != M * DM || ws_size < WS_END) { fprintf(stderr, "kernel_launch: unexpected shapes (n_in %d, in0 %d, out %d, ws %zu)\n", n_in, n_in > 0 ? in_sizes[0] : -1, out_size, ws_size); grid = -1; return; }
        int dev = 0, cus = 0, per_cu = 0;
        (void)hipGetDevice(&dev); (void)hipDeviceGetAttribute(&cus, hipDeviceAttributeMultiprocessorCount, dev);
        if (hipFuncSetAttribute((const void*)hybrid_fwd, hipFuncAttributeMaxDynamicSharedMemorySize, LDS_BYTES) != hipSuccess) { fprintf(stderr, "kernel_launch: hipFuncSetAttribute failed\n"); grid = -1; return; }
        if (hipOccupancyMaxActiveBlocksPerMultiprocessor(&per_cu, (const void*)hybrid_fwd, NTHR, LDS_BYTES) != hipSuccess || per_cu < 1) { fprintf(stderr, "kernel_launch: occupancy query gave %d\n", per_cu); per_cu = 1; }
        (void)hipGetLastError();
        grid = cus * per_cu;
    }
    if (grid < 0) return;
    if (hipMemsetAsync((char*)d_ws + WS_CTL, 0, 32768, stream) != hipSuccess) { fprintf(stderr, "kernel_launch: memset failed\n"); return; }
    Args a{};
    for (int i = 0; i < 14; ++i) a.in[i] = (const float*)d_in[i];
    a.out = (float*)d_out; a.ws = (unsigned char*)d_ws;
    for (int i = 0; i < 8; ++i) a.inv_freq[i] = (float)pow(500000.0, -(double)i / 8.0);
    const int cuts1[2] = {0, 7};
    const int cuts7[8] = {0, 1, 2, 3, 4, 5, 6, 7};
    const int* cuts = (N_LAUNCHES == 1) ? cuts1 : cuts7;
    for (int li = 0; li < N_LAUNCHES; ++li) {
        a.ph_lo = cuts[li]; a.ph_hi = cuts[li + 1];
        void* kargs[] = {&a};
        hipError_t e = hipLaunchCooperativeKernel((const void*)hybrid_fwd, dim3(grid), dim3(NTHR), kargs, LDS_BYTES, stream);
        if (e != hipSuccess) { fprintf(stderr, "kernel_launch: cooperative launch %d failed: %s (grid %d)\n", li, hipGetErrorString(e), grid); break; }
    }
}
```

```cpp
#include <hip/hip_runtime.h>
#include <hip/hip_cooperative_groups.h>
#include <cstdio>
#include <cstdint>
#include <cmath>
namespace cg = cooperative_groups;
namespace pg8 {
#define PG8_LAS __attribute__((address_space(3)))
typedef unsigned short bf16_t;
typedef short bf16x8 __attribute__((ext_vector_type(8)));
typedef float f32x4 __attribute__((ext_vector_type(4)));
typedef unsigned u32x4 __attribute__((ext_vector_type(4)));
constexpr int BM = 256, BK = 64, HALF = 128, HTB = HALF * BK * 2  , STAGE_BYTES = 8 * HTB, NXCD = 8, WGM = 8;

__host__ __device__ __forceinline__ int lds_byte(int r, int c) { const int st = (r >> 4) * 2 + (c >> 5), rr = r & 15, cc = c & 31, ob = rr * 64 + cc * 2; return st * 1024 + (ob ^ (((ob >> 9) & 1) << 5)); }
__host__ __device__ __forceinline__ void stage_rc(int b, int& R, int& C) { const int st = b / 1024, sb = b % 1024, swz = sb ^ (((sb >> 9) & 1) << 5); R = (st >> 1) * 16 + swz / 64; C = (st & 1) * 32 + (swz % 64) / 2; }
__host__ __device__ __forceinline__ int perm32(int rho) { const int n = rho >> 4, i = rho & 15; return 8 * (i >> 2) + 4 * n + (i & 3); }

struct Unit { int pm, pn; };
struct Gemm { const bf16_t* A; const bf16_t* Bt; int M, N, K; };

struct StaticOrder {
    int nM, nN, nwg, G, c;
    __host__ __device__ void init(int M, int N, int G_, int c_) { nM = M / BM; nN = N / BM; nwg = nM * nN; G = G_; c = c_; }
    __host__ __device__ bool next(int i, Unit& u) const {
        const long L = (long)i * G + c; if (L >= nwg) return false;
        int wgid = (int)L; { const int q = nwg / NXCD, r = nwg % NXCD, xcd = wgid % NXCD, off = wgid / NXCD; wgid = (xcd < r ? xcd * (q + 1) : r * (q + 1) + (xcd - r) * q) + off; }
        const int nig = WGM * nN, gid = wgid / nig, fm = gid * WGM, gsz = (nM - fm) < WGM ? (nM - fm) : WGM;
        u.pm = fm + ((wgid % nig) % gsz); u.pn = (wgid % nig) / gsz; return true;
    }
    __device__ __forceinline__ void a_ready(const Unit&) const {}
    __device__ __forceinline__ void done(const Unit&) const {}
};

__device__ __forceinline__ unsigned cvt_pk_bf16(float lo, float hi) { unsigned r; asm volatile("v_cvt_pk_bf16_f32 %0, %1, %2" : "=v"(r) : "v"(lo), "v"(hi)); return r; }
template <class Epi, class Sched, bool ALIGN_EPI = false, bool SP2 = false>
__device__ __forceinline__ void gemm_phase(PG8_LAS unsigned char* lds, const Gemm g, const Sched& S, const Epi& E, int wave_id) {
    int tid_ = wave_id * 64 + (int)__builtin_amdgcn_mbcnt_hi(~0u, __builtin_amdgcn_mbcnt_lo(~0u, 0u)); asm volatile("" : "+v"(tid_));
    const int tid = tid_, wid = __builtin_amdgcn_readfirstlane(tid >> 6), lane = tid & 63, wr = wid >> 2, wc = wid & 3, fr = lane & 15, fq = lane >> 4;
    const int K = g.K, nt = K / BK;
    unsigned voffA[2], voffB[2];
#pragma unroll
    for (int i = 0; i < 2; ++i) { int R, C; stage_rc(tid * 16 + i * 8192, R, C); const int Rb = Epi::PERM ? ((R & ~31) + perm32(R & 31)) : R;
        voffA[i] = (unsigned)(R * K + C) * 2u; voffB[i] = (unsigned)(Rb * K + C) * 2u; }
    const size_t kstep = (size_t)(BK * 2);
    const size_t hstep = (size_t)HALF * K * 2;
    const size_t tstep = 2 * hstep;
    const unsigned ldsw = (unsigned)wid * 1024u;
    const int aoff = lds_byte(wr * 64 + fr, fq * 8), boff = lds_byte(wc * 32 + fr, fq * 8);
#define PG8_SA(b, h) (((b) * 2 + (h)) * HTB)
#define PG8_SB(b, h) ((4 + (b) * 2 + (h)) * HTB)
#define PG8_STAGE(bufoff, gbase, voff) do { _Pragma("unroll") for (int _i = 0; _i < 2; ++_i) \
        __builtin_amdgcn_global_load_lds((const unsigned*)((const char*)(gbase) + (voff)[_i]), (PG8_LAS unsigned*)(lds + (bufoff) + ldsw + _i * 8192), 16, 0, 0); } while (0)
#define PG8_LDA(dst, b, h) do { _Pragma("unroll") for (int m = 0; m < 4; ++m) _Pragma("unroll") for (int k = 0; k < 2; ++k) dst[m][k] = *(const PG8_LAS bf16x8*)(lds + PG8_SA(b, h) + aoff + m * 2048 + k * 1024); } while (0)
#define PG8_LDB(dst, b, h) do { _Pragma("unroll") for (int n = 0; n < 2; ++n) _Pragma("unroll") for (int k = 0; k < 2; ++k) dst[n][k] = *(const PG8_LAS bf16x8*)(lds + PG8_SB(b, h) + boff + n * 2048 + k * 1024); } while (0)
#define PG8_MMA(ai, bj, At, Bt) do { __builtin_amdgcn_s_setprio(1); _Pragma("unroll") for (int m = 0; m < 4; ++m) _Pragma("unroll") for (int n = 0; n < 2; ++n) _Pragma("unroll") for (int k = 0; k < 2; ++k) \
        acc[ai][bj][m][n] = __builtin_amdgcn_mfma_f32_16x16x32_bf16(Bt[n][k], At[m][k], acc[ai][bj][m][n], 0, 0, 0); __builtin_amdgcn_s_setprio(0); } while (0)
#define PG8_WAIT_V(n) asm volatile("s_waitcnt vmcnt(" #n ")" ::: "memory")
#define PG8_WAIT_L(n) asm volatile("s_waitcnt lgkmcnt(" #n ")" ::: "memory")
#define PG8_BAR __builtin_amdgcn_s_barrier()
#define PG8_SCHED __builtin_amdgcn_sched_barrier(0)
    Unit cur, nxt; int ui = 0;
    if (!S.next(0, cur)) return;
    f32x4 acc[2][2][4][2];
#pragma unroll
    for (int a = 0; a < 2; ++a)
#pragma unroll
        for (int b = 0; b < 2; ++b)
#pragma unroll
            for (int m = 0; m < 4; ++m)
#pragma unroll
                for (int n = 0; n < 2; ++n) acc[a][b][m][n] = (f32x4){0.f, 0.f, 0.f, 0.f};
    bf16x8 At[4][2], B0[2][2], B1[2][2];
    const char* cA = (const char*)g.A + (size_t)cur.pm * tstep; const char* cB = (const char*)g.Bt + (size_t)cur.pn * tstep;
    S.a_ready(cur);
    if constexpr (SP2) {
        PG8_STAGE(PG8_SB(0, 0), cB, voffB); PG8_STAGE(PG8_SB(0, 1), cB + hstep, voffB); PG8_STAGE(PG8_SA(0, 0), cA, voffA); PG8_STAGE(PG8_SA(0, 1), cA + hstep, voffA);
        if (wr == 1) PG8_BAR;
        PG8_WAIT_V(2); PG8_BAR;
        PG8_STAGE(PG8_SB(1, 0), cB + kstep, voffB); PG8_STAGE(PG8_SA(1, 0), cA + kstep, voffA); PG8_STAGE(PG8_SB(1, 1), cB + hstep + kstep, voffB);
        PG8_WAIT_V(6); PG8_BAR;
    } else {
        PG8_STAGE(PG8_SB(0, 0), cB, voffB); PG8_STAGE(PG8_SA(0, 0), cA, voffA); PG8_STAGE(PG8_SB(0, 1), cB + hstep, voffB); PG8_STAGE(PG8_SA(0, 1), cA + hstep, voffA);
        if (wr == 1) PG8_BAR;
        PG8_WAIT_V(4); PG8_BAR;
        PG8_STAGE(PG8_SB(1, 0), cB + kstep, voffB); PG8_STAGE(PG8_SA(1, 0), cA + kstep, voffA); PG8_STAGE(PG8_SB(1, 1), cB + hstep + kstep, voffB);
        PG8_WAIT_V(6); PG8_BAR;
    }
    for (;;) {
        const bool has_next = S.next(ui + 1, nxt);
        const char* nA = has_next ? (const char*)g.A + (size_t)nxt.pm * tstep : cA; const char* nB = has_next ? (const char*)g.Bt + (size_t)nxt.pn * tstep : cB;
        for (int t = 0; t < nt; t += 2) {
            const bool last = (t == nt - 2);
            const char* a1 = cA + (size_t)(t + 1) * kstep;
            const char* a2 = last ? nA : cA + (size_t)(t + 2) * kstep; const char* b2 = last ? nB : cB + (size_t)(t + 2) * kstep;
            const char* a3 = a2 + kstep; const char* b3 = b2 + kstep;
            if (last && has_next) S.a_ready(nxt);
            if constexpr (SP2) {
            PG8_LDB(B0, 0, 0); PG8_LDB(B1, 0, 1); PG8_SCHED; PG8_LDA(At, 0, 0); PG8_STAGE(PG8_SA(1, 1), a1 + hstep, voffA);
            PG8_WAIT_V(8); PG8_WAIT_L(0); PG8_BAR; PG8_MMA(0, 0, At, B0); PG8_MMA(0, 1, At, B1); PG8_BAR; PG8_SCHED;
            PG8_LDA(At, 0, 1); PG8_STAGE(PG8_SB(0, 0), b2, voffB); PG8_STAGE(PG8_SB(0, 1), b2 + hstep, voffB); PG8_STAGE(PG8_SA(0, 0), a2, voffA);
            PG8_WAIT_V(8); PG8_WAIT_L(0); PG8_BAR; PG8_MMA(1, 0, At, B0); PG8_MMA(1, 1, At, B1); PG8_BAR; PG8_SCHED;
            PG8_LDB(B0, 1, 0); PG8_LDB(B1, 1, 1); PG8_SCHED; PG8_LDA(At, 1, 0); PG8_STAGE(PG8_SA(0, 1), a2 + hstep, voffA);
            PG8_WAIT_V(8); PG8_WAIT_L(0); PG8_BAR; PG8_MMA(0, 0, At, B0); PG8_MMA(0, 1, At, B1); PG8_BAR; PG8_SCHED;
            PG8_LDA(At, 1, 1); PG8_STAGE(PG8_SB(1, 0), b3, voffB); PG8_STAGE(PG8_SB(1, 1), b3 + hstep, voffB); PG8_STAGE(PG8_SA(1, 0), a3, voffA);
            PG8_WAIT_V(8); PG8_WAIT_L(0); PG8_BAR; PG8_MMA(1, 0, At, B0); PG8_MMA(1, 1, At, B1); PG8_BAR; PG8_SCHED;
            } else {
            PG8_LDB(B0, 0, 0); PG8_SCHED; PG8_LDA(At, 0, 0); PG8_STAGE(PG8_SA(1, 1), a1 + hstep, voffA);
            PG8_WAIT_L(8); PG8_BAR; PG8_WAIT_L(0); PG8_MMA(0, 0, At, B0); PG8_BAR; PG8_SCHED;
            PG8_LDB(B1, 0, 1); PG8_STAGE(PG8_SB(0, 0), b2, voffB);
            PG8_BAR; PG8_WAIT_L(0); PG8_MMA(0, 1, At, B1); PG8_BAR;
            PG8_LDA(At, 0, 1); PG8_STAGE(PG8_SA(0, 0), a2, voffA);
            PG8_BAR; PG8_WAIT_L(0); PG8_MMA(1, 0, At, B0); PG8_BAR; PG8_SCHED;
            PG8_STAGE(PG8_SB(0, 1), b2 + hstep, voffB);
            PG8_WAIT_V(6); PG8_BAR; PG8_MMA(1, 1, At, B1); PG8_BAR;
            PG8_LDB(B0, 1, 0); PG8_SCHED; PG8_LDA(At, 1, 0); PG8_STAGE(PG8_SA(0, 1), a2 + hstep, voffA);
            PG8_WAIT_L(8); PG8_BAR; PG8_WAIT_L(0); PG8_MMA(0, 0, At, B0); PG8_BAR; PG8_SCHED;
            PG8_LDB(B1, 1, 1); PG8_STAGE(PG8_SB(1, 0), b3, voffB);
            PG8_BAR; PG8_WAIT_L(0); PG8_MMA(0, 1, At, B1); PG8_BAR;
            PG8_LDA(At, 1, 1); PG8_STAGE(PG8_SA(1, 0), a3, voffA);
            PG8_BAR; PG8_WAIT_L(0); PG8_MMA(1, 0, At, B0); PG8_BAR; PG8_SCHED;
            PG8_STAGE(PG8_SB(1, 1), b3 + hstep, voffB);
            PG8_WAIT_V(6); PG8_BAR; PG8_MMA(1, 1, At, B1); PG8_BAR;
            }
        }
        if constexpr (ALIGN_EPI) { if (wr == 0) PG8_BAR; }
        if constexpr (!Epi::AFTER_DRAIN) { E(acc, cur, wr, wc, fr, fq); S.done(cur); }
        if (!has_next) break;
#pragma unroll
        for (int a = 0; a < 2; ++a)
#pragma unroll
            for (int b = 0; b < 2; ++b)
#pragma unroll
                for (int m = 0; m < 4; ++m)
#pragma unroll
                    for (int n = 0; n < 2; ++n) acc[a][b][m][n] = (f32x4){0.f, 0.f, 0.f, 0.f};
        cur = nxt; cA = nA; cB = nB; ++ui;
        if constexpr (ALIGN_EPI) { if (wr == 1) PG8_BAR; }
    }
    PG8_WAIT_V(0);
    if constexpr (!ALIGN_EPI) { if (wr == 0) PG8_BAR; }
    PG8_BAR;
    if constexpr (Epi::AFTER_DRAIN) { E.fused(acc, cur, wr, wc, fr, fq, lds, wid, lane); S.done(cur); }
#undef PG8_SA
#undef PG8_SB
#undef PG8_STAGE
#undef PG8_LDA
#undef PG8_LDB
#undef PG8_MMA
#undef PG8_WAIT_V
#undef PG8_WAIT_L
#undef PG8_BAR
#undef PG8_SCHED
}
}
#define GAS __attribute__((address_space(1)))
#define LAS __attribute__((address_space(3)))
typedef unsigned short bf16;
typedef unsigned v4u __attribute__((ext_vector_type(4)));
typedef unsigned v2u __attribute__((ext_vector_type(2)));
typedef float f32x4 __attribute__((ext_vector_type(4)));
typedef float f32x16 __attribute__((ext_vector_type(16)));
typedef short bf16x8 __attribute__((ext_vector_type(8)));
typedef short s16x4 __attribute__((ext_vector_type(4)));
using pg8::Unit; using pg8::cvt_pk_bf16; using pg8::BM; using pg8::HALF;

constexpr int SEQ = 16384, DM = 2048, PW = 6144, FF = 8192, M = SEQ;
constexpr int NWAVES = 8, NTHR = 512;
constexpr float EPS = 1e-6f;
constexpr float C2 = 0.125f * 1.4426950408889634f;
constexpr float SBSCALE = 0.08838834764831845f * 1.4426950408889634f;
constexpr float LAM_INIT = 0.2f;
constexpr int COL_DQ = 0, COL_DK = 1024, COL_DV = 2048, COL_SQ = 3072, COL_SK = 4096, COL_SV = 5120;

constexpr size_t MiB = 1u << 20;
constexpr size_t WS_WIN = 0;
constexpr size_t WS_WOUT = 24 * MiB;
constexpr size_t WS_W1 = 32 * MiB;
constexpr size_t WS_W2 = 64 * MiB;
constexpr size_t WS_CS = 96 * MiB;
constexpr size_t WS_SS1 = 97 * MiB;
constexpr size_t WS_SS2 = 97 * MiB + 65536;
constexpr size_t WS_H = 98 * MiB;
constexpr size_t WS_QKV = 162 * MiB;
constexpr size_t WS_MIX = 354 * MiB;
constexpr size_t WS_U = 162 * MiB;
constexpr size_t WS_CTL = 418 * MiB;
constexpr size_t WS_END = 419 * MiB;

constexpr int RING_BYTES = 131072, LDS_BYTES = 131072 + 1024;

__device__ __forceinline__ unsigned f2bf(float f) { unsigned u = __builtin_bit_cast(unsigned, f); return (u + 0x7fffu + ((u >> 16) & 1u)) >> 16; }
__device__ __forceinline__ unsigned pk2(float lo, float hi) { return f2bf(lo) | (f2bf(hi) << 16); }
__device__ __forceinline__ float wave_sum(float v) {
#pragma unroll
    for (int o = 1; o < 64; o <<= 1) v += __shfl_xor(v, o);
    return v;
}
typedef unsigned u32x2_t __attribute__((ext_vector_type(2)));
__device__ __forceinline__ void swap_x32(float& a, float& b) { asm volatile("s_nop 1\n\tv_permlane32_swap_b32 %0, %1" : "+v"(a), "+v"(b)); }
__device__ __forceinline__ float max_x32(float x) { float a = x, b = x; swap_x32(a, b); return fmaxf(a, b); }
__device__ __forceinline__ float sum_x32(float x) { float a = x, b = x; swap_x32(a, b); return a + b; }
__device__ __forceinline__ float partner_x32(float x, int hi) { float a = x, b = x; swap_x32(a, b); return hi ? a : b; }
#define LDS_WAIT() asm volatile("s_waitcnt lgkmcnt(0)" ::: "memory")
__device__ __forceinline__ int opaque(int v) { asm volatile("" : "+v"(v)); return v; }

struct EpiQKV {
    static constexpr bool PERM = true, AFTER_DRAIN = false;
    bf16* O; const float* cs;
    __device__ __forceinline__ void operator()(const f32x4 (&acc)[2][2][4][2], const Unit& u, int wr, int wc, int fr, int fq) const {
        const int row0 = u.pm * BM + wr * 64 + fr, col0 = u.pn * BM + wc * 32 + 8 * fq;
        float sc = 1.f; if (u.pn < 4) sc = C2; else if (u.pn >= 12 && u.pn < 16) sc = SBSCALE;
        const bool rot = (u.pn < 8) && ((wc & 1) == 0);
        if (rot) {
#pragma unroll
            for (int ai = 0; ai < 2; ++ai) {
                f32x4 cv[4][4];
#pragma unroll
                for (int m = 0; m < 4; ++m) { const f32x4* p = (const f32x4*)(cs + (size_t)(row0 + ai * HALF + m * 16) * 16); cv[m][0] = p[0]; cv[m][1] = p[1]; cv[m][2] = p[2]; cv[m][3] = p[3]; }
#pragma unroll
                for (int m = 0; m < 4; ++m) {
                    const int row = row0 + ai * HALF + m * 16;
                    const f32x4 c0 = cv[m][0], c1 = cv[m][1]; f32x4 s0 = cv[m][2], s1 = cv[m][3]; if (fq == 0) { s0 = -s0; s1 = -s1; }
#pragma unroll
                    for (int bj = 0; bj < 2; ++bj) {
                        f32x4 v0 = acc[ai][bj][m][0] * sc, v1 = acc[ai][bj][m][1] * sc, p0, p1;
#pragma unroll
                        for (int e = 0; e < 4; ++e) { p0[e] = __shfl_xor(v0[e], 16); p1[e] = __shfl_xor(v1[e], 16); }
                        if (fq < 2) { v0 = v0 * c0 + p0 * s0; v1 = v1 * c1 + p1 * s1; }
                        v4u w; w.x = cvt_pk_bf16(v0[0], v0[1]); w.y = cvt_pk_bf16(v0[2], v0[3]); w.z = cvt_pk_bf16(v1[0], v1[1]); w.w = cvt_pk_bf16(v1[2], v1[3]);
                        *(v4u*)(O + (size_t)row * PW + col0 + bj * HALF) = w;
                    }
                }
            }
        } else {
#pragma unroll
            for (int ai = 0; ai < 2; ++ai)
#pragma unroll
                for (int m = 0; m < 4; ++m) {
                    const int row = row0 + ai * HALF + m * 16;
#pragma unroll
                    for (int bj = 0; bj < 2; ++bj) {
                        const f32x4 v0 = acc[ai][bj][m][0] * sc, v1 = acc[ai][bj][m][1] * sc;
                        v4u w; w.x = cvt_pk_bf16(v0[0], v0[1]); w.y = cvt_pk_bf16(v0[2], v0[3]); w.z = cvt_pk_bf16(v1[0], v1[1]); w.w = cvt_pk_bf16(v1[2], v1[3]);
                        *(v4u*)(O + (size_t)row * PW + col0 + bj * HALF) = w;
                    }
                }
        }
    }
};
struct EpiRes {
    static constexpr bool PERM = true, AFTER_DRAIN = false;
    const float* R; float* Y; bf16* Yb; float* ss;
    __device__ __forceinline__ void operator()(const f32x4 (&acc)[2][2][4][2], const Unit& u, int wr, int wc, int fr, int fq) const {
        const int row0 = u.pm * BM + wr * 64 + fr, col0 = u.pn * BM + wc * 32 + 8 * fq;
#pragma unroll
        for (int ai = 0; ai < 2; ++ai) {
            f32x4 rv[4][2][2];
#pragma unroll
            for (int m = 0; m < 4; ++m)
#pragma unroll
                for (int bj = 0; bj < 2; ++bj) { const size_t off = (size_t)(row0 + ai * HALF + m * 16) * DM + col0 + bj * HALF; rv[m][bj][0] = *(const f32x4*)(R + off); rv[m][bj][1] = *(const f32x4*)(R + off + 4); }
            asm volatile("" ::: "memory");
#pragma unroll
            for (int m = 0; m < 4; ++m) {
                const int row = row0 + ai * HALF + m * 16; float s = 0.f;
#pragma unroll
                for (int bj = 0; bj < 2; ++bj) {
                    const size_t off = (size_t)row * DM + col0 + bj * HALF;
                    const f32x4 v0 = acc[ai][bj][m][0] + rv[m][bj][0], v1 = acc[ai][bj][m][1] + rv[m][bj][1];
                    *(f32x4*)(Y + off) = v0; *(f32x4*)(Y + off + 4) = v1;
                    if (Yb) { v4u w; w.x = cvt_pk_bf16(v0[0], v0[1]); w.y = cvt_pk_bf16(v0[2], v0[3]); w.z = cvt_pk_bf16(v1[0], v1[1]); w.w = cvt_pk_bf16(v1[2], v1[3]); *(v4u*)(Yb + off) = w; }
                    s += (v0[0] * v0[0] + v0[1] * v0[1]) + (v0[2] * v0[2] + v0[3] * v0[3]) + (v1[0] * v1[0] + v1[1] * v1[1]) + (v1[2] * v1[2] + v1[3] * v1[3]);
                }
                s += __shfl_xor(s, 16); s += __shfl_xor(s, 32);
                if (fq == 0) atomicAdd(ss + row, s);
            }
        }
    }
};
struct EpiMlpIn {
    static constexpr bool PERM = true, AFTER_DRAIN = false;
    bf16* O; const float* ss;
    __device__ __forceinline__ void operator()(const f32x4 (&acc)[2][2][4][2], const Unit& u, int wr, int wc, int fr, int fq) const {
        const int row0 = u.pm * BM + wr * 64 + fr, col0 = u.pn * BM + wc * 32 + 8 * fq;
        float rs[2][4];
#pragma unroll
        for (int ai = 0; ai < 2; ++ai)
#pragma unroll
            for (int m = 0; m < 4; ++m) rs[ai][m] = __hip_atomic_load(ss + row0 + ai * HALF + m * 16, __ATOMIC_RELAXED, __HIP_MEMORY_SCOPE_AGENT);
        asm volatile("" ::: "memory");
#pragma unroll
        for (int ai = 0; ai < 2; ++ai)
#pragma unroll
            for (int m = 0; m < 4; ++m) {
                const int row = row0 + ai * HALF + m * 16;
                const float rstd = __builtin_amdgcn_rsqf(rs[ai][m] * (1.f / DM) + EPS);
#pragma unroll
                for (int bj = 0; bj < 2; ++bj) {
                    f32x4 v0 = acc[ai][bj][m][0] * rstd, v1 = acc[ai][bj][m][1] * rstd;
#pragma unroll
                    for (int e = 0; e < 4; ++e) { const float a = fmaxf(v0[e], 0.f), b = fmaxf(v1[e], 0.f); v0[e] = a * a; v1[e] = b * b; }
                    v4u w; w.x = cvt_pk_bf16(v0[0], v0[1]); w.y = cvt_pk_bf16(v0[2], v0[3]); w.z = cvt_pk_bf16(v1[0], v1[1]); w.w = cvt_pk_bf16(v1[2], v1[3]);
                    *(v4u*)(O + (size_t)row * FF + col0 + bj * HALF) = w;
                }
            }
    }
};
#define MFMA32(a, b, c) __builtin_amdgcn_mfma_f32_32x32x16_bf16((a), (b), (c), 0, 0, 0)
__device__ __forceinline__ int crow(int r, int hi) { return (r & 3) + 8 * (r >> 2) + 4 * hi; }
typedef short v4i16_t __attribute__((ext_vector_type(4)));
__device__ __forceinline__ s16x4 vtr(LAS const unsigned char* p) { return __builtin_bit_cast(s16x4, __builtin_amdgcn_ds_read_tr16_b64_v4i16((LAS v4i16_t*)p)); }
typedef float f32x2_t __attribute__((ext_vector_type(2)));
typedef __bf16 bf16x2_t __attribute__((ext_vector_type(2)));
__device__ __forceinline__ unsigned cvtpk_s(float lo, float hi) { f32x2_t v = {lo, hi}; bf16x2_t b = __builtin_convertvector(v, bf16x2_t); return __builtin_bit_cast(unsigned, b); }
__device__ __forceinline__ bf16x8 pack8(const f32x16& x, int s) {
    v4u p; p.x = cvtpk_s(x[8 * s], x[8 * s + 1]); p.y = cvtpk_s(x[8 * s + 2], x[8 * s + 3]); p.z = cvtpk_s(x[8 * s + 4], x[8 * s + 5]); p.w = cvtpk_s(x[8 * s + 6], x[8 * s + 7]);
    return __builtin_bit_cast(bf16x8, p);
}

__device__ __forceinline__ void glds16(const void* sbase, unsigned voff, unsigned lds_dst) { unsigned keep;
    asm volatile("s_mov_b32 %0, m0\n\ts_mov_b32 m0, %3\n\ts_nop 0\n\tglobal_load_lds_dwordx4 %1, %2\n\ts_mov_b32 m0, %0" : "=&s"(keep) : "v"(voff), "s"(sbase), "s"(lds_dst) : "memory"); }
template <bool TAIL>
__device__ __forceinline__ void flash_half(f32x16 (&O)[4], f32x16& Sc, f32x16& Sn, float& m_run, float& l_run, bf16x8& mfrag, const bf16x8& onefrag, const bf16x8 (&qf)[4],
                                           LAS const unsigned char* Kn, LAS const unsigned char* Vc, unsigned ka, int kx, unsigned va, int vx, int blk, int hi, int key0, int qrow, int qmin) {
    if (TAIL) {
        const int kb = key0 + 4 * hi;
#pragma unroll
        for (int i = 0; i < 16; ++i) { const int key = kb + (i & 3) + 8 * (i >> 2); if (key > qrow) Sc[i] = -1e30f; }
    }
    float mloc = fmaxf(Sc[0], Sc[1]);
#pragma unroll
    for (int i = 2; i < 16; ++i) mloc = fmaxf(mloc, Sc[i]);
    mloc = max_x32(mloc);
    const bool first = (key0 == 0);
    if (__any(mloc > 8.f) || first) {
        const float m_new = (mloc > 8.f || first) ? __builtin_bit_cast(float, f2bf(m_run + mloc) << 16) : m_run;
        const float delta = m_new - m_run, alpha = __builtin_amdgcn_exp2f(-delta);
        l_run *= alpha;
#pragma unroll
        for (int d = 0; d < 4; ++d)
#pragma unroll
            for (int i = 0; i < 16; ++i) O[d][i] *= alpha;
#pragma unroll
        for (int i = 0; i < 16; ++i) Sc[i] -= delta;
        m_run = m_new;
        mfrag[0] = hi ? (short)0 : (short)(f2bf(-m_new));
    }
#pragma unroll
    for (int i = 0; i < 16; ++i) Sn[i] = 0.f;
    Sn = MFMA32(onefrag, mfrag, Sn);
#pragma unroll
    for (int ks = 0; ks < 4; ++ks) {
        const bf16x8 a0 = *(LAS const bf16x8*)(Kn + ka + (((2 * ks + hi) ^ kx) << 4));
        Sn = MFMA32(a0, qf[ks], Sn);
    }
    float ls = 0.f;
#pragma unroll
    for (int i = 0; i < 16; ++i) { Sc[i] = __builtin_amdgcn_exp2f(Sc[i]); ls += Sc[i]; }
    l_run += ls;
#pragma unroll
    for (int kk = 0; kk < 2; ++kk) {
        if (kk == 1) __builtin_amdgcn_sched_barrier(0);
        const bf16x8 pb = pack8(Sc, kk);
#pragma unroll
        for (int d = 0; d < 4; ++d) {
            LAS const unsigned char* p = Vc + va + kk * 4096 + (((2 * d + blk) ^ vx) << 5);
            const s16x4 lo = vtr(p), hi4 = vtr(p + 2048);
            const bf16x8 a = __builtin_shufflevector(lo, hi4, 0, 1, 2, 3, 4, 5, 6, 7);
            O[d] = MFMA32(a, pb, O[d]);
        }
    }
}

constexpr int DA_V = 49152, KT = 128;
__device__ __forceinline__ void flash_map(f32x16 (&O)[4], LAS unsigned char* lds, const bf16* QKV, int qcol, int kcol, int vcol, int qb, int w, int lane, int tid) {
    const int r32 = lane & 31, hi = lane >> 5;
    const int qmin = qb * 256 + w * 32, qrow = qmin + r32;
    bf16x8 qf[4];
    { const int lq = opaque(lane);
      const bf16* qp = QKV + (size_t)(qmin + (lq & 31)) * PW + qcol + 8 * (lq >> 5);
#pragma unroll
      for (int ks = 0; ks < 4; ++ks) qf[ks] = *(const bf16x8*)(qp + 16 * ks); }
#pragma unroll
    for (int d = 0; d < 4; ++d)
#pragma unroll
        for (int i = 0; i < 16; ++i) O[d][i] = 0.f;
    float m_run = 0.f, l_run = 0.f;
    bf16x8 mfrag = {0, 0, 0, 0, 0, 0, 0, 0}, onefrag = {0, 0, 0, 0, 0, 0, 0, 0}; onefrag[0] = hi ? (short)0 : (short)0x3F80;
    const int nkt = 2 * (qb + 1), nmain = 2 * qb;
    const int krow = tid >> 3, kc = (tid & 7) ^ ((krow >> 1) & 7);
    const unsigned kgo = (unsigned)(krow * PW + kc * 8) * 2u;
    const int vrow = tid >> 4, vpos = tid & 15, vc = ((((vpos >> 1) ^ (2 * (vrow & 3)))) << 1) | (vpos & 1);
    const unsigned vgo = (unsigned)(vrow * PW + vc * 8) * 2u;
    const bf16* kg = QKV + kcol; const bf16* vg = QKV + vcol;
    const unsigned wl = (unsigned)(tid >> 6) * 1024u;
    const size_t tstep = (size_t)KT * PW;
#define DMA16(g, vo, l) glds16((g), (vo), (unsigned)__builtin_amdgcn_readfirstlane((int)(unsigned)(size_t)(l)))
#define DMA_K(t, slot) do { const bf16* g_ = kg + (size_t)(t) * tstep; DMA16(g_, kgo, lds + (slot) + wl); DMA16(g_ + (size_t)64 * PW, kgo, lds + (slot) + 8192 + wl); } while (0)
#define DMA_V(t, b) do { const bf16* g_ = vg + (size_t)(t) * tstep; LAS unsigned char* l_ = lds + DA_V + (b) * 32768 + wl; \
        DMA16(g_, vgo, l_); DMA16(g_ + (size_t)32 * PW, vgo, l_ + 8192); DMA16(g_ + (size_t)64 * PW, vgo, l_ + 16384); DMA16(g_ + (size_t)96 * PW, vgo, l_ + 24576); } while (0)
    const unsigned ka = r32 * 128;
    const int kx = (r32 >> 1) & 7;
    const int q4 = (lane & 15) >> 2, p4 = lane & 3, blk = (lane >> 4) & 1;
    const int vr0 = 4 * hi + q4;
    const unsigned va = DA_V + vr0 * 256 + 8 * p4;
    const int vx = 2 * q4;
    DMA_K(0, 0); DMA_K(1, 16384); DMA_V(0, 0);
    asm volatile("s_waitcnt vmcnt(0) lgkmcnt(0)\n\ts_barrier" ::: "memory");
    f32x16 S0, S1;
#pragma unroll
    for (int i = 0; i < 16; ++i) S0[i] = 0.f;
#pragma unroll
    for (int ks = 0; ks < 4; ++ks) S0 = MFMA32(*(LAS const bf16x8*)(lds + ka + (((2 * ks + hi) ^ kx) << 4)), qf[ks], S0);
    int kb0 = 0, kb1 = 16384, kb2 = 32768;
    for (int kt = 0; kt < nkt; ++kt) {
        const int buf = kt & 1;
        if (kt + 2 < nkt) DMA_K(kt + 2, kb2);
        if (kt + 1 < nkt) DMA_V(kt + 1, buf ^ 1);
        LAS const unsigned char* Kc = lds + kb0; LAS const unsigned char* Vb = lds + buf * 32768;
        if (kt < nmain) {
            flash_half<false>(O, S0, S1, m_run, l_run, mfrag, onefrag, qf, Kc + 4096, Vb, ka, kx, va, vx, blk, hi, kt * KT, qrow, qmin);
            flash_half<false>(O, S1, S0, m_run, l_run, mfrag, onefrag, qf, Kc + 8192, Vb + 8192, ka, kx, va, vx, blk, hi, kt * KT + 32, qrow, qmin);
            flash_half<false>(O, S0, S1, m_run, l_run, mfrag, onefrag, qf, Kc + 12288, Vb + 16384, ka, kx, va, vx, blk, hi, kt * KT + 64, qrow, qmin);
            flash_half<false>(O, S1, S0, m_run, l_run, mfrag, onefrag, qf, lds + kb1, Vb + 24576, ka, kx, va, vx, blk, hi, kt * KT + 96, qrow, qmin);
        } else {
            flash_half<true>(O, S0, S1, m_run, l_run, mfrag, onefrag, qf, Kc + 4096, Vb, ka, kx, va, vx, blk, hi, kt * KT, qrow, qmin);
            flash_half<true>(O, S1, S0, m_run, l_run, mfrag, onefrag, qf, Kc + 8192, Vb + 8192, ka, kx, va, vx, blk, hi, kt * KT + 32, qrow, qmin);
            flash_half<true>(O, S0, S1, m_run, l_run, mfrag, onefrag, qf, Kc + 12288, Vb + 16384, ka, kx, va, vx, blk, hi, kt * KT + 64, qrow, qmin);
            flash_half<true>(O, S1, S0, m_run, l_run, mfrag, onefrag, qf, lds + kb1, Vb + 24576, ka, kx, va, vx, blk, hi, kt * KT + 96, qrow, qmin);
        }
        asm volatile("s_waitcnt vmcnt(0) lgkmcnt(0)\n\ts_barrier" ::: "memory");
        const int t0 = kb0; kb0 = kb1; kb1 = kb2; kb2 = t0;
    }
#undef DMA16
#undef DMA_K
#undef DMA_V
    const float l = sum_x32(l_run), inv = 1.f / l;
#pragma unroll
    for (int d = 0; d < 4; ++d)
#pragma unroll
        for (int i = 0; i < 16; ++i) O[d][i] *= inv;
}

__device__ __forceinline__ void headnorm_store(const f32x16 (&O)[4], const float* g, float post, bf16* MIX, int qrow, int col0, int hi) {
    float ss = 0.f;
#pragma unroll
    for (int d = 0; d < 4; ++d)
#pragma unroll
        for (int i = 0; i < 16; ++i) ss += O[d][i] * O[d][i];
    ss = sum_x32(ss);
    const float rs = __builtin_amdgcn_rsqf(ss * (1.f / 128.f) + EPS) * post;
    f32x4 gvv[4][4];
#pragma unroll
    for (int d = 0; d < 4; ++d)
#pragma unroll
        for (int gq = 0; gq < 4; ++gq) gvv[d][gq] = *(const f32x4*)(g + 32 * d + 8 * gq + 4 * hi);
    asm volatile("" ::: "memory");
#pragma unroll
    for (int d = 0; d < 4; ++d)
#pragma unroll
        for (int gq = 0; gq < 4; ++gq) {
            const int dv = 32 * d + 8 * gq + 4 * hi;
            const f32x4 gv = gvv[d][gq];
            v2u w; w.x = cvtpk_s(O[d][4 * gq] * rs * gv[0], O[d][4 * gq + 1] * rs * gv[1]); w.y = cvtpk_s(O[d][4 * gq + 2] * rs * gv[2], O[d][4 * gq + 3] * rs * gv[3]);
            *(v2u*)(MIX + (size_t)qrow * DM + col0 + dv) = w;
        }
}

__device__ __forceinline__ void diff_unit(LAS unsigned char* lds, const bf16* QKV, bf16* MIX, float* o1s, const float* gd, float lam, int head, int qb, int w, int lane, int tid) {
    f32x16 O[4];
#pragma unroll 1
    for (int j = 0; j < 2; ++j) {
        flash_map(O, lds, QKV, COL_DQ + head * 128 + 64 * j, COL_DK + head * 128 + 64 * j, COL_DV + head * 128, qb, w, lane, tid);
        if (j == 0) {
            f32x4* sc = (f32x4*)(o1s + ((size_t)(blockIdx.x * NWAVES + w) * 64 + opaque(lane)) * 64);
#pragma unroll
            for (int d = 0; d < 4; ++d)
#pragma unroll
                for (int i = 0; i < 4; ++i) sc[d * 4 + i] = (f32x4){O[d][4 * i], O[d][4 * i + 1], O[d][4 * i + 2], O[d][4 * i + 3]};
        }
    }
    lane = opaque(lane);
    const f32x4* sc = (const f32x4*)(o1s + ((size_t)(blockIdx.x * NWAVES + w) * 64 + lane) * 64);
#pragma unroll
    for (int d = 0; d < 4; ++d)
#pragma unroll
        for (int i = 0; i < 4; ++i) { const f32x4 t = sc[d * 4 + i];
#pragma unroll
            for (int e = 0; e < 4; ++e) O[d][4 * i + e] = t[e] - lam * O[d][4 * i + e]; }
    headnorm_store(O, gd, 1.f - LAM_INIT, MIX, qb * 256 + w * 32 + (lane & 31), head * 128, lane >> 5);
}

constexpr float SB_STOP = -44.f * 1.4426950408889634f;
__device__ __forceinline__ void sb_unit(LAS unsigned char* vl, const bf16* QKV, bf16* MIX, const float* gs, int head, int qg, int lane) {
    const int r32 = lane & 31, hi = lane >> 5;
    const int qrow = qg * 32 + r32;
    bf16x8 qf[8];
#pragma unroll
    for (int ks = 0; ks < 8; ++ks) qf[ks] = *(const bf16x8*)(QKV + (size_t)qrow * PW + COL_SQ + head * 128 + 16 * ks + 8 * hi);
    f32x16 O[4];
#pragma unroll
    for (int d = 0; d < 4; ++d)
#pragma unroll
        for (int i = 0; i < 16; ++i) O[d][i] = 0.f;
    float R = 0.f;
    const int q4 = (lane & 15) >> 2, p4 = lane & 3, blk = (lane >> 4) & 1;
    const int vr0 = 4 * hi + q4, vx = vr0 & 7;
    const unsigned va = vr0 * 256 + 8 * p4;
    const bf16* kgp = QKV + (size_t)r32 * PW + COL_SK + head * 128 + 8 * hi;
    const bf16* vgp = QKV + (size_t)(lane >> 4) * PW + COL_SV + head * 128 + (lane & 15) * 8;
    bf16x8 kf[8]; v4u vreg[8];
#pragma unroll
    for (int ks = 0; ks < 8; ++ks) kf[ks] = *(const bf16x8*)(kgp + (size_t)(qg * 32) * PW + 16 * ks);
#pragma unroll
    for (int i = 0; i < 8; ++i) vreg[i] = *(const v4u*)(vgp + (size_t)(qg * 32 + 4 * i) * PW);
    for (int kt = qg; kt >= 0; --kt) {
        const int k0 = kt * 32;
        f32x16 S;
#pragma unroll
        for (int i = 0; i < 16; ++i) S[i] = 0.f;
#pragma unroll
        for (int ks = 0; ks < 8; ++ks) S = MFMA32(kf[ks], qf[ks], S);
        LDS_WAIT();
#pragma unroll
        for (int i = 0; i < 8; ++i) { const int row = 4 * i + (lane >> 4), c = lane & 15; *(LAS v4u*)(vl + row * 256 + (((c >> 1) ^ (row & 7)) << 5) + ((c & 1) << 4)) = vreg[i]; }
        if (kt > 0) {
#pragma unroll
            for (int ks = 0; ks < 8; ++ks) kf[ks] = *(const bf16x8*)(kgp + (size_t)(k0 - 32) * PW + 16 * ks);
#pragma unroll
            for (int i = 0; i < 8; ++i) vreg[i] = *(const v4u*)(vgp + (size_t)(k0 - 32 + 4 * i) * PW);
        }
        float lb[16], lom[16];
#pragma unroll
        for (int i = 0; i < 16; ++i) {
            const int key = k0 + crow(i, hi); const float z = S[i];
            const float sp = __builtin_amdgcn_logf(1.f + __builtin_amdgcn_exp2f(-fabsf(z)));
            lb[i] = fminf(z, 0.f) - sp;
            lom[i] = (key < qrow) ? lb[i] - z : 0.f;
        }
        float gsum[4], pgs[4], after[4];
#pragma unroll
        for (int g = 0; g < 4; ++g) { gsum[g] = (lom[4 * g] + lom[4 * g + 1]) + (lom[4 * g + 2] + lom[4 * g + 3]); pgs[g] = partner_x32(gsum[g], hi); }
        float run = 0.f;
#pragma unroll
        for (int g = 3; g >= 0; --g) { after[g] = run + (hi == 0 ? pgs[g] : 0.f); run += gsum[g] + pgs[g]; }
#pragma unroll
        for (int g = 0; g < 4; ++g) {
            float suf = R + after[g];
#pragma unroll
            for (int e = 3; e >= 0; --e) {
                const int i = 4 * g + e; const int key = k0 + crow(i, hi);
                S[i] = (key < qrow) ? __builtin_amdgcn_exp2f(lb[i] + suf) : 0.f;
                suf += lom[i];
            }
        }
        R += run;
        LDS_WAIT();
#pragma unroll
        for (int kk = 0; kk < 2; ++kk) {
            const bf16x8 pb = pack8(S, kk);
#pragma unroll
            for (int d = 0; d < 4; ++d) {
                LAS const unsigned char* p = vl + va + kk * 4096 + (((2 * d + blk) ^ vx) << 5);
                const s16x4 lo = vtr(p), hi4 = vtr(p + 2048);
                const bf16x8 a = __builtin_shufflevector(lo, hi4, 0, 1, 2, 3, 4, 5, 6, 7);
                O[d] = MFMA32(a, pb, O[d]);
            }
        }
        if (__all(R < SB_STOP)) break;
    }
    LDS_WAIT();
    headnorm_store(O, gs, 1.f, MIX, qrow, 1024 + head * 128, hi);
}
__device__ __forceinline__ void transpose_item(const float* W, int K, int N, bf16* WT, const float* g, LAS float* scr, int item, int lane) {
    const int nblk = N / 32, kb = item / nblk, nb = item % nblk, k0 = 64 * kb, n0 = 32 * nb;
    const int r8 = lane >> 3, c4 = (lane & 7) * 4;
    f32x4 v[8];
#pragma unroll
    for (int i = 0; i < 8; ++i) v[i] = __builtin_nontemporal_load((const f32x4*)(W + (size_t)(k0 + r8 + 8 * i) * N + n0 + c4));
#pragma unroll
    for (int i = 0; i < 8; ++i) { const int kk = r8 + 8 * i; const float gs = g ? g[k0 + kk] : 1.f;
#pragma unroll
        for (int e = 0; e < 4; ++e) scr[kk * 33 + c4 + e] = v[i][e] * gs; }
    LDS_WAIT();
    const int c = lane & 7;
#pragma unroll
    for (int j = 0; j < 4; ++j) { const int n = (lane >> 3) + 8 * j; const LAS float* sp = scr + (8 * c) * 33 + n;
        v4u o; o.x = pk2(sp[0 * 33], sp[1 * 33]); o.y = pk2(sp[2 * 33], sp[3 * 33]); o.z = pk2(sp[4 * 33], sp[5 * 33]); o.w = pk2(sp[6 * 33], sp[7 * 33]);
        *(v4u*)(WT + (size_t)(n0 + n) * K + k0 + 8 * c) = o; }
    LDS_WAIT();
}

#define XB_TMO      128
#define XB_XCNT(j)  (256  + 64 * (j))
#define XB_XSUB(j)  (1280 + 64 * (j))
#define XB_XGEN(j)  (2304 + 64 * (j))
#define XB_TOP      3328
#define XB_TOPGEN   3392
#define XCD_BAR_WORDS 3456
#define XB_SPIN_CAP (1u << 18)
__device__ __forceinline__ unsigned xb_ld(unsigned* p)              { return __hip_atomic_load(p, __ATOMIC_RELAXED, __HIP_MEMORY_SCOPE_AGENT); }
__device__ __forceinline__ unsigned xb_add(unsigned* p, unsigned v) { return __hip_atomic_fetch_add(p, v, __ATOMIC_RELAXED, __HIP_MEMORY_SCOPE_AGENT); }
__device__ __forceinline__ unsigned xb_xcc_id() { return (unsigned)__builtin_amdgcn_s_getreg((3 << 11) | 20) & 0xFu; }
#define XB_SPIN(cond, bar) do { unsigned _sp = 0; while (cond) { __builtin_amdgcn_s_sleep(1); \
    if ((++_sp & 255u) == 0u) { if (xb_ld(&(bar)[XB_TMO])) break; if (_sp > XB_SPIN_CAP) { atomicAdd(&(bar)[XB_TMO], 1u); break; } } } } while (0)

struct XcdBarrier {
    unsigned* bar; unsigned x;
    volatile LAS unsigned* st;
};

__device__ __forceinline__ XcdBarrier xcd_barrier_post(unsigned* bar, volatile LAS unsigned* st, bool t0) {
    XcdBarrier b; b.bar = bar; b.x = xb_xcc_id(); b.st = st;
    if (t0) (void)xb_add(&bar[XB_XCNT(b.x)], 1u);
    return b;
}
__device__ __forceinline__ void xcd_barrier_complete(unsigned* bar, unsigned x, unsigned& nloc, unsigned& nx) {
    const unsigned G = gridDim.x * gridDim.y * gridDim.z;
    unsigned sum, cnt, mine, sp = 0u;
    for (;;) {
        sum = 0u; cnt = 0u; mine = 0u;
#pragma unroll
        for (unsigned j = 0; j < 16; ++j) { const unsigned c = xb_ld(&bar[XB_XCNT(j)]); sum += c; cnt += (c > 0u) ? 1u : 0u; mine = (j == x) ? c : mine; }
        if (sum == G) break;
        __builtin_amdgcn_s_sleep(1);
        if ((++sp & 255u) == 0u) { if (xb_ld(&bar[XB_TMO])) break; if (sp > XB_SPIN_CAP) { atomicAdd(&bar[XB_TMO], 1u); break; } }
    }
    nloc = mine > 0u ? mine : 1u; nx = cnt > 0u ? cnt : 1u;
}

__device__ __forceinline__ void xcd_barrier(const XcdBarrier& b, bool t0) {
    asm volatile("s_waitcnt vmcnt(0)" ::: "memory");
    __syncthreads();
    if (t0) {
        unsigned* bar = b.bar;
        __builtin_amdgcn_s_waitcnt(0);
        unsigned nloc = b.st[0], nx = b.st[1];
        if (nloc == 0u) { xcd_barrier_complete(bar, b.x, nloc, nx); b.st[0] = nloc; b.st[1] = nx; }
        const unsigned old = xb_add(&bar[XB_XSUB(b.x)], 1u);
        const unsigned gen = old / nloc;
        if (old + 1u == (gen + 1u) * nloc) {
            __builtin_amdgcn_fence(__ATOMIC_RELEASE, "agent");
            asm volatile("s_waitcnt vmcnt(0)" ::: "memory");
            const unsigned og = xb_add(&bar[XB_TOP], 1u);
            const unsigned tg = og / nx;
            if (og + 1u == (tg + 1u) * nx) xb_add(&bar[XB_TOPGEN], 1u);
            else XB_SPIN(xb_ld(&bar[XB_TOPGEN]) == tg, bar);
            __builtin_amdgcn_fence(__ATOMIC_ACQUIRE, "agent");
            xb_add(&bar[XB_XGEN(b.x)], 1u);
            asm volatile("s_waitcnt vmcnt(0)" ::: "memory");
        } else {
            XB_SPIN(xb_ld(&bar[XB_XGEN(b.x)]) == gen, bar);
            __builtin_amdgcn_fence(__ATOMIC_ACQUIRE, "agent");
            asm volatile("s_waitcnt vmcnt(0)" ::: "memory");
        }
    }
    __syncthreads();
}

__device__ __forceinline__ void grid_bar(unsigned* ctr, unsigned nblk, int wave_id) {
    asm volatile("s_waitcnt vmcnt(0) lgkmcnt(0)" ::: "memory");
    __syncthreads();
    if (wave_id == 0 && __builtin_amdgcn_mbcnt_hi(~0u, __builtin_amdgcn_mbcnt_lo(~0u, 0u)) == 0) {
        __builtin_amdgcn_fence(__ATOMIC_RELEASE, "agent");
        asm volatile("s_waitcnt vmcnt(0)" ::: "memory");
        __hip_atomic_fetch_add(ctr, 1u, __ATOMIC_RELAXED, __HIP_MEMORY_SCOPE_AGENT);
        while (__hip_atomic_load(ctr, __ATOMIC_RELAXED, __HIP_MEMORY_SCOPE_AGENT) < nblk) __builtin_amdgcn_s_sleep(2);
        __builtin_amdgcn_fence(__ATOMIC_ACQUIRE, "agent");
        asm volatile("s_waitcnt vmcnt(0)" ::: "memory");
    }
    __syncthreads();
}

struct Args { const float* in[14]; float* out; unsigned char* ws; float inv_freq[8]; int ph_lo, ph_hi; };

__global__ void __launch_bounds__(NTHR, 2) hybrid_fwd(Args args) {
    extern __shared__ __attribute__((aligned(16))) unsigned char lds_raw[];
    LAS unsigned char* lds = (LAS unsigned char*)lds_raw;
    cg::grid_group grid = cg::this_grid();
    const int wave = __builtin_amdgcn_readfirstlane((int)threadIdx.x >> 6);
    const int G = gridDim.x, bx = blockIdx.x;
    const int gw = bx * NWAVES + wave, NGW = G * NWAVES;
#define FRESH_IDS const int lane = opaque((int)__builtin_amdgcn_mbcnt_hi(~0u, __builtin_amdgcn_mbcnt_lo(~0u, 0u))), tid = wave * 64 + lane
    unsigned char* ws = args.ws;
    const float* x = args.in[0]; const float* ln1 = args.in[1]; const float* w_in = args.in[2];
    const float* lq1 = args.in[3]; const float* lk1 = args.in[4]; const float* lq2 = args.in[5]; const float* lk2 = args.in[6];
    const float* g_diff = args.in[7]; const float* g_sb = args.in[8]; const float* w_out = args.in[9]; const float* ln2 = args.in[10];
    const float* w1 = args.in[11]; const float* w2 = args.in[12]; const float* ln_f = args.in[13];
    float* out = args.out;
    bf16* Win_t = (bf16*)(ws + WS_WIN); bf16* Wout_t = (bf16*)(ws + WS_WOUT); bf16* W1_t = (bf16*)(ws + WS_W1); bf16* W2_t = (bf16*)(ws + WS_W2);
    float* cs = (float*)(ws + WS_CS); float* ss1 = (float*)(ws + WS_SS1); float* ss2 = (float*)(ws + WS_SS2);
    bf16* Hb = (bf16*)(ws + WS_H); bf16* QKV = (bf16*)(ws + WS_QKV); bf16* MIX = (bf16*)(ws + WS_MIX); bf16* U = (bf16*)(ws + WS_U);
    const int lo = args.ph_lo, hi_ph = args.ph_hi;
#define IN(k) (lo <= (k) && (k) < hi_ph)
#ifndef SKIPMASK
#define SKIPMASK 0
#endif
#define SKIP(k) ((SKIPMASK >> (k)) & 1)
    unsigned* ctl = (unsigned*)(ws + WS_CTL);
    const bool t0 = (wave == 0) && (__builtin_amdgcn_mbcnt_hi(~0u, __builtin_amdgcn_mbcnt_lo(~0u, 0u)) == 0);
    if (args.ph_lo < 0) grid.sync();
    volatile LAS unsigned* bst = (volatile LAS unsigned*)(lds + RING_BYTES);
    if (t0) { bst[0] = 0u; bst[1] = 0u; }
    __syncthreads();
    XcdBarrier xbar = xcd_barrier_post(ctl + 1024, bst, t0);
#define SEAM(k) do { if (IN(k) && IN((k) + 1)) xcd_barrier(xbar, t0); } while (0)
#ifndef REP0
#define REP0 1
#endif
    for (int rep0 = 0; rep0 < REP0; ++rep0)
    if (IN(0) && !SKIP(0)) {
        FRESH_IDS;
        LAS float* scr = (LAS float*)(lds + wave * 16384);
        constexpr int I_IN = (DM / 64) * (PW / 32), I_OUT = (DM / 64) * (DM / 32), I_1 = (DM / 64) * (FF / 32), I_2 = (FF / 64) * (DM / 32);
        constexpr int NITEMS = I_IN + I_OUT + I_1 + I_2;
        for (int it = gw; it < NITEMS; it += NGW) {
            int r = it;
            if (r < I_IN) { transpose_item(w_in, DM, PW, Win_t, nullptr, scr, r, lane); continue; } r -= I_IN;
            if (r < I_OUT) { transpose_item(w_out, DM, DM, Wout_t, nullptr, scr, r, lane); continue; } r -= I_OUT;
            if (r < I_1) { transpose_item(w1, DM, FF, W1_t, ln2, scr, r, lane); continue; } r -= I_1;
            transpose_item(w2, FF, DM, W2_t, nullptr, scr, r, lane);
        }
        for (int m = gw; m < M; m += NGW) {
            const f32x4* xr = (const f32x4*)(x + (size_t)m * DM) + lane; const f32x4* gr = (const f32x4*)ln1 + lane;
            f32x4 v[8], gv[8]; float s = 0.f;
#pragma unroll
            for (int j = 0; j < 8; ++j) { v[j] = __builtin_nontemporal_load(xr + 64 * j); gv[j] = gr[64 * j]; }
#pragma unroll
            for (int j = 0; j < 8; ++j) s += (v[j][0] * v[j][0] + v[j][1] * v[j][1]) + (v[j][2] * v[j][2] + v[j][3] * v[j][3]);
            const float rstd = 1.f / sqrtf(wave_sum(s) * (1.f / DM) + EPS);
            v2u* o8 = (v2u*)(Hb + (size_t)m * DM) + lane;
#pragma unroll
            for (int j = 0; j < 8; ++j) { const f32x4 gq = gv[j]; v2u w; w.x = pk2(v[j][0] * rstd * gq[0], v[j][1] * rstd * gq[1]); w.y = pk2(v[j][2] * rstd * gq[2], v[j][3] * rstd * gq[3]); o8[64 * j] = w; }
        }
        for (int e = bx * NTHR + tid; e < SEQ * 8; e += G * NTHR) {
            const int pos = e >> 3, i = e & 7;
            const float ang = (float)pos * args.inv_freq[i];
            const double rev = (double)ang * 0.15915494309189533577; const float fr = (float)(rev - rint(rev));
            cs[pos * 16 + i] = __builtin_amdgcn_cosf(fr); cs[pos * 16 + 8 + i] = __builtin_amdgcn_sinf(fr);
        }
        for (int e = bx * NTHR + tid; e < SEQ; e += G * NTHR) { ss1[e] = 0.f; ss2[e] = 0.f; }
    }
    SEAM(0);
#ifndef REP1
#define REP1 1
#endif
    for (int rep1 = 0; rep1 < REP1; ++rep1)
    if (IN(1) && !SKIP(1)) {
        pg8::Gemm g{Hb, Win_t, M, PW, DM}; pg8::StaticOrder S; S.init(M, PW, G, bx);
        EpiQKV E{QKV, cs};
        pg8::gemm_phase<EpiQKV, pg8::StaticOrder, true, true>(lds, g, S, E, wave);
    }
    SEAM(1);
#ifndef REP2
#define REP2 1
#endif
    for (int rep2 = 0; rep2 < REP2; ++rep2)
    if (IN(2) && !SKIP(2)) {
        FRESH_IDS;
        const float a = lq1[lane] * lk1[lane], b = lq2[lane] * lk2[lane];
        const float lam = __builtin_bit_cast(float, __builtin_amdgcn_readfirstlane(__builtin_bit_cast(int, __expf(wave_sum(a)) - __expf(wave_sum(b)) + LAM_INIT)));
        float* o1s = (float*)(ws + WS_H);
#ifndef NO_DIFF
        for (int u = bx; u < 256; u += G) {
            const int head = u & 7, p = u >> 3;
#pragma unroll 1
            for (int t = 0; t < 2; ++t) diff_unit(lds, QKV, MIX, o1s, g_diff, lam, head, t ? 63 - p : p, wave, lane, tid);
        }
#endif
        __syncthreads();
#ifndef NO_SB
        const int lane_sb = opaque(lane);
#ifndef REPSB
#define REPSB 1
#endif
        for (int repsb = 0; repsb < REPSB; ++repsb)
        for (int wu = gw; wu < 8 * 512; wu += NGW) sb_unit(lds + wave * 8192, QKV, MIX, g_sb, wu & 7, 511 - (wu >> 3), lane_sb);
#endif
        __syncthreads();
    }
    SEAM(2);
    if (IN(3) && !SKIP(3)) {
        pg8::Gemm g{MIX, Wout_t, M, DM, DM}; pg8::StaticOrder S; S.init(M, DM, G, bx);
        EpiRes E{x, out, Hb, ss1};
        pg8::gemm_phase<EpiRes, pg8::StaticOrder, true, true>(lds, g, S, E, wave);
    }
    SEAM(3);
    if (IN(4) && !SKIP(4)) {
        pg8::Gemm g{Hb, W1_t, M, FF, DM}; pg8::StaticOrder S; S.init(M, FF, G, bx);
        EpiMlpIn E{U, ss1};
        pg8::gemm_phase<EpiMlpIn, pg8::StaticOrder, true, true>(lds, g, S, E, wave);
    }
    SEAM(4);
    if (IN(5) && !SKIP(5)) {
        pg8::Gemm g{U, W2_t, M, DM, FF}; pg8::StaticOrder S; S.init(M, DM, G, bx);
        EpiRes E{out, out, nullptr, ss2};
        pg8::gemm_phase<EpiRes, pg8::StaticOrder, true, true>(lds, g, S, E, wave);
    }
    SEAM(5);
    if (IN(6) && !SKIP(6)) {
        FRESH_IDS;
        for (int m = gw; m < M; m += NGW) {
            f32x4* xr = (f32x4*)(out + (size_t)m * DM) + lane; const f32x4* gr = (const f32x4*)ln_f + lane;
            f32x4 v[8], gv[8];
#pragma unroll
            for (int j = 0; j < 8; ++j) { v[j] = xr[64 * j]; gv[j] = gr[64 * j]; }
            const float rstd = 1.f / sqrtf(__hip_atomic_load(ss2 + m, __ATOMIC_RELAXED, __HIP_MEMORY_SCOPE_AGENT) * (1.f / DM) + EPS);
            asm volatile("" ::: "memory");
#pragma unroll
            for (int j = 0; j < 8; ++j) __builtin_nontemporal_store(v[j] * rstd * gv[j], xr + 64 * j);
        }
    }
#ifdef EXTRA_BARS
    for (int e = 0; e < EXTRA_BARS; ++e) grid_bar(ctl + 64 * (8 + e), (unsigned)G, wave);
#endif
#undef IN
#undef SEAM
}

#ifndef N_LAUNCHES
#define N_LAUNCHES 1
#endif
extern "C" void kernel_launch(void* const* d_in, const int* in_sizes, int n_in, void* d_out, int out_size, void* d_ws, size_t ws_size, hipStream_t stream) {
    static int grid = 0;
    if (grid == 0) {
        if (n_in != 14 || in_sizes[0] != M * DM || out_size != M * DM || ws_size < WS_END) { fprintf(stderr, "kernel_launch: unexpected shapes (n_in %d, in0 %d, out %d, ws %zu)\n", n_in, n_in > 0 ? in_sizes[0] : -1, out_size, ws_size); grid = -1; return; }
        int dev = 0, cus = 0, per_cu = 0;
        (void)hipGetDevice(&dev); (void)hipDeviceGetAttribute(&cus, hipDeviceAttributeMultiprocessorCount, dev);
        if (hipFuncSetAttribute((const void*)hybrid_fwd, hipFuncAttributeMaxDynamicSharedMemorySize, LDS_BYTES) != hipSuccess) { fprintf(stderr, "kernel_launch: hipFuncSetAttribute failed\n"); grid = -1; return; }
        if (hipOccupancyMaxActiveBlocksPerMultiprocessor(&per_cu, (const void*)hybrid_fwd, NTHR, LDS_BYTES) != hipSuccess || per_cu < 1) { fprintf(stderr, "kernel_launch: occupancy query gave %d\n", per_cu); per_cu = 1; }
        (void)hipGetLastError();
        grid = cus * per_cu;
    }
    if (grid < 0) return;
    if (hipMemsetAsync((char*)d_ws + WS_CTL, 0, 32768, stream) != hipSuccess) { fprintf(stderr, "kernel_launch: memset failed\n"); return; }
    Args a{};
    for (int i = 0; i < 14; ++i) a.in[i] = (const float*)d_in[i];
    a.out = (float*)d_out; a.ws = (unsigned char*)d_ws;
    for (int i = 0; i < 8; ++i) a.inv_freq[i] = (float)pow(500000.0, -(double)i / 8.0);
    const int cuts1[2] = {0, 7};
    const int cuts7[8] = {0, 1, 2, 3, 4, 5, 6, 7};
    const int* cuts = (N_LAUNCHES == 1) ? cuts1 : cuts7;
    for (int li = 0; li < N_LAUNCHES; ++li) {
        a.ph_lo = cuts[li]; a.ph_hi = cuts[li + 1];
        void* kargs[] = {&a};
        hipError_t e = hipLaunchCooperativeKernel((const void*)hybrid_fwd, dim3(grid), dim3(NTHR), kargs, LDS_BYTES, stream);
        if (e != hipSuccess) { fprintf(stderr, "kernel_launch: cooperative launch %d failed: %s (grid %d)\n", li, hipGetErrorString(e), grid); break; }
    }
}
```

```cpp
#include <hip/hip_runtime.h>
#include <hip/hip_cooperative_groups.h>
#include <cstdio>
#include <cstdint>
#include <cmath>
namespace cg = cooperative_groups;
namespace pg8 {
#define PG8_LAS __attribute__((address_space(3)))
typedef unsigned short bf16_t;
typedef short bf16x8 __attribute__((ext_vector_type(8)));
typedef float f32x4 __attribute__((ext_vector_type(4)));
typedef unsigned u32x4 __attribute__((ext_vector_type(4)));
constexpr int BM = 256, BK = 64, HALF = 128, HTB = HALF * BK * 2  , STAGE_BYTES = 8 * HTB, NXCD = 8, WGM = 8;

__host__ __device__ __forceinline__ int lds_byte(int r, int c) { const int st = (r >> 4) * 2 + (c >> 5), rr = r & 15, cc = c & 31, ob = rr * 64 + cc * 2; return st * 1024 + (ob ^ (((ob >> 9) & 1) << 5)); }
__host__ __device__ __forceinline__ void stage_rc(int b, int& R, int& C) { const int st = b / 1024, sb = b % 1024, swz = sb ^ (((sb >> 9) & 1) << 5); R = (st >> 1) * 16 + swz / 64; C = (st & 1) * 32 + (swz % 64) / 2; }
__host__ __device__ __forceinline__ int perm32(int rho) { const int n = rho >> 4, i = rho & 15; return 8 * (i >> 2) + 4 * n + (i & 3); }

struct Unit { int pm, pn; };
struct Gemm { const bf16_t* A; const bf16_t* Bt; int M, N, K; };

struct StaticOrder {
    int nM, nN, nwg, G, c;
    __host__ __device__ void init(int M, int N, int G_, int c_) { nM = M / BM; nN = N / BM; nwg = nM * nN; G = G_; c = c_; }
    __host__ __device__ bool next(int i, Unit& u) const {
        const long L = (long)i * G + c; if (L >= nwg) return false;
        int wgid = (int)L; { const int q = nwg / NXCD, r = nwg % NXCD, xcd = wgid % NXCD, off = wgid / NXCD; wgid = (xcd < r ? xcd * (q + 1) : r * (q + 1) + (xcd - r) * q) + off; }
        const int nig = WGM * nN, gid = wgid / nig, fm = gid * WGM, gsz = (nM - fm) < WGM ? (nM - fm) : WGM;
        u.pm = fm + ((wgid % nig) % gsz); u.pn = (wgid % nig) / gsz; return true;
    }
    __device__ __forceinline__ void a_ready(const Unit&) const {}
    __device__ __forceinline__ void done(const Unit&) const {}
};

__device__ __forceinline__ unsigned cvt_pk_bf16(float lo, float hi) { unsigned r; asm volatile("v_cvt_pk_bf16_f32 %0, %1, %2" : "=v"(r) : "v"(lo), "v"(hi)); return r; }
template <class Epi, class Sched, bool ALIGN_EPI = false, bool SP2 = false>
__device__ __forceinline__ void gemm_phase(PG8_LAS unsigned char* lds, const Gemm g, const Sched& S, const Epi& E, int wave_id) {
    int tid_ = wave_id * 64 + (int)__builtin_amdgcn_mbcnt_hi(~0u, __builtin_amdgcn_mbcnt_lo(~0u, 0u)); asm volatile("" : "+v"(tid_));
    const int tid = tid_, wid = __builtin_amdgcn_readfirstlane(tid >> 6), lane = tid & 63, wr = wid >> 2, wc = wid & 3, fr = lane & 15, fq = lane >> 4;
    const int K = g.K, nt = K / BK;
    unsigned voffA[2], voffB[2];
#pragma unroll
    for (int i = 0; i < 2; ++i) { int R, C; stage_rc(tid * 16 + i * 8192, R, C); const int Rb = Epi::PERM ? ((R & ~31) + perm32(R & 31)) : R;
        voffA[i] = (unsigned)(R * K + C) * 2u; voffB[i] = (unsigned)(Rb * K + C) * 2u; }
    const size_t kstep = (size_t)(BK * 2);
    const size_t hstep = (size_t)HALF * K * 2;
    const size_t tstep = 2 * hstep;
    const unsigned ldsw = (unsigned)wid * 1024u;
    const int aoff = lds_byte(wr * 64 + fr, fq * 8), boff = lds_byte(wc * 32 + fr, fq * 8);
#define PG8_SA(b, h) (((b) * 2 + (h)) * HTB)
#define PG8_SB(b, h) ((4 + (b) * 2 + (h)) * HTB)
#define PG8_STAGE(bufoff, gbase, voff) do { _Pragma("unroll") for (int _i = 0; _i < 2; ++_i) \
        __builtin_amdgcn_global_load_lds((const unsigned*)((const char*)(gbase) + (voff)[_i]), (PG8_LAS unsigned*)(lds + (bufoff) + ldsw + _i * 8192), 16, 0, 0); } while (0)
#define PG8_LDA(dst, b, h) do { _Pragma("unroll") for (int m = 0; m < 4; ++m) _Pragma("unroll") for (int k = 0; k < 2; ++k) dst[m][k] = *(const PG8_LAS bf16x8*)(lds + PG8_SA(b, h) + aoff + m * 2048 + k * 1024); } while (0)
#define PG8_LDB(dst, b, h) do { _Pragma("unroll") for (int n = 0; n < 2; ++n) _Pragma("unroll") for (int k = 0; k < 2; ++k) dst[n][k] = *(const PG8_LAS bf16x8*)(lds + PG8_SB(b, h) + boff + n * 2048 + k * 1024); } while (0)
#define PG8_MMA(ai, bj, At, Bt) do { __builtin_amdgcn_s_setprio(1); _Pragma("unroll") for (int m = 0; m < 4; ++m) _Pragma("unroll") for (int n = 0; n < 2; ++n) _Pragma("unroll") for (int k = 0; k < 2; ++k) \
        acc[ai][bj][m][n] = __builtin_amdgcn_mfma_f32_16x16x32_bf16(Bt[n][k], At[m][k], acc[ai][bj][m][n], 0, 0, 0); __builtin_amdgcn_s_setprio(0); } while (0)
#define PG8_WAIT_V(n) asm volatile("s_waitcnt vmcnt(" #n ")" ::: "memory")
#define PG8_WAIT_L(n) asm volatile("s_waitcnt lgkmcnt(" #n ")" ::: "memory")
#define PG8_BAR __builtin_amdgcn_s_barrier()
#define PG8_SCHED __builtin_amdgcn_sched_barrier(0)
    Unit cur, nxt; int ui = 0;
    if (!S.next(0, cur)) return;
    f32x4 acc[2][2][4][2];
#pragma unroll
    for (int a = 0; a < 2; ++a)
#pragma unroll
        for (int b = 0; b < 2; ++b)
#pragma unroll
            for (int m = 0; m < 4; ++m)
#pragma unroll
                for (int n = 0; n < 2; ++n) acc[a][b][m][n] = (f32x4){0.f, 0.f, 0.f, 0.f};
    bf16x8 At[4][2], B0[2][2], B1[2][2];
    const char* cA = (const char*)g.A + (size_t)cur.pm * tstep; const char* cB = (const char*)g.Bt + (size_t)cur.pn * tstep;
    S.a_ready(cur);
    if constexpr (SP2) {
        PG8_STAGE(PG8_SB(0, 0), cB, voffB); PG8_STAGE(PG8_SB(0, 1), cB + hstep, voffB); PG8_STAGE(PG8_SA(0, 0), cA, voffA); PG8_STAGE(PG8_SA(0, 1), cA + hstep, voffA);
        if (wr == 1) PG8_BAR;
        PG8_WAIT_V(2); PG8_BAR;
        PG8_STAGE(PG8_SB(1, 0), cB + kstep, voffB); PG8_STAGE(PG8_SA(1, 0), cA + kstep, voffA); PG8_STAGE(PG8_SB(1, 1), cB + hstep + kstep, voffB);
        PG8_WAIT_V(6); PG8_BAR;
    } else {
        PG8_STAGE(PG8_SB(0, 0), cB, voffB); PG8_STAGE(PG8_SA(0, 0), cA, voffA); PG8_STAGE(PG8_SB(0, 1), cB + hstep, voffB); PG8_STAGE(PG8_SA(0, 1), cA + hstep, voffA);
        if (wr == 1) PG8_BAR;
        PG8_WAIT_V(4); PG8_BAR;
        PG8_STAGE(PG8_SB(1, 0), cB + kstep, voffB); PG8_STAGE(PG8_SA(1, 0), cA + kstep, voffA); PG8_STAGE(PG8_SB(1, 1), cB + hstep + kstep, voffB);
        PG8_WAIT_V(6); PG8_BAR;
    }
    for (;;) {
        const bool has_next = S.next(ui + 1, nxt);
        const char* nA = has_next ? (const char*)g.A + (size_t)nxt.pm * tstep : cA; const char* nB = has_next ? (const char*)g.Bt + (size_t)nxt.pn * tstep : cB;
        for (int t = 0; t < nt; t += 2) {
            const bool last = (t == nt - 2);
            const char* a1 = cA + (size_t)(t + 1) * kstep;
            const char* a2 = last ? nA : cA + (size_t)(t + 2) * kstep; const char* b2 = last ? nB : cB + (size_t)(t + 2) * kstep;
            const char* a3 = a2 + kstep; const char* b3 = b2 + kstep;
            if (last && has_next) S.a_ready(nxt);
            if constexpr (SP2) {
            PG8_LDB(B0, 0, 0); PG8_LDB(B1, 0, 1); PG8_SCHED; PG8_LDA(At, 0, 0); PG8_STAGE(PG8_SA(1, 1), a1 + hstep, voffA);
            PG8_WAIT_V(8); PG8_WAIT_L(0); PG8_BAR; PG8_MMA(0, 0, At, B0); PG8_MMA(0, 1, At, B1); PG8_BAR; PG8_SCHED;
            PG8_LDA(At, 0, 1); PG8_STAGE(PG8_SB(0, 0), b2, voffB); PG8_STAGE(PG8_SB(0, 1), b2 + hstep, voffB); PG8_STAGE(PG8_SA(0, 0), a2, voffA);
            PG8_WAIT_V(8); PG8_WAIT_L(0); PG8_BAR; PG8_MMA(1, 0, At, B0); PG8_MMA(1, 1, At, B1); PG8_BAR; PG8_SCHED;
            PG8_LDB(B0, 1, 0); PG8_LDB(B1, 1, 1); PG8_SCHED; PG8_LDA(At, 1, 0); PG8_STAGE(PG8_SA(0, 1), a2 + hstep, voffA);
            PG8_WAIT_V(8); PG8_WAIT_L(0); PG8_BAR; PG8_MMA(0, 0, At, B0); PG8_MMA(0, 1, At, B1); PG8_BAR; PG8_SCHED;
            PG8_LDA(At, 1, 1); PG8_STAGE(PG8_SB(1, 0), b3, voffB); PG8_STAGE(PG8_SB(1, 1), b3 + hstep, voffB); PG8_STAGE(PG8_SA(1, 0), a3, voffA);
            PG8_WAIT_V(8); PG8_WAIT_L(0); PG8_BAR; PG8_MMA(1, 0, At, B0); PG8_MMA(1, 1, At, B1); PG8_BAR; PG8_SCHED;
            } else {
            PG8_LDB(B0, 0, 0); PG8_SCHED; PG8_LDA(At, 0, 0); PG8_STAGE(PG8_SA(1, 1), a1 + hstep, voffA);
            PG8_WAIT_L(8); PG8_BAR; PG8_WAIT_L(0); PG8_MMA(0, 0, At, B0); PG8_BAR; PG8_SCHED;
            PG8_LDB(B1, 0, 1); PG8_STAGE(PG8_SB(0, 0), b2, voffB);
            PG8_BAR; PG8_WAIT_L(0); PG8_MMA(0, 1, At, B1); PG8_BAR;
            PG8_LDA(At, 0, 1); PG8_STAGE(PG8_SA(0, 0), a2, voffA);
            PG8_BAR; PG8_WAIT_L(0); PG8_MMA(1, 0, At, B0); PG8_BAR; PG8_SCHED;
            PG8_STAGE(PG8_SB(0, 1), b2 + hstep, voffB);
            PG8_WAIT_V(6); PG8_BAR; PG8_MMA(1, 1, At, B1); PG8_BAR;
            PG8_LDB(B0, 1, 0); PG8_SCHED; PG8_LDA(At, 1, 0); PG8_STAGE(PG8_SA(0, 1), a2 + hstep, voffA);
            PG8_WAIT_L(8); PG8_BAR; PG8_WAIT_L(0); PG8_MMA(0, 0, At, B0); PG8_BAR; PG8_SCHED;
            PG8_LDB(B1, 1, 1); PG8_STAGE(PG8_SB(1, 0), b3, voffB);
            PG8_BAR; PG8_WAIT_L(0); PG8_MMA(0, 1, At, B1); PG8_BAR;
            PG8_LDA(At, 1, 1); PG8_STAGE(PG8_SA(1, 0), a3, voffA);
            PG8_BAR; PG8_WAIT_L(0); PG8_MMA(1, 0, At, B0); PG8_BAR; PG8_SCHED;
            PG8_STAGE(PG8_SB(1, 1), b3 + hstep, voffB);
            PG8_WAIT_V(6); PG8_BAR; PG8_MMA(1, 1, At, B1); PG8_BAR;
            }
        }
        if constexpr (ALIGN_EPI) { if (wr == 0) PG8_BAR; }
        if constexpr (!Epi::AFTER_DRAIN) { E(acc, cur, wr, wc, fr, fq); S.done(cur); }
        if (!has_next) break;
#pragma unroll
        for (int a = 0; a < 2; ++a)
#pragma unroll
            for (int b = 0; b < 2; ++b)
#pragma unroll
                for (int m = 0; m < 4; ++m)
#pragma unroll
                    for (int n = 0; n < 2; ++n) acc[a][b][m][n] = (f32x4){0.f, 0.f, 0.f, 0.f};
        cur = nxt; cA = nA; cB = nB; ++ui;
        if constexpr (ALIGN_EPI) { if (wr == 1) PG8_BAR; }
    }
    PG8_WAIT_V(0);
    if constexpr (!ALIGN_EPI) { if (wr == 0) PG8_BAR; }
    PG8_BAR;
    if constexpr (Epi::AFTER_DRAIN) { E.fused(acc, cur, wr, wc, fr, fq, lds, wid, lane); S.done(cur); }
#undef PG8_SA
#undef PG8_SB
#undef PG8_STAGE
#undef PG8_LDA
#undef PG8_LDB
#undef PG8_MMA
#undef PG8_WAIT_V
#undef PG8_WAIT_L
#undef PG8_BAR
#undef PG8_SCHED
}
}
#define GAS __attribute__((address_space(1)))
#define LAS __attribute__((address_space(3)))
typedef unsigned short bf16;
typedef unsigned v4u __attribute__((ext_vector_type(4)));
typedef unsigned v2u __attribute__((ext_vector_type(2)));
typedef float f32x4 __attribute__((ext_vector_type(4)));
typedef float f32x16 __attribute__((ext_vector_type(16)));
typedef short bf16x8 __attribute__((ext_vector_type(8)));
typedef short s16x4 __attribute__((ext_vector_type(4)));
using pg8::Unit; using pg8::cvt_pk_bf16; using pg8::BM; using pg8::HALF;

constexpr int SEQ = 16384, DM = 2048, PW = 6144, FF = 8192, M = SEQ;
constexpr int NWAVES = 8, NTHR = 512;
constexpr float EPS = 1e-6f;
constexpr float C2 = 0.125f * 1.4426950408889634f;
constexpr float SBSCALE = 0.08838834764831845f * 1.4426950408889634f;
constexpr float LAM_INIT = 0.2f;
constexpr int COL_DQ = 0, COL_DK = 1024, COL_DV = 2048, COL_SQ = 3072, COL_SK = 4096, COL_SV = 5120;

constexpr size_t MiB = 1u << 20;
constexpr size_t WS_WIN = 0;
constexpr size_t WS_WOUT = 24 * MiB;
constexpr size_t WS_W1 = 32 * MiB;
constexpr size_t WS_W2 = 64 * MiB;
constexpr size_t WS_CS = 96 * MiB;
constexpr size_t WS_SS1 = 97 * MiB;
constexpr size_t WS_SS2 = 97 * MiB + 65536;
constexpr size_t WS_H = 98 * MiB;
constexpr size_t WS_QKV = 162 * MiB;
constexpr size_t WS_MIX = 354 * MiB;
constexpr size_t WS_U = 162 * MiB;
constexpr size_t WS_CTL = 418 * MiB;
constexpr size_t WS_END = 419 * MiB;

constexpr int RING_BYTES = 131072, LDS_BYTES = 131072 + 1024;

__device__ __forceinline__ unsigned f2bf(float f) { unsigned u = __builtin_bit_cast(unsigned, f); return (u + 0x7fffu + ((u >> 16) & 1u)) >> 16; }
__device__ __forceinline__ unsigned pk2(float lo, float hi) { return f2bf(lo) | (f2bf(hi) << 16); }
__device__ __forceinline__ float wave_sum(float v) {
#pragma unroll
    for (int o = 1; o < 64; o <<= 1) v += __shfl_xor(v, o);
    return v;
}
typedef unsigned u32x2_t __attribute__((ext_vector_type(2)));
__device__ __forceinline__ void swap_x32(float& a, float& b) { asm volatile("s_nop 1\n\tv_permlane32_swap_b32 %0, %1" : "+v"(a), "+v"(b)); }
__device__ __forceinline__ float max_x32(float x) { float a = x, b = x; swap_x32(a, b); return fmaxf(a, b); }
__device__ __forceinline__ float sum_x32(float x) { float a = x, b = x; swap_x32(a, b); return a + b; }
__device__ __forceinline__ float partner_x32(float x, int hi) { float a = x, b = x; swap_x32(a, b); return hi ? a : b; }
#define LDS_WAIT() asm volatile("s_waitcnt lgkmcnt(0)" ::: "memory")
__device__ __forceinline__ int opaque(int v) { asm volatile("" : "+v"(v)); return v; }

struct EpiQKV {
    static constexpr bool PERM = true, AFTER_DRAIN = false;
    bf16* O; const float* cs;
    __device__ __forceinline__ void operator()(const f32x4 (&acc)[2][2][4][2], const Unit& u, int wr, int wc, int fr, int fq) const {
        const int row0 = u.pm * BM + wr * 64 + fr, col0 = u.pn * BM + wc * 32 + 8 * fq;
        float sc = 1.f; if (u.pn < 4) sc = C2; else if (u.pn >= 12 && u.pn < 16) sc = SBSCALE;
        const bool rot = (u.pn < 8) && ((wc & 1) == 0);
        if (rot) {
#pragma unroll
            for (int ai = 0; ai < 2; ++ai) {
                f32x4 cv[4][4];
#pragma unroll
                for (int m = 0; m < 4; ++m) { const f32x4* p = (const f32x4*)(cs + (size_t)(row0 + ai * HALF + m * 16) * 16); cv[m][0] = p[0]; cv[m][1] = p[1]; cv[m][2] = p[2]; cv[m][3] = p[3]; }
#pragma unroll
                for (int m = 0; m < 4; ++m) {
                    const int row = row0 + ai * HALF + m * 16;
                    const f32x4 c0 = cv[m][0], c1 = cv[m][1]; f32x4 s0 = cv[m][2], s1 = cv[m][3]; if (fq == 0) { s0 = -s0; s1 = -s1; }
#pragma unroll
                    for (int bj = 0; bj < 2; ++bj) {
                        f32x4 v0 = acc[ai][bj][m][0] * sc, v1 = acc[ai][bj][m][1] * sc, p0, p1;
#pragma unroll
                        for (int e = 0; e < 4; ++e) { p0[e] = __shfl_xor(v0[e], 16); p1[e] = __shfl_xor(v1[e], 16); }
                        if (fq < 2) { v0 = v0 * c0 + p0 * s0; v1 = v1 * c1 + p1 * s1; }
                        v4u w; w.x = cvt_pk_bf16(v0[0], v0[1]); w.y = cvt_pk_bf16(v0[2], v0[3]); w.z = cvt_pk_bf16(v1[0], v1[1]); w.w = cvt_pk_bf16(v1[2], v1[3]);
                        *(v4u*)(O + (size_t)row * PW + col0 + bj * HALF) = w;
                    }
                }
            }
        } else {
#pragma unroll
            for (int ai = 0; ai < 2; ++ai)
#pragma unroll
                for (int m = 0; m < 4; ++m) {
                    const int row = row0 + ai * HALF + m * 16;
#pragma unroll
                    for (int bj = 0; bj < 2; ++bj) {
                        const f32x4 v0 = acc[ai][bj][m][0] * sc, v1 = acc[ai][bj][m][1] * sc;
                        v4u w; w.x = cvt_pk_bf16(v0[0], v0[1]); w.y = cvt_pk_bf16(v0[2], v0[3]); w.z = cvt_pk_bf16(v1[0], v1[1]); w.w = cvt_pk_bf16(v1[2], v1[3]);
                        *(v4u*)(O + (size_t)row * PW + col0 + bj * HALF) = w;
                    }
                }
        }
    }
};
struct EpiRes {
    static constexpr bool PERM = true, AFTER_DRAIN = false;
    const float* R; float* Y; bf16* Yb; float* ss;
    __device__ __forceinline__ void operator()(const f32x4 (&acc)[2][2][4][2], const Unit& u, int wr, int wc, int fr, int fq) const {
        const int row0 = u.pm * BM + wr * 64 + fr, col0 = u.pn * BM + wc * 32 + 8 * fq;
#pragma unroll
        for (int ai = 0; ai < 2; ++ai) {
            f32x4 rv[4][2][2];
#pragma unroll
            for (int m = 0; m < 4; ++m)
#pragma unroll
                for (int bj = 0; bj < 2; ++bj) { const size_t off = (size_t)(row0 + ai * HALF + m * 16) * DM + col0 + bj * HALF; rv[m][bj][0] = *(const f32x4*)(R + off); rv[m][bj][1] = *(const f32x4*)(R + off + 4); }
            asm volatile("" ::: "memory");
#pragma unroll
            for (int m = 0; m < 4; ++m) {
                const int row = row0 + ai * HALF + m * 16; float s = 0.f;
#pragma unroll
                for (int bj = 0; bj < 2; ++bj) {
                    const size_t off = (size_t)row * DM + col0 + bj * HALF;
                    const f32x4 v0 = acc[ai][bj][m][0] + rv[m][bj][0], v1 = acc[ai][bj][m][1] + rv[m][bj][1];
                    *(f32x4*)(Y + off) = v0; *(f32x4*)(Y + off + 4) = v1;
                    if (Yb) { v4u w; w.x = cvt_pk_bf16(v0[0], v0[1]); w.y = cvt_pk_bf16(v0[2], v0[3]); w.z = cvt_pk_bf16(v1[0], v1[1]); w.w = cvt_pk_bf16(v1[2], v1[3]); *(v4u*)(Yb + off) = w; }
                    s += (v0[0] * v0[0] + v0[1] * v0[1]) + (v0[2] * v0[2] + v0[3] * v0[3]) + (v1[0] * v1[0] + v1[1] * v1[1]) + (v1[2] * v1[2] + v1[3] * v1[3]);
                }
                s += __shfl_xor(s, 16); s += __shfl_xor(s, 32);
                if (fq == 0) atomicAdd(ss + row, s);
            }
        }
    }
};
struct EpiMlpIn {
    static constexpr bool PERM = true, AFTER_DRAIN = false;
    bf16* O; const float* ss;
    __device__ __forceinline__ void operator()(const f32x4 (&acc)[2][2][4][2], const Unit& u, int wr, int wc, int fr, int fq) const {
        const int row0 = u.pm * BM + wr * 64 + fr, col0 = u.pn * BM + wc * 32 + 8 * fq;
        float rs[2][4];
#pragma unroll
        for (int ai = 0; ai < 2; ++ai)
#pragma unroll
            for (int m = 0; m < 4; ++m) rs[ai][m] = __hip_atomic_load(ss + row0 + ai * HALF + m * 16, __ATOMIC_RELAXED, __HIP_MEMORY_SCOPE_AGENT);
        asm volatile("" ::: "memory");
#pragma unroll
        for (int ai = 0; ai < 2; ++ai)
#pragma unroll
            for (int m = 0; m < 4; ++m) {
                const int row = row0 + ai * HALF + m * 16;
                const float rstd = __builtin_amdgcn_rsqf(rs[ai][m] * (1.f / DM) + EPS);
#pragma unroll
                for (int bj = 0; bj < 2; ++bj) {
                    f32x4 v0 = acc[ai][bj][m][0] * rstd, v1 = acc[ai][bj][m][1] * rstd;
#pragma unroll
                    for (int e = 0; e < 4; ++e) { const float a = fmaxf(v0[e], 0.f), b = fmaxf(v1[e], 0.f); v0[e] = a * a; v1[e] = b * b; }
                    v4u w; w.x = cvt_pk_bf16(v0[0], v0[1]); w.y = cvt_pk_bf16(v0[2], v0[3]); w.z = cvt_pk_bf16(v1[0], v1[1]); w.w = cvt_pk_bf16(v1[2], v1[3]);
                    *(v4u*)(O + (size_t)row * FF + col0 + bj * HALF) = w;
                }
            }
    }
};
#define MFMA32(a, b, c) __builtin_amdgcn_mfma_f32_32x32x16_bf16((a), (b), (c), 0, 0, 0)
__device__ __forceinline__ int crow(int r, int hi) { return (r & 3) + 8 * (r >> 2) + 4 * hi; }
typedef short v4i16_t __attribute__((ext_vector_type(4)));
__device__ __forceinline__ s16x4 vtr(LAS const unsigned char* p) { return __builtin_bit_cast(s16x4, __builtin_amdgcn_ds_read_tr16_b64_v4i16((LAS v4i16_t*)p)); }
typedef float f32x2_t __attribute__((ext_vector_type(2)));
typedef __bf16 bf16x2_t __attribute__((ext_vector_type(2)));
__device__ __forceinline__ unsigned cvtpk_s(float lo, float hi) { f32x2_t v = {lo, hi}; bf16x2_t b = __builtin_convertvector(v, bf16x2_t); return __builtin_bit_cast(unsigned, b); }
__device__ __forceinline__ bf16x8 pack8(const f32x16& x, int s) {
    v4u p; p.x = cvtpk_s(x[8 * s], x[8 * s + 1]); p.y = cvtpk_s(x[8 * s + 2], x[8 * s + 3]); p.z = cvtpk_s(x[8 * s + 4], x[8 * s + 5]); p.w = cvtpk_s(x[8 * s + 6], x[8 * s + 7]);
    return __builtin_bit_cast(bf16x8, p);
}

__device__ __forceinline__ void glds16(const void* sbase, unsigned voff, unsigned lds_dst) { unsigned keep;
    asm volatile("s_mov_b32 %0, m0\n\ts_mov_b32 m0, %3\n\ts_nop 0\n\tglobal_load_lds_dwordx4 %1, %2\n\ts_mov_b32 m0, %0" : "=&s"(keep) : "v"(voff), "s"(sbase), "s"(lds_dst) : "memory"); }
template <bool TAIL>
__device__ __forceinline__ void flash_half(f32x16 (&O)[4], f32x16& Sc, f32x16& Sn, float& m_run, float& l_run, bf16x8& mfrag, const bf16x8& onefrag, const bf16x8 (&qf)[4],
                                           LAS const unsigned char* Kn, LAS const unsigned char* Vc, unsigned ka, int kx, unsigned va, int vx, int blk, int hi, int key0, int qrow, int qmin) {
    if (TAIL) {
        const int kb = key0 + 4 * hi;
#pragma unroll
        for (int i = 0; i < 16; ++i) { const int key = kb + (i & 3) + 8 * (i >> 2); if (key > qrow) Sc[i] = -1e30f; }
    }
    float mloc = fmaxf(Sc[0], Sc[1]);
#pragma unroll
    for (int i = 2; i < 16; ++i) mloc = fmaxf(mloc, Sc[i]);
    mloc = max_x32(mloc);
    const bool first = (key0 == 0);
    if (__any(mloc > 8.f) || first) {
        const float m_new = (mloc > 8.f || first) ? __builtin_bit_cast(float, f2bf(m_run + mloc) << 16) : m_run;
        const float delta = m_new - m_run, alpha = __builtin_amdgcn_exp2f(-delta);
        l_run *= alpha;
#pragma unroll
        for (int d = 0; d < 4; ++d)
#pragma unroll
            for (int i = 0; i < 16; ++i) O[d][i] *= alpha;
#pragma unroll
        for (int i = 0; i < 16; ++i) Sc[i] -= delta;
        m_run = m_new;
        mfrag[0] = hi ? (short)0 : (short)(f2bf(-m_new));
    }
#pragma unroll
    for (int i = 0; i < 16; ++i) Sn[i] = 0.f;
    Sn = MFMA32(onefrag, mfrag, Sn);
#pragma unroll
    for (int ks = 0; ks < 4; ++ks) {
        const bf16x8 a0 = *(LAS const bf16x8*)(Kn + ka + (((2 * ks + hi) ^ kx) << 4));
        Sn = MFMA32(a0, qf[ks], Sn);
    }
    float ls = 0.f;
#pragma unroll
    for (int i = 0; i < 16; ++i) { Sc[i] = __builtin_amdgcn_exp2f(Sc[i]); ls += Sc[i]; }
    l_run += ls;
#pragma unroll
    for (int kk = 0; kk < 2; ++kk) {
        if (kk == 1) __builtin_amdgcn_sched_barrier(0);
        const bf16x8 pb = pack8(Sc, kk);
#pragma unroll
        for (int d = 0; d < 4; ++d) {
            LAS const unsigned char* p = Vc + va + kk * 4096 + (((2 * d + blk) ^ vx) << 5);
            const s16x4 lo = vtr(p), hi4 = vtr(p + 2048);
            const bf16x8 a = __builtin_shufflevector(lo, hi4, 0, 1, 2, 3, 4, 5, 6, 7);
            O[d] = MFMA32(a, pb, O[d]);
        }
    }
}

constexpr int DA_V = 49152, KT = 128;
__device__ __forceinline__ void flash_map(f32x16 (&O)[4], LAS unsigned char* lds, const bf16* QKV, int qcol, int kcol, int vcol, int qb, int w, int lane, int tid) {
    const int r32 = lane & 31, hi = lane >> 5;
    const int qmin = qb * 256 + w * 32, qrow = qmin + r32;
    bf16x8 qf[4];
    { const int lq = opaque(lane);
      const bf16* qp = QKV + (size_t)(qmin + (lq & 31)) * PW + qcol + 8 * (lq >> 5);
#pragma unroll
      for (int ks = 0; ks < 4; ++ks) qf[ks] = *(const bf16x8*)(qp + 16 * ks); }
#pragma unroll
    for (int d = 0; d < 4; ++d)
#pragma unroll
        for (int i = 0; i < 16; ++i) O[d][i] = 0.f;
    float m_run = 0.f, l_run = 0.f;
    bf16x8 mfrag = {0, 0, 0, 0, 0, 0, 0, 0}, onefrag = {0, 0, 0, 0, 0, 0, 0, 0}; onefrag[0] = hi ? (short)0 : (short)0x3F80;
    const int nkt = 2 * (qb + 1), nmain = 2 * qb;
    const int krow = tid >> 3, kc = (tid & 7) ^ ((krow >> 1) & 7);
    const unsigned kgo = (unsigned)(krow * PW + kc * 8) * 2u;
    const int vrow = tid >> 4, vpos = tid & 15, vc = ((((vpos >> 1) ^ (2 * (vrow & 3)))) << 1) | (vpos & 1);
    const unsigned vgo = (unsigned)(vrow * PW + vc * 8) * 2u;
    const bf16* kg = QKV + kcol; const bf16* vg = QKV + vcol;
    const unsigned wl = (unsigned)(tid >> 6) * 1024u;
    const size_t tstep = (size_t)KT * PW;
#define DMA16(g, vo, l) glds16((g), (vo), (unsigned)__builtin_amdgcn_readfirstlane((int)(unsigned)(size_t)(l)))
#define DMA_K(t, slot) do { const bf16* g_ = kg + (size_t)(t) * tstep; DMA16(g_, kgo, lds + (slot) + wl); DMA16(g_ + (size_t)64 * PW, kgo, lds + (slot) + 8192 + wl); } while (0)
#define DMA_V(t, b) do { const bf16* g_ = vg + (size_t)(t) * tstep; LAS unsigned char* l_ = lds + DA_V + (b) * 32768 + wl; \
        DMA16(g_, vgo, l_); DMA16(g_ + (size_t)32 * PW, vgo, l_ + 8192); DMA16(g_ + (size_t)64 * PW, vgo, l_ + 16384); DMA16(g_ + (size_t)96 * PW, vgo, l_ + 24576); } while (0)
    const unsigned ka = r32 * 128;
    const int kx = (r32 >> 1) & 7;
    const int q4 = (lane & 15) >> 2, p4 = lane & 3, blk = (lane >> 4) & 1;
    const int vr0 = 4 * hi + q4;
    const unsigned va = DA_V + vr0 * 256 + 8 * p4;
    const int vx = 2 * q4;
    DMA_K(0, 0); DMA_K(1, 16384); DMA_V(0, 0);
    asm volatile("s_waitcnt vmcnt(0) lgkmcnt(0)\n\ts_barrier" ::: "memory");
    f32x16 S0, S1;
#pragma unroll
    for (int i = 0; i < 16; ++i) S0[i] = 0.f;
#pragma unroll
    for (int ks = 0; ks < 4; ++ks) S0 = MFMA32(*(LAS const bf16x8*)(lds + ka + (((2 * ks + hi) ^ kx) << 4)), qf[ks], S0);
    int kb0 = 0, kb1 = 16384, kb2 = 32768;
    for (int kt = 0; kt < nkt; ++kt) {
        const int buf = kt & 1;
        if (kt + 2 < nkt) DMA_K(kt + 2, kb2);
        if (kt + 1 < nkt) DMA_V(kt + 1, buf ^ 1);
        LAS const unsigned char* Kc = lds + kb0; LAS const unsigned char* Vb = lds + buf * 32768;
        if (kt < nmain) {
            flash_half<false>(O, S0, S1, m_run, l_run, mfrag, onefrag, qf, Kc + 4096, Vb, ka, kx, va, vx, blk, hi, kt * KT, qrow, qmin);
            flash_half<false>(O, S1, S0, m_run, l_run, mfrag, onefrag, qf, Kc + 8192, Vb + 8192, ka, kx, va, vx, blk, hi, kt * KT + 32, qrow, qmin);
            flash_half<false>(O, S0, S1, m_run, l_run, mfrag, onefrag, qf, Kc + 12288, Vb + 16384, ka, kx, va, vx, blk, hi, kt * KT + 64, qrow, qmin);
            flash_half<false>(O, S1, S0, m_run, l_run, mfrag, onefrag, qf, lds + kb1, Vb + 24576, ka, kx, va, vx, blk, hi, kt * KT + 96, qrow, qmin);
        } else {
            flash_half<true>(O, S0, S1, m_run, l_run, mfrag, onefrag, qf, Kc + 4096, Vb, ka, kx, va, vx, blk, hi, kt * KT, qrow, qmin);
            flash_half<true>(O, S1, S0, m_run, l_run, mfrag, onefrag, qf, Kc + 8192, Vb + 8192, ka, kx, va, vx, blk, hi, kt * KT + 32, qrow, qmin);
            flash_half<true>(O, S0, S1, m_run, l_run, mfrag, onefrag, qf, Kc + 12288, Vb + 16384, ka, kx, va, vx, blk, hi, kt * KT + 64, qrow, qmin);
            flash_half<true>(O, S1, S0, m_run, l_run, mfrag, onefrag, qf, lds + kb1, Vb + 24576, ka, kx, va, vx, blk, hi, kt * KT + 96, qrow, qmin);
        }
        asm volatile("s_waitcnt vmcnt(0) lgkmcnt(0)\n\ts_barrier" ::: "memory");
        const int t0 = kb0; kb0 = kb1; kb1 = kb2; kb2 = t0;
    }
#undef DMA16
#undef DMA_K
#undef DMA_V
    const float l = sum_x32(l_run), inv = 1.f / l;
#pragma unroll
    for (int d = 0; d < 4; ++d)
#pragma unroll
        for (int i = 0; i < 16; ++i) O[d][i] *= inv;
}

__device__ __forceinline__ void headnorm_store(const f32x16 (&O)[4], const float* g, float post, bf16* MIX, int qrow, int col0, int hi) {
    float ss = 0.f;
#pragma unroll
    for (int d = 0; d < 4; ++d)
#pragma unroll
        for (int i = 0; i < 16; ++i) ss += O[d][i] * O[d][i];
    ss = sum_x32(ss);
    const float rs = __builtin_amdgcn_rsqf(ss * (1.f / 128.f) + EPS) * post;
    f32x4 gvv[4][4];
#pragma unroll
    for (int d = 0; d < 4; ++d)
#pragma unroll
        for (int gq = 0; gq < 4; ++gq) gvv[d][gq] = *(const f32x4*)(g + 32 * d + 8 * gq + 4 * hi);
    asm volatile("" ::: "memory");
#pragma unroll
    for (int d = 0; d < 4; ++d)
#pragma unroll
        for (int gq = 0; gq < 4; ++gq) {
            const int dv = 32 * d + 8 * gq + 4 * hi;
            const f32x4 gv = gvv[d][gq];
            v2u w; w.x = cvtpk_s(O[d][4 * gq] * rs * gv[0], O[d][4 * gq + 1] * rs * gv[1]); w.y = cvtpk_s(O[d][4 * gq + 2] * rs * gv[2], O[d][4 * gq + 3] * rs * gv[3]);
            *(v2u*)(MIX + (size_t)qrow * DM + col0 + dv) = w;
        }
}

__device__ __forceinline__ void diff_unit(LAS unsigned char* lds, const bf16* QKV, bf16* MIX, float* o1s, const float* gd, float lam, int head, int qb, int w, int lane, int tid) {
    f32x16 O[4];
#pragma unroll 1
    for (int j = 0; j < 2; ++j) {
        flash_map(O, lds, QKV, COL_DQ + head * 128 + 64 * j, COL_DK + head * 128 + 64 * j, COL_DV + head * 128, qb, w, lane, tid);
        if (j == 0) {
            f32x4* sc = (f32x4*)(o1s + ((size_t)(blockIdx.x * NWAVES + w) * 64 + opaque(lane)) * 64);
#pragma unroll
            for (int d = 0; d < 4; ++d)
#pragma unroll
                for (int i = 0; i < 4; ++i) sc[d * 4 + i] = (f32x4){O[d][4 * i], O[d][4 * i + 1], O[d][4 * i + 2], O[d][4 * i + 3]};
        }
    }
    lane = opaque(lane);
    const f32x4* sc = (const f32x4*)(o1s + ((size_t)(blockIdx.x * NWAVES + w) * 64 + lane) * 64);
#pragma unroll
    for (int d = 0; d < 4; ++d)
#pragma unroll
        for (int i = 0; i < 4; ++i) { const f32x4 t = sc[d * 4 + i];
#pragma unroll
            for (int e = 0; e < 4; ++e) O[d][4 * i + e] = t[e] - lam * O[d][4 * i + e]; }
    headnorm_store(O, gd, 1.f - LAM_INIT, MIX, qb * 256 + w * 32 + (lane & 31), head * 128, lane >> 5);
}

constexpr float SB_STOP = -44.f * 1.4426950408889634f;
__device__ __forceinline__ void sb_unit(LAS unsigned char* vl, const bf16* QKV, bf16* MIX, const float* gs, int head, int qg, int lane) {
    const int r32 = lane & 31, hi = lane >> 5;
    const int qrow = qg * 32 + r32;
    bf16x8 qf[8];
#pragma unroll
    for (int ks = 0; ks < 8; ++ks) qf[ks] = *(const bf16x8*)(QKV + (size_t)qrow * PW + COL_SQ + head * 128 + 16 * ks + 8 * hi);
    f32x16 O[4];
#pragma unroll
    for (int d = 0; d < 4; ++d)
#pragma unroll
        for (int i = 0; i < 16; ++i) O[d][i] = 0.f;
    float R = 0.f;
    const int q4 = (lane & 15) >> 2, p4 = lane & 3, blk = (lane >> 4) & 1;
    const int vr0 = 4 * hi + q4, vx = vr0 & 7;
    const unsigned va = vr0 * 256 + 8 * p4;
    const bf16* kgp = QKV + (size_t)r32 * PW + COL_SK + head * 128 + 8 * hi;
    const bf16* vgp = QKV + (size_t)(lane >> 4) * PW + COL_SV + head * 128 + (lane & 15) * 8;
    bf16x8 kf[8]; v4u vreg[8];
#pragma unroll
    for (int ks = 0; ks < 8; ++ks) kf[ks] = *(const bf16x8*)(kgp + (size_t)(qg * 32) * PW + 16 * ks);
#pragma unroll
    for (int i = 0; i < 8; ++i) vreg[i] = *(const v4u*)(vgp + (size_t)(qg * 32 + 4 * i) * PW);
    for (int kt = qg; kt >= 0; --kt) {
        const int k0 = kt * 32;
        f32x16 S;
#pragma unroll
        for (int i = 0; i < 16; ++i) S[i] = 0.f;
#pragma unroll
        for (int ks = 0; ks < 8; ++ks) S = MFMA32(kf[ks], qf[ks], S);
        LDS_WAIT();
#pragma unroll
        for (int i = 0; i < 8; ++i) { const int row = 4 * i + (lane >> 4), c = lane & 15; *(LAS v4u*)(vl + row * 256 + (((c >> 1) ^ (row & 7)) << 5) + ((c & 1) << 4)) = vreg[i]; }
        if (kt > 0) {
#pragma unroll
            for (int ks = 0; ks < 8; ++ks) kf[ks] = *(const bf16x8*)(kgp + (size_t)(k0 - 32) * PW + 16 * ks);
#pragma unroll
            for (int i = 0; i < 8; ++i) vreg[i] = *(const v4u*)(vgp + (size_t)(k0 - 32 + 4 * i) * PW);
        }
        float lb[16], lom[16];
#pragma unroll
        for (int i = 0; i < 16; ++i) {
            const int key = k0 + crow(i, hi); const float z = S[i];
            const float sp = __builtin_amdgcn_logf(1.f + __builtin_amdgcn_exp2f(-fabsf(z)));
            lb[i] = fminf(z, 0.f) - sp;
            lom[i] = (key < qrow) ? lb[i] - z : 0.f;
        }
        float gsum[4], pgs[4], after[4];
#pragma unroll
        for (int g = 0; g < 4; ++g) { gsum[g] = (lom[4 * g] + lom[4 * g + 1]) + (lom[4 * g + 2] + lom[4 * g + 3]); pgs[g] = partner_x32(gsum[g], hi); }
        float run = 0.f;
#pragma unroll
        for (int g = 3; g >= 0; --g) { after[g] = run + (hi == 0 ? pgs[g] : 0.f); run += gsum[g] + pgs[g]; }
#pragma unroll
        for (int g = 0; g < 4; ++g) {
            float suf = R + after[g];
#pragma unroll
            for (int e = 3; e >= 0; --e) {
                const int i = 4 * g + e; const int key = k0 + crow(i, hi);
                S[i] = (key < qrow) ? __builtin_amdgcn_exp2f(lb[i] + suf) : 0.f;
                suf += lom[i];
            }
        }
        R += run;
        LDS_WAIT();
#pragma unroll
        for (int kk = 0; kk < 2; ++kk) {
            const bf16x8 pb = pack8(S, kk);
#pragma unroll
            for (int d = 0; d < 4; ++d) {
                LAS const unsigned char* p = vl + va + kk * 4096 + (((2 * d + blk) ^ vx) << 5);
                const s16x4 lo = vtr(p), hi4 = vtr(p + 2048);
                const bf16x8 a = __builtin_shufflevector(lo, hi4, 0, 1, 2, 3, 4, 5, 6, 7);
                O[d] = MFMA32(a, pb, O[d]);
            }
        }
        if (__all(R < SB_STOP)) break;
    }
    LDS_WAIT();
    headnorm_store(O, gs, 1.f, MIX, qrow, 1024 + head * 128, hi);
}
__device__ __forceinline__ void transpose_item(const float* W, int K, int N, bf16* WT, const float* g, LAS float* scr, int item, int lane) {
    const int nblk = N / 32, kb = item / nblk, nb = item % nblk, k0 = 64 * kb, n0 = 32 * nb;
    const int r8 = lane >> 3, c4 = (lane & 7) * 4;
    f32x4 v[8];
#pragma unroll
    for (int i = 0; i < 8; ++i) v[i] = __builtin_nontemporal_load((const f32x4*)(W + (size_t)(k0 + r8 + 8 * i) * N + n0 + c4));
#pragma unroll
    for (int i = 0; i < 8; ++i) { const int kk = r8 + 8 * i; const float gs = g ? g[k0 + kk] : 1.f;
#pragma unroll
        for (int e = 0; e < 4; ++e) scr[kk * 33 + c4 + e] = v[i][e] * gs; }
    LDS_WAIT();
    const int c = lane & 7;
#pragma unroll
    for (int j = 0; j < 4; ++j) { const int n = (lane >> 3) + 8 * j; const LAS float* sp = scr + (8 * c) * 33 + n;
        v4u o; o.x = pk2(sp[0 * 33], sp[1 * 33]); o.y = pk2(sp[2 * 33], sp[3 * 33]); o.z = pk2(sp[4 * 33], sp[5 * 33]); o.w = pk2(sp[6 * 33], sp[7 * 33]);
        *(v4u*)(WT + (size_t)(n0 + n) * K + k0 + 8 * c) = o; }
    LDS_WAIT();
}

#define XB_TMO      128
#define XB_XCNT(j)  (256  + 64 * (j))
#define XB_XSUB(j)  (1280 + 64 * (j))
#define XB_XGEN(j)  (2304 + 64 * (j))
#define XB_TOP      3328
#define XB_TOPGEN   3392
#define XCD_BAR_WORDS 3456
#define XB_SPIN_CAP (1u << 18)
__device__ __forceinline__ unsigned xb_ld(unsigned* p)              { return __hip_atomic_load(p, __ATOMIC_RELAXED, __HIP_MEMORY_SCOPE_AGENT); }
__device__ __forceinline__ unsigned xb_add(unsigned* p, unsigned v) { return __hip_atomic_fetch_add(p, v, __ATOMIC_RELAXED, __HIP_MEMORY_SCOPE_AGENT); }
__device__ __forceinline__ unsigned xb_xcc_id() { return (unsigned)__builtin_amdgcn_s_getreg((3 << 11) | 20) & 0xFu; }
#define XB_SPIN(cond, bar) do { unsigned _sp = 0; while (cond) { __builtin_amdgcn_s_sleep(1); \
    if ((++_sp & 255u) == 0u) { if (xb_ld(&(bar)[XB_TMO])) break; if (_sp > XB_SPIN_CAP) { atomicAdd(&(bar)[XB_TMO], 1u); break; } } } } while (0)

struct XcdBarrier {
    unsigned* bar; unsigned x;
    volatile LAS unsigned* st;
};

__device__ __forceinline__ XcdBarrier xcd_barrier_post(unsigned* bar, volatile LAS unsigned* st, bool t0) {
    XcdBarrier b; b.bar = bar; b.x = xb_xcc_id(); b.st = st;
    if (t0) (void)xb_add(&bar[XB_XCNT(b.x)], 1u);
    return b;
}
__device__ __forceinline__ void xcd_barrier_complete(unsigned* bar, unsigned x, unsigned& nloc, unsigned& nx) {
    const unsigned G = gridDim.x * gridDim.y * gridDim.z;
    unsigned sum, cnt, mine, sp = 0u;
    for (;;) {
        sum = 0u; cnt = 0u; mine = 0u;
#pragma unroll
        for (unsigned j = 0; j < 16; ++j) { const unsigned c = xb_ld(&bar[XB_XCNT(j)]); sum += c; cnt += (c > 0u) ? 1u : 0u; mine = (j == x) ? c : mine; }
        if (sum == G) break;
        __builtin_amdgcn_s_sleep(1);
        if ((++sp & 255u) == 0u) { if (xb_ld(&bar[XB_TMO])) break; if (sp > XB_SPIN_CAP) { atomicAdd(&bar[XB_TMO], 1u); break; } }
    }
    nloc = mine > 0u ? mine : 1u; nx = cnt > 0u ? cnt : 1u;
}

__device__ __forceinline__ void xcd_barrier(const XcdBarrier& b, bool t0) {
    asm volatile("s_waitcnt vmcnt(0)" ::: "memory");
    __syncthreads();
    if (t0) {
        unsigned* bar = b.bar;
        __builtin_amdgcn_s_waitcnt(0);
        unsigned nloc = b.st[0], nx = b.st[1];
        if (nloc == 0u) { xcd_barrier_complete(bar, b.x, nloc, nx); b.st[0] = nloc; b.st[1] = nx; }
        const unsigned old = xb_add(&bar[XB_XSUB(b.x)], 1u);
        const unsigned gen = old / nloc;
        if (old + 1u == (gen + 1u) * nloc) {
            __builtin_amdgcn_fence(__ATOMIC_RELEASE, "agent");
            asm volatile("s_waitcnt vmcnt(0)" ::: "memory");
            const unsigned og = xb_add(&bar[XB_TOP], 1u);
            const unsigned tg = og / nx;
            if (og + 1u == (tg + 1u) * nx) xb_add(&bar[XB_TOPGEN], 1u);
            else XB_SPIN(xb_ld(&bar[XB_TOPGEN]) == tg, bar);
            __builtin_amdgcn_fence(__ATOMIC_ACQUIRE, "agent");
            xb_add(&bar[XB_XGEN(b.x)], 1u);
            asm volatile("s_waitcnt vmcnt(0)" ::: "memory");
        } else {
            XB_SPIN(xb_ld(&bar[XB_XGEN(b.x)]) == gen, bar);
            __builtin_amdgcn_fence(__ATOMIC_ACQUIRE, "agent");
            asm volatile("s_waitcnt vmcnt(0)" ::: "memory");
        }
    }
    __syncthreads();
}

__device__ __forceinline__ void grid_bar(unsigned* ctr, unsigned nblk, int wave_id) {
    asm volatile("s_waitcnt vmcnt(0) lgkmcnt(0)" ::: "memory");
    __syncthreads();
    if (wave_id == 0 && __builtin_amdgcn_mbcnt_hi(~0u, __builtin_amdgcn_mbcnt_lo(~0u, 0u)) == 0) {
        __builtin_amdgcn_fence(__ATOMIC_RELEASE, "agent");
        asm volatile("s_waitcnt vmcnt(0)" ::: "memory");
        __hip_atomic_fetch_add(ctr, 1u, __ATOMIC_RELAXED, __HIP_MEMORY_SCOPE_AGENT);
        while (__hip_atomic_load(ctr, __ATOMIC_RELAXED, __HIP_MEMORY_SCOPE_AGENT) < nblk) __builtin_amdgcn_s_sleep(2);
        __builtin_amdgcn_fence(__ATOMIC_ACQUIRE, "agent");
        asm volatile("s_waitcnt vmcnt(0)" ::: "memory");
    }
    __syncthreads();
}

struct Args { const float* in[14]; float* out; unsigned char* ws; float inv_freq[8]; int ph_lo, ph_hi; };

__global__ void __launch_bounds__(NTHR, 2) hybrid_fwd(Args args) {
    extern __shared__ __attribute__((aligned(16))) unsigned char lds_raw[];
    LAS unsigned char* lds = (LAS unsigned char*)lds_raw;
    cg::grid_group grid = cg::this_grid();
    const int wave = __builtin_amdgcn_readfirstlane((int)threadIdx.x >> 6);
    const int G = gridDim.x, bx = blockIdx.x;
    const int gw = bx * NWAVES + wave, NGW = G * NWAVES;
#define FRESH_IDS const int lane = opaque((int)__builtin_amdgcn_mbcnt_hi(~0u, __builtin_amdgcn_mbcnt_lo(~0u, 0u))), tid = wave * 64 + lane
    unsigned char* ws = args.ws;
    const float* x = args.in[0]; const float* ln1 = args.in[1]; const float* w_in = args.in[2];
    const float* lq1 = args.in[3]; const float* lk1 = args.in[4]; const float* lq2 = args.in[5]; const float* lk2 = args.in[6];
    const float* g_diff = args.in[7]; const float* g_sb = args.in[8]; const float* w_out = args.in[9]; const float* ln2 = args.in[10];
    const float* w1 = args.in[11]; const float* w2 = args.in[12]; const float* ln_f = args.in[13];
    float* out = args.out;
    bf16* Win_t = (bf16*)(ws + WS_WIN); bf16* Wout_t = (bf16*)(ws + WS_WOUT); bf16* W1_t = (bf16*)(ws + WS_W1); bf16* W2_t = (bf16*)(ws + WS_W2);
    float* cs = (float*)(ws + WS_CS); float* ss1 = (float*)(ws + WS_SS1); float* ss2 = (float*)(ws + WS_SS2);
    bf16* Hb = (bf16*)(ws + WS_H); bf16* QKV = (bf16*)(ws + WS_QKV); bf16* MIX = (bf16*)(ws + WS_MIX); bf16* U = (bf16*)(ws + WS_U);
    const int lo = args.ph_lo, hi_ph = args.ph_hi;
#define IN(k) (lo <= (k) && (k) < hi_ph)
#ifndef SKIPMASK
#define SKIPMASK 0
#endif
#define SKIP(k) ((SKIPMASK >> (k)) & 1)
    unsigned* ctl = (unsigned*)(ws + WS_CTL);
    const bool t0 = (wave == 0) && (__builtin_amdgcn_mbcnt_hi(~0u, __builtin_amdgcn_mbcnt_lo(~0u, 0u)) == 0);
    if (args.ph_lo < 0) grid.sync();
    volatile LAS unsigned* bst = (volatile LAS unsigned*)(lds + RING_BYTES);
    if (t0) { bst[0] = 0u; bst[1] = 0u; }
    __syncthreads();
    XcdBarrier xbar = xcd_barrier_post(ctl + 1024, bst, t0);
#define SEAM(k) do { if (IN(k) && IN((k) + 1)) xcd_barrier(xbar, t0); } while (0)
#ifndef REP0
#define REP0 1
#endif
    for (int rep0 = 0; rep0 < REP0; ++rep0)
    if (IN(0) && !SKIP(0)) {
        FRESH_IDS;
        LAS float* scr = (LAS float*)(lds + wave * 16384);
        constexpr int I_IN = (DM / 64) * (PW / 32), I_OUT = (DM / 64) * (DM / 32), I_1 = (DM / 64) * (FF / 32), I_2 = (FF / 64) * (DM / 32);
        constexpr int NITEMS = I_IN + I_OUT + I_1 + I_2;
        for (int it = gw; it < NITEMS; it += NGW) {
            int r = it;
            if (r < I_IN) { transpose_item(w_in, DM, PW, Win_t, nullptr, scr, r, lane); continue; } r -= I_IN;
            if (r < I_OUT) { transpose_item(w_out, DM, DM, Wout_t, nullptr, scr, r, lane); continue; } r -= I_OUT;
            if (r < I_1) { transpose_item(w1, DM, FF, W1_t, ln2, scr, r, lane); continue; } r -= I_1;
            transpose_item(w2, FF, DM, W2_t, nullptr, scr, r, lane);
        }
        for (int m = gw; m < M; m += NGW) {
            const f32x4* xr = (const f32x4*)(x + (size_t)m * DM) + lane; const f32x4* gr = (const f32x4*)ln1 + lane;
            f32x4 v[8], gv[8]; float s = 0.f;
#pragma unroll
            for (int j = 0; j < 8; ++j) { v[j] = __builtin_nontemporal_load(xr + 64 * j); gv[j] = gr[64 * j]; }
#pragma unroll
            for (int j = 0; j < 8; ++j) s += (v[j][0] * v[j][0] + v[j][1] * v[j][1]) + (v[j][2] * v[j][2] + v[j][3] * v[j][3]);
            const float rstd = 1.f / sqrtf(wave_sum(s) * (1.f / DM) + EPS);
            v2u* o8 = (v2u*)(Hb + (size_t)m * DM) + lane;
#pragma unroll
            for (int j = 0; j < 8; ++j) { const f32x4 gq = gv[j]; v2u w; w.x = pk2(v[j][0] * rstd * gq[0], v[j][1] * rstd * gq[1]); w.y = pk2(v[j][2] * rstd * gq[2], v[j][3] * rstd * gq[3]); o8[64 * j] = w; }
        }
        for (int e = bx * NTHR + tid; e < SEQ * 8; e += G * NTHR) {
            const int pos = e >> 3, i = e & 7;
            const float ang = (float)pos * args.inv_freq[i];
            const double rev = (double)ang * 0.15915494309189533577; const float fr = (float)(rev - rint(rev));
            cs[pos * 16 + i] = __builtin_amdgcn_cosf(fr); cs[pos * 16 + 8 + i] = __builtin_amdgcn_sinf(fr);
        }
        for (int e = bx * NTHR + tid; e < SEQ; e += G * NTHR) { ss1[e] = 0.f; ss2[e] = 0.f; }
    }
    SEAM(0);
#ifndef REP1
#define REP1 1
#endif
    for (int rep1 = 0; rep1 < REP1; ++rep1)
    if (IN(1) && !SKIP(1)) {
        pg8::Gemm g{Hb, Win_t, M, PW, DM}; pg8::StaticOrder S; S.init(M, PW, G, bx);
        EpiQKV E{QKV, cs};
        pg8::gemm_phase<EpiQKV, pg8::StaticOrder, true, true>(lds, g, S, E, wave);
    }
    SEAM(1);
#ifndef REP2
#define REP2 1
#endif
    for (int rep2 = 0; rep2 < REP2; ++rep2)
    if (IN(2) && !SKIP(2)) {
        FRESH_IDS;
        const float a = lq1[lane] * lk1[lane], b = lq2[lane] * lk2[lane];
        const float lam = __builtin_bit_cast(float, __builtin_amdgcn_readfirstlane(__builtin_bit_cast(int, __expf(wave_sum(a)) - __expf(wave_sum(b)) + LAM_INIT)));
        float* o1s = (float*)(ws + WS_H);
#ifndef NO_DIFF
        for (int u = bx; u < 256; u += G) {
            const int head = u & 7, p = u >> 3;
#pragma unroll 1
            for (int t = 0; t < 2; ++t) diff_unit(lds, QKV, MIX, o1s, g_diff, lam, head, t ? 63 - p : p, wave, lane, tid);
        }
#endif
        __syncthreads();
#ifndef NO_SB
        const int lane_sb = opaque(lane);
#ifndef REPSB
#define REPSB 1
#endif
        for (int repsb = 0; repsb < REPSB; ++repsb)
        for (int wu = gw; wu < 8 * 512; wu += NGW) sb_unit(lds + wave * 8192, QKV, MIX, g_sb, wu & 7, 511 - (wu >> 3), lane_sb);
#endif
        __syncthreads();
    }
    SEAM(2);
    if (IN(3) && !SKIP(3)) {
        pg8::Gemm g{MIX, Wout_t, M, DM, DM}; pg8::StaticOrder S; S.init(M, DM, G, bx);
        EpiRes E{x, out, Hb, ss1};
        pg8::gemm_phase<EpiRes, pg8::StaticOrder, false, true>(lds, g, S, E, wave);
    }
    SEAM(3);
    if (IN(4) && !SKIP(4)) {
        pg8::Gemm g{Hb, W1_t, M, FF, DM}; pg8::StaticOrder S; S.init(M, FF, G, bx);
        EpiMlpIn E{U, ss1};
        pg8::gemm_phase<EpiMlpIn, pg8::StaticOrder, true, true>(lds, g, S, E, wave);
    }
    SEAM(4);
    if (IN(5) && !SKIP(5)) {
        pg8::Gemm g{U, W2_t, M, DM, FF}; pg8::StaticOrder S; S.init(M, DM, G, bx);
        EpiRes E{out, out, nullptr, ss2};
        pg8::gemm_phase<EpiRes, pg8::StaticOrder, false, true>(lds, g, S, E, wave);
    }
    SEAM(5);
    if (IN(6) && !SKIP(6)) {
        FRESH_IDS;
        for (int m = gw; m < M; m += NGW) {
            f32x4* xr = (f32x4*)(out + (size_t)m * DM) + lane; const f32x4* gr = (const f32x4*)ln_f + lane;
            f32x4 v[8], gv[8];
#pragma unroll
            for (int j = 0; j < 8; ++j) { v[j] = xr[64 * j]; gv[j] = gr[64 * j]; }
            const float rstd = 1.f / sqrtf(__hip_atomic_load(ss2 + m, __ATOMIC_RELAXED, __HIP_MEMORY_SCOPE_AGENT) * (1.f / DM) + EPS);
            asm volatile("" ::: "memory");
#pragma unroll
            for (int j = 0; j < 8; ++j) __builtin_nontemporal_store(v[j] * rstd * gv[j], xr + 64 * j);
        }
    }
#ifdef EXTRA_BARS
    for (int e = 0; e < EXTRA_BARS; ++e) grid_bar(ctl + 64 * (8 + e), (unsigned)G, wave);
#endif
#undef IN
#undef SEAM
}

#ifndef N_LAUNCHES
#define N_LAUNCHES 1
#endif
extern "C" void kernel_launch(void* const* d_in, const int* in_sizes, int n_in, void* d_out, int out_size, void* d_ws, size_t ws_size, hipStream_t stream) {
    static int grid = 0;
    if (grid == 0) {
        if (n_in != 14 || in_sizes[0] != M * DM || out_size != M * DM || ws_size < WS_END) { fprintf(stderr, "kernel_launch: unexpected shapes (n_in %d, in0 %d, out %d, ws %zu)\n", n_in, n_in > 0 ? in_sizes[0] : -1, out_size, ws_size); grid = -1; return; }
        int dev = 0, cus = 0, per_cu = 0;
        (void)hipGetDevice(&dev); (void)hipDeviceGetAttribute(&cus, hipDeviceAttributeMultiprocessorCount, dev);
        if (hipFuncSetAttribute((const void*)hybrid_fwd, hipFuncAttributeMaxDynamicSharedMemorySize, LDS_BYTES) != hipSuccess) { fprintf(stderr, "kernel_launch: hipFuncSetAttribute failed\n"); grid = -1; return; }
        if (hipOccupancyMaxActiveBlocksPerMultiprocessor(&per_cu, (const void*)hybrid_fwd, NTHR, LDS_BYTES) != hipSuccess || per_cu < 1) { fprintf(stderr, "kernel_launch: occupancy query gave %d\n", per_cu); per_cu = 1; }
        (void)hipGetLastError();
        grid = cus * per_cu;
    }
    if (grid < 0) return;
    if (hipMemsetAsync((char*)d_ws + WS_CTL, 0, 32768, stream) != hipSuccess) { fprintf(stderr, "kernel_launch: memset failed\n"); return; }
    Args a{};
    for (int i = 0; i < 14; ++i) a.in[i] = (const float*)d_in[i];
    a.out = (float*)d_out; a.ws = (unsigned char*)d_ws;
    for (int i = 0; i < 8; ++i) a.inv_freq[i] = (float)pow(500000.0, -(double)i / 8.0);
    const int cuts1[2] = {0, 7};
    const int cuts7[8] = {0, 1, 2, 3, 4, 5, 6, 7};
    const int* cuts = (N_LAUNCHES == 1) ? cuts1 : cuts7;
    for (int li = 0; li < N_LAUNCHES; ++li) {
        a.ph_lo = cuts[li]; a.ph_hi = cuts[li + 1];
        void* kargs[] = {&a};
        hipError_t e = hipLaunchCooperativeKernel((const void*)hybrid_fwd, dim3(grid), dim3(NTHR), kargs, LDS_BYTES, stream);
        if (e != hipSuccess) { fprintf(stderr, "kernel_launch: cooperative launch %d failed: %s (grid %d)\n", li, hipGetErrorString(e), grid); break; }
    }
}
```

```cpp
#include <hip/hip_runtime.h>
#include <hip/hip_cooperative_groups.h>
#include <cstdio>
#include <cstdint>
#include <cmath>
namespace cg = cooperative_groups;
namespace pg8 {
#define PG8_LAS __attribute__((address_space(3)))
typedef unsigned short bf16_t;
typedef short bf16x8 __attribute__((ext_vector_type(8)));
typedef float f32x4 __attribute__((ext_vector_type(4)));
typedef unsigned u32x4 __attribute__((ext_vector_type(4)));
constexpr int BM = 256, BK = 64, HALF = 128, HTB = HALF * BK * 2  , STAGE_BYTES = 8 * HTB, NXCD = 8, WGM = 8;

__host__ __device__ __forceinline__ int lds_byte(int r, int c) { const int st = (r >> 4) * 2 + (c >> 5), rr = r & 15, cc = c & 31, ob = rr * 64 + cc * 2; return st * 1024 + (ob ^ (((ob >> 9) & 1) << 5)); }
__host__ __device__ __forceinline__ void stage_rc(int b, int& R, int& C) { const int st = b / 1024, sb = b % 1024, swz = sb ^ (((sb >> 9) & 1) << 5); R = (st >> 1) * 16 + swz / 64; C = (st & 1) * 32 + (swz % 64) / 2; }
__host__ __device__ __forceinline__ int perm32(int rho) { const int n = rho >> 4, i = rho & 15; return 8 * (i >> 2) + 4 * n + (i & 3); }

struct Unit { int pm, pn; };
struct Gemm { const bf16_t* A; const bf16_t* Bt; int M, N, K; };

struct StaticOrder {
    int nM, nN, nwg, G, c;
    __host__ __device__ void init(int M, int N, int G_, int c_) { nM = M / BM; nN = N / BM; nwg = nM * nN; G = G_; c = c_; }
    __host__ __device__ bool next(int i, Unit& u) const {
        const long L = (long)i * G + c; if (L >= nwg) return false;
        int wgid = (int)L; { const int q = nwg / NXCD, r = nwg % NXCD, xcd = wgid % NXCD, off = wgid / NXCD; wgid = (xcd < r ? xcd * (q + 1) : r * (q + 1) + (xcd - r) * q) + off; }
        const int nig = WGM * nN, gid = wgid / nig, fm = gid * WGM, gsz = (nM - fm) < WGM ? (nM - fm) : WGM;
        u.pm = fm + ((wgid % nig) % gsz); u.pn = (wgid % nig) / gsz; return true;
    }
    __device__ __forceinline__ void a_ready(const Unit&) const {}
    __device__ __forceinline__ void done(const Unit&) const {}
};

__device__ __forceinline__ unsigned cvt_pk_bf16(float lo, float hi) { unsigned r; asm volatile("v_cvt_pk_bf16_f32 %0, %1, %2" : "=v"(r) : "v"(lo), "v"(hi)); return r; }
template <class Epi, class Sched, bool ALIGN_EPI = false, bool SP2 = false>
__device__ __forceinline__ void gemm_phase(PG8_LAS unsigned char* lds, const Gemm g, const Sched& S, const Epi& E, int wave_id) {
    int tid_ = wave_id * 64 + (int)__builtin_amdgcn_mbcnt_hi(~0u, __builtin_amdgcn_mbcnt_lo(~0u, 0u)); asm volatile("" : "+v"(tid_));
    const int tid = tid_, wid = __builtin_amdgcn_readfirstlane(tid >> 6), lane = tid & 63, wr = wid >> 2, wc = wid & 3, fr = lane & 15, fq = lane >> 4;
    const int K = g.K, nt = K / BK;
    unsigned voffA[2], voffB[2];
#pragma unroll
    for (int i = 0; i < 2; ++i) { int R, C; stage_rc(tid * 16 + i * 8192, R, C); const int Rb = Epi::PERM ? ((R & ~31) + perm32(R & 31)) : R;
        voffA[i] = (unsigned)(R * K + C) * 2u; voffB[i] = (unsigned)(Rb * K + C) * 2u; }
    const size_t kstep = (size_t)(BK * 2);
    const size_t hstep = (size_t)HALF * K * 2;
    const size_t tstep = 2 * hstep;
    const unsigned ldsw = (unsigned)wid * 1024u;
    const int aoff = lds_byte(wr * 64 + fr, fq * 8), boff = lds_byte(wc * 32 + fr, fq * 8);
#define PG8_SA(b, h) (((b) * 2 + (h)) * HTB)
#define PG8_SB(b, h) ((4 + (b) * 2 + (h)) * HTB)
#define PG8_STAGE(bufoff, gbase, voff) do { _Pragma("unroll") for (int _i = 0; _i < 2; ++_i) \
        __builtin_amdgcn_global_load_lds((const unsigned*)((const char*)(gbase) + (voff)[_i]), (PG8_LAS unsigned*)(lds + (bufoff) + ldsw + _i * 8192), 16, 0, 0); } while (0)
#define PG8_LDA(dst, b, h) do { _Pragma("unroll") for (int m = 0; m < 4; ++m) _Pragma("unroll") for (int k = 0; k < 2; ++k) dst[m][k] = *(const PG8_LAS bf16x8*)(lds + PG8_SA(b, h) + aoff + m * 2048 + k * 1024); } while (0)
#define PG8_LDB(dst, b, h) do { _Pragma("unroll") for (int n = 0; n < 2; ++n) _Pragma("unroll") for (int k = 0; k < 2; ++k) dst[n][k] = *(const PG8_LAS bf16x8*)(lds + PG8_SB(b, h) + boff + n * 2048 + k * 1024); } while (0)
#define PG8_MMA(ai, bj, At, Bt) do { __builtin_amdgcn_s_setprio(1); _Pragma("unroll") for (int m = 0; m < 4; ++m) _Pragma("unroll") for (int n = 0; n < 2; ++n) _Pragma("unroll") for (int k = 0; k < 2; ++k) \
        acc[ai][bj][m][n] = __builtin_amdgcn_mfma_f32_16x16x32_bf16(Bt[n][k], At[m][k], acc[ai][bj][m][n], 0, 0, 0); __builtin_amdgcn_s_setprio(0); } while (0)
#define PG8_WAIT_V(n) asm volatile("s_waitcnt vmcnt(" #n ")" ::: "memory")
#define PG8_WAIT_L(n) asm volatile("s_waitcnt lgkmcnt(" #n ")" ::: "memory")
#define PG8_BAR __builtin_amdgcn_s_barrier()
#define PG8_SCHED __builtin_amdgcn_sched_barrier(0)
    Unit cur, nxt; int ui = 0;
    if (!S.next(0, cur)) return;
    f32x4 acc[2][2][4][2];
#pragma unroll
    for (int a = 0; a < 2; ++a)
#pragma unroll
        for (int b = 0; b < 2; ++b)
#pragma unroll
            for (int m = 0; m < 4; ++m)
#pragma unroll
                for (int n = 0; n < 2; ++n) acc[a][b][m][n] = (f32x4){0.f, 0.f, 0.f, 0.f};
    bf16x8 At[4][2], B0[2][2], B1[2][2];
    const char* cA = (const char*)g.A + (size_t)cur.pm * tstep; const char* cB = (const char*)g.Bt + (size_t)cur.pn * tstep;
    S.a_ready(cur);
    if constexpr (SP2) {
        PG8_STAGE(PG8_SB(0, 0), cB, voffB); PG8_STAGE(PG8_SB(0, 1), cB + hstep, voffB); PG8_STAGE(PG8_SA(0, 0), cA, voffA); PG8_STAGE(PG8_SA(0, 1), cA + hstep, voffA);
        if (wr == 1) PG8_BAR;
        PG8_WAIT_V(2); PG8_BAR;
        PG8_STAGE(PG8_SB(1, 0), cB + kstep, voffB); PG8_STAGE(PG8_SA(1, 0), cA + kstep, voffA); PG8_STAGE(PG8_SB(1, 1), cB + hstep + kstep, voffB);
        PG8_WAIT_V(6); PG8_BAR;
    } else {
        PG8_STAGE(PG8_SB(0, 0), cB, voffB); PG8_STAGE(PG8_SA(0, 0), cA, voffA); PG8_STAGE(PG8_SB(0, 1), cB + hstep, voffB); PG8_STAGE(PG8_SA(0, 1), cA + hstep, voffA);
        if (wr == 1) PG8_BAR;
        PG8_WAIT_V(4); PG8_BAR;
        PG8_STAGE(PG8_SB(1, 0), cB + kstep, voffB); PG8_STAGE(PG8_SA(1, 0), cA + kstep, voffA); PG8_STAGE(PG8_SB(1, 1), cB + hstep + kstep, voffB);
        PG8_WAIT_V(6); PG8_BAR;
    }
    for (;;) {
        const bool has_next = S.next(ui + 1, nxt);
        const char* nA = has_next ? (const char*)g.A + (size_t)nxt.pm * tstep : cA; const char* nB = has_next ? (const char*)g.Bt + (size_t)nxt.pn * tstep : cB;
        for (int t = 0; t < nt; t += 2) {
            const bool last = (t == nt - 2);
            const char* a1 = cA + (size_t)(t + 1) * kstep;
            const char* a2 = last ? nA : cA + (size_t)(t + 2) * kstep; const char* b2 = last ? nB : cB + (size_t)(t + 2) * kstep;
            const char* a3 = a2 + kstep; const char* b3 = b2 + kstep;
            if (last && has_next) S.a_ready(nxt);
            if constexpr (SP2) {
            PG8_LDB(B0, 0, 0); PG8_LDB(B1, 0, 1); PG8_SCHED; PG8_LDA(At, 0, 0); PG8_STAGE(PG8_SA(1, 1), a1 + hstep, voffA);
            PG8_WAIT_V(8); PG8_WAIT_L(0); PG8_BAR; PG8_MMA(0, 0, At, B0); PG8_MMA(0, 1, At, B1); PG8_BAR; PG8_SCHED;
            PG8_LDA(At, 0, 1); PG8_STAGE(PG8_SB(0, 0), b2, voffB); PG8_STAGE(PG8_SB(0, 1), b2 + hstep, voffB); PG8_STAGE(PG8_SA(0, 0), a2, voffA);
            PG8_WAIT_V(8); PG8_WAIT_L(0); PG8_BAR; PG8_MMA(1, 0, At, B0); PG8_MMA(1, 1, At, B1); PG8_BAR; PG8_SCHED;
            PG8_LDB(B0, 1, 0); PG8_LDB(B1, 1, 1); PG8_SCHED; PG8_LDA(At, 1, 0); PG8_STAGE(PG8_SA(0, 1), a2 + hstep, voffA);
            PG8_WAIT_V(8); PG8_WAIT_L(0); PG8_BAR; PG8_MMA(0, 0, At, B0); PG8_MMA(0, 1, At, B1); PG8_BAR; PG8_SCHED;
            PG8_LDA(At, 1, 1); PG8_STAGE(PG8_SB(1, 0), b3, voffB); PG8_STAGE(PG8_SB(1, 1), b3 + hstep, voffB); PG8_STAGE(PG8_SA(1, 0), a3, voffA);
            PG8_WAIT_V(8); PG8_WAIT_L(0); PG8_BAR; PG8_MMA(1, 0, At, B0); PG8_MMA(1, 1, At, B1); PG8_BAR; PG8_SCHED;
            } else {
            PG8_LDB(B0, 0, 0); PG8_SCHED; PG8_LDA(At, 0, 0); PG8_STAGE(PG8_SA(1, 1), a1 + hstep, voffA);
            PG8_WAIT_L(8); PG8_BAR; PG8_WAIT_L(0); PG8_MMA(0, 0, At, B0); PG8_BAR; PG8_SCHED;
            PG8_LDB(B1, 0, 1); PG8_STAGE(PG8_SB(0, 0), b2, voffB);
            PG8_BAR; PG8_WAIT_L(0); PG8_MMA(0, 1, At, B1); PG8_BAR;
            PG8_LDA(At, 0, 1); PG8_STAGE(PG8_SA(0, 0), a2, voffA);
            PG8_BAR; PG8_WAIT_L(0); PG8_MMA(1, 0, At, B0); PG8_BAR; PG8_SCHED;
            PG8_STAGE(PG8_SB(0, 1), b2 + hstep, voffB);
            PG8_WAIT_V(6); PG8_BAR; PG8_MMA(1, 1, At, B1); PG8_BAR;
            PG8_LDB(B0, 1, 0); PG8_SCHED; PG8_LDA(At, 1, 0); PG8_STAGE(PG8_SA(0, 1), a2 + hstep, voffA);
            PG8_WAIT_L(8); PG8_BAR; PG8_WAIT_L(0); PG8_MMA(0, 0, At, B0); PG8_BAR; PG8_SCHED;
            PG8_LDB(B1, 1, 1); PG8_STAGE(PG8_SB(1, 0), b3, voffB);
            PG8_BAR; PG8_WAIT_L(0); PG8_MMA(0, 1, At, B1); PG8_BAR;
            PG8_LDA(At, 1, 1); PG8_STAGE(PG8_SA(1, 0), a3, voffA);
            PG8_BAR; PG8_WAIT_L(0); PG8_MMA(1, 0, At, B0); PG8_BAR; PG8_SCHED;
            PG8_STAGE(PG8_SB(1, 1), b3 + hstep, voffB);
            PG8_WAIT_V(6); PG8_BAR; PG8_MMA(1, 1, At, B1); PG8_BAR;
            }
        }
        if constexpr (ALIGN_EPI) { if (wr == 0) PG8_BAR; }
        if constexpr (!Epi::AFTER_DRAIN) { E(acc, cur, wr, wc, fr, fq); S.done(cur); }
        if (!has_next) break;
#pragma unroll
        for (int a = 0; a < 2; ++a)
#pragma unroll
            for (int b = 0; b < 2; ++b)
#pragma unroll
                for (int m = 0; m < 4; ++m)
#pragma unroll
                    for (int n = 0; n < 2; ++n) acc[a][b][m][n] = (f32x4){0.f, 0.f, 0.f, 0.f};
        cur = nxt; cA = nA; cB = nB; ++ui;
        if constexpr (ALIGN_EPI) { if (wr == 1) PG8_BAR; }
    }
    PG8_WAIT_V(0);
    if constexpr (!ALIGN_EPI) { if (wr == 0) PG8_BAR; }
    PG8_BAR;
    if constexpr (Epi::AFTER_DRAIN) { E.fused(acc, cur, wr, wc, fr, fq, lds, wid, lane); S.done(cur); }
#undef PG8_SA
#undef PG8_SB
#undef PG8_STAGE
#undef PG8_LDA
#undef PG8_LDB
#undef PG8_MMA
#undef PG8_WAIT_V
#undef PG8_WAIT_L
#undef PG8_BAR
#undef PG8_SCHED
}
}
#define GAS __attribute__((address_space(1)))
#define LAS __attribute__((address_space(3)))
typedef unsigned short bf16;
typedef unsigned v4u __attribute__((ext_vector_type(4)));
typedef unsigned v2u __attribute__((ext_vector_type(2)));
typedef float f32x4 __attribute__((ext_vector_type(4)));
typedef float f32x16 __attribute__((ext_vector_type(16)));
typedef short bf16x8 __attribute__((ext_vector_type(8)));
typedef short s16x4 __attribute__((ext_vector_type(4)));
using pg8::Unit; using pg8::cvt_pk_bf16; using pg8::BM; using pg8::HALF;

constexpr int SEQ = 16384, DM = 2048, PW = 6144, FF = 8192, M = SEQ;
constexpr int NWAVES = 8, NTHR = 512;
constexpr float EPS = 1e-6f;
constexpr float C2 = 0.125f * 1.4426950408889634f;
constexpr float SBSCALE = 0.08838834764831845f * 1.4426950408889634f;
constexpr float LAM_INIT = 0.2f;
constexpr int COL_DQ = 0, COL_DK = 1024, COL_DV = 2048, COL_SQ = 3072, COL_SK = 4096, COL_SV = 5120;

constexpr size_t MiB = 1u << 20;
constexpr size_t WS_WIN = 0;
constexpr size_t WS_WOUT = 24 * MiB;
constexpr size_t WS_W1 = 32 * MiB;
constexpr size_t WS_W2 = 64 * MiB;
constexpr size_t WS_CS = 96 * MiB;
constexpr size_t WS_SS1 = 97 * MiB;
constexpr size_t WS_SS2 = 97 * MiB + 65536;
constexpr size_t WS_H = 98 * MiB;
constexpr size_t WS_QKV = 162 * MiB;
constexpr size_t WS_MIX = 354 * MiB;
constexpr size_t WS_U = 162 * MiB;
constexpr size_t WS_CTL = 418 * MiB;
constexpr size_t WS_END = 419 * MiB;

constexpr int RING_BYTES = 131072, LDS_BYTES = 131072 + 1024;

__device__ __forceinline__ unsigned f2bf(float f) { unsigned u = __builtin_bit_cast(unsigned, f); return (u + 0x7fffu + ((u >> 16) & 1u)) >> 16; }
__device__ __forceinline__ unsigned pk2(float lo, float hi) { return f2bf(lo) | (f2bf(hi) << 16); }
__device__ __forceinline__ float wave_sum(float v) {
#pragma unroll
    for (int o = 1; o < 64; o <<= 1) v += __shfl_xor(v, o);
    return v;
}
typedef unsigned u32x2_t __attribute__((ext_vector_type(2)));
__device__ __forceinline__ void swap_x32(float& a, float& b) { asm volatile("s_nop 1\n\tv_permlane32_swap_b32 %0, %1" : "+v"(a), "+v"(b)); }
__device__ __forceinline__ float max_x32(float x) { float a = x, b = x; swap_x32(a, b); return fmaxf(a, b); }
__device__ __forceinline__ float sum_x32(float x) { float a = x, b = x; swap_x32(a, b); return a + b; }
__device__ __forceinline__ float partner_x32(float x, int hi) { float a = x, b = x; swap_x32(a, b); return hi ? a : b; }
#define LDS_WAIT() asm volatile("s_waitcnt lgkmcnt(0)" ::: "memory")
__device__ __forceinline__ int opaque(int v) { asm volatile("" : "+v"(v)); return v; }

struct EpiQKV {
    static constexpr bool PERM = true, AFTER_DRAIN = false;
    bf16* O; const float* cs;
    __device__ __forceinline__ void operator()(const f32x4 (&acc)[2][2][4][2], const Unit& u, int wr, int wc, int fr, int fq) const {
        const int row0 = u.pm * BM + wr * 64 + fr, col0 = u.pn * BM + wc * 32 + 8 * fq;
        float sc = 1.f; if (u.pn < 4) sc = C2; else if (u.pn >= 12 && u.pn < 16) sc = SBSCALE;
        const bool rot = (u.pn < 8) && ((wc & 1) == 0);
        if (rot) {
#pragma unroll
            for (int ai = 0; ai < 2; ++ai) {
                f32x4 cv[4][4];
#pragma unroll
                for (int m = 0; m < 4; ++m) { const f32x4* p = (const f32x4*)(cs + (size_t)(row0 + ai * HALF + m * 16) * 16); cv[m][0] = p[0]; cv[m][1] = p[1]; cv[m][2] = p[2]; cv[m][3] = p[3]; }
#pragma unroll
                for (int m = 0; m < 4; ++m) {
                    const int row = row0 + ai * HALF + m * 16;
                    const f32x4 c0 = cv[m][0], c1 = cv[m][1]; f32x4 s0 = cv[m][2], s1 = cv[m][3]; if (fq == 0) { s0 = -s0; s1 = -s1; }
#pragma unroll
                    for (int bj = 0; bj < 2; ++bj) {
                        f32x4 v0 = acc[ai][bj][m][0] * sc, v1 = acc[ai][bj][m][1] * sc, p0, p1;
#pragma unroll
                        for (int e = 0; e < 4; ++e) { p0[e] = __shfl_xor(v0[e], 16); p1[e] = __shfl_xor(v1[e], 16); }
                        if (fq < 2) { v0 = v0 * c0 + p0 * s0; v1 = v1 * c1 + p1 * s1; }
                        v4u w; w.x = cvt_pk_bf16(v0[0], v0[1]); w.y = cvt_pk_bf16(v0[2], v0[3]); w.z = cvt_pk_bf16(v1[0], v1[1]); w.w = cvt_pk_bf16(v1[2], v1[3]);
                        *(v4u*)(O + (size_t)row * PW + col0 + bj * HALF) = w;
                    }
                }
            }
        } else {
#pragma unroll
            for (int ai = 0; ai < 2; ++ai)
#pragma unroll
                for (int m = 0; m < 4; ++m) {
                    const int row = row0 + ai * HALF + m * 16;
#pragma unroll
                    for (int bj = 0; bj < 2; ++bj) {
                        const f32x4 v0 = acc[ai][bj][m][0] * sc, v1 = acc[ai][bj][m][1] * sc;
                        v4u w; w.x = cvt_pk_bf16(v0[0], v0[1]); w.y = cvt_pk_bf16(v0[2], v0[3]); w.z = cvt_pk_bf16(v1[0], v1[1]); w.w = cvt_pk_bf16(v1[2], v1[3]);
                        *(v4u*)(O + (size_t)row * PW + col0 + bj * HALF) = w;
                    }
                }
        }
    }
};
struct EpiRes {
    static constexpr bool PERM = true, AFTER_DRAIN = false;
    const float* R; float* Y; bf16* Yb; float* ss;
    __device__ __forceinline__ void operator()(const f32x4 (&acc)[2][2][4][2], const Unit& u, int wr, int wc, int fr, int fq) const {
        const int row0 = u.pm * BM + wr * 64 + fr, col0 = u.pn * BM + wc * 32 + 8 * fq;
#pragma unroll
        for (int ai = 0; ai < 2; ++ai) {
            f32x4 rv[4][2][2];
#pragma unroll
            for (int m = 0; m < 4; ++m)
#pragma unroll
                for (int bj = 0; bj < 2; ++bj) { const size_t off = (size_t)(row0 + ai * HALF + m * 16) * DM + col0 + bj * HALF; rv[m][bj][0] = *(const f32x4*)(R + off); rv[m][bj][1] = *(const f32x4*)(R + off + 4); }
            asm volatile("" ::: "memory");
#pragma unroll
            for (int m = 0; m < 4; ++m) {
                const int row = row0 + ai * HALF + m * 16; float s = 0.f;
#pragma unroll
                for (int bj = 0; bj < 2; ++bj) {
                    const size_t off = (size_t)row * DM + col0 + bj * HALF;
                    const f32x4 v0 = acc[ai][bj][m][0] + rv[m][bj][0], v1 = acc[ai][bj][m][1] + rv[m][bj][1];
                    *(f32x4*)(Y + off) = v0; *(f32x4*)(Y + off + 4) = v1;
                    if (Yb) { v4u w; w.x = cvt_pk_bf16(v0[0], v0[1]); w.y = cvt_pk_bf16(v0[2], v0[3]); w.z = cvt_pk_bf16(v1[0], v1[1]); w.w = cvt_pk_bf16(v1[2], v1[3]); *(v4u*)(Yb + off) = w; }
                    s += (v0[0] * v0[0] + v0[1] * v0[1]) + (v0[2] * v0[2] + v0[3] * v0[3]) + (v1[0] * v1[0] + v1[1] * v1[1]) + (v1[2] * v1[2] + v1[3] * v1[3]);
                }
                s += __shfl_xor(s, 16); s += __shfl_xor(s, 32);
                if (fq == 0) atomicAdd(ss + row, s);
            }
        }
    }
};
struct EpiMlpIn {
    static constexpr bool PERM = true, AFTER_DRAIN = false;
    bf16* O; const float* ss;
    __device__ __forceinline__ void operator()(const f32x4 (&acc)[2][2][4][2], const Unit& u, int wr, int wc, int fr, int fq) const {
        const int row0 = u.pm * BM + wr * 64 + fr, col0 = u.pn * BM + wc * 32 + 8 * fq;
        float rs[2][4];
#pragma unroll
        for (int ai = 0; ai < 2; ++ai)
#pragma unroll
            for (int m = 0; m < 4; ++m) rs[ai][m] = __hip_atomic_load(ss + row0 + ai * HALF + m * 16, __ATOMIC_RELAXED, __HIP_MEMORY_SCOPE_AGENT);
        asm volatile("" ::: "memory");
#pragma unroll
        for (int ai = 0; ai < 2; ++ai)
#pragma unroll
            for (int m = 0; m < 4; ++m) {
                const int row = row0 + ai * HALF + m * 16;
                const float rstd = __builtin_amdgcn_rsqf(rs[ai][m] * (1.f / DM) + EPS);
#pragma unroll
                for (int bj = 0; bj < 2; ++bj) {
                    f32x4 v0 = acc[ai][bj][m][0] * rstd, v1 = acc[ai][bj][m][1] * rstd;
#pragma unroll
                    for (int e = 0; e < 4; ++e) { const float a = fmaxf(v0[e], 0.f), b = fmaxf(v1[e], 0.f); v0[e] = a * a; v1[e] = b * b; }
                    v4u w; w.x = cvt_pk_bf16(v0[0], v0[1]); w.y = cvt_pk_bf16(v0[2], v0[3]); w.z = cvt_pk_bf16(v1[0], v1[1]); w.w = cvt_pk_bf16(v1[2], v1[3]);
                    *(v4u*)(O + (size_t)row * FF + col0 + bj * HALF) = w;
                }
            }
    }
};
#define MFMA32(a, b, c) __builtin_amdgcn_mfma_f32_32x32x16_bf16((a), (b), (c), 0, 0, 0)
__device__ __forceinline__ int crow(int r, int hi) { return (r & 3) + 8 * (r >> 2) + 4 * hi; }
typedef short v4i16_t __attribute__((ext_vector_type(4)));
__device__ __forceinline__ s16x4 vtr(LAS const unsigned char* p) { return __builtin_bit_cast(s16x4, __builtin_amdgcn_ds_read_tr16_b64_v4i16((LAS v4i16_t*)p)); }
typedef float f32x2_t __attribute__((ext_vector_type(2)));
typedef __bf16 bf16x2_t __attribute__((ext_vector_type(2)));
__device__ __forceinline__ unsigned cvtpk_s(float lo, float hi) { f32x2_t v = {lo, hi}; bf16x2_t b = __builtin_convertvector(v, bf16x2_t); return __builtin_bit_cast(unsigned, b); }
__device__ __forceinline__ bf16x8 pack8(const f32x16& x, int s) {
    v4u p; p.x = cvtpk_s(x[8 * s], x[8 * s + 1]); p.y = cvtpk_s(x[8 * s + 2], x[8 * s + 3]); p.z = cvtpk_s(x[8 * s + 4], x[8 * s + 5]); p.w = cvtpk_s(x[8 * s + 6], x[8 * s + 7]);
    return __builtin_bit_cast(bf16x8, p);
}

__device__ __forceinline__ void glds16(const void* sbase, unsigned voff, unsigned lds_dst) { unsigned keep;
    asm volatile("s_mov_b32 %0, m0\n\ts_mov_b32 m0, %3\n\ts_nop 0\n\tglobal_load_lds_dwordx4 %1, %2\n\ts_mov_b32 m0, %0" : "=&s"(keep) : "v"(voff), "s"(sbase), "s"(lds_dst) : "memory"); }
template <bool TAIL>
__device__ __forceinline__ void flash_half(f32x16 (&O)[4], f32x16& Sc, f32x16& Sn, float& m_run, float& l_run, bf16x8& mfrag, const bf16x8& onefrag, const bf16x8 (&qf)[4],
                                           LAS const unsigned char* Kn, LAS const unsigned char* Vc, unsigned ka, int kx, unsigned va, int vx, int blk, int hi, int key0, int qrow, int qmin) {
    if (TAIL) {
        const int kb = key0 + 4 * hi;
#pragma unroll
        for (int i = 0; i < 16; ++i) { const int key = kb + (i & 3) + 8 * (i >> 2); if (key > qrow) Sc[i] = -1e30f; }
    }
    float mloc = fmaxf(Sc[0], Sc[1]);
#pragma unroll
    for (int i = 2; i < 16; ++i) mloc = fmaxf(mloc, Sc[i]);
    mloc = max_x32(mloc);
    const bool first = (key0 == 0);
    if (__any(mloc > 8.f) || first) {
        const float m_new = (mloc > 8.f || first) ? __builtin_bit_cast(float, f2bf(m_run + mloc) << 16) : m_run;
        const float delta = m_new - m_run, alpha = __builtin_amdgcn_exp2f(-delta);
        l_run *= alpha;
#pragma unroll
        for (int d = 0; d < 4; ++d)
#pragma unroll
            for (int i = 0; i < 16; ++i) O[d][i] *= alpha;
#pragma unroll
        for (int i = 0; i < 16; ++i) Sc[i] -= delta;
        m_run = m_new;
        mfrag[0] = hi ? (short)0 : (short)(f2bf(-m_new));
    }
#pragma unroll
    for (int i = 0; i < 16; ++i) Sn[i] = 0.f;
    Sn = MFMA32(onefrag, mfrag, Sn);
#pragma unroll
    for (int ks = 0; ks < 4; ++ks) {
        const bf16x8 a0 = *(LAS const bf16x8*)(Kn + ka + (((2 * ks + hi) ^ kx) << 4));
        Sn = MFMA32(a0, qf[ks], Sn);
    }
    float ls = 0.f;
#pragma unroll
    for (int i = 0; i < 16; ++i) { Sc[i] = __builtin_amdgcn_exp2f(Sc[i]); ls += Sc[i]; }
    l_run += ls;
#pragma unroll
    for (int kk = 0; kk < 2; ++kk) {
        if (kk == 1) __builtin_amdgcn_sched_barrier(0);
        const bf16x8 pb = pack8(Sc, kk);
#pragma unroll
        for (int d = 0; d < 4; ++d) {
            LAS const unsigned char* p = Vc + va + kk * 4096 + (((2 * d + blk) ^ vx) << 5);
            const s16x4 lo = vtr(p), hi4 = vtr(p + 2048);
            const bf16x8 a = __builtin_shufflevector(lo, hi4, 0, 1, 2, 3, 4, 5, 6, 7);
            O[d] = MFMA32(a, pb, O[d]);
        }
    }
}

constexpr int DA_V = 49152, KT = 128;
__device__ __forceinline__ void flash_map(f32x16 (&O)[4], LAS unsigned char* lds, const bf16* QKV, int qcol, int kcol, int vcol, int qb, int w, int lane, int tid) {
    const int r32 = lane & 31, hi = lane >> 5;
    const int qmin = qb * 256 + w * 32, qrow = qmin + r32;
    bf16x8 qf[4];
    { const int lq = opaque(lane);
      const bf16* qp = QKV + (size_t)(qmin + (lq & 31)) * PW + qcol + 8 * (lq >> 5);
#pragma unroll
      for (int ks = 0; ks < 4; ++ks) qf[ks] = *(const bf16x8*)(qp + 16 * ks); }
#pragma unroll
    for (int d = 0; d < 4; ++d)
#pragma unroll
        for (int i = 0; i < 16; ++i) O[d][i] = 0.f;
    float m_run = 0.f, l_run = 0.f;
    bf16x8 mfrag = {0, 0, 0, 0, 0, 0, 0, 0}, onefrag = {0, 0, 0, 0, 0, 0, 0, 0}; onefrag[0] = hi ? (short)0 : (short)0x3F80;
    const int nkt = 2 * (qb + 1), nmain = 2 * qb;
    const int krow = tid >> 3, kc = (tid & 7) ^ ((krow >> 1) & 7);
    const unsigned kgo = (unsigned)(krow * PW + kc * 8) * 2u;
    const int vrow = tid >> 4, vpos = tid & 15, vc = ((((vpos >> 1) ^ (2 * (vrow & 3)))) << 1) | (vpos & 1);
    const unsigned vgo = (unsigned)(vrow * PW + vc * 8) * 2u;
    const bf16* kg = QKV + kcol; const bf16* vg = QKV + vcol;
    const unsigned wl = (unsigned)(tid >> 6) * 1024u;
    const size_t tstep = (size_t)KT * PW;
#define DMA16(g, vo, l) glds16((g), (vo), (unsigned)__builtin_amdgcn_readfirstlane((int)(unsigned)(size_t)(l)))
#define DMA_K(t, slot) do { const bf16* g_ = kg + (size_t)(t) * tstep; DMA16(g_, kgo, lds + (slot) + wl); DMA16(g_ + (size_t)64 * PW, kgo, lds + (slot) + 8192 + wl); } while (0)
#define DMA_V(t, b) do { const bf16* g_ = vg + (size_t)(t) * tstep; LAS unsigned char* l_ = lds + DA_V + (b) * 32768 + wl; \
        DMA16(g_, vgo, l_); DMA16(g_ + (size_t)32 * PW, vgo, l_ + 8192); DMA16(g_ + (size_t)64 * PW, vgo, l_ + 16384); DMA16(g_ + (size_t)96 * PW, vgo, l_ + 24576); } while (0)
    const unsigned ka = r32 * 128;
    const int kx = (r32 >> 1) & 7;
    const int q4 = (lane & 15) >> 2, p4 = lane & 3, blk = (lane >> 4) & 1;
    const int vr0 = 4 * hi + q4;
    const unsigned va = DA_V + vr0 * 256 + 8 * p4;
    const int vx = 2 * q4;
    DMA_K(0, 0); DMA_K(1, 16384); DMA_V(0, 0);
    asm volatile("s_waitcnt vmcnt(0) lgkmcnt(0)\n\ts_barrier" ::: "memory");
    f32x16 S0, S1;
#pragma unroll
    for (int i = 0; i < 16; ++i) S0[i] = 0.f;
#pragma unroll
    for (int ks = 0; ks < 4; ++ks) S0 = MFMA32(*(LAS const bf16x8*)(lds + ka + (((2 * ks + hi) ^ kx) << 4)), qf[ks], S0);
    int kb0 = 0, kb1 = 16384, kb2 = 32768;
    for (int kt = 0; kt < nkt; ++kt) {
        const int buf = kt & 1;
        if (kt + 2 < nkt) DMA_K(kt + 2, kb2);
        if (kt + 1 < nkt) DMA_V(kt + 1, buf ^ 1);
        LAS const unsigned char* Kc = lds + kb0; LAS const unsigned char* Vb = lds + buf * 32768;
        if (kt < nmain) {
            flash_half<false>(O, S0, S1, m_run, l_run, mfrag, onefrag, qf, Kc + 4096, Vb, ka, kx, va, vx, blk, hi, kt * KT, qrow, qmin);
            flash_half<false>(O, S1, S0, m_run, l_run, mfrag, onefrag, qf, Kc + 8192, Vb + 8192, ka, kx, va, vx, blk, hi, kt * KT + 32, qrow, qmin);
            flash_half<false>(O, S0, S1, m_run, l_run, mfrag, onefrag, qf, Kc + 12288, Vb + 16384, ka, kx, va, vx, blk, hi, kt * KT + 64, qrow, qmin);
            flash_half<false>(O, S1, S0, m_run, l_run, mfrag, onefrag, qf, lds + kb1, Vb + 24576, ka, kx, va, vx, blk, hi, kt * KT + 96, qrow, qmin);
        } else {
            flash_half<true>(O, S0, S1, m_run, l_run, mfrag, onefrag, qf, Kc + 4096, Vb, ka, kx, va, vx, blk, hi, kt * KT, qrow, qmin);
            flash_half<true>(O, S1, S0, m_run, l_run, mfrag, onefrag, qf, Kc + 8192, Vb + 8192, ka, kx, va, vx, blk, hi, kt * KT + 32, qrow, qmin);
            flash_half<true>(O, S0, S1, m_run, l_run, mfrag, onefrag, qf, Kc + 12288, Vb + 16384, ka, kx, va, vx, blk, hi, kt * KT + 64, qrow, qmin);
            flash_half<true>(O, S1, S0, m_run, l_run, mfrag, onefrag, qf, lds + kb1, Vb + 24576, ka, kx, va, vx, blk, hi, kt * KT + 96, qrow, qmin);
        }
        asm volatile("s_waitcnt vmcnt(0) lgkmcnt(0)\n\ts_barrier" ::: "memory");
        const int t0 = kb0; kb0 = kb1; kb1 = kb2; kb2 = t0;
    }
#undef DMA16
#undef DMA_K
#undef DMA_V
    const float l = sum_x32(l_run), inv = 1.f / l;
#pragma unroll
    for (int d = 0; d < 4; ++d)
#pragma unroll
        for (int i = 0; i < 16; ++i) O[d][i] *= inv;
}

__device__ __forceinline__ void headnorm_store(const f32x16 (&O)[4], const float* g, float post, bf16* MIX, int qrow, int col0, int hi) {
    float ss = 0.f;
#pragma unroll
    for (int d = 0; d < 4; ++d)
#pragma unroll
        for (int i = 0; i < 16; ++i) ss += O[d][i] * O[d][i];
    ss = sum_x32(ss);
    const float rs = __builtin_amdgcn_rsqf(ss * (1.f / 128.f) + EPS) * post;
    f32x4 gvv[4][4];
#pragma unroll
    for (int d = 0; d < 4; ++d)
#pragma unroll
        for (int gq = 0; gq < 4; ++gq) gvv[d][gq] = *(const f32x4*)(g + 32 * d + 8 * gq + 4 * hi);
    asm volatile("" ::: "memory");
#pragma unroll
    for (int d = 0; d < 4; ++d)
#pragma unroll
        for (int gq = 0; gq < 4; ++gq) {
            const int dv = 32 * d + 8 * gq + 4 * hi;
            const f32x4 gv = gvv[d][gq];
            v2u w; w.x = cvtpk_s(O[d][4 * gq] * rs * gv[0], O[d][4 * gq + 1] * rs * gv[1]); w.y = cvtpk_s(O[d][4 * gq + 2] * rs * gv[2], O[d][4 * gq + 3] * rs * gv[3]);
            *(v2u*)(MIX + (size_t)qrow * DM + col0 + dv) = w;
        }
}

__device__ __forceinline__ void diff_unit(LAS unsigned char* lds, const bf16* QKV, bf16* MIX, float* o1s, const float* gd, float lam, int head, int qb, int w, int lane, int tid) {
    f32x16 O[4];
#pragma unroll 1
    for (int j = 0; j < 2; ++j) {
        flash_map(O, lds, QKV, COL_DQ + head * 128 + 64 * j, COL_DK + head * 128 + 64 * j, COL_DV + head * 128, qb, w, lane, tid);
        if (j == 0) {
            f32x4* sc = (f32x4*)(o1s + ((size_t)(blockIdx.x * NWAVES + w) * 64 + opaque(lane)) * 64);
#pragma unroll
            for (int d = 0; d < 4; ++d)
#pragma unroll
                for (int i = 0; i < 4; ++i) sc[d * 4 + i] = (f32x4){O[d][4 * i], O[d][4 * i + 1], O[d][4 * i + 2], O[d][4 * i + 3]};
        }
    }
    lane = opaque(lane);
    const f32x4* sc = (const f32x4*)(o1s + ((size_t)(blockIdx.x * NWAVES + w) * 64 + lane) * 64);
#pragma unroll
    for (int d = 0; d < 4; ++d)
#pragma unroll
        for (int i = 0; i < 4; ++i) { const f32x4 t = sc[d * 4 + i];
#pragma unroll
            for (int e = 0; e < 4; ++e) O[d][4 * i + e] = t[e] - lam * O[d][4 * i + e]; }
    headnorm_store(O, gd, 1.f - LAM_INIT, MIX, qb * 256 + w * 32 + (lane & 31), head * 128, lane >> 5);
}

constexpr float SB_STOP = -44.f * 1.4426950408889634f;
__device__ __forceinline__ void sb_unit(LAS unsigned char* vl, const bf16* QKV, bf16* MIX, const float* gs, int head, int qg, int lane) {
    const int r32 = lane & 31, hi = lane >> 5;
    const int qrow = qg * 32 + r32;
    bf16x8 qf[8];
#pragma unroll
    for (int ks = 0; ks < 8; ++ks) qf[ks] = *(const bf16x8*)(QKV + (size_t)qrow * PW + COL_SQ + head * 128 + 16 * ks + 8 * hi);
    f32x16 O[4];
#pragma unroll
    for (int d = 0; d < 4; ++d)
#pragma unroll
        for (int i = 0; i < 16; ++i) O[d][i] = 0.f;
    float R = 0.f;
    const int q4 = (lane & 15) >> 2, p4 = lane & 3, blk = (lane >> 4) & 1;
    const int vr0 = 4 * hi + q4, vx = vr0 & 7;
    const unsigned va = vr0 * 256 + 8 * p4;
    const bf16* kgp = QKV + (size_t)r32 * PW + COL_SK + head * 128 + 8 * hi;
    const bf16* vgp = QKV + (size_t)(lane >> 4) * PW + COL_SV + head * 128 + (lane & 15) * 8;
    bf16x8 kf[8]; v4u vreg[8];
#pragma unroll
    for (int ks = 0; ks < 8; ++ks) kf[ks] = *(const bf16x8*)(kgp + (size_t)(qg * 32) * PW + 16 * ks);
#pragma unroll
    for (int i = 0; i < 8; ++i) vreg[i] = *(const v4u*)(vgp + (size_t)(qg * 32 + 4 * i) * PW);
    for (int kt = qg; kt >= 0; --kt) {
        const int k0 = kt * 32;
        f32x16 S;
#pragma unroll
        for (int i = 0; i < 16; ++i) S[i] = 0.f;
#pragma unroll
        for (int ks = 0; ks < 8; ++ks) S = MFMA32(kf[ks], qf[ks], S);
        LDS_WAIT();
#pragma unroll
        for (int i = 0; i < 8; ++i) { const int row = 4 * i + (lane >> 4), c = lane & 15; *(LAS v4u*)(vl + row * 256 + (((c >> 1) ^ (row & 7)) << 5) + ((c & 1) << 4)) = vreg[i]; }
        if (kt > 0) {
#pragma unroll
            for (int ks = 0; ks < 8; ++ks) kf[ks] = *(const bf16x8*)(kgp + (size_t)(k0 - 32) * PW + 16 * ks);
#pragma unroll
            for (int i = 0; i < 8; ++i) vreg[i] = *(const v4u*)(vgp + (size_t)(k0 - 32 + 4 * i) * PW);
        }
        float lb[16], lom[16];
#pragma unroll
        for (int i = 0; i < 16; ++i) {
            const int key = k0 + crow(i, hi); const float z = S[i];
            const float sp = __builtin_amdgcn_logf(1.f + __builtin_amdgcn_exp2f(-fabsf(z)));
            lb[i] = fminf(z, 0.f) - sp;
            lom[i] = (key < qrow) ? lb[i] - z : 0.f;
        }
        float gsum[4], pgs[4], after[4];
#pragma unroll
        for (int g = 0; g < 4; ++g) { gsum[g] = (lom[4 * g] + lom[4 * g + 1]) + (lom[4 * g + 2] + lom[4 * g + 3]); pgs[g] = partner_x32(gsum[g], hi); }
        float run = 0.f;
#pragma unroll
        for (int g = 3; g >= 0; --g) { after[g] = run + (hi == 0 ? pgs[g] : 0.f); run += gsum[g] + pgs[g]; }
#pragma unroll
        for (int g = 0; g < 4; ++g) {
            float suf = R + after[g];
#pragma unroll
            for (int e = 3; e >= 0; --e) {
                const int i = 4 * g + e; const int key = k0 + crow(i, hi);
                S[i] = (key < qrow) ? __builtin_amdgcn_exp2f(lb[i] + suf) : 0.f;
                suf += lom[i];
            }
        }
        R += run;
        LDS_WAIT();
#pragma unroll
        for (int kk = 0; kk < 2; ++kk) {
            const bf16x8 pb = pack8(S, kk);
#pragma unroll
            for (int d = 0; d < 4; ++d) {
                LAS const unsigned char* p = vl + va + kk * 4096 + (((2 * d + blk) ^ vx) << 5);
                const s16x4 lo = vtr(p), hi4 = vtr(p + 2048);
                const bf16x8 a = __builtin_shufflevector(lo, hi4, 0, 1, 2, 3, 4, 5, 6, 7);
                O[d] = MFMA32(a, pb, O[d]);
            }
        }
        if (__all(R < SB_STOP)) break;
    }
    LDS_WAIT();
    headnorm_store(O, gs, 1.f, MIX, qrow, 1024 + head * 128, hi);
}
__device__ __forceinline__ void transpose_item(const float* W, int K, int N, bf16* WT, const float* g, LAS float* scr, int item, int lane) {
    const int nblk = N / 32, kb = item / nblk, nb = item % nblk, k0 = 64 * kb, n0 = 32 * nb;
    const int r8 = lane >> 3, c4 = (lane & 7) * 4;
    f32x4 v[8];
#pragma unroll
    for (int i = 0; i < 8; ++i) v[i] = __builtin_nontemporal_load((const f32x4*)(W + (size_t)(k0 + r8 + 8 * i) * N + n0 + c4));
#pragma unroll
    for (int i = 0; i < 8; ++i) { const int kk = r8 + 8 * i; const float gs = g ? g[k0 + kk] : 1.f;
#pragma unroll
        for (int e = 0; e < 4; ++e) scr[kk * 33 + c4 + e] = v[i][e] * gs; }
    LDS_WAIT();
    const int c = lane & 7;
#pragma unroll
    for (int j = 0; j < 4; ++j) { const int n = (lane >> 3) + 8 * j; const LAS float* sp = scr + (8 * c) * 33 + n;
        v4u o; o.x = pk2(sp[0 * 33], sp[1 * 33]); o.y = pk2(sp[2 * 33], sp[3 * 33]); o.z = pk2(sp[4 * 33], sp[5 * 33]); o.w = pk2(sp[6 * 33], sp[7 * 33]);
        *(v4u*)(WT + (size_t)(n0 + n) * K + k0 + 8 * c) = o; }
    LDS_WAIT();
}

#define XB_TMO      128
#define XB_XCNT(j)  (256  + 64 * (j))
#define XB_XSUB(j)  (1280 + 64 * (j))
#define XB_XGEN(j)  (2304 + 64 * (j))
#define XB_TOP      3328
#define XB_TOPGEN   3392
#define XCD_BAR_WORDS 3456
#define XB_SPIN_CAP (1u << 18)
__device__ __forceinline__ unsigned xb_ld(unsigned* p)              { return __hip_atomic_load(p, __ATOMIC_RELAXED, __HIP_MEMORY_SCOPE_AGENT); }
__device__ __forceinline__ unsigned xb_add(unsigned* p, unsigned v) { return __hip_atomic_fetch_add(p, v, __ATOMIC_RELAXED, __HIP_MEMORY_SCOPE_AGENT); }
__device__ __forceinline__ unsigned xb_xcc_id() { return (unsigned)__builtin_amdgcn_s_getreg((3 << 11) | 20) & 0xFu; }
#define XB_SPIN(cond, bar) do { unsigned _sp = 0; while (cond) { __builtin_amdgcn_s_sleep(1); \
    if ((++_sp & 255u) == 0u) { if (xb_ld(&(bar)[XB_TMO])) break; if (_sp > XB_SPIN_CAP) { atomicAdd(&(bar)[XB_TMO], 1u); break; } } } } while (0)

struct XcdBarrier {
    unsigned* bar; unsigned x;
    volatile LAS unsigned* st;
};

__device__ __forceinline__ XcdBarrier xcd_barrier_post(unsigned* bar, volatile LAS unsigned* st, bool t0) {
    XcdBarrier b; b.bar = bar; b.x = xb_xcc_id(); b.st = st;
    if (t0) (void)xb_add(&bar[XB_XCNT(b.x)], 1u);
    return b;
}
__device__ __forceinline__ void xcd_barrier_complete(unsigned* bar, unsigned x, unsigned& nloc, unsigned& nx) {
    const unsigned G = gridDim.x * gridDim.y * gridDim.z;
    unsigned sum, cnt, mine, sp = 0u;
    for (;;) {
        sum = 0u; cnt = 0u; mine = 0u;
#pragma unroll
        for (unsigned j = 0; j < 16; ++j) { const unsigned c = xb_ld(&bar[XB_XCNT(j)]); sum += c; cnt += (c > 0u) ? 1u : 0u; mine = (j == x) ? c : mine; }
        if (sum == G) break;
        __builtin_amdgcn_s_sleep(1);
        if ((++sp & 255u) == 0u) { if (xb_ld(&bar[XB_TMO])) break; if (sp > XB_SPIN_CAP) { atomicAdd(&bar[XB_TMO], 1u); break; } }
    }
    nloc = mine > 0u ? mine : 1u; nx = cnt > 0u ? cnt : 1u;
}

__device__ __forceinline__ void xcd_barrier(const XcdBarrier& b, bool t0) {
    asm volatile("s_waitcnt vmcnt(0)" ::: "memory");
    __syncthreads();
    if (t0) {
        unsigned* bar = b.bar;
        __builtin_amdgcn_s_waitcnt(0);
        unsigned nloc = b.st[0], nx = b.st[1];
        if (nloc == 0u) { xcd_barrier_complete(bar, b.x, nloc, nx); b.st[0] = nloc; b.st[1] = nx; }
        const unsigned old = xb_add(&bar[XB_XSUB(b.x)], 1u);
        const unsigned gen = old / nloc;
        if (old + 1u == (gen + 1u) * nloc) {
            __builtin_amdgcn_fence(__ATOMIC_RELEASE, "agent");
            asm volatile("s_waitcnt vmcnt(0)" ::: "memory");
            const unsigned og = xb_add(&bar[XB_TOP], 1u);
            const unsigned tg = og / nx;
            if (og + 1u == (tg + 1u) * nx) xb_add(&bar[XB_TOPGEN], 1u);
            else XB_SPIN(xb_ld(&bar[XB_TOPGEN]) == tg, bar);
            __builtin_amdgcn_fence(__ATOMIC_ACQUIRE, "agent");
            xb_add(&bar[XB_XGEN(b.x)], 1u);
            asm volatile("s_waitcnt vmcnt(0)" ::: "memory");
        } else {
            XB_SPIN(xb_ld(&bar[XB_XGEN(b.x)]) == gen, bar);
            __builtin_amdgcn_fence(__ATOMIC_ACQUIRE, "agent");
            asm volatile("s_waitcnt vmcnt(0)" ::: "memory");
        }
    }
    __syncthreads();
}

struct Args { const float* in[14]; float* out; unsigned char* ws; float inv_freq[8]; int ph_lo, ph_hi; };

__global__ void __launch_bounds__(NTHR, 2) hybrid_fwd(Args args) {
    extern __shared__ __attribute__((aligned(16))) unsigned char lds_raw[];
    LAS unsigned char* lds = (LAS unsigned char*)lds_raw;
    cg::grid_group grid = cg::this_grid();
    const int wave = __builtin_amdgcn_readfirstlane((int)threadIdx.x >> 6);
    const int G = gridDim.x, bx = blockIdx.x;
    const int gw = bx * NWAVES + wave, NGW = G * NWAVES;
#define FRESH_IDS const int lane = opaque((int)__builtin_amdgcn_mbcnt_hi(~0u, __builtin_amdgcn_mbcnt_lo(~0u, 0u))), tid = wave * 64 + lane
    unsigned char* ws = args.ws;
    const float* x = args.in[0]; const float* ln1 = args.in[1]; const float* w_in = args.in[2];
    const float* lq1 = args.in[3]; const float* lk1 = args.in[4]; const float* lq2 = args.in[5]; const float* lk2 = args.in[6];
    const float* g_diff = args.in[7]; const float* g_sb = args.in[8]; const float* w_out = args.in[9]; const float* ln2 = args.in[10];
    const float* w1 = args.in[11]; const float* w2 = args.in[12]; const float* ln_f = args.in[13];
    float* out = args.out;
    bf16* Win_t = (bf16*)(ws + WS_WIN); bf16* Wout_t = (bf16*)(ws + WS_WOUT); bf16* W1_t = (bf16*)(ws + WS_W1); bf16* W2_t = (bf16*)(ws + WS_W2);
    float* cs = (float*)(ws + WS_CS); float* ss1 = (float*)(ws + WS_SS1); float* ss2 = (float*)(ws + WS_SS2);
    bf16* Hb = (bf16*)(ws + WS_H); bf16* QKV = (bf16*)(ws + WS_QKV); bf16* MIX = (bf16*)(ws + WS_MIX); bf16* U = (bf16*)(ws + WS_U);
    const int lo = args.ph_lo, hi_ph = args.ph_hi;
#define IN(k) (lo <= (k) && (k) < hi_ph)
    unsigned* ctl = (unsigned*)(ws + WS_CTL);
    const bool t0 = (wave == 0) && (__builtin_amdgcn_mbcnt_hi(~0u, __builtin_amdgcn_mbcnt_lo(~0u, 0u)) == 0);
    if (args.ph_lo < 0) grid.sync();
    volatile LAS unsigned* bst = (volatile LAS unsigned*)(lds + RING_BYTES);
    if (t0) { bst[0] = 0u; bst[1] = 0u; }
    __syncthreads();
    XcdBarrier xbar = xcd_barrier_post(ctl + 1024, bst, t0);
#define SEAM(k) do { if (IN(k) && IN((k) + 1)) xcd_barrier(xbar, t0); } while (0)
    if (IN(0)) {
        FRESH_IDS;
        LAS float* scr = (LAS float*)(lds + wave * 16384);
        constexpr int I_IN = (DM / 64) * (PW / 32), I_OUT = (DM / 64) * (DM / 32), I_1 = (DM / 64) * (FF / 32), I_2 = (FF / 64) * (DM / 32);
        constexpr int NITEMS = I_IN + I_OUT + I_1 + I_2;
        for (int it = gw; it < NITEMS; it += NGW) {
            int r = it;
            if (r < I_IN) { transpose_item(w_in, DM, PW, Win_t, nullptr, scr, r, lane); continue; } r -= I_IN;
            if (r < I_OUT) { transpose_item(w_out, DM, DM, Wout_t, nullptr, scr, r, lane); continue; } r -= I_OUT;
            if (r < I_1) { transpose_item(w1, DM, FF, W1_t, ln2, scr, r, lane); continue; } r -= I_1;
            transpose_item(w2, FF, DM, W2_t, nullptr, scr, r, lane);
        }
        for (int m = gw; m < M; m += NGW) {
            const f32x4* xr = (const f32x4*)(x + (size_t)m * DM) + lane; const f32x4* gr = (const f32x4*)ln1 + lane;
            f32x4 v[8], gv[8]; float s = 0.f;
#pragma unroll
            for (int j = 0; j < 8; ++j) { v[j] = __builtin_nontemporal_load(xr + 64 * j); gv[j] = gr[64 * j]; }
#pragma unroll
            for (int j = 0; j < 8; ++j) s += (v[j][0] * v[j][0] + v[j][1] * v[j][1]) + (v[j][2] * v[j][2] + v[j][3] * v[j][3]);
            const float rstd = 1.f / sqrtf(wave_sum(s) * (1.f / DM) + EPS);
            v2u* o8 = (v2u*)(Hb + (size_t)m * DM) + lane;
#pragma unroll
            for (int j = 0; j < 8; ++j) { const f32x4 gq = gv[j]; v2u w; w.x = pk2(v[j][0] * rstd * gq[0], v[j][1] * rstd * gq[1]); w.y = pk2(v[j][2] * rstd * gq[2], v[j][3] * rstd * gq[3]); o8[64 * j] = w; }
        }
        for (int e = bx * NTHR + tid; e < SEQ * 8; e += G * NTHR) {
            const int pos = e >> 3, i = e & 7;
            const float ang = (float)pos * args.inv_freq[i];
            const double rev = (double)ang * 0.15915494309189533577; const float fr = (float)(rev - rint(rev));
            cs[pos * 16 + i] = __builtin_amdgcn_cosf(fr); cs[pos * 16 + 8 + i] = __builtin_amdgcn_sinf(fr);
        }
        for (int e = bx * NTHR + tid; e < SEQ; e += G * NTHR) { ss1[e] = 0.f; ss2[e] = 0.f; }
    }
    SEAM(0);
    if (IN(1)) {
        pg8::Gemm g{Hb, Win_t, M, PW, DM}; pg8::StaticOrder S; S.init(M, PW, G, bx);
        EpiQKV E{QKV, cs};
        pg8::gemm_phase<EpiQKV, pg8::StaticOrder, true, true>(lds, g, S, E, wave);
    }
    SEAM(1);
    if (IN(2)) {
        FRESH_IDS;
        const float a = lq1[lane] * lk1[lane], b = lq2[lane] * lk2[lane];
        const float lam = __builtin_bit_cast(float, __builtin_amdgcn_readfirstlane(__builtin_bit_cast(int, __expf(wave_sum(a)) - __expf(wave_sum(b)) + LAM_INIT)));
        float* o1s = (float*)(ws + WS_H);
        for (int u = bx; u < 256; u += G) {
            const int head = u & 7, p = u >> 3;
#pragma unroll 1
            for (int t = 0; t < 2; ++t) diff_unit(lds, QKV, MIX, o1s, g_diff, lam, head, t ? 63 - p : p, wave, lane, tid);
        }
        __syncthreads();
        const int lane_sb = opaque(lane);
        for (int wu = gw; wu < 8 * 512; wu += NGW) sb_unit(lds + wave * 8192, QKV, MIX, g_sb, wu & 7, 511 - (wu >> 3), lane_sb);
        __syncthreads();
    }
    SEAM(2);
    if (IN(3)) {
        pg8::Gemm g{MIX, Wout_t, M, DM, DM}; pg8::StaticOrder S; S.init(M, DM, G, bx);
        EpiRes E{x, out, Hb, ss1};
        pg8::gemm_phase<EpiRes, pg8::StaticOrder, false, true>(lds, g, S, E, wave);
    }
    SEAM(3);
    if (IN(4)) {
        pg8::Gemm g{Hb, W1_t, M, FF, DM}; pg8::StaticOrder S; S.init(M, FF, G, bx);
        EpiMlpIn E{U, ss1};
        pg8::gemm_phase<EpiMlpIn, pg8::StaticOrder, true, true>(lds, g, S, E, wave);
    }
    SEAM(4);
    if (IN(5)) {
        pg8::Gemm g{U, W2_t, M, DM, FF}; pg8::StaticOrder S; S.init(M, DM, G, bx);
        EpiRes E{out, out, nullptr, ss2};
        pg8::gemm_phase<EpiRes, pg8::StaticOrder, false, true>(lds, g, S, E, wave);
    }
    SEAM(5);
    if (IN(6)) {
        FRESH_IDS;
        for (int m = gw; m < M; m += NGW) {
            f32x4* xr = (f32x4*)(out + (size_t)m * DM) + lane; const f32x4* gr = (const f32x4*)ln_f + lane;
            f32x4 v[8], gv[8];
#pragma unroll
            for (int j = 0; j < 8; ++j) { v[j] = xr[64 * j]; gv[j] = gr[64 * j]; }
            const float rstd = 1.f / sqrtf(__hip_atomic_load(ss2 + m, __ATOMIC_RELAXED, __HIP_MEMORY_SCOPE_AGENT) * (1.f / DM) + EPS);
            asm volatile("" ::: "memory");
#pragma unroll
            for (int j = 0; j < 8; ++j) __builtin_nontemporal_store(v[j] * rstd * gv[j], xr + 64 * j);
        }
    }
#undef IN
#undef SEAM
}

extern "C" void kernel_launch(void* const* d_in, const int* in_sizes, int n_in, void* d_out, int out_size, void* d_ws, size_t ws_size, hipStream_t stream) {
    static int grid = 0;
    if (grid == 0) {
        if (n_in != 14 || in_sizes[0] != M * DM || out_size != M * DM || ws_size < WS_END) { fprintf(stderr, "kernel_launch: unexpected shapes (n_in %d, in0 %d, out %d, ws %zu)\n", n_in, n_in > 0 ? in_sizes[0] : -1, out_size, ws_size); grid = -1; return; }
        int dev = 0, cus = 0, per_cu = 0;
        (void)hipGetDevice(&dev); (void)hipDeviceGetAttribute(&cus, hipDeviceAttributeMultiprocessorCount, dev);
        if (hipFuncSetAttribute((const void*)hybrid_fwd, hipFuncAttributeMaxDynamicSharedMemorySize, LDS_BYTES) != hipSuccess) { fprintf(stderr, "kernel_launch: hipFuncSetAttribute failed\n"); grid = -1; return; }
        if (hipOccupancyMaxActiveBlocksPerMultiprocessor(&per_cu, (const void*)hybrid_fwd, NTHR, LDS_BYTES) != hipSuccess || per_cu < 1) { fprintf(stderr, "kernel_launch: occupancy query gave %d\n", per_cu); per_cu = 1; }
        (void)hipGetLastError();
        grid = cus * per_cu;
    }
    if (grid < 0) return;
    if (hipMemsetAsync((char*)d_ws + WS_CTL, 0, 32768, stream) != hipSuccess) { fprintf(stderr, "kernel_launch: memset failed\n"); return; }
    Args a{};
    for (int i = 0; i < 14; ++i) a.in[i] = (const float*)d_in[i];
    a.out = (float*)d_out; a.ws = (unsigned char*)d_ws;
    for (int i = 0; i < 8; ++i) a.inv_freq[i] = (float)pow(500000.0, -(double)i / 8.0);
    a.ph_lo = 0; a.ph_hi = 7;
    void* kargs[] = {&a};
    hipError_t e = hipLaunchCooperativeKernel((const void*)hybrid_fwd, dim3(grid), dim3(NTHR), kargs, LDS_BYTES, stream);
    if (e != hipSuccess) fprintf(stderr, "kernel_launch: cooperative launch failed: %s (grid %d)\n", hipGetErrorString(e), grid);
}
```

```cpp
#include <hip/hip_runtime.h>
#include <hip/hip_cooperative_groups.h>
#include <cstdio>
#include <cstdint>
#include <cmath>
namespace cg = cooperative_groups;
namespace pg8 {
#define PG8_LAS __attribute__((address_space(3)))
typedef unsigned short bf16_t;
typedef short bf16x8 __attribute__((ext_vector_type(8)));
typedef float f32x4 __attribute__((ext_vector_type(4)));
typedef unsigned u32x4 __attribute__((ext_vector_type(4)));
constexpr int BM = 256, BK = 64, HALF = 128, HTB = HALF * BK * 2  , STAGE_BYTES = 8 * HTB, NXCD = 8, WGM = 8;

__host__ __device__ __forceinline__ int lds_byte(int r, int c) { const int st = (r >> 4) * 2 + (c >> 5), rr = r & 15, cc = c & 31, ob = rr * 64 + cc * 2; return st * 1024 + (ob ^ (((ob >> 9) & 1) << 5)); }
__host__ __device__ __forceinline__ void stage_rc(int b, int& R, int& C) { const int st = b / 1024, sb = b % 1024, swz = sb ^ (((sb >> 9) & 1) << 5); R = (st >> 1) * 16 + swz / 64; C = (st & 1) * 32 + (swz % 64) / 2; }
__host__ __device__ __forceinline__ int perm32(int rho) { const int n = rho >> 4, i = rho & 15; return 8 * (i >> 2) + 4 * n + (i & 3); }

struct Unit { int pm, pn; };
struct Gemm { const bf16_t* A; const bf16_t* Bt; int M, N, K; };

struct StaticOrder {
    int nM, nN, nwg, G, c;
    __host__ __device__ void init(int M, int N, int G_, int c_) { nM = M / BM; nN = N / BM; nwg = nM * nN; G = G_; c = c_; }
    __host__ __device__ bool next(int i, Unit& u) const {
        const long L = (long)i * G + c; if (L >= nwg) return false;
        int wgid = (int)L; { const int q = nwg / NXCD, r = nwg % NXCD, xcd = wgid % NXCD, off = wgid / NXCD; wgid = (xcd < r ? xcd * (q + 1) : r * (q + 1) + (xcd - r) * q) + off; }
        const int nig = WGM * nN, gid = wgid / nig, fm = gid * WGM, gsz = (nM - fm) < WGM ? (nM - fm) : WGM;
        u.pm = fm + ((wgid % nig) % gsz); u.pn = (wgid % nig) / gsz; return true;
    }
    __device__ __forceinline__ void a_ready(const Unit&) const {}
    __device__ __forceinline__ void done(const Unit&) const {}
};

__device__ __forceinline__ unsigned cvt_pk_bf16(float lo, float hi) { unsigned r; asm volatile("v_cvt_pk_bf16_f32 %0, %1, %2" : "=v"(r) : "v"(lo), "v"(hi)); return r; }
template <class Epi, class Sched, bool ALIGN_EPI = false, bool SP2 = false>
__device__ __forceinline__ void gemm_phase(PG8_LAS unsigned char* lds, const Gemm g, const Sched& S, const Epi& E, int wave_id) {
    int tid_ = wave_id * 64 + (int)__builtin_amdgcn_mbcnt_hi(~0u, __builtin_amdgcn_mbcnt_lo(~0u, 0u)); asm volatile("" : "+v"(tid_));
    const int tid = tid_, wid = __builtin_amdgcn_readfirstlane(tid >> 6), lane = tid & 63, wr = wid >> 2, wc = wid & 3, fr = lane & 15, fq = lane >> 4;
    const int K = g.K, nt = K / BK;
    unsigned voffA[2], voffB[2];
#pragma unroll
    for (int i = 0; i < 2; ++i) { int R, C; stage_rc(tid * 16 + i * 8192, R, C); const int Rb = Epi::PERM ? ((R & ~31) + perm32(R & 31)) : R;
        voffA[i] = (unsigned)(R * K + C) * 2u; voffB[i] = (unsigned)(Rb * K + C) * 2u; }
    const size_t kstep = (size_t)(BK * 2);
    const size_t hstep = (size_t)HALF * K * 2;
    const size_t tstep = 2 * hstep;
    const unsigned ldsw = (unsigned)wid * 1024u;
    const int aoff = lds_byte(wr * 64 + fr, fq * 8), boff = lds_byte(wc * 32 + fr, fq * 8);
#define PG8_SA(b, h) (((b) * 2 + (h)) * HTB)
#define PG8_SB(b, h) ((4 + (b) * 2 + (h)) * HTB)
#define PG8_STAGE(bufoff, gbase, voff) do { _Pragma("unroll") for (int _i = 0; _i < 2; ++_i) \
        __builtin_amdgcn_global_load_lds((const unsigned*)((const char*)(gbase) + (voff)[_i]), (PG8_LAS unsigned*)(lds + (bufoff) + ldsw + _i * 8192), 16, 0, 0); } while (0)
#define PG8_LDA(dst, b, h) do { _Pragma("unroll") for (int m = 0; m < 4; ++m) _Pragma("unroll") for (int k = 0; k < 2; ++k) dst[m][k] = *(const PG8_LAS bf16x8*)(lds + PG8_SA(b, h) + aoff + m * 2048 + k * 1024); } while (0)
#define PG8_LDB(dst, b, h) do { _Pragma("unroll") for (int n = 0; n < 2; ++n) _Pragma("unroll") for (int k = 0; k < 2; ++k) dst[n][k] = *(const PG8_LAS bf16x8*)(lds + PG8_SB(b, h) + boff + n * 2048 + k * 1024); } while (0)
#define PG8_MMA(ai, bj, At, Bt) do { __builtin_amdgcn_s_setprio(1); _Pragma("unroll") for (int m = 0; m < 4; ++m) _Pragma("unroll") for (int n = 0; n < 2; ++n) _Pragma("unroll") for (int k = 0; k < 2; ++k) \
        acc[ai][bj][m][n] = __builtin_amdgcn_mfma_f32_16x16x32_bf16(Bt[n][k], At[m][k], acc[ai][bj][m][n], 0, 0, 0); __builtin_amdgcn_s_setprio(0); } while (0)
#define PG8_WAIT_V(n) asm volatile("s_waitcnt vmcnt(" #n ")" ::: "memory")
#define PG8_WAIT_L(n) asm volatile("s_waitcnt lgkmcnt(" #n ")" ::: "memory")
#define PG8_BAR __builtin_amdgcn_s_barrier()
#define PG8_SCHED __builtin_amdgcn_sched_barrier(0)
    Unit cur, nxt; int ui = 0;
    if (!S.next(0, cur)) return;
    f32x4 acc[2][2][4][2];
#pragma unroll
    for (int a = 0; a < 2; ++a)
#pragma unroll
        for (int b = 0; b < 2; ++b)
#pragma unroll
            for (int m = 0; m < 4; ++m)
#pragma unroll
                for (int n = 0; n < 2; ++n) acc[a][b][m][n] = (f32x4){0.f, 0.f, 0.f, 0.f};
    bf16x8 At[4][2], B0[2][2], B1[2][2];
    const char* cA = (const char*)g.A + (size_t)cur.pm * tstep; const char* cB = (const char*)g.Bt + (size_t)cur.pn * tstep;
    S.a_ready(cur);
    if constexpr (SP2) {
        PG8_STAGE(PG8_SB(0, 0), cB, voffB); PG8_STAGE(PG8_SB(0, 1), cB + hstep, voffB); PG8_STAGE(PG8_SA(0, 0), cA, voffA); PG8_STAGE(PG8_SA(0, 1), cA + hstep, voffA);
        if (wr == 1) PG8_BAR;
        PG8_WAIT_V(2); PG8_BAR;
        PG8_STAGE(PG8_SB(1, 0), cB + kstep, voffB); PG8_STAGE(PG8_SA(1, 0), cA + kstep, voffA); PG8_STAGE(PG8_SB(1, 1), cB + hstep + kstep, voffB);
        PG8_WAIT_V(6); PG8_BAR;
    } else {
        PG8_STAGE(PG8_SB(0, 0), cB, voffB); PG8_STAGE(PG8_SA(0, 0), cA, voffA); PG8_STAGE(PG8_SB(0, 1), cB + hstep, voffB); PG8_STAGE(PG8_SA(0, 1), cA + hstep, voffA);
        if (wr == 1) PG8_BAR;
        PG8_WAIT_V(4); PG8_BAR;
        PG8_STAGE(PG8_SB(1, 0), cB + kstep, voffB); PG8_STAGE(PG8_SA(1, 0), cA + kstep, voffA); PG8_STAGE(PG8_SB(1, 1), cB + hstep + kstep, voffB);
        PG8_WAIT_V(6); PG8_BAR;
    }
    for (;;) {
        const bool has_next = S.next(ui + 1, nxt);
        const char* nA = has_next ? (const char*)g.A + (size_t)nxt.pm * tstep : cA; const char* nB = has_next ? (const char*)g.Bt + (size_t)nxt.pn * tstep : cB;
        for (int t = 0; t < nt; t += 2) {
            const bool last = (t == nt - 2);
            const char* a1 = cA + (size_t)(t + 1) * kstep;
            const char* a2 = last ? nA : cA + (size_t)(t + 2) * kstep; const char* b2 = last ? nB : cB + (size_t)(t + 2) * kstep;
            const char* a3 = a2 + kstep; const char* b3 = b2 + kstep;
            if (last && has_next) S.a_ready(nxt);
            if constexpr (SP2) {
            PG8_LDB(B0, 0, 0); PG8_LDB(B1, 0, 1); PG8_SCHED; PG8_LDA(At, 0, 0); PG8_STAGE(PG8_SA(1, 1), a1 + hstep, voffA);
            PG8_WAIT_V(8); PG8_WAIT_L(0); PG8_BAR; PG8_MMA(0, 0, At, B0); PG8_MMA(0, 1, At, B1); PG8_BAR; PG8_SCHED;
            PG8_LDA(At, 0, 1); PG8_STAGE(PG8_SB(0, 0), b2, voffB); PG8_STAGE(PG8_SB(0, 1), b2 + hstep, voffB); PG8_STAGE(PG8_SA(0, 0), a2, voffA);
            PG8_WAIT_V(8); PG8_WAIT_L(0); PG8_BAR; PG8_MMA(1, 0, At, B0); PG8_MMA(1, 1, At, B1); PG8_BAR; PG8_SCHED;
            PG8_LDB(B0, 1, 0); PG8_LDB(B1, 1, 1); PG8_SCHED; PG8_LDA(At, 1, 0); PG8_STAGE(PG8_SA(0, 1), a2 + hstep, voffA);
            PG8_WAIT_V(8); PG8_WAIT_L(0); PG8_BAR; PG8_MMA(0, 0, At, B0); PG8_MMA(0, 1, At, B1); PG8_BAR; PG8_SCHED;
            PG8_LDA(At, 1, 1); PG8_STAGE(PG8_SB(1, 0), b3, voffB); PG8_STAGE(PG8_SB(1, 1), b3 + hstep, voffB); PG8_STAGE(PG8_SA(1, 0), a3, voffA);
            PG8_WAIT_V(8); PG8_WAIT_L(0); PG8_BAR; PG8_MMA(1, 0, At, B0); PG8_MMA(1, 1, At, B1); PG8_BAR; PG8_SCHED;
            } else {
            PG8_LDB(B0, 0, 0); PG8_SCHED; PG8_LDA(At, 0, 0); PG8_STAGE(PG8_SA(1, 1), a1 + hstep, voffA);
            PG8_WAIT_L(8); PG8_BAR; PG8_WAIT_L(0); PG8_MMA(0, 0, At, B0); PG8_BAR; PG8_SCHED;
            PG8_LDB(B1, 0, 1); PG8_STAGE(PG8_SB(0, 0), b2, voffB);
            PG8_BAR; PG8_WAIT_L(0); PG8_MMA(0, 1, At, B1); PG8_BAR;
            PG8_LDA(At, 0, 1); PG8_STAGE(PG8_SA(0, 0), a2, voffA);
            PG8_BAR; PG8_WAIT_L(0); PG8_MMA(1, 0, At, B0); PG8_BAR; PG8_SCHED;
            PG8_STAGE(PG8_SB(0, 1), b2 + hstep, voffB);
            PG8_WAIT_V(6); PG8_BAR; PG8_MMA(1, 1, At, B1); PG8_BAR;
            PG8_LDB(B0, 1, 0); PG8_SCHED; PG8_LDA(At, 1, 0); PG8_STAGE(PG8_SA(0, 1), a2 + hstep, voffA);
            PG8_WAIT_L(8); PG8_BAR; PG8_WAIT_L(0); PG8_MMA(0, 0, At, B0); PG8_BAR; PG8_SCHED;
            PG8_LDB(B1, 1, 1); PG8_STAGE(PG8_SB(1, 0), b3, voffB);
            PG8_BAR; PG8_WAIT_L(0); PG8_MMA(0, 1, At, B1); PG8_BAR;
            PG8_LDA(At, 1, 1); PG8_STAGE(PG8_SA(1, 0), a3, voffA);
            PG8_BAR; PG8_WAIT_L(0); PG8_MMA(1, 0, At, B0); PG8_BAR; PG8_SCHED;
            PG8_STAGE(PG8_SB(1, 1), b3 + hstep, voffB);
            PG8_WAIT_V(6); PG8_BAR; PG8_MMA(1, 1, At, B1); PG8_BAR;
            }
        }
        if constexpr (ALIGN_EPI) { if (wr == 0) PG8_BAR; }
        if constexpr (!Epi::AFTER_DRAIN) { E(acc, cur, wr, wc, fr, fq); S.done(cur); }
        if (!has_next) break;
#pragma unroll
        for (int a = 0; a < 2; ++a)
#pragma unroll
            for (int b = 0; b < 2; ++b)
#pragma unroll
                for (int m = 0; m < 4; ++m)
#pragma unroll
                    for (int n = 0; n < 2; ++n) acc[a][b][m][n] = (f32x4){0.f, 0.f, 0.f, 0.f};
        cur = nxt; cA = nA; cB = nB; ++ui;
        if constexpr (ALIGN_EPI) { if (wr == 1) PG8_BAR; }
    }
    PG8_WAIT_V(0);
    if constexpr (!ALIGN_EPI) { if (wr == 0) PG8_BAR; }
    PG8_BAR;
    if constexpr (Epi::AFTER_DRAIN) { E.fused(acc, cur, wr, wc, fr, fq, lds, wid, lane); S.done(cur); }
#undef PG8_SA
#undef PG8_SB
#undef PG8_STAGE
#undef PG8_LDA
#undef PG8_LDB
#undef PG8_MMA
#undef PG8_WAIT_V
#undef PG8_WAIT_L
#undef PG8_BAR
#undef PG8_SCHED
}
}
#define GAS __attribute__((address_space(1)))
#define LAS __attribute__((address_space(3)))
typedef unsigned short bf16;
typedef unsigned v4u __attribute__((ext_vector_type(4)));
typedef unsigned v2u __attribute__((ext_vector_type(2)));
typedef float f32x4 __attribute__((ext_vector_type(4)));
typedef float f32x16 __attribute__((ext_vector_type(16)));
typedef short bf16x8 __attribute__((ext_vector_type(8)));
typedef short s16x4 __attribute__((ext_vector_type(4)));
using pg8::Unit; using pg8::cvt_pk_bf16; using pg8::BM; using pg8::HALF;

constexpr int SEQ = 16384, DM = 2048, PW = 6144, FF = 8192, M = SEQ;
constexpr int NWAVES = 8, NTHR = 512;
constexpr float EPS = 1e-6f;
constexpr float C2 = 0.125f * 1.4426950408889634f;
constexpr float SBSCALE = 0.08838834764831845f * 1.4426950408889634f;
constexpr float LAM_INIT = 0.2f;
constexpr int COL_DQ = 0, COL_DK = 1024, COL_DV = 2048, COL_SQ = 3072, COL_SK = 4096, COL_SV = 5120;

constexpr size_t MiB = 1u << 20;
constexpr size_t WS_WIN = 0;
constexpr size_t WS_WOUT = 24 * MiB;
constexpr size_t WS_W1 = 32 * MiB;
constexpr size_t WS_W2 = 64 * MiB;
constexpr size_t WS_CS = 96 * MiB;
constexpr size_t WS_SS1 = 97 * MiB;
constexpr size_t WS_SS2 = 97 * MiB + 65536;
constexpr size_t WS_H = 98 * MiB;
constexpr size_t WS_QKV = 162 * MiB;
constexpr size_t WS_MIX = 354 * MiB;
constexpr size_t WS_U = 162 * MiB;
constexpr size_t WS_CTL = 418 * MiB;
constexpr size_t WS_END = 419 * MiB;

constexpr int RING_BYTES = 131072, LDS_BYTES = 131072 + 1024;

__device__ __forceinline__ unsigned f2bf(float f) { unsigned u = __builtin_bit_cast(unsigned, f); return (u + 0x7fffu + ((u >> 16) & 1u)) >> 16; }
__device__ __forceinline__ unsigned pk2(float lo, float hi) { return f2bf(lo) | (f2bf(hi) << 16); }
__device__ __forceinline__ float wave_sum(float v) {
#pragma unroll
    for (int o = 1; o < 64; o <<= 1) v += __shfl_xor(v, o);
    return v;
}
typedef unsigned u32x2_t __attribute__((ext_vector_type(2)));
__device__ __forceinline__ void swap_x32(float& a, float& b) { asm volatile("s_nop 1\n\tv_permlane32_swap_b32 %0, %1" : "+v"(a), "+v"(b)); }
__device__ __forceinline__ float max_x32(float x) { float a = x, b = x; swap_x32(a, b); return fmaxf(a, b); }
__device__ __forceinline__ float sum_x32(float x) { float a = x, b = x; swap_x32(a, b); return a + b; }
__device__ __forceinline__ float partner_x32(float x, int hi) { float a = x, b = x; swap_x32(a, b); return hi ? a : b; }
#define LDS_WAIT() asm volatile("s_waitcnt lgkmcnt(0)" ::: "memory")
__device__ __forceinline__ int opaque(int v) { asm volatile("" : "+v"(v)); return v; }

struct EpiQKV {
    static constexpr bool PERM = true, AFTER_DRAIN = false;
    bf16* O; const float* cs;
    __device__ __forceinline__ void operator()(const f32x4 (&acc)[2][2][4][2], const Unit& u, int wr, int wc, int fr, int fq) const {
        const int row0 = u.pm * BM + wr * 64 + fr, col0 = u.pn * BM + wc * 32 + 8 * fq;
        float sc = 1.f; if (u.pn < 4) sc = C2; else if (u.pn >= 12 && u.pn < 16) sc = SBSCALE;
        const bool rot = (u.pn < 8) && ((wc & 1) == 0);
        if (rot) {
#pragma unroll
            for (int ai = 0; ai < 2; ++ai) {
                f32x4 cv[4][4];
#pragma unroll
                for (int m = 0; m < 4; ++m) { const f32x4* p = (const f32x4*)(cs + (size_t)(row0 + ai * HALF + m * 16) * 16); cv[m][0] = p[0]; cv[m][1] = p[1]; cv[m][2] = p[2]; cv[m][3] = p[3]; }
#pragma unroll
                for (int m = 0; m < 4; ++m) {
                    const int row = row0 + ai * HALF + m * 16;
                    const f32x4 c0 = cv[m][0], c1 = cv[m][1]; f32x4 s0 = cv[m][2], s1 = cv[m][3]; if (fq == 0) { s0 = -s0; s1 = -s1; }
#pragma unroll
                    for (int bj = 0; bj < 2; ++bj) {
                        f32x4 v0 = acc[ai][bj][m][0] * sc, v1 = acc[ai][bj][m][1] * sc, p0, p1;
#pragma unroll
                        for (int e = 0; e < 4; ++e) { p0[e] = __shfl_xor(v0[e], 16); p1[e] = __shfl_xor(v1[e], 16); }
                        if (fq < 2) { v0 = v0 * c0 + p0 * s0; v1 = v1 * c1 + p1 * s1; }
                        v4u w; w.x = cvt_pk_bf16(v0[0], v0[1]); w.y = cvt_pk_bf16(v0[2], v0[3]); w.z = cvt_pk_bf16(v1[0], v1[1]); w.w = cvt_pk_bf16(v1[2], v1[3]);
                        *(v4u*)(O + (size_t)row * PW + col0 + bj * HALF) = w;
                    }
                }
            }
        } else {
#pragma unroll
            for (int ai = 0; ai < 2; ++ai)
#pragma unroll
                for (int m = 0; m < 4; ++m) {
                    const int row = row0 + ai * HALF + m * 16;
#pragma unroll
                    for (int bj = 0; bj < 2; ++bj) {
                        const f32x4 v0 = acc[ai][bj][m][0] * sc, v1 = acc[ai][bj][m][1] * sc;
                        v4u w; w.x = cvt_pk_bf16(v0[0], v0[1]); w.y = cvt_pk_bf16(v0[2], v0[3]); w.z = cvt_pk_bf16(v1[0], v1[1]); w.w = cvt_pk_bf16(v1[2], v1[3]);
                        *(v4u*)(O + (size_t)row * PW + col0 + bj * HALF) = w;
                    }
                }
        }
    }
};
struct EpiRes {
    static constexpr bool PERM = true, AFTER_DRAIN = false;
    const float* R; float* Y; bf16* Yb; float* ss;
    __device__ __forceinline__ void operator()(const f32x4 (&acc)[2][2][4][2], const Unit& u, int wr, int wc, int fr, int fq) const {
        const int row0 = u.pm * BM + wr * 64 + fr, col0 = u.pn * BM + wc * 32 + 8 * fq;
#pragma unroll
        for (int ai = 0; ai < 2; ++ai) {
            f32x4 rv[4][2][2];
#pragma unroll
            for (int m = 0; m < 4; ++m)
#pragma unroll
                for (int bj = 0; bj < 2; ++bj) { const size_t off = (size_t)(row0 + ai * HALF + m * 16) * DM + col0 + bj * HALF; rv[m][bj][0] = *(const f32x4*)(R + off); rv[m][bj][1] = *(const f32x4*)(R + off + 4); }
            asm volatile("" ::: "memory");
#pragma unroll
            for (int m = 0; m < 4; ++m) {
                const int row = row0 + ai * HALF + m * 16; float s = 0.f;
#pragma unroll
                for (int bj = 0; bj < 2; ++bj) {
                    const size_t off = (size_t)row * DM + col0 + bj * HALF;
                    const f32x4 v0 = acc[ai][bj][m][0] + rv[m][bj][0], v1 = acc[ai][bj][m][1] + rv[m][bj][1];
                    *(f32x4*)(Y + off) = v0; *(f32x4*)(Y + off + 4) = v1;
                    if (Yb) { v4u w; w.x = cvt_pk_bf16(v0[0], v0[1]); w.y = cvt_pk_bf16(v0[2], v0[3]); w.z = cvt_pk_bf16(v1[0], v1[1]); w.w = cvt_pk_bf16(v1[2], v1[3]); *(v4u*)(Yb + off) = w; }
                    s += (v0[0] * v0[0] + v0[1] * v0[1]) + (v0[2] * v0[2] + v0[3] * v0[3]) + (v1[0] * v1[0] + v1[1] * v1[1]) + (v1[2] * v1[2] + v1[3] * v1[3]);
                }
                s += __shfl_xor(s, 16); s += __shfl_xor(s, 32);
                if (fq == 0) atomicAdd(ss + row, s);
            }
        }
    }
};
struct EpiMlpIn {
    static constexpr bool PERM = true, AFTER_DRAIN = false;
    bf16* O; const float* ss;
    __device__ __forceinline__ void operator()(const f32x4 (&acc)[2][2][4][2], const Unit& u, int wr, int wc, int fr, int fq) const {
        const int row0 = u.pm * BM + wr * 64 + fr, col0 = u.pn * BM + wc * 32 + 8 * fq;
        float rs[2][4];
#pragma unroll
        for (int ai = 0; ai < 2; ++ai)
#pragma unroll
            for (int m = 0; m < 4; ++m) rs[ai][m] = __hip_atomic_load(ss + row0 + ai * HALF + m * 16, __ATOMIC_RELAXED, __HIP_MEMORY_SCOPE_AGENT);
        asm volatile("" ::: "memory");
#pragma unroll
        for (int ai = 0; ai < 2; ++ai)
#pragma unroll
            for (int m = 0; m < 4; ++m) {
                const int row = row0 + ai * HALF + m * 16;
                const float rstd = __builtin_amdgcn_rsqf(rs[ai][m] * (1.f / DM) + EPS);
#pragma unroll
                for (int bj = 0; bj < 2; ++bj) {
                    f32x4 v0 = acc[ai][bj][m][0] * rstd, v1 = acc[ai][bj][m][1] * rstd;
#pragma unroll
                    for (int e = 0; e < 4; ++e) { const float a = fmaxf(v0[e], 0.f), b = fmaxf(v1[e], 0.f); v0[e] = a * a; v1[e] = b * b; }
                    v4u w; w.x = cvt_pk_bf16(v0[0], v0[1]); w.y = cvt_pk_bf16(v0[2], v0[3]); w.z = cvt_pk_bf16(v1[0], v1[1]); w.w = cvt_pk_bf16(v1[2], v1[3]);
                    *(v4u*)(O + (size_t)row * FF + col0 + bj * HALF) = w;
                }
            }
    }
};
#define MFMA32(a, b, c) __builtin_amdgcn_mfma_f32_32x32x16_bf16((a), (b), (c), 0, 0, 0)
__device__ __forceinline__ int crow(int r, int hi) { return (r & 3) + 8 * (r >> 2) + 4 * hi; }
typedef short v4i16_t __attribute__((ext_vector_type(4)));
__device__ __forceinline__ s16x4 vtr(LAS const unsigned char* p) { return __builtin_bit_cast(s16x4, __builtin_amdgcn_ds_read_tr16_b64_v4i16((LAS v4i16_t*)p)); }
typedef float f32x2_t __attribute__((ext_vector_type(2)));
typedef __bf16 bf16x2_t __attribute__((ext_vector_type(2)));
__device__ __forceinline__ unsigned cvtpk_s(float lo, float hi) { f32x2_t v = {lo, hi}; bf16x2_t b = __builtin_convertvector(v, bf16x2_t); return __builtin_bit_cast(unsigned, b); }
__device__ __forceinline__ bf16x8 pack8(const f32x16& x, int s) {
    v4u p; p.x = cvtpk_s(x[8 * s], x[8 * s + 1]); p.y = cvtpk_s(x[8 * s + 2], x[8 * s + 3]); p.z = cvtpk_s(x[8 * s + 4], x[8 * s + 5]); p.w = cvtpk_s(x[8 * s + 6], x[8 * s + 7]);
    return __builtin_bit_cast(bf16x8, p);
}

__device__ __forceinline__ void glds16(const void* sbase, unsigned voff, unsigned lds_dst) { unsigned keep;
    asm volatile("s_mov_b32 %0, m0\n\ts_mov_b32 m0, %3\n\ts_nop 0\n\tglobal_load_lds_dwordx4 %1, %2\n\ts_mov_b32 m0, %0" : "=&s"(keep) : "v"(voff), "s"(sbase), "s"(lds_dst) : "memory"); }
template <bool TAIL>
__device__ __forceinline__ void flash_half(f32x16 (&O)[4], f32x16& Sc, f32x16& Sn, float& m_run, float& l_run, bf16x8& mfrag, const bf16x8& onefrag, const bf16x8 (&qf)[4],
                                           LAS const unsigned char* Kn, LAS const unsigned char* Vc, unsigned ka, int kx, unsigned va, int vx, int blk, int hi, int key0, int qrow, int qmin) {
    if (TAIL) {
        const int kb = key0 + 4 * hi;
#pragma unroll
        for (int i = 0; i < 16; ++i) { const int key = kb + (i & 3) + 8 * (i >> 2); if (key > qrow) Sc[i] = -1e30f; }
    }
    float mloc = fmaxf(Sc[0], Sc[1]);
#pragma unroll
    for (int i = 2; i < 16; ++i) mloc = fmaxf(mloc, Sc[i]);
    mloc = max_x32(mloc);
    const bool first = (key0 == 0);
    if (__any(mloc > 8.f) || first) {
        const float m_new = (mloc > 8.f || first) ? __builtin_bit_cast(float, f2bf(m_run + mloc) << 16) : m_run;
        const float delta = m_new - m_run, alpha = __builtin_amdgcn_exp2f(-delta);
        l_run *= alpha;
#pragma unroll
        for (int d = 0; d < 4; ++d)
#pragma unroll
            for (int i = 0; i < 16; ++i) O[d][i] *= alpha;
#pragma unroll
        for (int i = 0; i < 16; ++i) Sc[i] -= delta;
        m_run = m_new;
        mfrag[0] = hi ? (short)0 : (short)(f2bf(-m_new));
    }
#pragma unroll
    for (int i = 0; i < 16; ++i) Sn[i] = 0.f;
    Sn = MFMA32(onefrag, mfrag, Sn);
#pragma unroll
    for (int ks = 0; ks < 4; ++ks) {
        const bf16x8 a0 = *(LAS const bf16x8*)(Kn + ka + (((2 * ks + hi) ^ kx) << 4));
        Sn = MFMA32(a0, qf[ks], Sn);
    }
    float ls = 0.f;
#pragma unroll
    for (int i = 0; i < 16; ++i) { Sc[i] = __builtin_amdgcn_exp2f(Sc[i]); ls += Sc[i]; }
    l_run += ls;
#pragma unroll
    for (int kk = 0; kk < 2; ++kk) {
        if (kk == 1) __builtin_amdgcn_sched_barrier(0);
        const bf16x8 pb = pack8(Sc, kk);
#pragma unroll
        for (int d = 0; d < 4; ++d) {
            LAS const unsigned char* p = Vc + va + kk * 4096 + (((2 * d + blk) ^ vx) << 5);
            const s16x4 lo = vtr(p), hi4 = vtr(p + 2048);
            const bf16x8 a = __builtin_shufflevector(lo, hi4, 0, 1, 2, 3, 4, 5, 6, 7);
            O[d] = MFMA32(a, pb, O[d]);
        }
    }
}

constexpr int DA_V = 49152, KT = 128;
__device__ __forceinline__ void flash_map(f32x16 (&O)[4], LAS unsigned char* lds, const bf16* QKV, int qcol, int kcol, int vcol, int qb, int w, int lane, int tid) {
    const int r32 = lane & 31, hi = lane >> 5;
    const int qmin = qb * 256 + w * 32, qrow = qmin + r32;
    bf16x8 qf[4];
    { const int lq = opaque(lane);
      const bf16* qp = QKV + (size_t)(qmin + (lq & 31)) * PW + qcol + 8 * (lq >> 5);
#pragma unroll
      for (int ks = 0; ks < 4; ++ks) qf[ks] = *(const bf16x8*)(qp + 16 * ks); }
#pragma unroll
    for (int d = 0; d < 4; ++d)
#pragma unroll
        for (int i = 0; i < 16; ++i) O[d][i] = 0.f;
    float m_run = 0.f, l_run = 0.f;
    bf16x8 mfrag = {0, 0, 0, 0, 0, 0, 0, 0}, onefrag = {0, 0, 0, 0, 0, 0, 0, 0}; onefrag[0] = hi ? (short)0 : (short)0x3F80;
    const int nkt = 2 * (qb + 1), nmain = 2 * qb;
    const int krow = tid >> 3, kc = (tid & 7) ^ ((krow >> 1) & 7);
    const unsigned kgo = (unsigned)(krow * PW + kc * 8) * 2u;
    const int vrow = tid >> 4, vpos = tid & 15, vc = ((((vpos >> 1) ^ (2 * (vrow & 3)))) << 1) | (vpos & 1);
    const unsigned vgo = (unsigned)(vrow * PW + vc * 8) * 2u;
    const bf16* kg = QKV + kcol; const bf16* vg = QKV + vcol;
    const unsigned wl = (unsigned)(tid >> 6) * 1024u;
    const size_t tstep = (size_t)KT * PW;
#define DMA16(g, vo, l) glds16((g), (vo), (unsigned)__builtin_amdgcn_readfirstlane((int)(unsigned)(size_t)(l)))
#define DMA_K(t, slot) do { const bf16* g_ = kg + (size_t)(t) * tstep; DMA16(g_, kgo, lds + (slot) + wl); DMA16(g_ + (size_t)64 * PW, kgo, lds + (slot) + 8192 + wl); } while (0)
#define DMA_VH(t, b, h) do { const bf16* g_ = vg + (size_t)(t) * tstep + (size_t)(64 * (h)) * PW; LAS unsigned char* l_ = lds + DA_V + (b) * 32768 + 16384 * (h) + wl; \
        DMA16(g_, vgo, l_); DMA16(g_ + (size_t)32 * PW, vgo, l_ + 8192); } while (0)
#define DMA_V(t, b) do { DMA_VH(t, b, 0); DMA_VH(t, b, 1); } while (0)
    const unsigned ka = r32 * 128;
    const int kx = (r32 >> 1) & 7;
    const int q4 = (lane & 15) >> 2, p4 = lane & 3, blk = (lane >> 4) & 1;
    const int vr0 = 4 * hi + q4;
    const unsigned va = DA_V + vr0 * 256 + 8 * p4;
    const int vx = 2 * q4;
    DMA_K(0, 0); DMA_K(1, 16384); DMA_V(0, 0);
    asm volatile("s_waitcnt vmcnt(0) lgkmcnt(0)\n\ts_barrier" ::: "memory");
    f32x16 S0, S1;
#pragma unroll
    for (int i = 0; i < 16; ++i) S0[i] = 0.f;
#pragma unroll
    for (int ks = 0; ks < 4; ++ks) S0 = MFMA32(*(LAS const bf16x8*)(lds + ka + (((2 * ks + hi) ^ kx) << 4)), qf[ks], S0);
    int kb0 = 0, kb1 = 16384, kb2 = 32768;
    for (int kt = 0; kt < nkt; ++kt) {
        const int buf = kt & 1;
        const bool more = kt + 1 < nkt;
        if (kt + 2 < nkt) DMA_K(kt + 2, kb2);
        LAS const unsigned char* Kc = lds + kb0; LAS const unsigned char* Vb = lds + buf * 32768;
        if (kt < nmain) {
            flash_half<false>(O, S0, S1, m_run, l_run, mfrag, onefrag, qf, Kc + 4096, Vb, ka, kx, va, vx, blk, hi, kt * KT, qrow, qmin);
            if (more) DMA_VH(kt + 1, buf ^ 1, 0);
            flash_half<false>(O, S1, S0, m_run, l_run, mfrag, onefrag, qf, Kc + 8192, Vb + 8192, ka, kx, va, vx, blk, hi, kt * KT + 32, qrow, qmin);
            if (more) DMA_VH(kt + 1, buf ^ 1, 1);
            flash_half<false>(O, S0, S1, m_run, l_run, mfrag, onefrag, qf, Kc + 12288, Vb + 16384, ka, kx, va, vx, blk, hi, kt * KT + 64, qrow, qmin);
            flash_half<false>(O, S1, S0, m_run, l_run, mfrag, onefrag, qf, lds + kb1, Vb + 24576, ka, kx, va, vx, blk, hi, kt * KT + 96, qrow, qmin);
        } else {
            if (more) DMA_V(kt + 1, buf ^ 1);
            flash_half<true>(O, S0, S1, m_run, l_run, mfrag, onefrag, qf, Kc + 4096, Vb, ka, kx, va, vx, blk, hi, kt * KT, qrow, qmin);
            flash_half<true>(O, S1, S0, m_run, l_run, mfrag, onefrag, qf, Kc + 8192, Vb + 8192, ka, kx, va, vx, blk, hi, kt * KT + 32, qrow, qmin);
            flash_half<true>(O, S0, S1, m_run, l_run, mfrag, onefrag, qf, Kc + 12288, Vb + 16384, ka, kx, va, vx, blk, hi, kt * KT + 64, qrow, qmin);
            flash_half<true>(O, S1, S0, m_run, l_run, mfrag, onefrag, qf, lds + kb1, Vb + 24576, ka, kx, va, vx, blk, hi, kt * KT + 96, qrow, qmin);
        }
        asm volatile("s_waitcnt vmcnt(0) lgkmcnt(0)\n\ts_barrier" ::: "memory");
        const int t0 = kb0; kb0 = kb1; kb1 = kb2; kb2 = t0;
    }
#undef DMA16
#undef DMA_K
#undef DMA_V
#undef DMA_VH
    const float l = sum_x32(l_run), inv = 1.f / l;
#pragma unroll
    for (int d = 0; d < 4; ++d)
#pragma unroll
        for (int i = 0; i < 16; ++i) O[d][i] *= inv;
}

__device__ __forceinline__ void headnorm_store(const f32x16 (&O)[4], const float* g, float post, bf16* MIX, int qrow, int col0, int hi) {
    float ss = 0.f;
#pragma unroll
    for (int d = 0; d < 4; ++d)
#pragma unroll
        for (int i = 0; i < 16; ++i) ss += O[d][i] * O[d][i];
    ss = sum_x32(ss);
    const float rs = __builtin_amdgcn_rsqf(ss * (1.f / 128.f) + EPS) * post;
    f32x4 gvv[4][4];
#pragma unroll
    for (int d = 0; d < 4; ++d)
#pragma unroll
        for (int gq = 0; gq < 4; ++gq) gvv[d][gq] = *(const f32x4*)(g + 32 * d + 8 * gq + 4 * hi);
    asm volatile("" ::: "memory");
#pragma unroll
    for (int d = 0; d < 4; ++d)
#pragma unroll
        for (int gq = 0; gq < 4; ++gq) {
            const int dv = 32 * d + 8 * gq + 4 * hi;
            const f32x4 gv = gvv[d][gq];
            v2u w; w.x = cvtpk_s(O[d][4 * gq] * rs * gv[0], O[d][4 * gq + 1] * rs * gv[1]); w.y = cvtpk_s(O[d][4 * gq + 2] * rs * gv[2], O[d][4 * gq + 3] * rs * gv[3]);
            *(v2u*)(MIX + (size_t)qrow * DM + col0 + dv) = w;
        }
}

__device__ __forceinline__ void diff_unit(LAS unsigned char* lds, const bf16* QKV, bf16* MIX, float* o1s, const float* gd, float lam, int head, int qb, int w, int lane, int tid) {
    f32x16 O[4];
#pragma unroll 1
    for (int j = 0; j < 2; ++j) {
        flash_map(O, lds, QKV, COL_DQ + head * 128 + 64 * j, COL_DK + head * 128 + 64 * j, COL_DV + head * 128, qb, w, lane, tid);
        if (j == 0) {
            f32x4* sc = (f32x4*)(o1s + ((size_t)(blockIdx.x * NWAVES + w) * 64 + opaque(lane)) * 64);
#pragma unroll
            for (int d = 0; d < 4; ++d)
#pragma unroll
                for (int i = 0; i < 4; ++i) sc[d * 4 + i] = (f32x4){O[d][4 * i], O[d][4 * i + 1], O[d][4 * i + 2], O[d][4 * i + 3]};
        }
    }
    lane = opaque(lane);
    const f32x4* sc = (const f32x4*)(o1s + ((size_t)(blockIdx.x * NWAVES + w) * 64 + lane) * 64);
#pragma unroll
    for (int d = 0; d < 4; ++d)
#pragma unroll
        for (int i = 0; i < 4; ++i) { const f32x4 t = sc[d * 4 + i];
#pragma unroll
            for (int e = 0; e < 4; ++e) O[d][4 * i + e] = t[e] - lam * O[d][4 * i + e]; }
    headnorm_store(O, gd, 1.f - LAM_INIT, MIX, qb * 256 + w * 32 + (lane & 31), head * 128, lane >> 5);
}

constexpr float SB_STOP = -44.f * 1.4426950408889634f;
__device__ __forceinline__ void sb_unit(LAS unsigned char* vl, const bf16* QKV, bf16* MIX, const float* gs, int head, int qg, int lane) {
    const int r32 = lane & 31, hi = lane >> 5;
    const int qrow = qg * 32 + r32;
    bf16x8 qf[8];
#pragma unroll
    for (int ks = 0; ks < 8; ++ks) qf[ks] = *(const bf16x8*)(QKV + (size_t)qrow * PW + COL_SQ + head * 128 + 16 * ks + 8 * hi);
    f32x16 O[4];
#pragma unroll
    for (int d = 0; d < 4; ++d)
#pragma unroll
        for (int i = 0; i < 16; ++i) O[d][i] = 0.f;
    float R = 0.f;
    const int q4 = (lane & 15) >> 2, p4 = lane & 3, blk = (lane >> 4) & 1;
    const int vr0 = 4 * hi + q4, vx = vr0 & 7;
    const unsigned va = vr0 * 256 + 8 * p4;
    const bf16* kgp = QKV + (size_t)r32 * PW + COL_SK + head * 128 + 8 * hi;
    const bf16* vgp = QKV + (size_t)(lane >> 4) * PW + COL_SV + head * 128 + (lane & 15) * 8;
    bf16x8 kf[8]; v4u vreg[8];
#pragma unroll
    for (int ks = 0; ks < 8; ++ks) kf[ks] = *(const bf16x8*)(kgp + (size_t)(qg * 32) * PW + 16 * ks);
#pragma unroll
    for (int i = 0; i < 8; ++i) vreg[i] = *(const v4u*)(vgp + (size_t)(qg * 32 + 4 * i) * PW);
    for (int kt = qg; kt >= 0; --kt) {
        const int k0 = kt * 32;
        f32x16 S;
#pragma unroll
        for (int i = 0; i < 16; ++i) S[i] = 0.f;
#pragma unroll
        for (int ks = 0; ks < 8; ++ks) S = MFMA32(kf[ks], qf[ks], S);
        LDS_WAIT();
#pragma unroll
        for (int i = 0; i < 8; ++i) { const int row = 4 * i + (lane >> 4), c = lane & 15; *(LAS v4u*)(vl + row * 256 + (((c >> 1) ^ (row & 7)) << 5) + ((c & 1) << 4)) = vreg[i]; }
        if (kt > 0) {
#pragma unroll
            for (int ks = 0; ks < 8; ++ks) kf[ks] = *(const bf16x8*)(kgp + (size_t)(k0 - 32) * PW + 16 * ks);
#pragma unroll
            for (int i = 0; i < 8; ++i) vreg[i] = *(const v4u*)(vgp + (size_t)(k0 - 32 + 4 * i) * PW);
        }
        float lb[16], lom[16];
#pragma unroll
        for (int i = 0; i < 16; ++i) {
            const int key = k0 + crow(i, hi); const float z = S[i];
            const float sp = __builtin_amdgcn_logf(1.f + __builtin_amdgcn_exp2f(-fabsf(z)));
            lb[i] = fminf(z, 0.f) - sp;
            lom[i] = (key < qrow) ? lb[i] - z : 0.f;
        }
        float gsum[4], pgs[4], after[4];
#pragma unroll
        for (int g = 0; g < 4; ++g) { gsum[g] = (lom[4 * g] + lom[4 * g + 1]) + (lom[4 * g + 2] + lom[4 * g + 3]); pgs[g] = partner_x32(gsum[g], hi); }
        float run = 0.f;
#pragma unroll
        for (int g = 3; g >= 0; --g) { after[g] = run + (hi == 0 ? pgs[g] : 0.f); run += gsum[g] + pgs[g]; }
#pragma unroll
        for (int g = 0; g < 4; ++g) {
            float suf = R + after[g];
#pragma unroll
            for (int e = 3; e >= 0; --e) {
                const int i = 4 * g + e; const int key = k0 + crow(i, hi);
                S[i] = (key < qrow) ? __builtin_amdgcn_exp2f(lb[i] + suf) : 0.f;
                suf += lom[i];
            }
        }
        R += run;
        LDS_WAIT();
#pragma unroll
        for (int kk = 0; kk < 2; ++kk) {
            const bf16x8 pb = pack8(S, kk);
#pragma unroll
            for (int d = 0; d < 4; ++d) {
                LAS const unsigned char* p = vl + va + kk * 4096 + (((2 * d + blk) ^ vx) << 5);
                const s16x4 lo = vtr(p), hi4 = vtr(p + 2048);
                const bf16x8 a = __builtin_shufflevector(lo, hi4, 0, 1, 2, 3, 4, 5, 6, 7);
                O[d] = MFMA32(a, pb, O[d]);
            }
        }
        if (__all(R < SB_STOP)) break;
    }
    LDS_WAIT();
    headnorm_store(O, gs, 1.f, MIX, qrow, 1024 + head * 128, hi);
}
__device__ __forceinline__ void transpose_item(const float* W, int K, int N, bf16* WT, const float* g, LAS float* scr, int item, int lane) {
    const int nblk = N / 32, kb = item / nblk, nb = item % nblk, k0 = 64 * kb, n0 = 32 * nb;
    const int r8 = lane >> 3, c4 = (lane & 7) * 4;
    f32x4 v[8];
#pragma unroll
    for (int i = 0; i < 8; ++i) v[i] = __builtin_nontemporal_load((const f32x4*)(W + (size_t)(k0 + r8 + 8 * i) * N + n0 + c4));
#pragma unroll
    for (int i = 0; i < 8; ++i) { const int kk = r8 + 8 * i; const float gs = g ? g[k0 + kk] : 1.f;
#pragma unroll
        for (int e = 0; e < 4; ++e) scr[kk * 33 + c4 + e] = v[i][e] * gs; }
    LDS_WAIT();
    const int c = lane & 7;
#pragma unroll
    for (int j = 0; j < 4; ++j) { const int n = (lane >> 3) + 8 * j; const LAS float* sp = scr + (8 * c) * 33 + n;
        v4u o; o.x = pk2(sp[0 * 33], sp[1 * 33]); o.y = pk2(sp[2 * 33], sp[3 * 33]); o.z = pk2(sp[4 * 33], sp[5 * 33]); o.w = pk2(sp[6 * 33], sp[7 * 33]);
        *(v4u*)(WT + (size_t)(n0 + n) * K + k0 + 8 * c) = o; }
    LDS_WAIT();
}

#define XB_TMO      128
#define XB_XCNT(j)  (256  + 64 * (j))
#define XB_XSUB(j)  (1280 + 64 * (j))
#define XB_XGEN(j)  (2304 + 64 * (j))
#define XB_TOP      3328
#define XB_TOPGEN   3392
#define XCD_BAR_WORDS 3456
#define XB_SPIN_CAP (1u << 18)
__device__ __forceinline__ unsigned xb_ld(unsigned* p)              { return __hip_atomic_load(p, __ATOMIC_RELAXED, __HIP_MEMORY_SCOPE_AGENT); }
__device__ __forceinline__ unsigned xb_add(unsigned* p, unsigned v) { return __hip_atomic_fetch_add(p, v, __ATOMIC_RELAXED, __HIP_MEMORY_SCOPE_AGENT); }
__device__ __forceinline__ unsigned xb_xcc_id() { return (unsigned)__builtin_amdgcn_s_getreg((3 << 11) | 20) & 0xFu; }
#define XB_SPIN(cond, bar) do { unsigned _sp = 0; while (cond) { __builtin_amdgcn_s_sleep(1); \
    if ((++_sp & 255u) == 0u) { if (xb_ld(&(bar)[XB_TMO])) break; if (_sp > XB_SPIN_CAP) { atomicAdd(&(bar)[XB_TMO], 1u); break; } } } } while (0)

struct XcdBarrier {
    unsigned* bar; unsigned x;
    volatile LAS unsigned* st;
};

__device__ __forceinline__ XcdBarrier xcd_barrier_post(unsigned* bar, volatile LAS unsigned* st, bool t0) {
    XcdBarrier b; b.bar = bar; b.x = xb_xcc_id(); b.st = st;
    if (t0) (void)xb_add(&bar[XB_XCNT(b.x)], 1u);
    return b;
}
__device__ __forceinline__ void xcd_barrier_complete(unsigned* bar, unsigned x, unsigned& nloc, unsigned& nx) {
    const unsigned G = gridDim.x * gridDim.y * gridDim.z;
    unsigned sum, cnt, mine, sp = 0u;
    for (;;) {
        sum = 0u; cnt = 0u; mine = 0u;
#pragma unroll
        for (unsigned j = 0; j < 16; ++j) { const unsigned c = xb_ld(&bar[XB_XCNT(j)]); sum += c; cnt += (c > 0u) ? 1u : 0u; mine = (j == x) ? c : mine; }
        if (sum == G) break;
        __builtin_amdgcn_s_sleep(1);
        if ((++sp & 255u) == 0u) { if (xb_ld(&bar[XB_TMO])) break; if (sp > XB_SPIN_CAP) { atomicAdd(&bar[XB_TMO], 1u); break; } }
    }
    nloc = mine > 0u ? mine : 1u; nx = cnt > 0u ? cnt : 1u;
}

__device__ __forceinline__ void xcd_barrier(const XcdBarrier& b, bool t0) {
    asm volatile("s_waitcnt vmcnt(0)" ::: "memory");
    __syncthreads();
    if (t0) {
        unsigned* bar = b.bar;
        __builtin_amdgcn_s_waitcnt(0);
        unsigned nloc = b.st[0], nx = b.st[1];
        if (nloc == 0u) { xcd_barrier_complete(bar, b.x, nloc, nx); b.st[0] = nloc; b.st[1] = nx; }
        const unsigned old = xb_add(&bar[XB_XSUB(b.x)], 1u);
        const unsigned gen = old / nloc;
        if (old + 1u == (gen + 1u) * nloc) {
            __builtin_amdgcn_fence(__ATOMIC_RELEASE, "agent");
            asm volatile("s_waitcnt vmcnt(0)" ::: "memory");
            const unsigned og = xb_add(&bar[XB_TOP], 1u);
            const unsigned tg = og / nx;
            if (og + 1u == (tg + 1u) * nx) xb_add(&bar[XB_TOPGEN], 1u);
            else XB_SPIN(xb_ld(&bar[XB_TOPGEN]) == tg, bar);
            __builtin_amdgcn_fence(__ATOMIC_ACQUIRE, "agent");
            xb_add(&bar[XB_XGEN(b.x)], 1u);
            asm volatile("s_waitcnt vmcnt(0)" ::: "memory");
        } else {
            XB_SPIN(xb_ld(&bar[XB_XGEN(b.x)]) == gen, bar);
            __builtin_amdgcn_fence(__ATOMIC_ACQUIRE, "agent");
            asm volatile("s_waitcnt vmcnt(0)" ::: "memory");
        }
    }
    __syncthreads();
}

struct Args { const float* in[14]; float* out; unsigned char* ws; float inv_freq[8]; int ph_lo, ph_hi; };

__global__ void __launch_bounds__(NTHR, 2) hybrid_fwd(Args args) {
    extern __shared__ __attribute__((aligned(16))) unsigned char lds_raw[];
    LAS unsigned char* lds = (LAS unsigned char*)lds_raw;
    cg::grid_group grid = cg::this_grid();
    const int wave = __builtin_amdgcn_readfirstlane((int)threadIdx.x >> 6);
    const int G = gridDim.x, bx = blockIdx.x;
    const int gw = bx * NWAVES + wave, NGW = G * NWAVES;
#define FRESH_IDS const int lane = opaque((int)__builtin_amdgcn_mbcnt_hi(~0u, __builtin_amdgcn_mbcnt_lo(~0u, 0u))), tid = wave * 64 + lane
    unsigned char* ws = args.ws;
    const float* x = args.in[0]; const float* ln1 = args.in[1]; const float* w_in = args.in[2];
    const float* lq1 = args.in[3]; const float* lk1 = args.in[4]; const float* lq2 = args.in[5]; const float* lk2 = args.in[6];
    const float* g_diff = args.in[7]; const float* g_sb = args.in[8]; const float* w_out = args.in[9]; const float* ln2 = args.in[10];
    const float* w1 = args.in[11]; const float* w2 = args.in[12]; const float* ln_f = args.in[13];
    float* out = args.out;
    bf16* Win_t = (bf16*)(ws + WS_WIN); bf16* Wout_t = (bf16*)(ws + WS_WOUT); bf16* W1_t = (bf16*)(ws + WS_W1); bf16* W2_t = (bf16*)(ws + WS_W2);
    float* cs = (float*)(ws + WS_CS); float* ss1 = (float*)(ws + WS_SS1); float* ss2 = (float*)(ws + WS_SS2);
    bf16* Hb = (bf16*)(ws + WS_H); bf16* QKV = (bf16*)(ws + WS_QKV); bf16* MIX = (bf16*)(ws + WS_MIX); bf16* U = (bf16*)(ws + WS_U);
    const int lo = args.ph_lo, hi_ph = args.ph_hi;
#define IN(k) (lo <= (k) && (k) < hi_ph)
    unsigned* ctl = (unsigned*)(ws + WS_CTL);
    const bool t0 = (wave == 0) && (__builtin_amdgcn_mbcnt_hi(~0u, __builtin_amdgcn_mbcnt_lo(~0u, 0u)) == 0);
    if (args.ph_lo < 0) grid.sync();
    volatile LAS unsigned* bst = (volatile LAS unsigned*)(lds + RING_BYTES);
    if (t0) { bst[0] = 0u; bst[1] = 0u; }
    __syncthreads();
    XcdBarrier xbar = xcd_barrier_post(ctl + 1024, bst, t0);
#define SEAM(k) do { if (IN(k) && IN((k) + 1)) xcd_barrier(xbar, t0); } while (0)
    if (IN(0)) {
        FRESH_IDS;
        LAS float* scr = (LAS float*)(lds + wave * 16384);
        constexpr int I_IN = (DM / 64) * (PW / 32), I_OUT = (DM / 64) * (DM / 32), I_1 = (DM / 64) * (FF / 32), I_2 = (FF / 64) * (DM / 32);
        constexpr int NITEMS = I_IN + I_OUT + I_1 + I_2;
        for (int it = gw; it < NITEMS; it += NGW) {
            int r = it;
            if (r < I_IN) { transpose_item(w_in, DM, PW, Win_t, nullptr, scr, r, lane); continue; } r -= I_IN;
            if (r < I_OUT) { transpose_item(w_out, DM, DM, Wout_t, nullptr, scr, r, lane); continue; } r -= I_OUT;
            if (r < I_1) { transpose_item(w1, DM, FF, W1_t, ln2, scr, r, lane); continue; } r -= I_1;
            transpose_item(w2, FF, DM, W2_t, nullptr, scr, r, lane);
        }
        for (int m = gw; m < M; m += NGW) {
            const f32x4* xr = (const f32x4*)(x + (size_t)m * DM) + lane; const f32x4* gr = (const f32x4*)ln1 + lane;
            f32x4 v[8], gv[8]; float s = 0.f;
#pragma unroll
            for (int j = 0; j < 8; ++j) { v[j] = __builtin_nontemporal_load(xr + 64 * j); gv[j] = gr[64 * j]; }
#pragma unroll
            for (int j = 0; j < 8; ++j) s += (v[j][0] * v[j][0] + v[j][1] * v[j][1]) + (v[j][2] * v[j][2] + v[j][3] * v[j][3]);
            const float rstd = 1.f / sqrtf(wave_sum(s) * (1.f / DM) + EPS);
            v2u* o8 = (v2u*)(Hb + (size_t)m * DM) + lane;
#pragma unroll
            for (int j = 0; j < 8; ++j) { const f32x4 gq = gv[j]; v2u w; w.x = pk2(v[j][0] * rstd * gq[0], v[j][1] * rstd * gq[1]); w.y = pk2(v[j][2] * rstd * gq[2], v[j][3] * rstd * gq[3]); o8[64 * j] = w; }
        }
        for (int e = bx * NTHR + tid; e < SEQ * 8; e += G * NTHR) {
            const int pos = e >> 3, i = e & 7;
            const float ang = (float)pos * args.inv_freq[i];
            const double rev = (double)ang * 0.15915494309189533577; const float fr = (float)(rev - rint(rev));
            cs[pos * 16 + i] = __builtin_amdgcn_cosf(fr); cs[pos * 16 + 8 + i] = __builtin_amdgcn_sinf(fr);
        }
        for (int e = bx * NTHR + tid; e < SEQ; e += G * NTHR) { ss1[e] = 0.f; ss2[e] = 0.f; }
    }
    SEAM(0);
    if (IN(1)) {
        pg8::Gemm g{Hb, Win_t, M, PW, DM}; pg8::StaticOrder S; S.init(M, PW, G, bx);
        EpiQKV E{QKV, cs};
        pg8::gemm_phase<EpiQKV, pg8::StaticOrder, true, true>(lds, g, S, E, wave);
    }
    SEAM(1);
    if (IN(2)) {
        FRESH_IDS;
        const float a = lq1[lane] * lk1[lane], b = lq2[lane] * lk2[lane];
        const float lam = __builtin_bit_cast(float, __builtin_amdgcn_readfirstlane(__builtin_bit_cast(int, __expf(wave_sum(a)) - __expf(wave_sum(b)) + LAM_INIT)));
        float* o1s = (float*)(ws + WS_H);
        for (int u = bx; u < 256; u += G) {
            const int head = u & 7, p = u >> 3;
#pragma unroll 1
            for (int t = 0; t < 2; ++t) diff_unit(lds, QKV, MIX, o1s, g_diff, lam, head, t ? 63 - p : p, wave, lane, tid);
        }
        __syncthreads();
        const int lane_sb = opaque(lane);
        for (int wu = gw; wu < 8 * 512; wu += NGW) sb_unit(lds + wave * 8192, QKV, MIX, g_sb, wu & 7, 511 - (wu >> 3), lane_sb);
        __syncthreads();
    }
    SEAM(2);
    if (IN(3)) {
        pg8::Gemm g{MIX, Wout_t, M, DM, DM}; pg8::StaticOrder S; S.init(M, DM, G, bx);
        EpiRes E{x, out, Hb, ss1};
        pg8::gemm_phase<EpiRes, pg8::StaticOrder, false, true>(lds, g, S, E, wave);
    }
    SEAM(3);
    if (IN(4)) {
        pg8::Gemm g{Hb, W1_t, M, FF, DM}; pg8::StaticOrder S; S.init(M, FF, G, bx);
        EpiMlpIn E{U, ss1};
        pg8::gemm_phase<EpiMlpIn, pg8::StaticOrder, true, true>(lds, g, S, E, wave);
    }
    SEAM(4);
    if (IN(5)) {
        pg8::Gemm g{U, W2_t, M, DM, FF}; pg8::StaticOrder S; S.init(M, DM, G, bx);
        EpiRes E{out, out, nullptr, ss2};
        pg8::gemm_phase<EpiRes, pg8::StaticOrder, false, true>(lds, g, S, E, wave);
    }
    SEAM(5);
    if (IN(6)) {
        FRESH_IDS;
        for (int m = gw; m < M; m += NGW) {
            f32x4* xr = (f32x4*)(out + (size_t)m * DM) + lane; const f32x4* gr = (const f32x4*)ln_f + lane;
            f32x4 v[8], gv[8];
#pragma unroll
            for (int j = 0; j < 8; ++j) { v[j] = xr[64 * j]; gv[j] = gr[64 * j]; }
            const float rstd = 1.f / sqrtf(__hip_atomic_load(ss2 + m, __ATOMIC_RELAXED, __HIP_MEMORY_SCOPE_AGENT) * (1.f / DM) + EPS);
            asm volatile("" ::: "memory");
#pragma unroll
            for (int j = 0; j < 8; ++j) __builtin_nontemporal_store(v[j] * rstd * gv[j], xr + 64 * j);
        }
    }
#undef IN
#undef SEAM
}

extern "C" void kernel_launch(void* const* d_in, const int* in_sizes, int n_in, void* d_out, int out_size, void* d_ws, size_t ws_size, hipStream_t stream) {
    static int grid = 0;
    if (grid == 0) {
        if (n_in != 14 || in_sizes[0] != M * DM || out_size != M * DM || ws_size < WS_END) { fprintf(stderr, "kernel_launch: unexpected shapes (n_in %d, in0 %d, out %d, ws %zu)\n", n_in, n_in > 0 ? in_sizes[0] : -1, out_size, ws_size); grid = -1; return; }
        int dev = 0, cus = 0, per_cu = 0;
        (void)hipGetDevice(&dev); (void)hipDeviceGetAttribute(&cus, hipDeviceAttributeMultiprocessorCount, dev);
        if (hipFuncSetAttribute((const void*)hybrid_fwd, hipFuncAttributeMaxDynamicSharedMemorySize, LDS_BYTES) != hipSuccess) { fprintf(stderr, "kernel_launch: hipFuncSetAttribute failed\n"); grid = -1; return; }
        if (hipOccupancyMaxActiveBlocksPerMultiprocessor(&per_cu, (const void*)hybrid_fwd, NTHR, LDS_BYTES) != hipSuccess || per_cu < 1) { fprintf(stderr, "kernel_launch: occupancy query gave %d\n", per_cu); per_cu = 1; }
        (void)hipGetLastError();
        grid = cus * per_cu;
    }
    if (grid < 0) return;
    if (hipMemsetAsync((char*)d_ws + WS_CTL, 0, 32768, stream) != hipSuccess) { fprintf(stderr, "kernel_launch: memset failed\n"); return; }
    Args a{};
    for (int i = 0; i < 14; ++i) a.in[i] = (const float*)d_in[i];
    a.out = (float*)d_out; a.ws = (unsigned char*)d_ws;
    for (int i = 0; i < 8; ++i) a.inv_freq[i] = (float)pow(500000.0, -(double)i / 8.0);
    a.ph_lo = 0; a.ph_hi = 7;
    void* kargs[] = {&a};
    hipError_t e = hipLaunchCooperativeKernel((const void*)hybrid_fwd, dim3(grid), dim3(NTHR), kargs, LDS_BYTES, stream);
    if (e != hipSuccess) fprintf(stderr, "kernel_launch: cooperative launch failed: %s (grid %d)\n", hipGetErrorString(e), grid);
}
```

```cpp
#include <hip/hip_runtime.h>
#include <hip/hip_cooperative_groups.h>
#include <cstdio>
#include <cstdint>
#include <cmath>
namespace cg = cooperative_groups;
namespace pg8 {
#define PG8_LAS __attribute__((address_space(3)))
typedef unsigned short bf16_t;
typedef short bf16x8 __attribute__((ext_vector_type(8)));
typedef float f32x4 __attribute__((ext_vector_type(4)));
typedef unsigned u32x4 __attribute__((ext_vector_type(4)));
constexpr int BM = 256, BK = 64, HALF = 128, HTB = HALF * BK * 2  , STAGE_BYTES = 8 * HTB, NXCD = 8, WGM = 8;

__host__ __device__ __forceinline__ int lds_byte(int r, int c) { const int st = (r >> 4) * 2 + (c >> 5), rr = r & 15, cc = c & 31, ob = rr * 64 + cc * 2; return st * 1024 + (ob ^ (((ob >> 9) & 1) << 5)); }
__host__ __device__ __forceinline__ void stage_rc(int b, int& R, int& C) { const int st = b / 1024, sb = b % 1024, swz = sb ^ (((sb >> 9) & 1) << 5); R = (st >> 1) * 16 + swz / 64; C = (st & 1) * 32 + (swz % 64) / 2; }
__host__ __device__ __forceinline__ int perm32(int rho) { const int n = rho >> 4, i = rho & 15; return 8 * (i >> 2) + 4 * n + (i & 3); }

struct Unit { int pm, pn; };
struct Gemm { const bf16_t* A; const bf16_t* Bt; int M, N, K; };

struct StaticOrder {
    int nM, nN, nwg, G, c;
    __host__ __device__ void init(int M, int N, int G_, int c_) { nM = M / BM; nN = N / BM; nwg = nM * nN; G = G_; c = c_; }
    __host__ __device__ bool next(int i, Unit& u) const {
        const long L = (long)i * G + c; if (L >= nwg) return false;
        int wgid = (int)L; { const int q = nwg / NXCD, r = nwg % NXCD, xcd = wgid % NXCD, off = wgid / NXCD; wgid = (xcd < r ? xcd * (q + 1) : r * (q + 1) + (xcd - r) * q) + off; }
        const int nig = WGM * nN, gid = wgid / nig, fm = gid * WGM, gsz = (nM - fm) < WGM ? (nM - fm) : WGM;
        u.pm = fm + ((wgid % nig) % gsz); u.pn = (wgid % nig) / gsz; return true;
    }
    __device__ __forceinline__ void a_ready(const Unit&) const {}
    __device__ __forceinline__ void done(const Unit&) const {}
};

__device__ __forceinline__ unsigned cvt_pk_bf16(float lo, float hi) { unsigned r; asm volatile("v_cvt_pk_bf16_f32 %0, %1, %2" : "=v"(r) : "v"(lo), "v"(hi)); return r; }
template <class Epi, class Sched, bool ALIGN_EPI = false, bool SP2 = false>
__device__ __forceinline__ void gemm_phase(PG8_LAS unsigned char* lds, const Gemm g, const Sched& S, const Epi& E, int wave_id) {
    int tid_ = wave_id * 64 + (int)__builtin_amdgcn_mbcnt_hi(~0u, __builtin_amdgcn_mbcnt_lo(~0u, 0u)); asm volatile("" : "+v"(tid_));
    const int tid = tid_, wid = __builtin_amdgcn_readfirstlane(tid >> 6), lane = tid & 63, wr = wid >> 2, wc = wid & 3, fr = lane & 15, fq = lane >> 4;
    const int K = g.K, nt = K / BK;
    unsigned voffA[2], voffB[2];
#pragma unroll
    for (int i = 0; i < 2; ++i) { int R, C; stage_rc(tid * 16 + i * 8192, R, C); const int Rb = Epi::PERM ? ((R & ~31) + perm32(R & 31)) : R;
        voffA[i] = (unsigned)(R * K + C) * 2u; voffB[i] = (unsigned)(Rb * K + C) * 2u; }
    const size_t kstep = (size_t)(BK * 2);
    const size_t hstep = (size_t)HALF * K * 2;
    const size_t tstep = 2 * hstep;
    const unsigned ldsw = (unsigned)wid * 1024u;
    const int aoff = lds_byte(wr * 64 + fr, fq * 8), boff = lds_byte(wc * 32 + fr, fq * 8);
#define PG8_SA(b, h) (((b) * 2 + (h)) * HTB)
#define PG8_SB(b, h) ((4 + (b) * 2 + (h)) * HTB)
#define PG8_STAGE(bufoff, gbase, voff) do { _Pragma("unroll") for (int _i = 0; _i < 2; ++_i) \
        __builtin_amdgcn_global_load_lds((const unsigned*)((const char*)(gbase) + (voff)[_i]), (PG8_LAS unsigned*)(lds + (bufoff) + ldsw + _i * 8192), 16, 0, 0); } while (0)
#define PG8_LDA(dst, b, h) do { _Pragma("unroll") for (int m = 0; m < 4; ++m) _Pragma("unroll") for (int k = 0; k < 2; ++k) dst[m][k] = *(const PG8_LAS bf16x8*)(lds + PG8_SA(b, h) + aoff + m * 2048 + k * 1024); } while (0)
#define PG8_LDB(dst, b, h) do { _Pragma("unroll") for (int n = 0; n < 2; ++n) _Pragma("unroll") for (int k = 0; k < 2; ++k) dst[n][k] = *(const PG8_LAS bf16x8*)(lds + PG8_SB(b, h) + boff + n * 2048 + k * 1024); } while (0)
#define PG8_MMA(ai, bj, At, Bt) do { __builtin_amdgcn_s_setprio(1); _Pragma("unroll") for (int m = 0; m < 4; ++m) _Pragma("unroll") for (int n = 0; n < 2; ++n) _Pragma("unroll") for (int k = 0; k < 2; ++k) \
        acc[ai][bj][m][n] = __builtin_amdgcn_mfma_f32_16x16x32_bf16(Bt[n][k], At[m][k], acc[ai][bj][m][n], 0, 0, 0); __builtin_amdgcn_s_setprio(0); } while (0)
#define PG8_WAIT_V(n) asm volatile("s_waitcnt vmcnt(" #n ")" ::: "memory")
#define PG8_WAIT_L(n) asm volatile("s_waitcnt lgkmcnt(" #n ")" ::: "memory")
#define PG8_BAR __builtin_amdgcn_s_barrier()
#define PG8_SCHED __builtin_amdgcn_sched_barrier(0)
    Unit cur, nxt; int ui = 0;
    if (!S.next(0, cur)) return;
    f32x4 acc[2][2][4][2];
#pragma unroll
    for (int a = 0; a < 2; ++a)
#pragma unroll
        for (int b = 0; b < 2; ++b)
#pragma unroll
            for (int m = 0; m < 4; ++m)
#pragma unroll
                for (int n = 0; n < 2; ++n) acc[a][b][m][n] = (f32x4){0.f, 0.f, 0.f, 0.f};
    bf16x8 At[4][2], B0[2][2], B1[2][2];
    const char* cA = (const char*)g.A + (size_t)cur.pm * tstep; const char* cB = (const char*)g.Bt + (size_t)cur.pn * tstep;
    S.a_ready(cur);
    if constexpr (SP2) {
        PG8_STAGE(PG8_SB(0, 0), cB, voffB); PG8_STAGE(PG8_SB(0, 1), cB + hstep, voffB); PG8_STAGE(PG8_SA(0, 0), cA, voffA); PG8_STAGE(PG8_SA(0, 1), cA + hstep, voffA);
        if (wr == 1) PG8_BAR;
        PG8_WAIT_V(2); PG8_BAR;
        PG8_STAGE(PG8_SB(1, 0), cB + kstep, voffB); PG8_STAGE(PG8_SA(1, 0), cA + kstep, voffA); PG8_STAGE(PG8_SB(1, 1), cB + hstep + kstep, voffB);
        PG8_WAIT_V(6); PG8_BAR;
    } else {
        PG8_STAGE(PG8_SB(0, 0), cB, voffB); PG8_STAGE(PG8_SA(0, 0), cA, voffA); PG8_STAGE(PG8_SB(0, 1), cB + hstep, voffB); PG8_STAGE(PG8_SA(0, 1), cA + hstep, voffA);
        if (wr == 1) PG8_BAR;
        PG8_WAIT_V(4); PG8_BAR;
        PG8_STAGE(PG8_SB(1, 0), cB + kstep, voffB); PG8_STAGE(PG8_SA(1, 0), cA + kstep, voffA); PG8_STAGE(PG8_SB(1, 1), cB + hstep + kstep, voffB);
        PG8_WAIT_V(6); PG8_BAR;
    }
    for (;;) {
        const bool has_next = S.next(ui + 1, nxt);
        const char* nA = has_next ? (const char*)g.A + (size_t)nxt.pm * tstep : cA; const char* nB = has_next ? (const char*)g.Bt + (size_t)nxt.pn * tstep : cB;
        for (int t = 0; t < nt; t += 2) {
            const bool last = (t == nt - 2);
            const char* a1 = cA + (size_t)(t + 1) * kstep;
            const char* a2 = last ? nA : cA + (size_t)(t + 2) * kstep; const char* b2 = last ? nB : cB + (size_t)(t + 2) * kstep;
            const char* a3 = a2 + kstep; const char* b3 = b2 + kstep;
            if (last && has_next) S.a_ready(nxt);
            if constexpr (SP2) {
            PG8_LDB(B0, 0, 0); PG8_LDB(B1, 0, 1); PG8_SCHED; PG8_LDA(At, 0, 0); PG8_STAGE(PG8_SA(1, 1), a1 + hstep, voffA);
            PG8_WAIT_V(8); PG8_WAIT_L(0); PG8_BAR; PG8_MMA(0, 0, At, B0); PG8_MMA(0, 1, At, B1); PG8_BAR; PG8_SCHED;
            PG8_LDA(At, 0, 1); PG8_STAGE(PG8_SB(0, 0), b2, voffB); PG8_STAGE(PG8_SB(0, 1), b2 + hstep, voffB); PG8_STAGE(PG8_SA(0, 0), a2, voffA);
            PG8_WAIT_V(8); PG8_WAIT_L(0); PG8_BAR; PG8_MMA(1, 0, At, B0); PG8_MMA(1, 1, At, B1); PG8_BAR; PG8_SCHED;
            PG8_LDB(B0, 1, 0); PG8_LDB(B1, 1, 1); PG8_SCHED; PG8_LDA(At, 1, 0); PG8_STAGE(PG8_SA(0, 1), a2 + hstep, voffA);
            PG8_WAIT_V(8); PG8_WAIT_L(0); PG8_BAR; PG8_MMA(0, 0, At, B0); PG8_MMA(0, 1, At, B1); PG8_BAR; PG8_SCHED;
            PG8_LDA(At, 1, 1); PG8_STAGE(PG8_SB(1, 0), b3, voffB); PG8_STAGE(PG8_SB(1, 1), b3 + hstep, voffB); PG8_STAGE(PG8_SA(1, 0), a3, voffA);
            PG8_WAIT_V(8); PG8_WAIT_L(0); PG8_BAR; PG8_MMA(1, 0, At, B0); PG8_MMA(1, 1, At, B1); PG8_BAR; PG8_SCHED;
            } else {
            PG8_LDB(B0, 0, 0); PG8_SCHED; PG8_LDA(At, 0, 0); PG8_STAGE(PG8_SA(1, 1), a1 + hstep, voffA);
            PG8_WAIT_L(8); PG8_BAR; PG8_WAIT_L(0); PG8_MMA(0, 0, At, B0); PG8_BAR; PG8_SCHED;
            PG8_LDB(B1, 0, 1); PG8_STAGE(PG8_SB(0, 0), b2, voffB);
            PG8_BAR; PG8_WAIT_L(0); PG8_MMA(0, 1, At, B1); PG8_BAR;
            PG8_LDA(At, 0, 1); PG8_STAGE(PG8_SA(0, 0), a2, voffA);
            PG8_BAR; PG8_WAIT_L(0); PG8_MMA(1, 0, At, B0); PG8_BAR; PG8_SCHED;
            PG8_STAGE(PG8_SB(0, 1), b2 + hstep, voffB);
            PG8_WAIT_V(6); PG8_BAR; PG8_MMA(1, 1, At, B1); PG8_BAR;
            PG8_LDB(B0, 1, 0); PG8_SCHED; PG8_LDA(At, 1, 0); PG8_STAGE(PG8_SA(0, 1), a2 + hstep, voffA);
            PG8_WAIT_L(8); PG8_BAR; PG8_WAIT_L(0); PG8_MMA(0, 0, At, B0); PG8_BAR; PG8_SCHED;
            PG8_LDB(B1, 1, 1); PG8_STAGE(PG8_SB(1, 0), b3, voffB);
            PG8_BAR; PG8_WAIT_L(0); PG8_MMA(0, 1, At, B1); PG8_BAR;
            PG8_LDA(At, 1, 1); PG8_STAGE(PG8_SA(1, 0), a3, voffA);
            PG8_BAR; PG8_WAIT_L(0); PG8_MMA(1, 0, At, B0); PG8_BAR; PG8_SCHED;
            PG8_STAGE(PG8_SB(1, 1), b3 + hstep, voffB);
            PG8_WAIT_V(6); PG8_BAR; PG8_MMA(1, 1, At, B1); PG8_BAR;
            }
        }
        if constexpr (ALIGN_EPI) { if (wr == 0) PG8_BAR; }
        if constexpr (!Epi::AFTER_DRAIN) { E(acc, cur, wr, wc, fr, fq); S.done(cur); }
        if (!has_next) break;
#pragma unroll
        for (int a = 0; a < 2; ++a)
#pragma unroll
            for (int b = 0; b < 2; ++b)
#pragma unroll
                for (int m = 0; m < 4; ++m)
#pragma unroll
                    for (int n = 0; n < 2; ++n) acc[a][b][m][n] = (f32x4){0.f, 0.f, 0.f, 0.f};
        cur = nxt; cA = nA; cB = nB; ++ui;
        if constexpr (ALIGN_EPI) { if (wr == 1) PG8_BAR; }
    }
    PG8_WAIT_V(0);
    if constexpr (!ALIGN_EPI) { if (wr == 0) PG8_BAR; }
    PG8_BAR;
    if constexpr (Epi::AFTER_DRAIN) { E.fused(acc, cur, wr, wc, fr, fq, lds, wid, lane); S.done(cur); }
#undef PG8_SA
#undef PG8_SB
#undef PG8_STAGE
#undef PG8_LDA
#undef PG8_LDB
#undef PG8_MMA
#undef PG8_WAIT_V
#undef PG8_WAIT_L
#undef PG8_BAR
#undef PG8_SCHED
}
}
#define GAS __attribute__((address_space(1)))
#define LAS __attribute__((address_space(3)))
typedef unsigned short bf16;
typedef unsigned v4u __attribute__((ext_vector_type(4)));
typedef unsigned v2u __attribute__((ext_vector_type(2)));
typedef float f32x4 __attribute__((ext_vector_type(4)));
typedef float f32x16 __attribute__((ext_vector_type(16)));
typedef short bf16x8 __attribute__((ext_vector_type(8)));
typedef short s16x4 __attribute__((ext_vector_type(4)));
using pg8::Unit; using pg8::cvt_pk_bf16; using pg8::BM; using pg8::HALF;

constexpr int SEQ = 16384, DM = 2048, PW = 6144, FF = 8192, M = SEQ;
constexpr int NWAVES = 8, NTHR = 512;
constexpr float EPS = 1e-6f;
constexpr float C2 = 0.125f * 1.4426950408889634f;
constexpr float SBSCALE = 0.08838834764831845f * 1.4426950408889634f;
constexpr float LAM_INIT = 0.2f;
constexpr int COL_DQ = 0, COL_DK = 1024, COL_DV = 2048, COL_SQ = 3072, COL_SK = 4096, COL_SV = 5120;

constexpr size_t MiB = 1u << 20;
constexpr size_t WS_WIN = 0;
constexpr size_t WS_WOUT = 24 * MiB;
constexpr size_t WS_W1 = 32 * MiB;
constexpr size_t WS_W2 = 64 * MiB;
constexpr size_t WS_CS = 96 * MiB;
constexpr size_t WS_SS1 = 97 * MiB;
constexpr size_t WS_SS2 = 97 * MiB + 65536;
constexpr size_t WS_H = 98 * MiB;
constexpr size_t WS_QKV = 162 * MiB;
constexpr size_t WS_MIX = 354 * MiB;
constexpr size_t WS_U = 162 * MiB;
constexpr size_t WS_CTL = 418 * MiB;
constexpr size_t WS_END = 419 * MiB;

constexpr int RING_BYTES = 131072, LDS_BYTES = 131072 + 1024;

__device__ __forceinline__ unsigned f2bf(float f) { unsigned u = __builtin_bit_cast(unsigned, f); return (u + 0x7fffu + ((u >> 16) & 1u)) >> 16; }
__device__ __forceinline__ unsigned pk2(float lo, float hi) { return f2bf(lo) | (f2bf(hi) << 16); }
__device__ __forceinline__ float wave_sum(float v) {
#pragma unroll
    for (int o = 1; o < 64; o <<= 1) v += __shfl_xor(v, o);
    return v;
}
typedef unsigned u32x2_t __attribute__((ext_vector_type(2)));
__device__ __forceinline__ void swap_x32(float& a, float& b) { asm volatile("s_nop 1\n\tv_permlane32_swap_b32 %0, %1" : "+v"(a), "+v"(b)); }
__device__ __forceinline__ float max_x32(float x) { float a = x, b = x; swap_x32(a, b); return fmaxf(a, b); }
__device__ __forceinline__ float sum_x32(float x) { float a = x, b = x; swap_x32(a, b); return a + b; }
__device__ __forceinline__ float partner_x32(float x, int hi) { float a = x, b = x; swap_x32(a, b); return hi ? a : b; }
#define LDS_WAIT() asm volatile("s_waitcnt lgkmcnt(0)" ::: "memory")
__device__ __forceinline__ int opaque(int v) { asm volatile("" : "+v"(v)); return v; }

struct EpiQKV {
    static constexpr bool PERM = true, AFTER_DRAIN = false;
    bf16* O; const float* cs;
    __device__ __forceinline__ void operator()(const f32x4 (&acc)[2][2][4][2], const Unit& u, int wr, int wc, int fr, int fq) const {
        const int row0 = u.pm * BM + wr * 64 + fr, col0 = u.pn * BM + wc * 32 + 8 * fq;
        float sc = 1.f; if (u.pn < 4) sc = C2; else if (u.pn >= 12 && u.pn < 16) sc = SBSCALE;
        const bool rot = (u.pn < 8) && ((wc & 1) == 0);
        if (rot) {
#pragma unroll
            for (int ai = 0; ai < 2; ++ai) {
                f32x4 cv[4][4];
#pragma unroll
                for (int m = 0; m < 4; ++m) { const f32x4* p = (const f32x4*)(cs + (size_t)(row0 + ai * HALF + m * 16) * 16); cv[m][0] = p[0]; cv[m][1] = p[1]; cv[m][2] = p[2]; cv[m][3] = p[3]; }
#pragma unroll
                for (int m = 0; m < 4; ++m) {
                    const int row = row0 + ai * HALF + m * 16;
                    const f32x4 c0 = cv[m][0], c1 = cv[m][1]; f32x4 s0 = cv[m][2], s1 = cv[m][3]; if (fq == 0) { s0 = -s0; s1 = -s1; }
#pragma unroll
                    for (int bj = 0; bj < 2; ++bj) {
                        f32x4 v0 = acc[ai][bj][m][0] * sc, v1 = acc[ai][bj][m][1] * sc, p0, p1;
#pragma unroll
                        for (int e = 0; e < 4; ++e) { p0[e] = __shfl_xor(v0[e], 16); p1[e] = __shfl_xor(v1[e], 16); }
                        if (fq < 2) { v0 = v0 * c0 + p0 * s0; v1 = v1 * c1 + p1 * s1; }
                        v4u w; w.x = cvt_pk_bf16(v0[0], v0[1]); w.y = cvt_pk_bf16(v0[2], v0[3]); w.z = cvt_pk_bf16(v1[0], v1[1]); w.w = cvt_pk_bf16(v1[2], v1[3]);
                        *(v4u*)(O + (size_t)row * PW + col0 + bj * HALF) = w;
                    }
                }
            }
        } else {
#pragma unroll
            for (int ai = 0; ai < 2; ++ai)
#pragma unroll
                for (int m = 0; m < 4; ++m) {
                    const int row = row0 + ai * HALF + m * 16;
#pragma unroll
                    for (int bj = 0; bj < 2; ++bj) {
                        const f32x4 v0 = acc[ai][bj][m][0] * sc, v1 = acc[ai][bj][m][1] * sc;
                        v4u w; w.x = cvt_pk_bf16(v0[0], v0[1]); w.y = cvt_pk_bf16(v0[2], v0[3]); w.z = cvt_pk_bf16(v1[0], v1[1]); w.w = cvt_pk_bf16(v1[2], v1[3]);
                        *(v4u*)(O + (size_t)row * PW + col0 + bj * HALF) = w;
                    }
                }
        }
    }
};
template <bool RES_BF16>
struct EpiRes {
    static constexpr bool PERM = true, AFTER_DRAIN = false;
    const float* R; const bf16* Rb; float* Y; bf16* Yb; float* ss;
    __device__ __forceinline__ void operator()(const f32x4 (&acc)[2][2][4][2], const Unit& u, int wr, int wc, int fr, int fq) const {
        const int row0 = u.pm * BM + wr * 64 + fr, col0 = u.pn * BM + wc * 32 + 8 * fq;
#pragma unroll
        for (int ai = 0; ai < 2; ++ai) {
            f32x4 rv[4][2][2];
#pragma unroll
            for (int m = 0; m < 4; ++m)
#pragma unroll
                for (int bj = 0; bj < 2; ++bj) {
                    const size_t off = (size_t)(row0 + ai * HALF + m * 16) * DM + col0 + bj * HALF;
                    if (RES_BF16) {
                        const v4u t = *(const v4u*)(Rb + off);
                        rv[m][bj][0] = (f32x4){__builtin_bit_cast(float, t.x << 16), __builtin_bit_cast(float, t.x & 0xffff0000u), __builtin_bit_cast(float, t.y << 16), __builtin_bit_cast(float, t.y & 0xffff0000u)};
                        rv[m][bj][1] = (f32x4){__builtin_bit_cast(float, t.z << 16), __builtin_bit_cast(float, t.z & 0xffff0000u), __builtin_bit_cast(float, t.w << 16), __builtin_bit_cast(float, t.w & 0xffff0000u)};
                    } else { rv[m][bj][0] = *(const f32x4*)(R + off); rv[m][bj][1] = *(const f32x4*)(R + off + 4); }
                }
            asm volatile("" ::: "memory");
#pragma unroll
            for (int m = 0; m < 4; ++m) {
                const int row = row0 + ai * HALF + m * 16; float s = 0.f;
#pragma unroll
                for (int bj = 0; bj < 2; ++bj) {
                    const size_t off = (size_t)row * DM + col0 + bj * HALF;
                    const f32x4 v0 = acc[ai][bj][m][0] + rv[m][bj][0], v1 = acc[ai][bj][m][1] + rv[m][bj][1];
                    if (RES_BF16) { *(f32x4*)(Y + off) = v0; *(f32x4*)(Y + off + 4) = v1; }
                    else { v4u w; w.x = cvt_pk_bf16(v0[0], v0[1]); w.y = cvt_pk_bf16(v0[2], v0[3]); w.z = cvt_pk_bf16(v1[0], v1[1]); w.w = cvt_pk_bf16(v1[2], v1[3]); *(v4u*)(Yb + off) = w; }
                    s += (v0[0] * v0[0] + v0[1] * v0[1]) + (v0[2] * v0[2] + v0[3] * v0[3]) + (v1[0] * v1[0] + v1[1] * v1[1]) + (v1[2] * v1[2] + v1[3] * v1[3]);
                }
                s += __shfl_xor(s, 16); s += __shfl_xor(s, 32);
                if (fq == 0) atomicAdd(ss + row, s);
            }
        }
    }
};
struct EpiMlpIn {
    static constexpr bool PERM = true, AFTER_DRAIN = false;
    bf16* O; const float* ss;
    __device__ __forceinline__ void operator()(const f32x4 (&acc)[2][2][4][2], const Unit& u, int wr, int wc, int fr, int fq) const {
        const int row0 = u.pm * BM + wr * 64 + fr, col0 = u.pn * BM + wc * 32 + 8 * fq;
        float rs[2][4];
#pragma unroll
        for (int ai = 0; ai < 2; ++ai)
#pragma unroll
            for (int m = 0; m < 4; ++m) rs[ai][m] = __hip_atomic_load(ss + row0 + ai * HALF + m * 16, __ATOMIC_RELAXED, __HIP_MEMORY_SCOPE_AGENT);
        asm volatile("" ::: "memory");
#pragma unroll
        for (int ai = 0; ai < 2; ++ai)
#pragma unroll
            for (int m = 0; m < 4; ++m) {
                const int row = row0 + ai * HALF + m * 16;
                const float rstd = __builtin_amdgcn_rsqf(rs[ai][m] * (1.f / DM) + EPS);
#pragma unroll
                for (int bj = 0; bj < 2; ++bj) {
                    f32x4 v0 = acc[ai][bj][m][0] * rstd, v1 = acc[ai][bj][m][1] * rstd;
#pragma unroll
                    for (int e = 0; e < 4; ++e) { const float a = fmaxf(v0[e], 0.f), b = fmaxf(v1[e], 0.f); v0[e] = a * a; v1[e] = b * b; }
                    v4u w; w.x = cvt_pk_bf16(v0[0], v0[1]); w.y = cvt_pk_bf16(v0[2], v0[3]); w.z = cvt_pk_bf16(v1[0], v1[1]); w.w = cvt_pk_bf16(v1[2], v1[3]);
                    *(v4u*)(O + (size_t)row * FF + col0 + bj * HALF) = w;
                }
            }
    }
};
#define MFMA32(a, b, c) __builtin_amdgcn_mfma_f32_32x32x16_bf16((a), (b), (c), 0, 0, 0)
__device__ __forceinline__ int crow(int r, int hi) { return (r & 3) + 8 * (r >> 2) + 4 * hi; }
typedef short v4i16_t __attribute__((ext_vector_type(4)));
__device__ __forceinline__ s16x4 vtr(LAS const unsigned char* p) { return __builtin_bit_cast(s16x4, __builtin_amdgcn_ds_read_tr16_b64_v4i16((LAS v4i16_t*)p)); }
typedef float f32x2_t __attribute__((ext_vector_type(2)));
typedef __bf16 bf16x2_t __attribute__((ext_vector_type(2)));
__device__ __forceinline__ unsigned cvtpk_s(float lo, float hi) { f32x2_t v = {lo, hi}; bf16x2_t b = __builtin_convertvector(v, bf16x2_t); return __builtin_bit_cast(unsigned, b); }
__device__ __forceinline__ bf16x8 pack8(const f32x16& x, int s) {
    v4u p; p.x = cvtpk_s(x[8 * s], x[8 * s + 1]); p.y = cvtpk_s(x[8 * s + 2], x[8 * s + 3]); p.z = cvtpk_s(x[8 * s + 4], x[8 * s + 5]); p.w = cvtpk_s(x[8 * s + 6], x[8 * s + 7]);
    return __builtin_bit_cast(bf16x8, p);
}

__device__ __forceinline__ void glds16(const void* sbase, unsigned voff, unsigned lds_dst) { unsigned keep;
    asm volatile("s_mov_b32 %0, m0\n\ts_mov_b32 m0, %3\n\ts_nop 0\n\tglobal_load_lds_dwordx4 %1, %2\n\ts_mov_b32 m0, %0" : "=&s"(keep) : "v"(voff), "s"(sbase), "s"(lds_dst) : "memory"); }
template <bool TAIL>
__device__ __forceinline__ void flash_half(f32x16 (&O)[4], f32x16& Sc, f32x16& Sn, float& m_run, float& l_run, bf16x8& mfrag, const bf16x8& onefrag, const bf16x8 (&qf)[4],
                                           LAS const unsigned char* Kn, LAS const unsigned char* Vc, unsigned ka, int kx, unsigned va, int vx, int blk, int hi, int key0, int qrow, int qmin) {
    if (TAIL) {
        const int kb = key0 + 4 * hi;
#pragma unroll
        for (int i = 0; i < 16; ++i) { const int key = kb + (i & 3) + 8 * (i >> 2); if (key > qrow) Sc[i] = -1e30f; }
    }
    float mloc = fmaxf(Sc[0], Sc[1]);
#pragma unroll
    for (int i = 2; i < 16; ++i) mloc = fmaxf(mloc, Sc[i]);
    mloc = max_x32(mloc);
    const bool first = (key0 == 0);
    if (__any(mloc > 8.f) || first) {
        const float m_new = (mloc > 8.f || first) ? __builtin_bit_cast(float, f2bf(m_run + mloc) << 16) : m_run;
        const float delta = m_new - m_run, alpha = __builtin_amdgcn_exp2f(-delta);
        l_run *= alpha;
#pragma unroll
        for (int d = 0; d < 4; ++d)
#pragma unroll
            for (int i = 0; i < 16; ++i) O[d][i] *= alpha;
#pragma unroll
        for (int i = 0; i < 16; ++i) Sc[i] -= delta;
        m_run = m_new;
        mfrag[0] = hi ? (short)0 : (short)(f2bf(-m_new));
    }
#pragma unroll
    for (int i = 0; i < 16; ++i) Sn[i] = 0.f;
    Sn = MFMA32(onefrag, mfrag, Sn);
#pragma unroll
    for (int ks = 0; ks < 4; ++ks) {
        const bf16x8 a0 = *(LAS const bf16x8*)(Kn + ka + (((2 * ks + hi) ^ kx) << 4));
        Sn = MFMA32(a0, qf[ks], Sn);
    }
    float ls = 0.f;
#pragma unroll
    for (int i = 0; i < 16; ++i) { Sc[i] = __builtin_amdgcn_exp2f(Sc[i]); ls += Sc[i]; }
    l_run += ls;
#pragma unroll
    for (int kk = 0; kk < 2; ++kk) {
        if (kk == 1) __builtin_amdgcn_sched_barrier(0);
        const bf16x8 pb = pack8(Sc, kk);
#pragma unroll
        for (int d = 0; d < 4; ++d) {
            LAS const unsigned char* p = Vc + va + kk * 4096 + (((2 * d + blk) ^ vx) << 5);
            const s16x4 lo = vtr(p), hi4 = vtr(p + 2048);
            const bf16x8 a = __builtin_shufflevector(lo, hi4, 0, 1, 2, 3, 4, 5, 6, 7);
            O[d] = MFMA32(a, pb, O[d]);
        }
    }
}

constexpr int DA_V = 49152, KT = 128;
__device__ __forceinline__ void flash_map(f32x16 (&O)[4], LAS unsigned char* lds, const bf16* QKV, int qcol, int kcol, int vcol, int qb, int w, int lane, int tid) {
    const int r32 = lane & 31, hi = lane >> 5;
    const int qmin = qb * 256 + w * 32, qrow = qmin + r32;
    bf16x8 qf[4];
    { const int lq = opaque(lane);
      const bf16* qp = QKV + (size_t)(qmin + (lq & 31)) * PW + qcol + 8 * (lq >> 5);
#pragma unroll
      for (int ks = 0; ks < 4; ++ks) qf[ks] = *(const bf16x8*)(qp + 16 * ks); }
#pragma unroll
    for (int d = 0; d < 4; ++d)
#pragma unroll
        for (int i = 0; i < 16; ++i) O[d][i] = 0.f;
    float m_run = 0.f, l_run = 0.f;
    bf16x8 mfrag = {0, 0, 0, 0, 0, 0, 0, 0}, onefrag = {0, 0, 0, 0, 0, 0, 0, 0}; onefrag[0] = hi ? (short)0 : (short)0x3F80;
    const int nkt = 2 * (qb + 1), nmain = 2 * qb;
    const int krow = tid >> 3, kc = (tid & 7) ^ ((krow >> 1) & 7);
    const unsigned kgo = (unsigned)(krow * PW + kc * 8) * 2u;
    const int vrow = tid >> 4, vpos = tid & 15, vc = ((((vpos >> 1) ^ (2 * (vrow & 3)))) << 1) | (vpos & 1);
    const unsigned vgo = (unsigned)(vrow * PW + vc * 8) * 2u;
    const bf16* kg = QKV + kcol; const bf16* vg = QKV + vcol;
    const unsigned wl = (unsigned)(tid >> 6) * 1024u;
    const size_t tstep = (size_t)KT * PW;
#define DMA16(g, vo, l) glds16((g), (vo), (unsigned)__builtin_amdgcn_readfirstlane((int)(unsigned)(size_t)(l)))
#define DMA_K(t, slot) do { const bf16* g_ = kg + (size_t)(t) * tstep; DMA16(g_, kgo, lds + (slot) + wl); DMA16(g_ + (size_t)64 * PW, kgo, lds + (slot) + 8192 + wl); } while (0)
#define DMA_VH(t, b, h) do { const bf16* g_ = vg + (size_t)(t) * tstep + (size_t)(64 * (h)) * PW; LAS unsigned char* l_ = lds + DA_V + (b) * 32768 + 16384 * (h) + wl; \
        DMA16(g_, vgo, l_); DMA16(g_ + (size_t)32 * PW, vgo, l_ + 8192); } while (0)
#define DMA_V(t, b) do { DMA_VH(t, b, 0); DMA_VH(t, b, 1); } while (0)
    const unsigned ka = r32 * 128;
    const int kx = (r32 >> 1) & 7;
    const int q4 = (lane & 15) >> 2, p4 = lane & 3, blk = (lane >> 4) & 1;
    const int vr0 = 4 * hi + q4;
    const unsigned va = DA_V + vr0 * 256 + 8 * p4;
    const int vx = 2 * q4;
    DMA_K(0, 0); DMA_K(1, 16384); DMA_V(0, 0);
    asm volatile("s_waitcnt vmcnt(0) lgkmcnt(0)\n\ts_barrier" ::: "memory");
    f32x16 S0, S1;
#pragma unroll
    for (int i = 0; i < 16; ++i) S0[i] = 0.f;
#pragma unroll
    for (int ks = 0; ks < 4; ++ks) S0 = MFMA32(*(LAS const bf16x8*)(lds + ka + (((2 * ks + hi) ^ kx) << 4)), qf[ks], S0);
    int kb0 = 0, kb1 = 16384, kb2 = 32768;
    for (int kt = 0; kt < nkt; ++kt) {
        const int buf = kt & 1;
        const bool more = kt + 1 < nkt;
        if (kt + 2 < nkt) DMA_K(kt + 2, kb2);
        LAS const unsigned char* Kc = lds + kb0; LAS const unsigned char* Vb = lds + buf * 32768;
        if (kt < nmain) {
            flash_half<false>(O, S0, S1, m_run, l_run, mfrag, onefrag, qf, Kc + 4096, Vb, ka, kx, va, vx, blk, hi, kt * KT, qrow, qmin);
            if (more) DMA_VH(kt + 1, buf ^ 1, 0);
            flash_half<false>(O, S1, S0, m_run, l_run, mfrag, onefrag, qf, Kc + 8192, Vb + 8192, ka, kx, va, vx, blk, hi, kt * KT + 32, qrow, qmin);
            if (more) DMA_VH(kt + 1, buf ^ 1, 1);
            flash_half<false>(O, S0, S1, m_run, l_run, mfrag, onefrag, qf, Kc + 12288, Vb + 16384, ka, kx, va, vx, blk, hi, kt * KT + 64, qrow, qmin);
            flash_half<false>(O, S1, S0, m_run, l_run, mfrag, onefrag, qf, lds + kb1, Vb + 24576, ka, kx, va, vx, blk, hi, kt * KT + 96, qrow, qmin);
        } else {
            if (more) DMA_V(kt + 1, buf ^ 1);
            flash_half<true>(O, S0, S1, m_run, l_run, mfrag, onefrag, qf, Kc + 4096, Vb, ka, kx, va, vx, blk, hi, kt * KT, qrow, qmin);
            flash_half<true>(O, S1, S0, m_run, l_run, mfrag, onefrag, qf, Kc + 8192, Vb + 8192, ka, kx, va, vx, blk, hi, kt * KT + 32, qrow, qmin);
            flash_half<true>(O, S0, S1, m_run, l_run, mfrag, onefrag, qf, Kc + 12288, Vb + 16384, ka, kx, va, vx, blk, hi, kt * KT + 64, qrow, qmin);
            flash_half<true>(O, S1, S0, m_run, l_run, mfrag, onefrag, qf, lds + kb1, Vb + 24576, ka, kx, va, vx, blk, hi, kt * KT + 96, qrow, qmin);
        }
        asm volatile("s_waitcnt vmcnt(0) lgkmcnt(0)\n\ts_barrier" ::: "memory");
        const int t0 = kb0; kb0 = kb1; kb1 = kb2; kb2 = t0;
    }
#undef DMA16
#undef DMA_K
#undef DMA_V
#undef DMA_VH
    const float l = sum_x32(l_run), inv = 1.f / l;
#pragma unroll
    for (int d = 0; d < 4; ++d)
#pragma unroll
        for (int i = 0; i < 16; ++i) O[d][i] *= inv;
}

__device__ __forceinline__ void headnorm_store(const f32x16 (&O)[4], const float* g, float post, bf16* MIX, int qrow, int col0, int hi) {
    float ss = 0.f;
#pragma unroll
    for (int d = 0; d < 4; ++d)
#pragma unroll
        for (int i = 0; i < 16; ++i) ss += O[d][i] * O[d][i];
    ss = sum_x32(ss);
    const float rs = __builtin_amdgcn_rsqf(ss * (1.f / 128.f) + EPS) * post;
    f32x4 gvv[4][4];
#pragma unroll
    for (int d = 0; d < 4; ++d)
#pragma unroll
        for (int gq = 0; gq < 4; ++gq) gvv[d][gq] = *(const f32x4*)(g + 32 * d + 8 * gq + 4 * hi);
    asm volatile("" ::: "memory");
#pragma unroll
    for (int d = 0; d < 4; ++d)
#pragma unroll
        for (int gq = 0; gq < 4; ++gq) {
            const int dv = 32 * d + 8 * gq + 4 * hi;
            const f32x4 gv = gvv[d][gq];
            v2u w; w.x = cvtpk_s(O[d][4 * gq] * rs * gv[0], O[d][4 * gq + 1] * rs * gv[1]); w.y = cvtpk_s(O[d][4 * gq + 2] * rs * gv[2], O[d][4 * gq + 3] * rs * gv[3]);
            *(v2u*)(MIX + (size_t)qrow * DM + col0 + dv) = w;
        }
}

__device__ __forceinline__ void diff_unit(LAS unsigned char* lds, const bf16* QKV, bf16* MIX, float* o1s, const float* gd, float lam, int head, int qb, int w, int lane, int tid) {
    f32x16 O[4];
#pragma unroll 1
    for (int j = 0; j < 2; ++j) {
        flash_map(O, lds, QKV, COL_DQ + head * 128 + 64 * j, COL_DK + head * 128 + 64 * j, COL_DV + head * 128, qb, w, lane, tid);
        if (j == 0) {
            f32x4* sc = (f32x4*)(o1s + ((size_t)(blockIdx.x * NWAVES + w) * 64 + opaque(lane)) * 64);
#pragma unroll
            for (int d = 0; d < 4; ++d)
#pragma unroll
                for (int i = 0; i < 4; ++i) sc[d * 4 + i] = (f32x4){O[d][4 * i], O[d][4 * i + 1], O[d][4 * i + 2], O[d][4 * i + 3]};
        }
    }
    lane = opaque(lane);
    const f32x4* sc = (const f32x4*)(o1s + ((size_t)(blockIdx.x * NWAVES + w) * 64 + lane) * 64);
#pragma unroll
    for (int d = 0; d < 4; ++d)
#pragma unroll
        for (int i = 0; i < 4; ++i) { const f32x4 t = sc[d * 4 + i];
#pragma unroll
            for (int e = 0; e < 4; ++e) O[d][4 * i + e] = t[e] - lam * O[d][4 * i + e]; }
    headnorm_store(O, gd, 1.f - LAM_INIT, MIX, qb * 256 + w * 32 + (lane & 31), head * 128, lane >> 5);
}

constexpr float SB_STOP = -44.f * 1.4426950408889634f;
__device__ __forceinline__ void sb_unit(LAS unsigned char* vl, const bf16* QKV, bf16* MIX, const float* gs, int head, int qg, int lane) {
    const int r32 = lane & 31, hi = lane >> 5;
    const int qrow = qg * 32 + r32;
    bf16x8 qf[8];
#pragma unroll
    for (int ks = 0; ks < 8; ++ks) qf[ks] = *(const bf16x8*)(QKV + (size_t)qrow * PW + COL_SQ + head * 128 + 16 * ks + 8 * hi);
    f32x16 O[4];
#pragma unroll
    for (int d = 0; d < 4; ++d)
#pragma unroll
        for (int i = 0; i < 16; ++i) O[d][i] = 0.f;
    float R = 0.f;
    const int q4 = (lane & 15) >> 2, p4 = lane & 3, blk = (lane >> 4) & 1;
    const int vr0 = 4 * hi + q4, vx = vr0 & 7;
    const unsigned va = vr0 * 256 + 8 * p4;
    const bf16* kgp = QKV + (size_t)r32 * PW + COL_SK + head * 128 + 8 * hi;
    const bf16* vgp = QKV + (size_t)(lane >> 4) * PW + COL_SV + head * 128 + (lane & 15) * 8;
    bf16x8 kf[8]; v4u vreg[8];
#pragma unroll
    for (int ks = 0; ks < 8; ++ks) kf[ks] = *(const bf16x8*)(kgp + (size_t)(qg * 32) * PW + 16 * ks);
#pragma unroll
    for (int i = 0; i < 8; ++i) vreg[i] = *(const v4u*)(vgp + (size_t)(qg * 32 + 4 * i) * PW);
    for (int kt = qg; kt >= 0; --kt) {
        const int k0 = kt * 32;
        f32x16 S;
#pragma unroll
        for (int i = 0; i < 16; ++i) S[i] = 0.f;
#pragma unroll
        for (int ks = 0; ks < 8; ++ks) S = MFMA32(kf[ks], qf[ks], S);
        LDS_WAIT();
#pragma unroll
        for (int i = 0; i < 8; ++i) { const int row = 4 * i + (lane >> 4), c = lane & 15; *(LAS v4u*)(vl + row * 256 + (((c >> 1) ^ (row & 7)) << 5) + ((c & 1) << 4)) = vreg[i]; }
        if (kt > 0) {
#pragma unroll
            for (int ks = 0; ks < 8; ++ks) kf[ks] = *(const bf16x8*)(kgp + (size_t)(k0 - 32) * PW + 16 * ks);
#pragma unroll
            for (int i = 0; i < 8; ++i) vreg[i] = *(const v4u*)(vgp + (size_t)(k0 - 32 + 4 * i) * PW);
        }
        float lb[16], lom[16];
#pragma unroll
        for (int i = 0; i < 16; ++i) {
            const int key = k0 + crow(i, hi); const float z = S[i];
            const float sp = __builtin_amdgcn_logf(1.f + __builtin_amdgcn_exp2f(-fabsf(z)));
            lb[i] = fminf(z, 0.f) - sp;
            lom[i] = (key < qrow) ? lb[i] - z : 0.f;
        }
        float gsum[4], pgs[4], after[4];
#pragma unroll
        for (int g = 0; g < 4; ++g) { gsum[g] = (lom[4 * g] + lom[4 * g + 1]) + (lom[4 * g + 2] + lom[4 * g + 3]); pgs[g] = partner_x32(gsum[g], hi); }
        float run = 0.f;
#pragma unroll
        for (int g = 3; g >= 0; --g) { after[g] = run + (hi == 0 ? pgs[g] : 0.f); run += gsum[g] + pgs[g]; }
#pragma unroll
        for (int g = 0; g < 4; ++g) {
            float suf = R + after[g];
#pragma unroll
            for (int e = 3; e >= 0; --e) {
                const int i = 4 * g + e; const int key = k0 + crow(i, hi);
                S[i] = (key < qrow) ? __builtin_amdgcn_exp2f(lb[i] + suf) : 0.f;
                suf += lom[i];
            }
        }
        R += run;
        LDS_WAIT();
#pragma unroll
        for (int kk = 0; kk < 2; ++kk) {
            const bf16x8 pb = pack8(S, kk);
#pragma unroll
            for (int d = 0; d < 4; ++d) {
                LAS const unsigned char* p = vl + va + kk * 4096 + (((2 * d + blk) ^ vx) << 5);
                const s16x4 lo = vtr(p), hi4 = vtr(p + 2048);
                const bf16x8 a = __builtin_shufflevector(lo, hi4, 0, 1, 2, 3, 4, 5, 6, 7);
                O[d] = MFMA32(a, pb, O[d]);
            }
        }
        if (__all(R < SB_STOP)) break;
    }
    LDS_WAIT();
    headnorm_store(O, gs, 1.f, MIX, qrow, 1024 + head * 128, hi);
}
__device__ __forceinline__ void transpose_item(const float* W, int K, int N, bf16* WT, const float* g, LAS float* scr, int item, int lane) {
    const int nblk = N / 32, kb = item / nblk, nb = item % nblk, k0 = 64 * kb, n0 = 32 * nb;
    const int r8 = lane >> 3, c4 = (lane & 7) * 4;
    f32x4 v[8];
#pragma unroll
    for (int i = 0; i < 8; ++i) v[i] = __builtin_nontemporal_load((const f32x4*)(W + (size_t)(k0 + r8 + 8 * i) * N + n0 + c4));
#pragma unroll
    for (int i = 0; i < 8; ++i) { const int kk = r8 + 8 * i; const float gs = g ? g[k0 + kk] : 1.f;
#pragma unroll
        for (int e = 0; e < 4; ++e) scr[kk * 33 + c4 + e] = v[i][e] * gs; }
    LDS_WAIT();
    const int c = lane & 7;
#pragma unroll
    for (int j = 0; j < 4; ++j) { const int n = (lane >> 3) + 8 * j; const LAS float* sp = scr + (8 * c) * 33 + n;
        v4u o; o.x = pk2(sp[0 * 33], sp[1 * 33]); o.y = pk2(sp[2 * 33], sp[3 * 33]); o.z = pk2(sp[4 * 33], sp[5 * 33]); o.w = pk2(sp[6 * 33], sp[7 * 33]);
        *(v4u*)(WT + (size_t)(n0 + n) * K + k0 + 8 * c) = o; }
    LDS_WAIT();
}

#define XB_TMO      128
#define XB_XCNT(j)  (256  + 64 * (j))
#define XB_XSUB(j)  (1280 + 64 * (j))
#define XB_XGEN(j)  (2304 + 64 * (j))
#define XB_TOP      3328
#define XB_TOPGEN   3392
#define XCD_BAR_WORDS 3456
#define XB_SPIN_CAP (1u << 18)
__device__ __forceinline__ unsigned xb_ld(unsigned* p)              { return __hip_atomic_load(p, __ATOMIC_RELAXED, __HIP_MEMORY_SCOPE_AGENT); }
__device__ __forceinline__ unsigned xb_add(unsigned* p, unsigned v) { return __hip_atomic_fetch_add(p, v, __ATOMIC_RELAXED, __HIP_MEMORY_SCOPE_AGENT); }
__device__ __forceinline__ unsigned xb_xcc_id() { return (unsigned)__builtin_amdgcn_s_getreg((3 << 11) | 20) & 0xFu; }
#define XB_SPIN(cond, bar) do { unsigned _sp = 0; while (cond) { __builtin_amdgcn_s_sleep(1); \
    if ((++_sp & 255u) == 0u) { if (xb_ld(&(bar)[XB_TMO])) break; if (_sp > XB_SPIN_CAP) { atomicAdd(&(bar)[XB_TMO], 1u); break; } } } } while (0)

struct XcdBarrier {
    unsigned* bar; unsigned x;
    volatile LAS unsigned* st;
};

__device__ __forceinline__ XcdBarrier xcd_barrier_post(unsigned* bar, volatile LAS unsigned* st, bool t0) {
    XcdBarrier b; b.bar = bar; b.x = xb_xcc_id(); b.st = st;
    if (t0) (void)xb_add(&bar[XB_XCNT(b.x)], 1u);
    return b;
}
__device__ __forceinline__ void xcd_barrier_complete(unsigned* bar, unsigned x, unsigned& nloc, unsigned& nx) {
    const unsigned G = gridDim.x * gridDim.y * gridDim.z;
    unsigned sum, cnt, mine, sp = 0u;
    for (;;) {
        sum = 0u; cnt = 0u; mine = 0u;
#pragma unroll
        for (unsigned j = 0; j < 16; ++j) { const unsigned c = xb_ld(&bar[XB_XCNT(j)]); sum += c; cnt += (c > 0u) ? 1u : 0u; mine = (j == x) ? c : mine; }
        if (sum == G) break;
        __builtin_amdgcn_s_sleep(1);
        if ((++sp & 255u) == 0u) { if (xb_ld(&bar[XB_TMO])) break; if (sp > XB_SPIN_CAP) { atomicAdd(&bar[XB_TMO], 1u); break; } }
    }
    nloc = mine > 0u ? mine : 1u; nx = cnt > 0u ? cnt : 1u;
}

__device__ __forceinline__ void xcd_barrier(const XcdBarrier& b, bool t0) {
    asm volatile("s_waitcnt vmcnt(0)" ::: "memory");
    __syncthreads();
    if (t0) {
        unsigned* bar = b.bar;
        __builtin_amdgcn_s_waitcnt(0);
        unsigned nloc = b.st[0], nx = b.st[1];
        if (nloc == 0u) { xcd_barrier_complete(bar, b.x, nloc, nx); b.st[0] = nloc; b.st[1] = nx; }
        const unsigned old = xb_add(&bar[XB_XSUB(b.x)], 1u);
        const unsigned gen = old / nloc;
        if (old + 1u == (gen + 1u) * nloc) {
            __builtin_amdgcn_fence(__ATOMIC_RELEASE, "agent");
            asm volatile("s_waitcnt vmcnt(0)" ::: "memory");
            const unsigned og = xb_add(&bar[XB_TOP], 1u);
            const unsigned tg = og / nx;
            if (og + 1u == (tg + 1u) * nx) xb_add(&bar[XB_TOPGEN], 1u);
            else XB_SPIN(xb_ld(&bar[XB_TOPGEN]) == tg, bar);
            __builtin_amdgcn_fence(__ATOMIC_ACQUIRE, "agent");
            xb_add(&bar[XB_XGEN(b.x)], 1u);
            asm volatile("s_waitcnt vmcnt(0)" ::: "memory");
        } else {
            XB_SPIN(xb_ld(&bar[XB_XGEN(b.x)]) == gen, bar);
            __builtin_amdgcn_fence(__ATOMIC_ACQUIRE, "agent");
            asm volatile("s_waitcnt vmcnt(0)" ::: "memory");
        }
    }
    __syncthreads();
}

struct Args { const float* in[14]; float* out; unsigned char* ws; float inv_freq[8]; int ph_lo, ph_hi; };

__global__ void __launch_bounds__(NTHR, 2) hybrid_fwd(Args args) {
    extern __shared__ __attribute__((aligned(16))) unsigned char lds_raw[];
    LAS unsigned char* lds = (LAS unsigned char*)lds_raw;
    cg::grid_group grid = cg::this_grid();
    const int wave = __builtin_amdgcn_readfirstlane((int)threadIdx.x >> 6);
    const int G = gridDim.x, bx = blockIdx.x;
    const int gw = bx * NWAVES + wave, NGW = G * NWAVES;
#define FRESH_IDS const int lane = opaque((int)__builtin_amdgcn_mbcnt_hi(~0u, __builtin_amdgcn_mbcnt_lo(~0u, 0u))), tid = wave * 64 + lane
    unsigned char* ws = args.ws;
    const float* x = args.in[0]; const float* ln1 = args.in[1]; const float* w_in = args.in[2];
    const float* lq1 = args.in[3]; const float* lk1 = args.in[4]; const float* lq2 = args.in[5]; const float* lk2 = args.in[6];
    const float* g_diff = args.in[7]; const float* g_sb = args.in[8]; const float* w_out = args.in[9]; const float* ln2 = args.in[10];
    const float* w1 = args.in[11]; const float* w2 = args.in[12]; const float* ln_f = args.in[13];
    float* out = args.out;
    bf16* Win_t = (bf16*)(ws + WS_WIN); bf16* Wout_t = (bf16*)(ws + WS_WOUT); bf16* W1_t = (bf16*)(ws + WS_W1); bf16* W2_t = (bf16*)(ws + WS_W2);
    float* cs = (float*)(ws + WS_CS); float* ss1 = (float*)(ws + WS_SS1); float* ss2 = (float*)(ws + WS_SS2);
    bf16* Hb = (bf16*)(ws + WS_H); bf16* QKV = (bf16*)(ws + WS_QKV); bf16* MIX = (bf16*)(ws + WS_MIX); bf16* U = (bf16*)(ws + WS_U);
    const int lo = args.ph_lo, hi_ph = args.ph_hi;
#define IN(k) (lo <= (k) && (k) < hi_ph)
    unsigned* ctl = (unsigned*)(ws + WS_CTL);
    const bool t0 = (wave == 0) && (__builtin_amdgcn_mbcnt_hi(~0u, __builtin_amdgcn_mbcnt_lo(~0u, 0u)) == 0);
    if (args.ph_lo < 0) grid.sync();
    volatile LAS unsigned* bst = (volatile LAS unsigned*)(lds + RING_BYTES);
    if (t0) { bst[0] = 0u; bst[1] = 0u; }
    __syncthreads();
    XcdBarrier xbar = xcd_barrier_post(ctl + 1024, bst, t0);
#define SEAM(k) do { if (IN(k) && IN((k) + 1)) xcd_barrier(xbar, t0); } while (0)
    if (IN(0)) {
        FRESH_IDS;
        LAS float* scr = (LAS float*)(lds + wave * 16384);
        constexpr int I_IN = (DM / 64) * (PW / 32), I_OUT = (DM / 64) * (DM / 32), I_1 = (DM / 64) * (FF / 32), I_2 = (FF / 64) * (DM / 32);
        constexpr int NITEMS = I_IN + I_OUT + I_1 + I_2;
        for (int it = gw; it < NITEMS; it += NGW) {
            int r = it;
            if (r < I_IN) { transpose_item(w_in, DM, PW, Win_t, nullptr, scr, r, lane); continue; } r -= I_IN;
            if (r < I_OUT) { transpose_item(w_out, DM, DM, Wout_t, nullptr, scr, r, lane); continue; } r -= I_OUT;
            if (r < I_1) { transpose_item(w1, DM, FF, W1_t, ln2, scr, r, lane); continue; } r -= I_1;
            transpose_item(w2, FF, DM, W2_t, nullptr, scr, r, lane);
        }
        for (int m = gw; m < M; m += NGW) {
            const f32x4* xr = (const f32x4*)(x + (size_t)m * DM) + lane; const f32x4* gr = (const f32x4*)ln1 + lane;
            f32x4 v[8], gv[8]; float s = 0.f;
#pragma unroll
            for (int j = 0; j < 8; ++j) { v[j] = __builtin_nontemporal_load(xr + 64 * j); gv[j] = gr[64 * j]; }
#pragma unroll
            for (int j = 0; j < 8; ++j) s += (v[j][0] * v[j][0] + v[j][1] * v[j][1]) + (v[j][2] * v[j][2] + v[j][3] * v[j][3]);
            const float rstd = 1.f / sqrtf(wave_sum(s) * (1.f / DM) + EPS);
            v2u* o8 = (v2u*)(Hb + (size_t)m * DM) + lane;
#pragma unroll
            for (int j = 0; j < 8; ++j) { const f32x4 gq = gv[j]; v2u w; w.x = pk2(v[j][0] * rstd * gq[0], v[j][1] * rstd * gq[1]); w.y = pk2(v[j][2] * rstd * gq[2], v[j][3] * rstd * gq[3]); o8[64 * j] = w; }
        }
        for (int e = bx * NTHR + tid; e < SEQ * 8; e += G * NTHR) {
            const int pos = e >> 3, i = e & 7;
            const float ang = (float)pos * args.inv_freq[i];
            const double rev = (double)ang * 0.15915494309189533577; const float fr = (float)(rev - rint(rev));
            cs[pos * 16 + i] = __builtin_amdgcn_cosf(fr); cs[pos * 16 + 8 + i] = __builtin_amdgcn_sinf(fr);
        }
        for (int e = bx * NTHR + tid; e < SEQ; e += G * NTHR) { ss1[e] = 0.f; ss2[e] = 0.f; }
    }
    SEAM(0);
    if (IN(1)) {
        pg8::Gemm g{Hb, Win_t, M, PW, DM}; pg8::StaticOrder S; S.init(M, PW, G, bx);
        EpiQKV E{QKV, cs};
        pg8::gemm_phase<EpiQKV, pg8::StaticOrder, true, true>(lds, g, S, E, wave);
    }
    SEAM(1);
    if (IN(2)) {
        FRESH_IDS;
        const float a = lq1[lane] * lk1[lane], b = lq2[lane] * lk2[lane];
        const float lam = __builtin_bit_cast(float, __builtin_amdgcn_readfirstlane(__builtin_bit_cast(int, __expf(wave_sum(a)) - __expf(wave_sum(b)) + LAM_INIT)));
        float* o1s = (float*)(ws + WS_H);
        for (int u = bx; u < 256; u += G) {
            const int head = u & 7, p = u >> 3;
#pragma unroll 1
            for (int t = 0; t < 2; ++t) diff_unit(lds, QKV, MIX, o1s, g_diff, lam, head, t ? 63 - p : p, wave, lane, tid);
        }
        __syncthreads();
        const int lane_sb = opaque(lane);
        for (int wu = gw; wu < 8 * 512; wu += NGW) sb_unit(lds + wave * 8192, QKV, MIX, g_sb, wu & 7, 511 - (wu >> 3), lane_sb);
        __syncthreads();
    }
    SEAM(2);
    if (IN(3)) {
        pg8::Gemm g{MIX, Wout_t, M, DM, DM}; pg8::StaticOrder S; S.init(M, DM, G, bx);
        EpiRes<false> E{x, nullptr, nullptr, Hb, ss1};
        pg8::gemm_phase<EpiRes<false>, pg8::StaticOrder, false, true>(lds, g, S, E, wave);
    }
    SEAM(3);
    if (IN(4)) {
        pg8::Gemm g{Hb, W1_t, M, FF, DM}; pg8::StaticOrder S; S.init(M, FF, G, bx);
        EpiMlpIn E{U, ss1};
        pg8::gemm_phase<EpiMlpIn, pg8::StaticOrder, true, true>(lds, g, S, E, wave);
    }
    SEAM(4);
    if (IN(5)) {
        pg8::Gemm g{U, W2_t, M, DM, FF}; pg8::StaticOrder S; S.init(M, DM, G, bx);
        EpiRes<true> E{nullptr, Hb, out, nullptr, ss2};
        pg8::gemm_phase<EpiRes<true>, pg8::StaticOrder, false, true>(lds, g, S, E, wave);
    }
    SEAM(5);
    if (IN(6)) {
        FRESH_IDS;
        for (int m = gw; m < M; m += NGW) {
            f32x4* xr = (f32x4*)(out + (size_t)m * DM) + lane; const f32x4* gr = (const f32x4*)ln_f + lane;
            f32x4 v[8], gv[8];
#pragma unroll
            for (int j = 0; j < 8; ++j) { v[j] = xr[64 * j]; gv[j] = gr[64 * j]; }
            const float rstd = 1.f / sqrtf(__hip_atomic_load(ss2 + m, __ATOMIC_RELAXED, __HIP_MEMORY_SCOPE_AGENT) * (1.f / DM) + EPS);
            asm volatile("" ::: "memory");
#pragma unroll
            for (int j = 0; j < 8; ++j) __builtin_nontemporal_store(v[j] * rstd * gv[j], xr + 64 * j);
        }
    }
#undef IN
#undef SEAM
}

extern "C" void kernel_launch(void* const* d_in, const int* in_sizes, int n_in, void* d_out, int out_size, void* d_ws, size_t ws_size, hipStream_t stream) {
    static int grid = 0;
    if (grid == 0) {
        if (n_in != 14 || in_sizes[0] != M * DM || out_size != M * DM || ws_size < WS_END) { fprintf(stderr, "kernel_launch: unexpected shapes (n_in %d, in0 %d, out %d, ws %zu)\n", n_in, n_in > 0 ? in_sizes[0] : -1, out_size, ws_size); grid = -1; return; }
        int dev = 0, cus = 0, per_cu = 0;
        (void)hipGetDevice(&dev); (void)hipDeviceGetAttribute(&cus, hipDeviceAttributeMultiprocessorCount, dev);
        if (hipFuncSetAttribute((const void*)hybrid_fwd, hipFuncAttributeMaxDynamicSharedMemorySize, LDS_BYTES) != hipSuccess) { fprintf(stderr, "kernel_launch: hipFuncSetAttribute failed\n"); grid = -1; return; }
        if (hipOccupancyMaxActiveBlocksPerMultiprocessor(&per_cu, (const void*)hybrid_fwd, NTHR, LDS_BYTES) != hipSuccess || per_cu < 1) { fprintf(stderr, "kernel_launch: occupancy query gave %d\n", per_cu); per_cu = 1; }
        (void)hipGetLastError();
        grid = cus * per_cu;
    }
    if (grid < 0) return;
    if (hipMemsetAsync((char*)d_ws + WS_CTL, 0, 32768, stream) != hipSuccess) { fprintf(stderr, "kernel_launch: memset failed\n"); return; }
    Args a{};
    for (int i = 0; i < 14; ++i) a.in[i] = (const float*)d_in[i];
    a.out = (float*)d_out; a.ws = (unsigned char*)d_ws;
    for (int i = 0; i < 8; ++i) a.inv_freq[i] = (float)pow(500000.0, -(double)i / 8.0);
    a.ph_lo = 0; a.ph_hi = 7;
    void* kargs[] = {&a};
    hipError_t e = hipLaunchCooperativeKernel((const void*)hybrid_fwd, dim3(grid), dim3(NTHR), kargs, LDS_BYTES, stream);
    if (e != hipSuccess) fprintf(stderr, "kernel_launch: cooperative launch failed: %s (grid %d)\n", hipGetErrorString(e), grid);
}
```

```cpp
#include <hip/hip_runtime.h>
#include <hip/hip_cooperative_groups.h>
#include <cstdio>
#include <cstdint>
#include <cmath>
namespace cg = cooperative_groups;
namespace pg8 {
#define PG8_LAS __attribute__((address_space(3)))
typedef unsigned short bf16_t;
typedef short bf16x8 __attribute__((ext_vector_type(8)));
typedef float f32x4 __attribute__((ext_vector_type(4)));
typedef unsigned u32x4 __attribute__((ext_vector_type(4)));
constexpr int BM = 256, BK = 64, HALF = 128, HTB = HALF * BK * 2  , STAGE_BYTES = 8 * HTB, NXCD = 8, WGM = 8;

__host__ __device__ __forceinline__ int lds_byte(int r, int c) { const int st = (r >> 4) * 2 + (c >> 5), rr = r & 15, cc = c & 31, ob = rr * 64 + cc * 2; return st * 1024 + (ob ^ (((ob >> 9) & 1) << 5)); }
__host__ __device__ __forceinline__ void stage_rc(int b, int& R, int& C) { const int st = b / 1024, sb = b % 1024, swz = sb ^ (((sb >> 9) & 1) << 5); R = (st >> 1) * 16 + swz / 64; C = (st & 1) * 32 + (swz % 64) / 2; }
__host__ __device__ __forceinline__ int perm32(int rho) { const int n = rho >> 4, i = rho & 15; return 8 * (i >> 2) + 4 * n + (i & 3); }

struct Unit { int pm, pn; };
struct Gemm { const bf16_t* A; const bf16_t* Bt; int M, N, K; };

struct StaticOrder {
    int nM, nN, nwg, G, c;
    __host__ __device__ void init(int M, int N, int G_, int c_) { nM = M / BM; nN = N / BM; nwg = nM * nN; G = G_; c = c_; }
    __host__ __device__ bool next(int i, Unit& u) const {
        const long L = (long)i * G + c; if (L >= nwg) return false;
        int wgid = (int)L; { const int q = nwg / NXCD, r = nwg % NXCD, xcd = wgid % NXCD, off = wgid / NXCD; wgid = (xcd < r ? xcd * (q + 1) : r * (q + 1) + (xcd - r) * q) + off; }
        const int nig = WGM * nN, gid = wgid / nig, fm = gid * WGM, gsz = (nM - fm) < WGM ? (nM - fm) : WGM;
        u.pm = fm + ((wgid % nig) % gsz); u.pn = (wgid % nig) / gsz; return true;
    }
    __device__ __forceinline__ void a_ready(const Unit&) const {}
    __device__ __forceinline__ void done(const Unit&) const {}
};

__device__ __forceinline__ unsigned cvt_pk_bf16(float lo, float hi) { unsigned r; asm volatile("v_cvt_pk_bf16_f32 %0, %1, %2" : "=v"(r) : "v"(lo), "v"(hi)); return r; }
template <class Epi, class Sched, bool ALIGN_EPI = false, bool SP2 = false>
__device__ __forceinline__ void gemm_phase(PG8_LAS unsigned char* lds, const Gemm g, const Sched& S, const Epi& E, int wave_id) {
    int tid_ = wave_id * 64 + (int)__builtin_amdgcn_mbcnt_hi(~0u, __builtin_amdgcn_mbcnt_lo(~0u, 0u)); asm volatile("" : "+v"(tid_));
    const int tid = tid_, wid = __builtin_amdgcn_readfirstlane(tid >> 6), lane = tid & 63, wr = wid >> 2, wc = wid & 3, fr = lane & 15, fq = lane >> 4;
    const int K = g.K, nt = K / BK;
    unsigned voffA[2], voffB[2];
#pragma unroll
    for (int i = 0; i < 2; ++i) { int R, C; stage_rc(tid * 16 + i * 8192, R, C); const int Rb = Epi::PERM ? ((R & ~31) + perm32(R & 31)) : R;
        voffA[i] = (unsigned)(R * K + C) * 2u; voffB[i] = (unsigned)(Rb * K + C) * 2u; }
    const size_t kstep = (size_t)(BK * 2);
    const size_t hstep = (size_t)HALF * K * 2;
    const size_t tstep = 2 * hstep;
    const unsigned ldsw = (unsigned)wid * 1024u;
    const int aoff = lds_byte(wr * 64 + fr, fq * 8), boff = lds_byte(wc * 32 + fr, fq * 8);
#define PG8_SA(b, h) (((b) * 2 + (h)) * HTB)
#define PG8_SB(b, h) ((4 + (b) * 2 + (h)) * HTB)
#define PG8_STAGE(bufoff, gbase, voff) do { _Pragma("unroll") for (int _i = 0; _i < 2; ++_i) \
        __builtin_amdgcn_global_load_lds((const unsigned*)((const char*)(gbase) + (voff)[_i]), (PG8_LAS unsigned*)(lds + (bufoff) + ldsw + _i * 8192), 16, 0, 0); } while (0)
#define PG8_LDA(dst, b, h) do { _Pragma("unroll") for (int m = 0; m < 4; ++m) _Pragma("unroll") for (int k = 0; k < 2; ++k) dst[m][k] = *(const PG8_LAS bf16x8*)(lds + PG8_SA(b, h) + aoff + m * 2048 + k * 1024); } while (0)
#define PG8_LDB(dst, b, h) do { _Pragma("unroll") for (int n = 0; n < 2; ++n) _Pragma("unroll") for (int k = 0; k < 2; ++k) dst[n][k] = *(const PG8_LAS bf16x8*)(lds + PG8_SB(b, h) + boff + n * 2048 + k * 1024); } while (0)
#define PG8_MMA(ai, bj, At, Bt) do { __builtin_amdgcn_s_setprio(1); _Pragma("unroll") for (int m = 0; m < 4; ++m) _Pragma("unroll") for (int n = 0; n < 2; ++n) _Pragma("unroll") for (int k = 0; k < 2; ++k) \
        acc[ai][bj][m][n] = __builtin_amdgcn_mfma_f32_16x16x32_bf16(Bt[n][k], At[m][k], acc[ai][bj][m][n], 0, 0, 0); __builtin_amdgcn_s_setprio(0); } while (0)
#define PG8_WAIT_V(n) asm volatile("s_waitcnt vmcnt(" #n ")" ::: "memory")
#define PG8_WAIT_L(n) asm volatile("s_waitcnt lgkmcnt(" #n ")" ::: "memory")
#define PG8_BAR __builtin_amdgcn_s_barrier()
#define PG8_SCHED __builtin_amdgcn_sched_barrier(0)
    Unit cur, nxt; int ui = 0;
    if (!S.next(0, cur)) return;
    f32x4 acc[2][2][4][2];
#pragma unroll
    for (int a = 0; a < 2; ++a)
#pragma unroll
        for (int b = 0; b < 2; ++b)
#pragma unroll
            for (int m = 0; m < 4; ++m)
#pragma unroll
                for (int n = 0; n < 2; ++n) acc[a][b][m][n] = (f32x4){0.f, 0.f, 0.f, 0.f};
    bf16x8 At[4][2], B0[2][2], B1[2][2];
    const char* cA = (const char*)g.A + (size_t)cur.pm * tstep; const char* cB = (const char*)g.Bt + (size_t)cur.pn * tstep;
    S.a_ready(cur);
    if constexpr (SP2) {
        PG8_STAGE(PG8_SB(0, 0), cB, voffB); PG8_STAGE(PG8_SB(0, 1), cB + hstep, voffB); PG8_STAGE(PG8_SA(0, 0), cA, voffA); PG8_STAGE(PG8_SA(0, 1), cA + hstep, voffA);
        if (wr == 1) PG8_BAR;
        PG8_WAIT_V(2); PG8_BAR;
        PG8_STAGE(PG8_SB(1, 0), cB + kstep, voffB); PG8_STAGE(PG8_SA(1, 0), cA + kstep, voffA); PG8_STAGE(PG8_SB(1, 1), cB + hstep + kstep, voffB);
        PG8_WAIT_V(6); PG8_BAR;
    } else {
        PG8_STAGE(PG8_SB(0, 0), cB, voffB); PG8_STAGE(PG8_SA(0, 0), cA, voffA); PG8_STAGE(PG8_SB(0, 1), cB + hstep, voffB); PG8_STAGE(PG8_SA(0, 1), cA + hstep, voffA);
        if (wr == 1) PG8_BAR;
        PG8_WAIT_V(4); PG8_BAR;
        PG8_STAGE(PG8_SB(1, 0), cB + kstep, voffB); PG8_STAGE(PG8_SA(1, 0), cA + kstep, voffA); PG8_STAGE(PG8_SB(1, 1), cB + hstep + kstep, voffB);
        PG8_WAIT_V(6); PG8_BAR;
    }
    for (;;) {
        const bool has_next = S.next(ui + 1, nxt);
        const char* nA = has_next ? (const char*)g.A + (size_t)nxt.pm * tstep : cA; const char* nB = has_next ? (const char*)g.Bt + (size_t)nxt.pn * tstep : cB;
        for (int t = 0; t < nt; t += 2) {
            const bool last = (t == nt - 2);
            const char* a1 = cA + (size_t)(t + 1) * kstep;
            const char* a2 = last ? nA : cA + (size_t)(t + 2) * kstep; const char* b2 = last ? nB : cB + (size_t)(t + 2) * kstep;
            const char* a3 = a2 + kstep; const char* b3 = b2 + kstep;
            if (last && has_next) S.a_ready(nxt);
            if constexpr (SP2) {
            PG8_LDB(B0, 0, 0); PG8_LDB(B1, 0, 1); PG8_SCHED; PG8_LDA(At, 0, 0); PG8_STAGE(PG8_SA(1, 1), a1 + hstep, voffA);
            PG8_WAIT_V(8); PG8_WAIT_L(0); PG8_BAR; PG8_MMA(0, 0, At, B0); PG8_MMA(0, 1, At, B1); PG8_BAR; PG8_SCHED;
            PG8_LDA(At, 0, 1); PG8_STAGE(PG8_SB(0, 0), b2, voffB); PG8_STAGE(PG8_SB(0, 1), b2 + hstep, voffB); PG8_STAGE(PG8_SA(0, 0), a2, voffA);
            PG8_WAIT_V(8); PG8_WAIT_L(0); PG8_BAR; PG8_MMA(1, 0, At, B0); PG8_MMA(1, 1, At, B1); PG8_BAR; PG8_SCHED;
            PG8_LDB(B0, 1, 0); PG8_LDB(B1, 1, 1); PG8_SCHED; PG8_LDA(At, 1, 0); PG8_STAGE(PG8_SA(0, 1), a2 + hstep, voffA);
            PG8_WAIT_V(8); PG8_WAIT_L(0); PG8_BAR; PG8_MMA(0, 0, At, B0); PG8_MMA(0, 1, At, B1); PG8_BAR; PG8_SCHED;
            PG8_LDA(At, 1, 1); PG8_STAGE(PG8_SB(1, 0), b3, voffB); PG8_STAGE(PG8_SB(1, 1), b3 + hstep, voffB); PG8_STAGE(PG8_SA(1, 0), a3, voffA);
            PG8_WAIT_V(8); PG8_WAIT_L(0); PG8_BAR; PG8_MMA(1, 0, At, B0); PG8_MMA(1, 1, At, B1); PG8_BAR; PG8_SCHED;
            } else {
            PG8_LDB(B0, 0, 0); PG8_SCHED; PG8_LDA(At, 0, 0); PG8_STAGE(PG8_SA(1, 1), a1 + hstep, voffA);
            PG8_WAIT_L(8); PG8_BAR; PG8_WAIT_L(0); PG8_MMA(0, 0, At, B0); PG8_BAR; PG8_SCHED;
            PG8_LDB(B1, 0, 1); PG8_STAGE(PG8_SB(0, 0), b2, voffB);
            PG8_BAR; PG8_WAIT_L(0); PG8_MMA(0, 1, At, B1); PG8_BAR;
            PG8_LDA(At, 0, 1); PG8_STAGE(PG8_SA(0, 0), a2, voffA);
            PG8_BAR; PG8_WAIT_L(0); PG8_MMA(1, 0, At, B0); PG8_BAR; PG8_SCHED;
            PG8_STAGE(PG8_SB(0, 1), b2 + hstep, voffB);
            PG8_WAIT_V(6); PG8_BAR; PG8_MMA(1, 1, At, B1); PG8_BAR;
            PG8_LDB(B0, 1, 0); PG8_SCHED; PG8_LDA(At, 1, 0); PG8_STAGE(PG8_SA(0, 1), a2 + hstep, voffA);
            PG8_WAIT_L(8); PG8_BAR; PG8_WAIT_L(0); PG8_MMA(0, 0, At, B0); PG8_BAR; PG8_SCHED;
            PG8_LDB(B1, 1, 1); PG8_STAGE(PG8_SB(1, 0), b3, voffB);
            PG8_BAR; PG8_WAIT_L(0); PG8_MMA(0, 1, At, B1); PG8_BAR;
            PG8_LDA(At, 1, 1); PG8_STAGE(PG8_SA(1, 0), a3, voffA);
            PG8_BAR; PG8_WAIT_L(0); PG8_MMA(1, 0, At, B0); PG8_BAR; PG8_SCHED;
            PG8_STAGE(PG8_SB(1, 1), b3 + hstep, voffB);
            PG8_WAIT_V(6); PG8_BAR; PG8_MMA(1, 1, At, B1); PG8_BAR;
            }
        }
        if constexpr (ALIGN_EPI) { if (wr == 0) PG8_BAR; }
        if constexpr (!Epi::AFTER_DRAIN) { E(acc, cur, wr, wc, fr, fq); S.done(cur); }
        if (!has_next) break;
#pragma unroll
        for (int a = 0; a < 2; ++a)
#pragma unroll
            for (int b = 0; b < 2; ++b)
#pragma unroll
                for (int m = 0; m < 4; ++m)
#pragma unroll
                    for (int n = 0; n < 2; ++n) acc[a][b][m][n] = (f32x4){0.f, 0.f, 0.f, 0.f};
        cur = nxt; cA = nA; cB = nB; ++ui;
        if constexpr (ALIGN_EPI) { if (wr == 1) PG8_BAR; }
    }
    PG8_WAIT_V(0);
    if constexpr (!ALIGN_EPI) { if (wr == 0) PG8_BAR; }
    PG8_BAR;
    if constexpr (Epi::AFTER_DRAIN) { E.fused(acc, cur, wr, wc, fr, fq, lds, wid, lane); S.done(cur); }
#undef PG8_SA
#undef PG8_SB
#undef PG8_STAGE
#undef PG8_LDA
#undef PG8_LDB
#undef PG8_MMA
#undef PG8_WAIT_V
#undef PG8_WAIT_L
#undef PG8_BAR
#undef PG8_SCHED
}
}
#define GAS __attribute__((address_space(1)))
#define LAS __attribute__((address_space(3)))
typedef unsigned short bf16;
typedef unsigned v4u __attribute__((ext_vector_type(4)));
typedef unsigned v2u __attribute__((ext_vector_type(2)));
typedef float f32x4 __attribute__((ext_vector_type(4)));
typedef float f32x16 __attribute__((ext_vector_type(16)));
typedef short bf16x8 __attribute__((ext_vector_type(8)));
typedef short s16x4 __attribute__((ext_vector_type(4)));
using pg8::Unit; using pg8::cvt_pk_bf16; using pg8::BM; using pg8::HALF;

constexpr int SEQ = 16384, DM = 2048, PW = 6144, FF = 8192, M = SEQ;
constexpr int NWAVES = 8, NTHR = 512;
constexpr float EPS = 1e-6f;
constexpr float C2 = 0.125f * 1.4426950408889634f;
constexpr float SBSCALE = 0.08838834764831845f * 1.4426950408889634f;
constexpr float LAM_INIT = 0.2f;
constexpr int COL_DQ = 0, COL_DK = 1024, COL_DV = 2048, COL_SQ = 3072, COL_SK = 4096, COL_SV = 5120;

constexpr size_t MiB = 1u << 20;
constexpr size_t WS_WIN = 0;
constexpr size_t WS_WOUT = 24 * MiB;
constexpr size_t WS_W1 = 32 * MiB;
constexpr size_t WS_W2 = 64 * MiB;
constexpr size_t WS_CS = 96 * MiB;
constexpr size_t WS_SS1 = 97 * MiB;
constexpr size_t WS_SS2 = 97 * MiB + 65536;
constexpr size_t WS_H = 98 * MiB;
constexpr size_t WS_QKV = 162 * MiB;
constexpr size_t WS_MIX = 354 * MiB;
constexpr size_t WS_U = 162 * MiB;
constexpr size_t WS_CTL = 418 * MiB;
constexpr size_t WS_END = 419 * MiB;

constexpr int RING_BYTES = 131072, LDS_BYTES = 131072 + 1024;

__device__ __forceinline__ unsigned f2bf(float f) { unsigned u = __builtin_bit_cast(unsigned, f); return (u + 0x7fffu + ((u >> 16) & 1u)) >> 16; }
__device__ __forceinline__ unsigned pk2(float lo, float hi) { return f2bf(lo) | (f2bf(hi) << 16); }
__device__ __forceinline__ float wave_sum(float v) {
#pragma unroll
    for (int o = 1; o < 64; o <<= 1) v += __shfl_xor(v, o);
    return v;
}
typedef unsigned u32x2_t __attribute__((ext_vector_type(2)));
__device__ __forceinline__ void swap_x32(float& a, float& b) { asm volatile("s_nop 1\n\tv_permlane32_swap_b32 %0, %1" : "+v"(a), "+v"(b)); }
__device__ __forceinline__ float max_x32(float x) { float a = x, b = x; swap_x32(a, b); return fmaxf(a, b); }
__device__ __forceinline__ float sum_x32(float x) { float a = x, b = x; swap_x32(a, b); return a + b; }
__device__ __forceinline__ float partner_x32(float x, int hi) { float a = x, b = x; swap_x32(a, b); return hi ? a : b; }
#define LDS_WAIT() asm volatile("s_waitcnt lgkmcnt(0)" ::: "memory")
__device__ __forceinline__ int opaque(int v) { asm volatile("" : "+v"(v)); return v; }

struct EpiQKV {
    static constexpr bool PERM = true, AFTER_DRAIN = false;
    bf16* O; const float* cs;
    __device__ __forceinline__ void operator()(const f32x4 (&acc)[2][2][4][2], const Unit& u, int wr, int wc, int fr, int fq) const {
        const int row0 = u.pm * BM + wr * 64 + fr, col0 = u.pn * BM + wc * 32 + 8 * fq;
        float sc = 1.f; if (u.pn < 4) sc = C2; else if (u.pn >= 12 && u.pn < 16) sc = SBSCALE;
        const bool rot = (u.pn < 8) && ((wc & 1) == 0);
        if (rot) {
#pragma unroll
            for (int ai = 0; ai < 2; ++ai) {
                f32x4 cv[4][4];
#pragma unroll
                for (int m = 0; m < 4; ++m) { const f32x4* p = (const f32x4*)(cs + (size_t)(row0 + ai * HALF + m * 16) * 16); cv[m][0] = p[0]; cv[m][1] = p[1]; cv[m][2] = p[2]; cv[m][3] = p[3]; }
#pragma unroll
                for (int m = 0; m < 4; ++m) {
                    const int row = row0 + ai * HALF + m * 16;
                    const f32x4 c0 = cv[m][0], c1 = cv[m][1]; f32x4 s0 = cv[m][2], s1 = cv[m][3]; if (fq == 0) { s0 = -s0; s1 = -s1; }
#pragma unroll
                    for (int bj = 0; bj < 2; ++bj) {
                        f32x4 v0 = acc[ai][bj][m][0] * sc, v1 = acc[ai][bj][m][1] * sc, p0, p1;
#pragma unroll
                        for (int e = 0; e < 4; ++e) { p0[e] = __shfl_xor(v0[e], 16); p1[e] = __shfl_xor(v1[e], 16); }
                        if (fq < 2) { v0 = v0 * c0 + p0 * s0; v1 = v1 * c1 + p1 * s1; }
                        v4u w; w.x = cvt_pk_bf16(v0[0], v0[1]); w.y = cvt_pk_bf16(v0[2], v0[3]); w.z = cvt_pk_bf16(v1[0], v1[1]); w.w = cvt_pk_bf16(v1[2], v1[3]);
                        *(v4u*)(O + (size_t)row * PW + col0 + bj * HALF) = w;
                    }
                }
            }
        } else {
#pragma unroll
            for (int ai = 0; ai < 2; ++ai)
#pragma unroll
                for (int m = 0; m < 4; ++m) {
                    const int row = row0 + ai * HALF + m * 16;
#pragma unroll
                    for (int bj = 0; bj < 2; ++bj) {
                        const f32x4 v0 = acc[ai][bj][m][0] * sc, v1 = acc[ai][bj][m][1] * sc;
                        v4u w; w.x = cvt_pk_bf16(v0[0], v0[1]); w.y = cvt_pk_bf16(v0[2], v0[3]); w.z = cvt_pk_bf16(v1[0], v1[1]); w.w = cvt_pk_bf16(v1[2], v1[3]);
                        *(v4u*)(O + (size_t)row * PW + col0 + bj * HALF) = w;
                    }
                }
        }
    }
};
template <bool RES_BF16>
struct EpiRes {
    static constexpr bool PERM = true, AFTER_DRAIN = false;
    const float* R; const bf16* Rb; float* Y; bf16* Yb; float* ss;
    __device__ __forceinline__ void operator()(const f32x4 (&acc)[2][2][4][2], const Unit& u, int wr, int wc, int fr, int fq) const {
        const int row0 = u.pm * BM + wr * 64 + fr, col0 = u.pn * BM + wc * 32 + 8 * fq;
#pragma unroll
        for (int ai = 0; ai < 2; ++ai) {
            f32x4 rv[4][2][2];
#pragma unroll
            for (int m = 0; m < 4; ++m)
#pragma unroll
                for (int bj = 0; bj < 2; ++bj) {
                    const size_t off = (size_t)(row0 + ai * HALF + m * 16) * DM + col0 + bj * HALF;
                    if (RES_BF16) {
                        const v4u t = *(const v4u*)(Rb + off);
                        rv[m][bj][0] = (f32x4){__builtin_bit_cast(float, t.x << 16), __builtin_bit_cast(float, t.x & 0xffff0000u), __builtin_bit_cast(float, t.y << 16), __builtin_bit_cast(float, t.y & 0xffff0000u)};
                        rv[m][bj][1] = (f32x4){__builtin_bit_cast(float, t.z << 16), __builtin_bit_cast(float, t.z & 0xffff0000u), __builtin_bit_cast(float, t.w << 16), __builtin_bit_cast(float, t.w & 0xffff0000u)};
                    } else { rv[m][bj][0] = *(const f32x4*)(R + off); rv[m][bj][1] = *(const f32x4*)(R + off + 4); }
                }
            asm volatile("" ::: "memory");
#pragma unroll
            for (int m = 0; m < 4; ++m) {
                const int row = row0 + ai * HALF + m * 16; float s = 0.f;
#pragma unroll
                for (int bj = 0; bj < 2; ++bj) {
                    const size_t off = (size_t)row * DM + col0 + bj * HALF;
                    const f32x4 v0 = acc[ai][bj][m][0] + rv[m][bj][0], v1 = acc[ai][bj][m][1] + rv[m][bj][1];
                    { v4u w; w.x = cvt_pk_bf16(v0[0], v0[1]); w.y = cvt_pk_bf16(v0[2], v0[3]); w.z = cvt_pk_bf16(v1[0], v1[1]); w.w = cvt_pk_bf16(v1[2], v1[3]); *(v4u*)(Yb + off) = w; }
                    s += (v0[0] * v0[0] + v0[1] * v0[1]) + (v0[2] * v0[2] + v0[3] * v0[3]) + (v1[0] * v1[0] + v1[1] * v1[1]) + (v1[2] * v1[2] + v1[3] * v1[3]);
                }
                s += __shfl_xor(s, 16); s += __shfl_xor(s, 32);
                if (fq == 0) atomicAdd(ss + row, s);
            }
        }
    }
};
struct EpiMlpIn {
    static constexpr bool PERM = true, AFTER_DRAIN = false;
    bf16* O; const float* ss;
    __device__ __forceinline__ void operator()(const f32x4 (&acc)[2][2][4][2], const Unit& u, int wr, int wc, int fr, int fq) const {
        const int row0 = u.pm * BM + wr * 64 + fr, col0 = u.pn * BM + wc * 32 + 8 * fq;
        float rs[2][4];
#pragma unroll
        for (int ai = 0; ai < 2; ++ai)
#pragma unroll
            for (int m = 0; m < 4; ++m) rs[ai][m] = __hip_atomic_load(ss + row0 + ai * HALF + m * 16, __ATOMIC_RELAXED, __HIP_MEMORY_SCOPE_AGENT);
        asm volatile("" ::: "memory");
#pragma unroll
        for (int ai = 0; ai < 2; ++ai)
#pragma unroll
            for (int m = 0; m < 4; ++m) {
                const int row = row0 + ai * HALF + m * 16;
                const float rstd = __builtin_amdgcn_rsqf(rs[ai][m] * (1.f / DM) + EPS);
#pragma unroll
                for (int bj = 0; bj < 2; ++bj) {
                    f32x4 v0 = acc[ai][bj][m][0] * rstd, v1 = acc[ai][bj][m][1] * rstd;
#pragma unroll
                    for (int e = 0; e < 4; ++e) { const float a = fmaxf(v0[e], 0.f), b = fmaxf(v1[e], 0.f); v0[e] = a * a; v1[e] = b * b; }
                    v4u w; w.x = cvt_pk_bf16(v0[0], v0[1]); w.y = cvt_pk_bf16(v0[2], v0[3]); w.z = cvt_pk_bf16(v1[0], v1[1]); w.w = cvt_pk_bf16(v1[2], v1[3]);
                    *(v4u*)(O + (size_t)row * FF + col0 + bj * HALF) = w;
                }
            }
    }
};
#define MFMA32(a, b, c) __builtin_amdgcn_mfma_f32_32x32x16_bf16((a), (b), (c), 0, 0, 0)
__device__ __forceinline__ int crow(int r, int hi) { return (r & 3) + 8 * (r >> 2) + 4 * hi; }
typedef short v4i16_t __attribute__((ext_vector_type(4)));
__device__ __forceinline__ s16x4 vtr(LAS const unsigned char* p) { return __builtin_bit_cast(s16x4, __builtin_amdgcn_ds_read_tr16_b64_v4i16((LAS v4i16_t*)p)); }
typedef float f32x2_t __attribute__((ext_vector_type(2)));
typedef __bf16 bf16x2_t __attribute__((ext_vector_type(2)));
__device__ __forceinline__ unsigned cvtpk_s(float lo, float hi) { f32x2_t v = {lo, hi}; bf16x2_t b = __builtin_convertvector(v, bf16x2_t); return __builtin_bit_cast(unsigned, b); }
__device__ __forceinline__ bf16x8 pack8(const f32x16& x, int s) {
    v4u p; p.x = cvtpk_s(x[8 * s], x[8 * s + 1]); p.y = cvtpk_s(x[8 * s + 2], x[8 * s + 3]); p.z = cvtpk_s(x[8 * s + 4], x[8 * s + 5]); p.w = cvtpk_s(x[8 * s + 6], x[8 * s + 7]);
    return __builtin_bit_cast(bf16x8, p);
}

__device__ __forceinline__ void glds16(const void* sbase, unsigned voff, unsigned lds_dst) { unsigned keep;
    asm volatile("s_mov_b32 %0, m0\n\ts_mov_b32 m0, %3\n\ts_nop 0\n\tglobal_load_lds_dwordx4 %1, %2\n\ts_mov_b32 m0, %0" : "=&s"(keep) : "v"(voff), "s"(sbase), "s"(lds_dst) : "memory"); }
template <bool TAIL>
__device__ __forceinline__ void flash_half(f32x16 (&O)[4], f32x16& Sc, f32x16& Sn, float& m_run, float& l_run, bf16x8& mfrag, const bf16x8& onefrag, const bf16x8 (&qf)[4],
                                           LAS const unsigned char* Kn, LAS const unsigned char* Vc, unsigned ka, int kx, unsigned va, int vx, int blk, int hi, int key0, int qrow, int qmin) {
    if (TAIL) {
        const int kb = key0 + 4 * hi;
#pragma unroll
        for (int i = 0; i < 16; ++i) { const int key = kb + (i & 3) + 8 * (i >> 2); if (key > qrow) Sc[i] = -1e30f; }
    }
    float mloc = fmaxf(Sc[0], Sc[1]);
#pragma unroll
    for (int i = 2; i < 16; ++i) mloc = fmaxf(mloc, Sc[i]);
    mloc = max_x32(mloc);
    const bool first = (key0 == 0);
    if (__any(mloc > 8.f) || first) {
        const float m_new = (mloc > 8.f || first) ? __builtin_bit_cast(float, f2bf(m_run + mloc) << 16) : m_run;
        const float delta = m_new - m_run, alpha = __builtin_amdgcn_exp2f(-delta);
        l_run *= alpha;
#pragma unroll
        for (int d = 0; d < 4; ++d)
#pragma unroll
            for (int i = 0; i < 16; ++i) O[d][i] *= alpha;
#pragma unroll
        for (int i = 0; i < 16; ++i) Sc[i] -= delta;
        m_run = m_new;
        mfrag[0] = hi ? (short)0 : (short)(f2bf(-m_new));
    }
#pragma unroll
    for (int i = 0; i < 16; ++i) Sn[i] = 0.f;
    Sn = MFMA32(onefrag, mfrag, Sn);
#pragma unroll
    for (int ks = 0; ks < 4; ++ks) {
        const bf16x8 a0 = *(LAS const bf16x8*)(Kn + ka + (((2 * ks + hi) ^ kx) << 4));
        Sn = MFMA32(a0, qf[ks], Sn);
    }
    float ls = 0.f;
#pragma unroll
    for (int i = 0; i < 16; ++i) { Sc[i] = __builtin_amdgcn_exp2f(Sc[i]); ls += Sc[i]; }
    l_run += ls;
#pragma unroll
    for (int kk = 0; kk < 2; ++kk) {
        if (kk == 1) __builtin_amdgcn_sched_barrier(0);
        const bf16x8 pb = pack8(Sc, kk);
#pragma unroll
        for (int d = 0; d < 4; ++d) {
            LAS const unsigned char* p = Vc + va + kk * 4096 + (((2 * d + blk) ^ vx) << 5);
            const s16x4 lo = vtr(p), hi4 = vtr(p + 2048);
            const bf16x8 a = __builtin_shufflevector(lo, hi4, 0, 1, 2, 3, 4, 5, 6, 7);
            O[d] = MFMA32(a, pb, O[d]);
        }
    }
}

constexpr int DA_V = 49152, KT = 128;
__device__ __forceinline__ void flash_map(f32x16 (&O)[4], LAS unsigned char* lds, const bf16* QKV, int qcol, int kcol, int vcol, int qb, int w, int lane, int tid) {
    const int r32 = lane & 31, hi = lane >> 5;
    const int qmin = qb * 256 + w * 32, qrow = qmin + r32;
    bf16x8 qf[4];
    { const int lq = opaque(lane);
      const bf16* qp = QKV + (size_t)(qmin + (lq & 31)) * PW + qcol + 8 * (lq >> 5);
#pragma unroll
      for (int ks = 0; ks < 4; ++ks) qf[ks] = *(const bf16x8*)(qp + 16 * ks); }
#pragma unroll
    for (int d = 0; d < 4; ++d)
#pragma unroll
        for (int i = 0; i < 16; ++i) O[d][i] = 0.f;
    float m_run = 0.f, l_run = 0.f;
    bf16x8 mfrag = {0, 0, 0, 0, 0, 0, 0, 0}, onefrag = {0, 0, 0, 0, 0, 0, 0, 0}; onefrag[0] = hi ? (short)0 : (short)0x3F80;
    const int nkt = 2 * (qb + 1), nmain = 2 * qb;
    const int krow = tid >> 3, kc = (tid & 7) ^ ((krow >> 1) & 7);
    const unsigned kgo = (unsigned)(krow * PW + kc * 8) * 2u;
    const int vrow = tid >> 4, vpos = tid & 15, vc = ((((vpos >> 1) ^ (2 * (vrow & 3)))) << 1) | (vpos & 1);
    const unsigned vgo = (unsigned)(vrow * PW + vc * 8) * 2u;
    const bf16* kg = QKV + kcol; const bf16* vg = QKV + vcol;
    const unsigned wl = (unsigned)(tid >> 6) * 1024u;
    const size_t tstep = (size_t)KT * PW;
#define DMA16(g, vo, l) glds16((g), (vo), (unsigned)__builtin_amdgcn_readfirstlane((int)(unsigned)(size_t)(l)))
#define DMA_K(t, slot) do { const bf16* g_ = kg + (size_t)(t) * tstep; DMA16(g_, kgo, lds + (slot) + wl); DMA16(g_ + (size_t)64 * PW, kgo, lds + (slot) + 8192 + wl); } while (0)
#define DMA_VH(t, b, h) do { const bf16* g_ = vg + (size_t)(t) * tstep + (size_t)(64 * (h)) * PW; LAS unsigned char* l_ = lds + DA_V + (b) * 32768 + 16384 * (h) + wl; \
        DMA16(g_, vgo, l_); DMA16(g_ + (size_t)32 * PW, vgo, l_ + 8192); } while (0)
#define DMA_V(t, b) do { DMA_VH(t, b, 0); DMA_VH(t, b, 1); } while (0)
    const unsigned ka = r32 * 128;
    const int kx = (r32 >> 1) & 7;
    const int q4 = (lane & 15) >> 2, p4 = lane & 3, blk = (lane >> 4) & 1;
    const int vr0 = 4 * hi + q4;
    const unsigned va = DA_V + vr0 * 256 + 8 * p4;
    const int vx = 2 * q4;
    DMA_K(0, 0); DMA_K(1, 16384); DMA_V(0, 0);
    asm volatile("s_waitcnt vmcnt(0) lgkmcnt(0)\n\ts_barrier" ::: "memory");
    f32x16 S0, S1;
#pragma unroll
    for (int i = 0; i < 16; ++i) S0[i] = 0.f;
#pragma unroll
    for (int ks = 0; ks < 4; ++ks) S0 = MFMA32(*(LAS const bf16x8*)(lds + ka + (((2 * ks + hi) ^ kx) << 4)), qf[ks], S0);
    int kb0 = 0, kb1 = 16384, kb2 = 32768;
    for (int kt = 0; kt < nkt; ++kt) {
        const int buf = kt & 1;
        const bool more = kt + 1 < nkt;
        if (kt + 2 < nkt) DMA_K(kt + 2, kb2);
        LAS const unsigned char* Kc = lds + kb0; LAS const unsigned char* Vb = lds + buf * 32768;
        if (kt < nmain) {
            flash_half<false>(O, S0, S1, m_run, l_run, mfrag, onefrag, qf, Kc + 4096, Vb, ka, kx, va, vx, blk, hi, kt * KT, qrow, qmin);
            if (more) DMA_VH(kt + 1, buf ^ 1, 0);
            flash_half<false>(O, S1, S0, m_run, l_run, mfrag, onefrag, qf, Kc + 8192, Vb + 8192, ka, kx, va, vx, blk, hi, kt * KT + 32, qrow, qmin);
            if (more) DMA_VH(kt + 1, buf ^ 1, 1);
            flash_half<false>(O, S0, S1, m_run, l_run, mfrag, onefrag, qf, Kc + 12288, Vb + 16384, ka, kx, va, vx, blk, hi, kt * KT + 64, qrow, qmin);
            flash_half<false>(O, S1, S0, m_run, l_run, mfrag, onefrag, qf, lds + kb1, Vb + 24576, ka, kx, va, vx, blk, hi, kt * KT + 96, qrow, qmin);
        } else {
            if (more) DMA_V(kt + 1, buf ^ 1);
            flash_half<true>(O, S0, S1, m_run, l_run, mfrag, onefrag, qf, Kc + 4096, Vb, ka, kx, va, vx, blk, hi, kt * KT, qrow, qmin);
            flash_half<true>(O, S1, S0, m_run, l_run, mfrag, onefrag, qf, Kc + 8192, Vb + 8192, ka, kx, va, vx, blk, hi, kt * KT + 32, qrow, qmin);
            flash_half<true>(O, S0, S1, m_run, l_run, mfrag, onefrag, qf, Kc + 12288, Vb + 16384, ka, kx, va, vx, blk, hi, kt * KT + 64, qrow, qmin);
            flash_half<true>(O, S1, S0, m_run, l_run, mfrag, onefrag, qf, lds + kb1, Vb + 24576, ka, kx, va, vx, blk, hi, kt * KT + 96, qrow, qmin);
        }
        asm volatile("s_waitcnt vmcnt(0) lgkmcnt(0)\n\ts_barrier" ::: "memory");
        const int t0 = kb0; kb0 = kb1; kb1 = kb2; kb2 = t0;
    }
#undef DMA16
#undef DMA_K
#undef DMA_V
#undef DMA_VH
    const float l = sum_x32(l_run), inv = 1.f / l;
#pragma unroll
    for (int d = 0; d < 4; ++d)
#pragma unroll
        for (int i = 0; i < 16; ++i) O[d][i] *= inv;
}

__device__ __forceinline__ void headnorm_store(const f32x16 (&O)[4], const float* g, float post, bf16* MIX, int qrow, int col0, int hi) {
    float ss = 0.f;
#pragma unroll
    for (int d = 0; d < 4; ++d)
#pragma unroll
        for (int i = 0; i < 16; ++i) ss += O[d][i] * O[d][i];
    ss = sum_x32(ss);
    const float rs = __builtin_amdgcn_rsqf(ss * (1.f / 128.f) + EPS) * post;
    f32x4 gvv[4][4];
#pragma unroll
    for (int d = 0; d < 4; ++d)
#pragma unroll
        for (int gq = 0; gq < 4; ++gq) gvv[d][gq] = *(const f32x4*)(g + 32 * d + 8 * gq + 4 * hi);
    asm volatile("" ::: "memory");
#pragma unroll
    for (int d = 0; d < 4; ++d)
#pragma unroll
        for (int gq = 0; gq < 4; ++gq) {
            const int dv = 32 * d + 8 * gq + 4 * hi;
            const f32x4 gv = gvv[d][gq];
            v2u w; w.x = cvtpk_s(O[d][4 * gq] * rs * gv[0], O[d][4 * gq + 1] * rs * gv[1]); w.y = cvtpk_s(O[d][4 * gq + 2] * rs * gv[2], O[d][4 * gq + 3] * rs * gv[3]);
            *(v2u*)(MIX + (size_t)qrow * DM + col0 + dv) = w;
        }
}

__device__ __forceinline__ void diff_unit(LAS unsigned char* lds, const bf16* QKV, bf16* MIX, float* o1s, const float* gd, float lam, int head, int qb, int w, int lane, int tid) {
    f32x16 O[4];
#pragma unroll 1
    for (int j = 0; j < 2; ++j) {
        flash_map(O, lds, QKV, COL_DQ + head * 128 + 64 * j, COL_DK + head * 128 + 64 * j, COL_DV + head * 128, qb, w, lane, tid);
        if (j == 0) {
            f32x4* sc = (f32x4*)(o1s + ((size_t)(blockIdx.x * NWAVES + w) * 64 + opaque(lane)) * 64);
#pragma unroll
            for (int d = 0; d < 4; ++d)
#pragma unroll
                for (int i = 0; i < 4; ++i) sc[d * 4 + i] = (f32x4){O[d][4 * i], O[d][4 * i + 1], O[d][4 * i + 2], O[d][4 * i + 3]};
        }
    }
    lane = opaque(lane);
    const f32x4* sc = (const f32x4*)(o1s + ((size_t)(blockIdx.x * NWAVES + w) * 64 + lane) * 64);
#pragma unroll
    for (int d = 0; d < 4; ++d)
#pragma unroll
        for (int i = 0; i < 4; ++i) { const f32x4 t = sc[d * 4 + i];
#pragma unroll
            for (int e = 0; e < 4; ++e) O[d][4 * i + e] = t[e] - lam * O[d][4 * i + e]; }
    headnorm_store(O, gd, 1.f - LAM_INIT, MIX, qb * 256 + w * 32 + (lane & 31), head * 128, lane >> 5);
}

constexpr float SB_STOP = -44.f * 1.4426950408889634f;
__device__ __forceinline__ void sb_unit(LAS unsigned char* vl, const bf16* QKV, bf16* MIX, const float* gs, int head, int qg, int lane) {
    const int r32 = lane & 31, hi = lane >> 5;
    const int qrow = qg * 32 + r32;
    bf16x8 qf[8];
#pragma unroll
    for (int ks = 0; ks < 8; ++ks) qf[ks] = *(const bf16x8*)(QKV + (size_t)qrow * PW + COL_SQ + head * 128 + 16 * ks + 8 * hi);
    f32x16 O[4];
#pragma unroll
    for (int d = 0; d < 4; ++d)
#pragma unroll
        for (int i = 0; i < 16; ++i) O[d][i] = 0.f;
    float R = 0.f;
    const int q4 = (lane & 15) >> 2, p4 = lane & 3, blk = (lane >> 4) & 1;
    const int vr0 = 4 * hi + q4, vx = vr0 & 7;
    const unsigned va = vr0 * 256 + 8 * p4;
    const bf16* kgp = QKV + (size_t)r32 * PW + COL_SK + head * 128 + 8 * hi;
    const bf16* vgp = QKV + (size_t)(lane >> 4) * PW + COL_SV + head * 128 + (lane & 15) * 8;
    bf16x8 kf[8]; v4u vreg[8];
#pragma unroll
    for (int ks = 0; ks < 8; ++ks) kf[ks] = *(const bf16x8*)(kgp + (size_t)(qg * 32) * PW + 16 * ks);
#pragma unroll
    for (int i = 0; i < 8; ++i) vreg[i] = *(const v4u*)(vgp + (size_t)(qg * 32 + 4 * i) * PW);
    for (int kt = qg; kt >= 0; --kt) {
        const int k0 = kt * 32;
        f32x16 S;
#pragma unroll
        for (int i = 0; i < 16; ++i) S[i] = 0.f;
#pragma unroll
        for (int ks = 0; ks < 8; ++ks) S = MFMA32(kf[ks], qf[ks], S);
        LDS_WAIT();
#pragma unroll
        for (int i = 0; i < 8; ++i) { const int row = 4 * i + (lane >> 4), c = lane & 15; *(LAS v4u*)(vl + row * 256 + (((c >> 1) ^ (row & 7)) << 5) + ((c & 1) << 4)) = vreg[i]; }
        if (kt > 0) {
#pragma unroll
            for (int ks = 0; ks < 8; ++ks) kf[ks] = *(const bf16x8*)(kgp + (size_t)(k0 - 32) * PW + 16 * ks);
#pragma unroll
            for (int i = 0; i < 8; ++i) vreg[i] = *(const v4u*)(vgp + (size_t)(k0 - 32 + 4 * i) * PW);
        }
        float lb[16], lom[16];
#pragma unroll
        for (int i = 0; i < 16; ++i) {
            const int key = k0 + crow(i, hi); const float z = S[i];
            const float sp = __builtin_amdgcn_logf(1.f + __builtin_amdgcn_exp2f(-fabsf(z)));
            lb[i] = fminf(z, 0.f) - sp;
            lom[i] = (key < qrow) ? lb[i] - z : 0.f;
        }
        float gsum[4], pgs[4], after[4];
#pragma unroll
        for (int g = 0; g < 4; ++g) { gsum[g] = (lom[4 * g] + lom[4 * g + 1]) + (lom[4 * g + 2] + lom[4 * g + 3]); pgs[g] = partner_x32(gsum[g], hi); }
        float run = 0.f;
#pragma unroll
        for (int g = 3; g >= 0; --g) { after[g] = run + (hi == 0 ? pgs[g] : 0.f); run += gsum[g] + pgs[g]; }
#pragma unroll
        for (int g = 0; g < 4; ++g) {
            float suf = R + after[g];
#pragma unroll
            for (int e = 3; e >= 0; --e) {
                const int i = 4 * g + e; const int key = k0 + crow(i, hi);
                S[i] = (key < qrow) ? __builtin_amdgcn_exp2f(lb[i] + suf) : 0.f;
                suf += lom[i];
            }
        }
        R += run;
        LDS_WAIT();
#pragma unroll
        for (int kk = 0; kk < 2; ++kk) {
            const bf16x8 pb = pack8(S, kk);
#pragma unroll
            for (int d = 0; d < 4; ++d) {
                LAS const unsigned char* p = vl + va + kk * 4096 + (((2 * d + blk) ^ vx) << 5);
                const s16x4 lo = vtr(p), hi4 = vtr(p + 2048);
                const bf16x8 a = __builtin_shufflevector(lo, hi4, 0, 1, 2, 3, 4, 5, 6, 7);
                O[d] = MFMA32(a, pb, O[d]);
            }
        }
        if (__all(R < SB_STOP)) break;
    }
    LDS_WAIT();
    headnorm_store(O, gs, 1.f, MIX, qrow, 1024 + head * 128, hi);
}
__device__ __forceinline__ void transpose_item(const float* W, int K, int N, bf16* WT, const float* g, LAS float* scr, int item, int lane) {
    const int nblk = N / 32, kb = item / nblk, nb = item % nblk, k0 = 64 * kb, n0 = 32 * nb;
    const int r8 = lane >> 3, c4 = (lane & 7) * 4;
    f32x4 v[8];
#pragma unroll
    for (int i = 0; i < 8; ++i) v[i] = __builtin_nontemporal_load((const f32x4*)(W + (size_t)(k0 + r8 + 8 * i) * N + n0 + c4));
#pragma unroll
    for (int i = 0; i < 8; ++i) { const int kk = r8 + 8 * i; const float gs = g ? g[k0 + kk] : 1.f;
#pragma unroll
        for (int e = 0; e < 4; ++e) scr[kk * 33 + c4 + e] = v[i][e] * gs; }
    LDS_WAIT();
    const int c = lane & 7;
#pragma unroll
    for (int j = 0; j < 4; ++j) { const int n = (lane >> 3) + 8 * j; const LAS float* sp = scr + (8 * c) * 33 + n;
        v4u o; o.x = pk2(sp[0 * 33], sp[1 * 33]); o.y = pk2(sp[2 * 33], sp[3 * 33]); o.z = pk2(sp[4 * 33], sp[5 * 33]); o.w = pk2(sp[6 * 33], sp[7 * 33]);
        *(v4u*)(WT + (size_t)(n0 + n) * K + k0 + 8 * c) = o; }
    LDS_WAIT();
}

#define XB_TMO      128
#define XB_XCNT(j)  (256  + 64 * (j))
#define XB_XSUB(j)  (1280 + 64 * (j))
#define XB_XGEN(j)  (2304 + 64 * (j))
#define XB_TOP      3328
#define XB_TOPGEN   3392
#define XCD_BAR_WORDS 3456
#define XB_SPIN_CAP (1u << 18)
__device__ __forceinline__ unsigned xb_ld(unsigned* p)              { return __hip_atomic_load(p, __ATOMIC_RELAXED, __HIP_MEMORY_SCOPE_AGENT); }
__device__ __forceinline__ unsigned xb_add(unsigned* p, unsigned v) { return __hip_atomic_fetch_add(p, v, __ATOMIC_RELAXED, __HIP_MEMORY_SCOPE_AGENT); }
__device__ __forceinline__ unsigned xb_xcc_id() { return (unsigned)__builtin_amdgcn_s_getreg((3 << 11) | 20) & 0xFu; }
#define XB_SPIN(cond, bar) do { unsigned _sp = 0; while (cond) { __builtin_amdgcn_s_sleep(1); \
    if ((++_sp & 255u) == 0u) { if (xb_ld(&(bar)[XB_TMO])) break; if (_sp > XB_SPIN_CAP) { atomicAdd(&(bar)[XB_TMO], 1u); break; } } } } while (0)

struct XcdBarrier {
    unsigned* bar; unsigned x;
    volatile LAS unsigned* st;
};

__device__ __forceinline__ XcdBarrier xcd_barrier_post(unsigned* bar, volatile LAS unsigned* st, bool t0) {
    XcdBarrier b; b.bar = bar; b.x = xb_xcc_id(); b.st = st;
    if (t0) (void)xb_add(&bar[XB_XCNT(b.x)], 1u);
    return b;
}
__device__ __forceinline__ void xcd_barrier_complete(unsigned* bar, unsigned x, unsigned& nloc, unsigned& nx) {
    const unsigned G = gridDim.x * gridDim.y * gridDim.z;
    unsigned sum, cnt, mine, sp = 0u;
    for (;;) {
        sum = 0u; cnt = 0u; mine = 0u;
#pragma unroll
        for (unsigned j = 0; j < 16; ++j) { const unsigned c = xb_ld(&bar[XB_XCNT(j)]); sum += c; cnt += (c > 0u) ? 1u : 0u; mine = (j == x) ? c : mine; }
        if (sum == G) break;
        __builtin_amdgcn_s_sleep(1);
        if ((++sp & 255u) == 0u) { if (xb_ld(&bar[XB_TMO])) break; if (sp > XB_SPIN_CAP) { atomicAdd(&bar[XB_TMO], 1u); break; } }
    }
    nloc = mine > 0u ? mine : 1u; nx = cnt > 0u ? cnt : 1u;
}

__device__ __forceinline__ void xcd_barrier(const XcdBarrier& b, bool t0) {
    asm volatile("s_waitcnt vmcnt(0)" ::: "memory");
    __syncthreads();
    if (t0) {
        unsigned* bar = b.bar;
        __builtin_amdgcn_s_waitcnt(0);
        unsigned nloc = b.st[0], nx = b.st[1];
        if (nloc == 0u) { xcd_barrier_complete(bar, b.x, nloc, nx); b.st[0] = nloc; b.st[1] = nx; }
        const unsigned old = xb_add(&bar[XB_XSUB(b.x)], 1u);
        const unsigned gen = old / nloc;
        if (old + 1u == (gen + 1u) * nloc) {
            __builtin_amdgcn_fence(__ATOMIC_RELEASE, "agent");
            asm volatile("s_waitcnt vmcnt(0)" ::: "memory");
            const unsigned og = xb_add(&bar[XB_TOP], 1u);
            const unsigned tg = og / nx;
            if (og + 1u == (tg + 1u) * nx) xb_add(&bar[XB_TOPGEN], 1u);
            else XB_SPIN(xb_ld(&bar[XB_TOPGEN]) == tg, bar);
            __builtin_amdgcn_fence(__ATOMIC_ACQUIRE, "agent");
            xb_add(&bar[XB_XGEN(b.x)], 1u);
            asm volatile("s_waitcnt vmcnt(0)" ::: "memory");
        } else {
            XB_SPIN(xb_ld(&bar[XB_XGEN(b.x)]) == gen, bar);
            __builtin_amdgcn_fence(__ATOMIC_ACQUIRE, "agent");
            asm volatile("s_waitcnt vmcnt(0)" ::: "memory");
        }
    }
    __syncthreads();
}

struct Args { const float* in[14]; float* out; unsigned char* ws; float inv_freq[8]; int ph_lo, ph_hi; };

__global__ void __launch_bounds__(NTHR, 2) hybrid_fwd(Args args) {
    extern __shared__ __attribute__((aligned(16))) unsigned char lds_raw[];
    LAS unsigned char* lds = (LAS unsigned char*)lds_raw;
    cg::grid_group grid = cg::this_grid();
    const int wave = __builtin_amdgcn_readfirstlane((int)threadIdx.x >> 6);
    const int G = gridDim.x, bx = blockIdx.x;
    const int gw = bx * NWAVES + wave, NGW = G * NWAVES;
#define FRESH_IDS const int lane = opaque((int)__builtin_amdgcn_mbcnt_hi(~0u, __builtin_amdgcn_mbcnt_lo(~0u, 0u))), tid = wave * 64 + lane
    unsigned char* ws = args.ws;
    const float* x = args.in[0]; const float* ln1 = args.in[1]; const float* w_in = args.in[2];
    const float* lq1 = args.in[3]; const float* lk1 = args.in[4]; const float* lq2 = args.in[5]; const float* lk2 = args.in[6];
    const float* g_diff = args.in[7]; const float* g_sb = args.in[8]; const float* w_out = args.in[9]; const float* ln2 = args.in[10];
    const float* w1 = args.in[11]; const float* w2 = args.in[12]; const float* ln_f = args.in[13];
    float* out = args.out;
    bf16* Win_t = (bf16*)(ws + WS_WIN); bf16* Wout_t = (bf16*)(ws + WS_WOUT); bf16* W1_t = (bf16*)(ws + WS_W1); bf16* W2_t = (bf16*)(ws + WS_W2);
    float* cs = (float*)(ws + WS_CS); float* ss1 = (float*)(ws + WS_SS1); float* ss2 = (float*)(ws + WS_SS2);
    bf16* Hb = (bf16*)(ws + WS_H); bf16* QKV = (bf16*)(ws + WS_QKV); bf16* MIX = (bf16*)(ws + WS_MIX); bf16* U = (bf16*)(ws + WS_U);
    const int lo = args.ph_lo, hi_ph = args.ph_hi;
#define IN(k) (lo <= (k) && (k) < hi_ph)
    unsigned* ctl = (unsigned*)(ws + WS_CTL);
    const bool t0 = (wave == 0) && (__builtin_amdgcn_mbcnt_hi(~0u, __builtin_amdgcn_mbcnt_lo(~0u, 0u)) == 0);
    if (args.ph_lo < 0) grid.sync();
    volatile LAS unsigned* bst = (volatile LAS unsigned*)(lds + RING_BYTES);
    if (t0) { bst[0] = 0u; bst[1] = 0u; }
    __syncthreads();
    XcdBarrier xbar = xcd_barrier_post(ctl + 1024, bst, t0);
#define SEAM(k) do { if (IN(k) && IN((k) + 1)) xcd_barrier(xbar, t0); } while (0)
    if (IN(0)) {
        FRESH_IDS;
        LAS float* scr = (LAS float*)(lds + wave * 16384);
        constexpr int I_IN = (DM / 64) * (PW / 32), I_OUT = (DM / 64) * (DM / 32), I_1 = (DM / 64) * (FF / 32), I_2 = (FF / 64) * (DM / 32);
        constexpr int NITEMS = I_IN + I_OUT + I_1 + I_2;
        for (int it = gw; it < NITEMS; it += NGW) {
            int r = it;
            if (r < I_IN) { transpose_item(w_in, DM, PW, Win_t, nullptr, scr, r, lane); continue; } r -= I_IN;
            if (r < I_OUT) { transpose_item(w_out, DM, DM, Wout_t, nullptr, scr, r, lane); continue; } r -= I_OUT;
            if (r < I_1) { transpose_item(w1, DM, FF, W1_t, ln2, scr, r, lane); continue; } r -= I_1;
            transpose_item(w2, FF, DM, W2_t, nullptr, scr, r, lane);
        }
        for (int m = gw; m < M; m += NGW) {
            const f32x4* xr = (const f32x4*)(x + (size_t)m * DM) + lane; const f32x4* gr = (const f32x4*)ln1 + lane;
            f32x4 v[8], gv[8]; float s = 0.f;
#pragma unroll
            for (int j = 0; j < 8; ++j) { v[j] = __builtin_nontemporal_load(xr + 64 * j); gv[j] = gr[64 * j]; }
#pragma unroll
            for (int j = 0; j < 8; ++j) s += (v[j][0] * v[j][0] + v[j][1] * v[j][1]) + (v[j][2] * v[j][2] + v[j][3] * v[j][3]);
            const float rstd = 1.f / sqrtf(wave_sum(s) * (1.f / DM) + EPS);
            v2u* o8 = (v2u*)(Hb + (size_t)m * DM) + lane;
#pragma unroll
            for (int j = 0; j < 8; ++j) { const f32x4 gq = gv[j]; v2u w; w.x = pk2(v[j][0] * rstd * gq[0], v[j][1] * rstd * gq[1]); w.y = pk2(v[j][2] * rstd * gq[2], v[j][3] * rstd * gq[3]); o8[64 * j] = w; }
        }
        for (int e = bx * NTHR + tid; e < SEQ * 8; e += G * NTHR) {
            const int pos = e >> 3, i = e & 7;
            const float ang = (float)pos * args.inv_freq[i];
            const double rev = (double)ang * 0.15915494309189533577; const float fr = (float)(rev - rint(rev));
            cs[pos * 16 + i] = __builtin_amdgcn_cosf(fr); cs[pos * 16 + 8 + i] = __builtin_amdgcn_sinf(fr);
        }
        for (int e = bx * NTHR + tid; e < SEQ; e += G * NTHR) { ss1[e] = 0.f; ss2[e] = 0.f; }
    }
    SEAM(0);
    if (IN(1)) {
        pg8::Gemm g{Hb, Win_t, M, PW, DM}; pg8::StaticOrder S; S.init(M, PW, G, bx);
        EpiQKV E{QKV, cs};
        pg8::gemm_phase<EpiQKV, pg8::StaticOrder, true, true>(lds, g, S, E, wave);
    }
    SEAM(1);
    if (IN(2)) {
        FRESH_IDS;
        const float a = lq1[lane] * lk1[lane], b = lq2[lane] * lk2[lane];
        const float lam = __builtin_bit_cast(float, __builtin_amdgcn_readfirstlane(__builtin_bit_cast(int, __expf(wave_sum(a)) - __expf(wave_sum(b)) + LAM_INIT)));
        float* o1s = (float*)(ws + WS_H);
        for (int u = bx; u < 256; u += G) {
            const int head = u & 7, p = u >> 3;
#pragma unroll 1
            for (int t = 0; t < 2; ++t) diff_unit(lds, QKV, MIX, o1s, g_diff, lam, head, t ? 63 - p : p, wave, lane, tid);
        }
        __syncthreads();
        const int lane_sb = opaque(lane);
        for (int wu = gw; wu < 8 * 512; wu += NGW) sb_unit(lds + wave * 8192, QKV, MIX, g_sb, wu & 7, 511 - (wu >> 3), lane_sb);
        __syncthreads();
    }
    SEAM(2);
    if (IN(3)) {
        pg8::Gemm g{MIX, Wout_t, M, DM, DM}; pg8::StaticOrder S; S.init(M, DM, G, bx);
        EpiRes<false> E{x, nullptr, nullptr, Hb, ss1};
        pg8::gemm_phase<EpiRes<false>, pg8::StaticOrder, false, true>(lds, g, S, E, wave);
    }
    SEAM(3);
    if (IN(4)) {
        pg8::Gemm g{Hb, W1_t, M, FF, DM}; pg8::StaticOrder S; S.init(M, FF, G, bx);
        EpiMlpIn E{U, ss1};
        pg8::gemm_phase<EpiMlpIn, pg8::StaticOrder, true, true>(lds, g, S, E, wave);
    }
    SEAM(4);
    if (IN(5)) {
        pg8::Gemm g{U, W2_t, M, DM, FF}; pg8::StaticOrder S; S.init(M, DM, G, bx);
        EpiRes<true> E{nullptr, Hb, nullptr, Hb, ss2};
        pg8::gemm_phase<EpiRes<true>, pg8::StaticOrder, false, true>(lds, g, S, E, wave);
    }
    SEAM(5);
    if (IN(6)) {
        FRESH_IDS;
        for (int m = gw; m < M; m += NGW) {
            const v4u* xr = (const v4u*)(Hb + (size_t)m * DM) + lane; const f32x4* gr = (const f32x4*)ln_f + 2 * lane; f32x4* orow = (f32x4*)(out + (size_t)m * DM) + 2 * lane;
            v4u v[4]; f32x4 g0[4], g1[4];
#pragma unroll
            for (int j = 0; j < 4; ++j) { v[j] = xr[64 * j]; g0[j] = gr[128 * j]; g1[j] = gr[128 * j + 1]; }
            const float rstd = 1.f / sqrtf(__hip_atomic_load(ss2 + m, __ATOMIC_RELAXED, __HIP_MEMORY_SCOPE_AGENT) * (1.f / DM) + EPS);
            asm volatile("" ::: "memory");
#pragma unroll
            for (int j = 0; j < 4; ++j) {
                const f32x4 a = {__builtin_bit_cast(float, v[j].x << 16), __builtin_bit_cast(float, v[j].x & 0xffff0000u), __builtin_bit_cast(float, v[j].y << 16), __builtin_bit_cast(float, v[j].y & 0xffff0000u)};
                const f32x4 c = {__builtin_bit_cast(float, v[j].z << 16), __builtin_bit_cast(float, v[j].z & 0xffff0000u), __builtin_bit_cast(float, v[j].w << 16), __builtin_bit_cast(float, v[j].w & 0xffff0000u)};
                __builtin_nontemporal_store(a * rstd * g0[j], orow + 128 * j); __builtin_nontemporal_store(c * rstd * g1[j], orow + 128 * j + 1);
            }
        }
    }
#undef IN
#undef SEAM
}

extern "C" void kernel_launch(void* const* d_in, const int* in_sizes, int n_in, void* d_out, int out_size, void* d_ws, size_t ws_size, hipStream_t stream) {
    static int grid = 0;
    if (grid == 0) {
        if (n_in != 14 || in_sizes[0] != M * DM || out_size != M * DM || ws_size < WS_END) { fprintf(stderr, "kernel_launch: unexpected shapes (n_in %d, in0 %d, out %d, ws %zu)\n", n_in, n_in > 0 ? in_sizes[0] : -1, out_size, ws_size); grid = -1; return; }
        int dev = 0, cus = 0, per_cu = 0;
        (void)hipGetDevice(&dev); (void)hipDeviceGetAttribute(&cus, hipDeviceAttributeMultiprocessorCount, dev);
        if (hipFuncSetAttribute((const void*)hybrid_fwd, hipFuncAttributeMaxDynamicSharedMemorySize, LDS_BYTES) != hipSuccess) { fprintf(stderr, "kernel_launch: hipFuncSetAttribute failed\n"); grid = -1; return; }
        if (hipOccupancyMaxActiveBlocksPerMultiprocessor(&per_cu, (const void*)hybrid_fwd, NTHR, LDS_BYTES) != hipSuccess || per_cu < 1) { fprintf(stderr, "kernel_launch: occupancy query gave %d\n", per_cu); per_cu = 1; }
        (void)hipGetLastError();
        grid = cus * per_cu;
    }
    if (grid < 0) return;
    if (hipMemsetAsync((char*)d_ws + WS_CTL, 0, 32768, stream) != hipSuccess) { fprintf(stderr, "kernel_launch: memset failed\n"); return; }
    Args a{};
    for (int i = 0; i < 14; ++i) a.in[i] = (const float*)d_in[i];
    a.out = (float*)d_out; a.ws = (unsigned char*)d_ws;
    for (int i = 0; i < 8; ++i) a.inv_freq[i] = (float)pow(500000.0, -(double)i / 8.0);
    a.ph_lo = 0; a.ph_hi = 7;
    void* kargs[] = {&a};
    hipError_t e = hipLaunchCooperativeKernel((const void*)hybrid_fwd, dim3(grid), dim3(NTHR), kargs, LDS_BYTES, stream);
    if (e != hipSuccess) fprintf(stderr, "kernel_launch: cooperative launch failed: %s (grid %d)\n", hipGetErrorString(e), grid);
}
```

```cpp
#include <hip/hip_runtime.h>
#include <hip/hip_cooperative_groups.h>
#include <cstdio>
#include <cstdint>
#include <cmath>
namespace cg = cooperative_groups;
namespace pg8 {
#define PG8_LAS __attribute__((address_space(3)))
typedef unsigned short bf16_t;
typedef short bf16x8 __attribute__((ext_vector_type(8)));
typedef float f32x4 __attribute__((ext_vector_type(4)));
typedef unsigned u32x4 __attribute__((ext_vector_type(4)));
typedef int v8i32 __attribute__((ext_vector_type(8)));
typedef int i32x4 __attribute__((ext_vector_type(4)));
constexpr int BM = 256, BK = 64, HALF = 128, HTB = HALF * BK * 2  , STAGE_BYTES = 8 * HTB, NXCD = 8, WGM = 8;

__host__ __device__ __forceinline__ int lds_byte(int r, int c) { const int st = (r >> 4) * 2 + (c >> 5), rr = r & 15, cc = c & 31, ob = rr * 64 + cc * 2; return st * 1024 + (ob ^ (((ob >> 9) & 1) << 5)); }
__host__ __device__ __forceinline__ void stage_rc(int b, int& R, int& C) { const int st = b / 1024, sb = b % 1024, swz = sb ^ (((sb >> 9) & 1) << 5); R = (st >> 1) * 16 + swz / 64; C = (st & 1) * 32 + (swz % 64) / 2; }
__host__ __device__ __forceinline__ int perm32(int rho) { const int n = rho >> 4, i = rho & 15; return 8 * (i >> 2) + 4 * n + (i & 3); }

struct Unit { int pm, pn; };
struct Gemm { const bf16_t* A; const bf16_t* Bt; int M, N, K; };

struct StaticOrder {
    int nM, nN, nwg, G, c;
    __host__ __device__ void init(int M, int N, int G_, int c_) { nM = M / BM; nN = N / BM; nwg = nM * nN; G = G_; c = c_; }
    __host__ __device__ bool next(int i, Unit& u) const {
        const long L = (long)i * G + c; if (L >= nwg) return false;
        int wgid = (int)L; { const int q = nwg / NXCD, r = nwg % NXCD, xcd = wgid % NXCD, off = wgid / NXCD; wgid = (xcd < r ? xcd * (q + 1) : r * (q + 1) + (xcd - r) * q) + off; }
        const int nig = WGM * nN, gid = wgid / nig, fm = gid * WGM, gsz = (nM - fm) < WGM ? (nM - fm) : WGM;
        u.pm = fm + ((wgid % nig) % gsz); u.pn = (wgid % nig) / gsz; return true;
    }
    __device__ __forceinline__ void a_ready(const Unit&) const {}
    __device__ __forceinline__ void done(const Unit&) const {}
};

__device__ __forceinline__ unsigned cvt_pk_bf16(float lo, float hi) { unsigned r; asm volatile("v_cvt_pk_bf16_f32 %0, %1, %2" : "=v"(r) : "v"(lo), "v"(hi)); return r; }
template <class Epi, class Sched, bool ALIGN_EPI = false, bool SP2 = false, bool FP8 = false>
__device__ __forceinline__ void gemm_phase(PG8_LAS unsigned char* lds, const Gemm g, const Sched& S, const Epi& E, int wave_id) {
    int tid_ = wave_id * 64 + (int)__builtin_amdgcn_mbcnt_hi(~0u, __builtin_amdgcn_mbcnt_lo(~0u, 0u)); asm volatile("" : "+v"(tid_));
    const int tid = tid_, wid = __builtin_amdgcn_readfirstlane(tid >> 6), lane = tid & 63, wr = wid >> 2, wc = wid & 3, fr = lane & 15, fq = lane >> 4;
    const int K = g.K, nt = K / BK;
    unsigned voffA[2], voffB[2];
#pragma unroll
    for (int i = 0; i < 2; ++i) { int R, C; stage_rc(tid * 16 + i * 8192, R, C); const int Rb = Epi::PERM ? ((R & ~31) + perm32(R & 31)) : R;
        voffA[i] = (unsigned)(R * K + C) * 2u; voffB[i] = (unsigned)(Rb * K + C) * 2u; }
    const size_t kstep = (size_t)(BK * 2);
    const size_t hstep = (size_t)HALF * K * 2;
    const size_t tstep = 2 * hstep;
    const unsigned ldsw = (unsigned)wid * 1024u;
    const int aoff = lds_byte(wr * 64 + fr, fq * 8), boff = lds_byte(wc * 32 + fr, fq * 8);
#define PG8_SA(b, h) (((b) * 2 + (h)) * HTB)
#define PG8_SB(b, h) ((4 + (b) * 2 + (h)) * HTB)
#define PG8_STAGE(bufoff, gbase, voff) do { _Pragma("unroll") for (int _i = 0; _i < 2; ++_i) \
        __builtin_amdgcn_global_load_lds((const unsigned*)((const char*)(gbase) + (voff)[_i]), (PG8_LAS unsigned*)(lds + (bufoff) + ldsw + _i * 8192), 16, 0, 0); } while (0)
#define PG8_LD32(p) __builtin_shufflevector(*(const PG8_LAS i32x4*)(p), *(const PG8_LAS i32x4*)((p) + 1024), 0, 1, 2, 3, 4, 5, 6, 7)
#define PG8_LDA(dst, b, h) do { _Pragma("unroll") for (int m = 0; m < 4; ++m) { if constexpr (FP8) dst##8[m] = PG8_LD32(lds + PG8_SA(b, h) + aoff + m * 2048); else { _Pragma("unroll") for (int k = 0; k < 2; ++k) dst[m][k] = *(const PG8_LAS bf16x8*)(lds + PG8_SA(b, h) + aoff + m * 2048 + k * 1024); } } } while (0)
#define PG8_LDB(dst, b, h) do { _Pragma("unroll") for (int n = 0; n < 2; ++n) { if constexpr (FP8) dst##8[n] = PG8_LD32(lds + PG8_SB(b, h) + boff + n * 2048); else { _Pragma("unroll") for (int k = 0; k < 2; ++k) dst[n][k] = *(const PG8_LAS bf16x8*)(lds + PG8_SB(b, h) + boff + n * 2048 + k * 1024); } } } while (0)
#define PG8_MMA(ai, bj, At, Bt) do { __builtin_amdgcn_s_setprio(1); _Pragma("unroll") for (int m = 0; m < 4; ++m) _Pragma("unroll") for (int n = 0; n < 2; ++n) { \
        if constexpr (FP8) asm volatile("v_mfma_f32_16x16x128_f8f6f4 %0, %1, %2, %0" : "+v"(acc[ai][bj][m][n]) : "v"(Bt##8[n]), "v"(At##8[m]));   \
        else { _Pragma("unroll") for (int k = 0; k < 2; ++k) acc[ai][bj][m][n] = __builtin_amdgcn_mfma_f32_16x16x32_bf16(Bt[n][k], At[m][k], acc[ai][bj][m][n], 0, 0, 0); } } \
        __builtin_amdgcn_s_setprio(0); } while (0)
#define PG8_WAIT_V(n) asm volatile("s_waitcnt vmcnt(" #n ")" ::: "memory")
#define PG8_WAIT_L(n) asm volatile("s_waitcnt lgkmcnt(" #n ")" ::: "memory")
#define PG8_BAR __builtin_amdgcn_s_barrier()
#define PG8_SCHED __builtin_amdgcn_sched_barrier(0)
    Unit cur, nxt; int ui = 0;
    if (!S.next(0, cur)) return;
    f32x4 acc[2][2][4][2];
#pragma unroll
    for (int a = 0; a < 2; ++a)
#pragma unroll
        for (int b = 0; b < 2; ++b)
#pragma unroll
            for (int m = 0; m < 4; ++m)
#pragma unroll
                for (int n = 0; n < 2; ++n) acc[a][b][m][n] = (f32x4){0.f, 0.f, 0.f, 0.f};
    bf16x8 At[4][2], B0[2][2], B1[2][2];
    v8i32 At8[4], B08[2], B18[2];
    const char* cA = (const char*)g.A + (size_t)cur.pm * tstep; const char* cB = (const char*)g.Bt + (size_t)cur.pn * tstep;
    S.a_ready(cur);
    if constexpr (SP2) {
        PG8_STAGE(PG8_SB(0, 0), cB, voffB); PG8_STAGE(PG8_SB(0, 1), cB + hstep, voffB); PG8_STAGE(PG8_SA(0, 0), cA, voffA); PG8_STAGE(PG8_SA(0, 1), cA + hstep, voffA);
        if (wr == 1) PG8_BAR;
        PG8_WAIT_V(2); PG8_BAR;
        PG8_STAGE(PG8_SB(1, 0), cB + kstep, voffB); PG8_STAGE(PG8_SA(1, 0), cA + kstep, voffA); PG8_STAGE(PG8_SB(1, 1), cB + hstep + kstep, voffB);
        PG8_WAIT_V(6); PG8_BAR;
    } else {
        PG8_STAGE(PG8_SB(0, 0), cB, voffB); PG8_STAGE(PG8_SA(0, 0), cA, voffA); PG8_STAGE(PG8_SB(0, 1), cB + hstep, voffB); PG8_STAGE(PG8_SA(0, 1), cA + hstep, voffA);
        if (wr == 1) PG8_BAR;
        PG8_WAIT_V(4); PG8_BAR;
        PG8_STAGE(PG8_SB(1, 0), cB + kstep, voffB); PG8_STAGE(PG8_SA(1, 0), cA + kstep, voffA); PG8_STAGE(PG8_SB(1, 1), cB + hstep + kstep, voffB);
        PG8_WAIT_V(6); PG8_BAR;
    }
    for (;;) {
        const bool has_next = S.next(ui + 1, nxt);
        const char* nA = has_next ? (const char*)g.A + (size_t)nxt.pm * tstep : cA; const char* nB = has_next ? (const char*)g.Bt + (size_t)nxt.pn * tstep : cB;
        for (int t = 0; t < nt; t += 2) {
            const bool last = (t == nt - 2);
            const char* a1 = cA + (size_t)(t + 1) * kstep;
            const char* a2 = last ? nA : cA + (size_t)(t + 2) * kstep; const char* b2 = last ? nB : cB + (size_t)(t + 2) * kstep;
            const char* a3 = a2 + kstep; const char* b3 = b2 + kstep;
            if (last && has_next) S.a_ready(nxt);
            if constexpr (SP2) {
            PG8_LDB(B0, 0, 0); PG8_LDB(B1, 0, 1); PG8_SCHED; PG8_LDA(At, 0, 0); PG8_STAGE(PG8_SA(1, 1), a1 + hstep, voffA);
            PG8_WAIT_V(8); PG8_WAIT_L(0); PG8_BAR; PG8_MMA(0, 0, At, B0); PG8_MMA(0, 1, At, B1); PG8_BAR; PG8_SCHED;
            PG8_LDA(At, 0, 1); PG8_STAGE(PG8_SB(0, 0), b2, voffB); PG8_STAGE(PG8_SB(0, 1), b2 + hstep, voffB); PG8_STAGE(PG8_SA(0, 0), a2, voffA);
            PG8_WAIT_V(8); PG8_WAIT_L(0); PG8_BAR; PG8_MMA(1, 0, At, B0); PG8_MMA(1, 1, At, B1); PG8_BAR; PG8_SCHED;
            PG8_LDB(B0, 1, 0); PG8_LDB(B1, 1, 1); PG8_SCHED; PG8_LDA(At, 1, 0); PG8_STAGE(PG8_SA(0, 1), a2 + hstep, voffA);
            PG8_WAIT_V(8); PG8_WAIT_L(0); PG8_BAR; PG8_MMA(0, 0, At, B0); PG8_MMA(0, 1, At, B1); PG8_BAR; PG8_SCHED;
            PG8_LDA(At, 1, 1); PG8_STAGE(PG8_SB(1, 0), b3, voffB); PG8_STAGE(PG8_SB(1, 1), b3 + hstep, voffB); PG8_STAGE(PG8_SA(1, 0), a3, voffA);
            PG8_WAIT_V(8); PG8_WAIT_L(0); PG8_BAR; PG8_MMA(1, 0, At, B0); PG8_MMA(1, 1, At, B1); PG8_BAR; PG8_SCHED;
            } else {
            PG8_LDB(B0, 0, 0); PG8_SCHED; PG8_LDA(At, 0, 0); PG8_STAGE(PG8_SA(1, 1), a1 + hstep, voffA);
            PG8_WAIT_L(8); PG8_BAR; PG8_WAIT_L(0); PG8_MMA(0, 0, At, B0); PG8_BAR; PG8_SCHED;
            PG8_LDB(B1, 0, 1); PG8_STAGE(PG8_SB(0, 0), b2, voffB);
            PG8_BAR; PG8_WAIT_L(0); PG8_MMA(0, 1, At, B1); PG8_BAR;
            PG8_LDA(At, 0, 1); PG8_STAGE(PG8_SA(0, 0), a2, voffA);
            PG8_BAR; PG8_WAIT_L(0); PG8_MMA(1, 0, At, B0); PG8_BAR; PG8_SCHED;
            PG8_STAGE(PG8_SB(0, 1), b2 + hstep, voffB);
            PG8_WAIT_V(6); PG8_BAR; PG8_MMA(1, 1, At, B1); PG8_BAR;
            PG8_LDB(B0, 1, 0); PG8_SCHED; PG8_LDA(At, 1, 0); PG8_STAGE(PG8_SA(0, 1), a2 + hstep, voffA);
            PG8_WAIT_L(8); PG8_BAR; PG8_WAIT_L(0); PG8_MMA(0, 0, At, B0); PG8_BAR; PG8_SCHED;
            PG8_LDB(B1, 1, 1); PG8_STAGE(PG8_SB(1, 0), b3, voffB);
            PG8_BAR; PG8_WAIT_L(0); PG8_MMA(0, 1, At, B1); PG8_BAR;
            PG8_LDA(At, 1, 1); PG8_STAGE(PG8_SA(1, 0), a3, voffA);
            PG8_BAR; PG8_WAIT_L(0); PG8_MMA(1, 0, At, B0); PG8_BAR; PG8_SCHED;
            PG8_STAGE(PG8_SB(1, 1), b3 + hstep, voffB);
            PG8_WAIT_V(6); PG8_BAR; PG8_MMA(1, 1, At, B1); PG8_BAR;
            }
        }
        if constexpr (FP8) asm volatile("s_nop 15\n\ts_nop 15" ::: "memory");
        if constexpr (ALIGN_EPI) { if (wr == 0) PG8_BAR; }
        if constexpr (!Epi::AFTER_DRAIN) { E(acc, cur, wr, wc, fr, fq); S.done(cur); }
        if (!has_next) break;
#pragma unroll
        for (int a = 0; a < 2; ++a)
#pragma unroll
            for (int b = 0; b < 2; ++b)
#pragma unroll
                for (int m = 0; m < 4; ++m)
#pragma unroll
                    for (int n = 0; n < 2; ++n) acc[a][b][m][n] = (f32x4){0.f, 0.f, 0.f, 0.f};
        cur = nxt; cA = nA; cB = nB; ++ui;
        if constexpr (ALIGN_EPI) { if (wr == 1) PG8_BAR; }
    }
    PG8_WAIT_V(0);
    if constexpr (!ALIGN_EPI) { if (wr == 0) PG8_BAR; }
    PG8_BAR;
    if constexpr (Epi::AFTER_DRAIN) { E.fused(acc, cur, wr, wc, fr, fq, lds, wid, lane); S.done(cur); }
#undef PG8_SA
#undef PG8_SB
#undef PG8_STAGE
#undef PG8_LDA
#undef PG8_LDB
#undef PG8_MMA
#undef PG8_LD32
#undef PG8_WAIT_V
#undef PG8_WAIT_L
#undef PG8_BAR
#undef PG8_SCHED
}
}
#define GAS __attribute__((address_space(1)))
#define LAS __attribute__((address_space(3)))
typedef unsigned short bf16;
typedef unsigned v4u __attribute__((ext_vector_type(4)));
typedef unsigned v2u __attribute__((ext_vector_type(2)));
typedef float f32x4 __attribute__((ext_vector_type(4)));
typedef float f32x16 __attribute__((ext_vector_type(16)));
typedef short bf16x8 __attribute__((ext_vector_type(8)));
typedef short s16x4 __attribute__((ext_vector_type(4)));
using pg8::Unit; using pg8::cvt_pk_bf16; using pg8::BM; using pg8::HALF;

constexpr int SEQ = 16384, DM = 2048, PW = 6144, FF = 8192, M = SEQ;
constexpr int NWAVES = 8, NTHR = 512;
constexpr float EPS = 1e-6f;
constexpr float C2 = 0.125f * 1.4426950408889634f;
constexpr float SBSCALE = 0.08838834764831845f * 1.4426950408889634f;
constexpr float LAM_INIT = 0.2f;
constexpr float W2_SCALE = 512.f;
constexpr int COL_DQ = 0, COL_DK = 1024, COL_DV = 2048, COL_SQ = 3072, COL_SK = 4096, COL_SV = 5120;

constexpr size_t MiB = 1u << 20;
constexpr size_t WS_WIN = 0;
constexpr size_t WS_WOUT = 24 * MiB;
constexpr size_t WS_W1 = 32 * MiB;
constexpr size_t WS_W2 = 64 * MiB;
constexpr size_t WS_CS = 96 * MiB;
constexpr size_t WS_SS1 = 97 * MiB;
constexpr size_t WS_SS2 = 97 * MiB + 65536;
constexpr size_t WS_H = 98 * MiB;
constexpr size_t WS_QKV = 162 * MiB;
constexpr size_t WS_MIX = 354 * MiB;
constexpr size_t WS_U = 162 * MiB;
constexpr size_t WS_CTL = 418 * MiB;
constexpr size_t WS_END = 419 * MiB;

constexpr int RING_BYTES = 131072, LDS_BYTES = 131072 + 1024;

__device__ __forceinline__ unsigned f2bf(float f) { unsigned u = __builtin_bit_cast(unsigned, f); return (u + 0x7fffu + ((u >> 16) & 1u)) >> 16; }
__device__ __forceinline__ unsigned pk2(float lo, float hi) { return f2bf(lo) | (f2bf(hi) << 16); }
__device__ __forceinline__ float wave_sum(float v) {
#pragma unroll
    for (int o = 1; o < 64; o <<= 1) v += __shfl_xor(v, o);
    return v;
}
typedef unsigned u32x2_t __attribute__((ext_vector_type(2)));
__device__ __forceinline__ void swap_x32(float& a, float& b) { asm volatile("s_nop 1\n\tv_permlane32_swap_b32 %0, %1" : "+v"(a), "+v"(b)); }
__device__ __forceinline__ float max_x32(float x) { float a = x, b = x; swap_x32(a, b); return fmaxf(a, b); }
__device__ __forceinline__ float sum_x32(float x) { float a = x, b = x; swap_x32(a, b); return a + b; }
__device__ __forceinline__ float partner_x32(float x, int hi) { float a = x, b = x; swap_x32(a, b); return hi ? a : b; }
#define LDS_WAIT() asm volatile("s_waitcnt lgkmcnt(0)" ::: "memory")
__device__ __forceinline__ int opaque(int v) { asm volatile("" : "+v"(v)); return v; }

struct EpiQKV {
    static constexpr bool PERM = true, AFTER_DRAIN = false;
    bf16* O; const float* cs;
    __device__ __forceinline__ void operator()(const f32x4 (&acc)[2][2][4][2], const Unit& u, int wr, int wc, int fr, int fq) const {
        const int row0 = u.pm * BM + wr * 64 + fr, col0 = u.pn * BM + wc * 32 + 8 * fq;
        float sc = 1.f; if (u.pn < 4) sc = C2; else if (u.pn >= 12 && u.pn < 16) sc = SBSCALE;
        const bool rot = (u.pn < 8) && ((wc & 1) == 0);
        if (rot) {
#pragma unroll
            for (int ai = 0; ai < 2; ++ai) {
                f32x4 cv[4][4];
#pragma unroll
                for (int m = 0; m < 4; ++m) { const f32x4* p = (const f32x4*)(cs + (size_t)(row0 + ai * HALF + m * 16) * 16); cv[m][0] = p[0]; cv[m][1] = p[1]; cv[m][2] = p[2]; cv[m][3] = p[3]; }
#pragma unroll
                for (int m = 0; m < 4; ++m) {
                    const int row = row0 + ai * HALF + m * 16;
                    const f32x4 c0 = cv[m][0], c1 = cv[m][1]; f32x4 s0 = cv[m][2], s1 = cv[m][3]; if (fq == 0) { s0 = -s0; s1 = -s1; }
#pragma unroll
                    for (int bj = 0; bj < 2; ++bj) {
                        f32x4 v0 = acc[ai][bj][m][0] * sc, v1 = acc[ai][bj][m][1] * sc, p0, p1;
#pragma unroll
                        for (int e = 0; e < 4; ++e) { p0[e] = __shfl_xor(v0[e], 16); p1[e] = __shfl_xor(v1[e], 16); }
                        if (fq < 2) { v0 = v0 * c0 + p0 * s0; v1 = v1 * c1 + p1 * s1; }
                        v4u w; w.x = cvt_pk_bf16(v0[0], v0[1]); w.y = cvt_pk_bf16(v0[2], v0[3]); w.z = cvt_pk_bf16(v1[0], v1[1]); w.w = cvt_pk_bf16(v1[2], v1[3]);
                        *(v4u*)(O + (size_t)row * PW + col0 + bj * HALF) = w;
                    }
                }
            }
        } else {
#pragma unroll
            for (int ai = 0; ai < 2; ++ai)
#pragma unroll
                for (int m = 0; m < 4; ++m) {
                    const int row = row0 + ai * HALF + m * 16;
#pragma unroll
                    for (int bj = 0; bj < 2; ++bj) {
                        const f32x4 v0 = acc[ai][bj][m][0] * sc, v1 = acc[ai][bj][m][1] * sc;
                        v4u w; w.x = cvt_pk_bf16(v0[0], v0[1]); w.y = cvt_pk_bf16(v0[2], v0[3]); w.z = cvt_pk_bf16(v1[0], v1[1]); w.w = cvt_pk_bf16(v1[2], v1[3]);
                        *(v4u*)(O + (size_t)row * PW + col0 + bj * HALF) = w;
                    }
                }
        }
    }
};
template <bool RES_BF16>
struct EpiRes {
    static constexpr bool PERM = true, AFTER_DRAIN = false;
    const float* R; const bf16* Rb; float* Y; bf16* Yb; float* ss; float ascale;
    __device__ __forceinline__ void operator()(const f32x4 (&acc)[2][2][4][2], const Unit& u, int wr, int wc, int fr, int fq) const {
        const int row0 = u.pm * BM + wr * 64 + fr, col0 = u.pn * BM + wc * 32 + 8 * fq;
#pragma unroll
        for (int ai = 0; ai < 2; ++ai) {
            f32x4 rv[4][2][2];
#pragma unroll
            for (int m = 0; m < 4; ++m)
#pragma unroll
                for (int bj = 0; bj < 2; ++bj) {
                    const size_t off = (size_t)(row0 + ai * HALF + m * 16) * DM + col0 + bj * HALF;
                    if (RES_BF16) {
                        const v4u t = *(const v4u*)(Rb + off);
                        rv[m][bj][0] = (f32x4){__builtin_bit_cast(float, t.x << 16), __builtin_bit_cast(float, t.x & 0xffff0000u), __builtin_bit_cast(float, t.y << 16), __builtin_bit_cast(float, t.y & 0xffff0000u)};
                        rv[m][bj][1] = (f32x4){__builtin_bit_cast(float, t.z << 16), __builtin_bit_cast(float, t.z & 0xffff0000u), __builtin_bit_cast(float, t.w << 16), __builtin_bit_cast(float, t.w & 0xffff0000u)};
                    } else { rv[m][bj][0] = *(const f32x4*)(R + off); rv[m][bj][1] = *(const f32x4*)(R + off + 4); }
                }
            asm volatile("" ::: "memory");
#pragma unroll
            for (int m = 0; m < 4; ++m) {
                const int row = row0 + ai * HALF + m * 16; float s = 0.f;
#pragma unroll
                for (int bj = 0; bj < 2; ++bj) {
                    const size_t off = (size_t)row * DM + col0 + bj * HALF;
                    const f32x4 v0 = acc[ai][bj][m][0] * ascale + rv[m][bj][0], v1 = acc[ai][bj][m][1] * ascale + rv[m][bj][1];
                    { v4u w; w.x = cvt_pk_bf16(v0[0], v0[1]); w.y = cvt_pk_bf16(v0[2], v0[3]); w.z = cvt_pk_bf16(v1[0], v1[1]); w.w = cvt_pk_bf16(v1[2], v1[3]); *(v4u*)(Yb + off) = w; }
                    s += (v0[0] * v0[0] + v0[1] * v0[1]) + (v0[2] * v0[2] + v0[3] * v0[3]) + (v1[0] * v1[0] + v1[1] * v1[1]) + (v1[2] * v1[2] + v1[3] * v1[3]);
                }
                s += __shfl_xor(s, 16); s += __shfl_xor(s, 32);
                if (fq == 0) atomicAdd(ss + row, s);
            }
        }
    }
};
struct EpiMlpIn {
    static constexpr bool PERM = true, AFTER_DRAIN = false;
    unsigned char* O; const float* ss;
    __device__ __forceinline__ void operator()(const f32x4 (&acc)[2][2][4][2], const Unit& u, int wr, int wc, int fr, int fq) const {
        const int row0 = u.pm * BM + wr * 64 + fr, col0 = u.pn * BM + wc * 32 + 8 * fq;
        float rs[2][4];
#pragma unroll
        for (int ai = 0; ai < 2; ++ai)
#pragma unroll
            for (int m = 0; m < 4; ++m) rs[ai][m] = __hip_atomic_load(ss + row0 + ai * HALF + m * 16, __ATOMIC_RELAXED, __HIP_MEMORY_SCOPE_AGENT);
        asm volatile("" ::: "memory");
#pragma unroll
        for (int ai = 0; ai < 2; ++ai)
#pragma unroll
            for (int m = 0; m < 4; ++m) {
                const int row = row0 + ai * HALF + m * 16;
                const float rstd = __builtin_amdgcn_rsqf(rs[ai][m] * (1.f / DM) + EPS);
#pragma unroll
                for (int bj = 0; bj < 2; ++bj) {
                    f32x4 v0 = acc[ai][bj][m][0] * rstd, v1 = acc[ai][bj][m][1] * rstd;
#pragma unroll
                    for (int e = 0; e < 4; ++e) { const float a = fmaxf(v0[e], 0.f), b = fmaxf(v1[e], 0.f); v0[e] = a * a; v1[e] = b * b; }
                    int w0 = __builtin_amdgcn_cvt_pk_fp8_f32(v0[0], v0[1], 0, false); w0 = __builtin_amdgcn_cvt_pk_fp8_f32(v0[2], v0[3], w0, true);
                    int w1 = __builtin_amdgcn_cvt_pk_fp8_f32(v1[0], v1[1], 0, false); w1 = __builtin_amdgcn_cvt_pk_fp8_f32(v1[2], v1[3], w1, true);
                    *(v2u*)(O + (size_t)row * FF + col0 + bj * HALF) = (v2u){(unsigned)w0, (unsigned)w1};
                }
            }
    }
};
#define MFMA32(a, b, c) __builtin_amdgcn_mfma_f32_32x32x16_bf16((a), (b), (c), 0, 0, 0)
__device__ __forceinline__ int crow(int r, int hi) { return (r & 3) + 8 * (r >> 2) + 4 * hi; }
typedef short v4i16_t __attribute__((ext_vector_type(4)));
__device__ __forceinline__ s16x4 vtr(LAS const unsigned char* p) { return __builtin_bit_cast(s16x4, __builtin_amdgcn_ds_read_tr16_b64_v4i16((LAS v4i16_t*)p)); }
typedef float f32x2_t __attribute__((ext_vector_type(2)));
typedef __bf16 bf16x2_t __attribute__((ext_vector_type(2)));
__device__ __forceinline__ unsigned cvtpk_s(float lo, float hi) { f32x2_t v = {lo, hi}; bf16x2_t b = __builtin_convertvector(v, bf16x2_t); return __builtin_bit_cast(unsigned, b); }
__device__ __forceinline__ bf16x8 pack8(const f32x16& x, int s) {
    v4u p; p.x = cvtpk_s(x[8 * s], x[8 * s + 1]); p.y = cvtpk_s(x[8 * s + 2], x[8 * s + 3]); p.z = cvtpk_s(x[8 * s + 4], x[8 * s + 5]); p.w = cvtpk_s(x[8 * s + 6], x[8 * s + 7]);
    return __builtin_bit_cast(bf16x8, p);
}

__device__ __forceinline__ void glds16(const void* sbase, unsigned voff, unsigned lds_dst) { unsigned keep;
    asm volatile("s_mov_b32 %0, m0\n\ts_mov_b32 m0, %3\n\ts_nop 0\n\tglobal_load_lds_dwordx4 %1, %2\n\ts_mov_b32 m0, %0" : "=&s"(keep) : "v"(voff), "s"(sbase), "s"(lds_dst) : "memory"); }
template <bool TAIL>
__device__ __forceinline__ void flash_half(f32x16 (&O)[4], f32x16& Sc, f32x16& Sn, float& m_run, float& l_run, bf16x8& mfrag, const bf16x8& onefrag, const bf16x8 (&qf)[4],
                                           LAS const unsigned char* Kn, LAS const unsigned char* Vc, unsigned ka, int kx, unsigned va, int vx, int blk, int hi, int key0, int qrow, int qmin) {
    if (TAIL) {
        const int kb = key0 + 4 * hi;
#pragma unroll
        for (int i = 0; i < 16; ++i) { const int key = kb + (i & 3) + 8 * (i >> 2); if (key > qrow) Sc[i] = -1e30f; }
    }
    float mloc = fmaxf(Sc[0], Sc[1]);
#pragma unroll
    for (int i = 2; i < 16; ++i) mloc = fmaxf(mloc, Sc[i]);
    mloc = max_x32(mloc);
    const bool first = (key0 == 0);
    if (__any(mloc > 8.f) || first) {
        const float m_new = (mloc > 8.f || first) ? __builtin_bit_cast(float, f2bf(m_run + mloc) << 16) : m_run;
        const float delta = m_new - m_run, alpha = __builtin_amdgcn_exp2f(-delta);
        l_run *= alpha;
#pragma unroll
        for (int d = 0; d < 4; ++d)
#pragma unroll
            for (int i = 0; i < 16; ++i) O[d][i] *= alpha;
#pragma unroll
        for (int i = 0; i < 16; ++i) Sc[i] -= delta;
        m_run = m_new;
        mfrag[0] = hi ? (short)0 : (short)(f2bf(-m_new));
    }
#pragma unroll
    for (int i = 0; i < 16; ++i) Sn[i] = 0.f;
    Sn = MFMA32(onefrag, mfrag, Sn);
#pragma unroll
    for (int ks = 0; ks < 4; ++ks) {
        const bf16x8 a0 = *(LAS const bf16x8*)(Kn + ka + (((2 * ks + hi) ^ kx) << 4));
        Sn = MFMA32(a0, qf[ks], Sn);
    }
    float ls = 0.f;
#pragma unroll
    for (int i = 0; i < 16; ++i) { Sc[i] = __builtin_amdgcn_exp2f(Sc[i]); ls += Sc[i]; }
    l_run += ls;
#pragma unroll
    for (int kk = 0; kk < 2; ++kk) {
        if (kk == 1) __builtin_amdgcn_sched_barrier(0);
        const bf16x8 pb = pack8(Sc, kk);
#pragma unroll
        for (int d = 0; d < 4; ++d) {
            LAS const unsigned char* p = Vc + va + kk * 4096 + (((2 * d + blk) ^ vx) << 5);
            const s16x4 lo = vtr(p), hi4 = vtr(p + 2048);
            const bf16x8 a = __builtin_shufflevector(lo, hi4, 0, 1, 2, 3, 4, 5, 6, 7);
            O[d] = MFMA32(a, pb, O[d]);
        }
    }
}

constexpr int DA_V = 49152, KT = 128;
__device__ __forceinline__ void flash_map(f32x16 (&O)[4], LAS unsigned char* lds, const bf16* QKV, int qcol, int kcol, int vcol, int qb, int w, int lane, int tid) {
    const int r32 = lane & 31, hi = lane >> 5;
    const int qmin = qb * 256 + w * 32, qrow = qmin + r32;
    bf16x8 qf[4];
    { const int lq = opaque(lane);
      const bf16* qp = QKV + (size_t)(qmin + (lq & 31)) * PW + qcol + 8 * (lq >> 5);
#pragma unroll
      for (int ks = 0; ks < 4; ++ks) qf[ks] = *(const bf16x8*)(qp + 16 * ks); }
#pragma unroll
    for (int d = 0; d < 4; ++d)
#pragma unroll
        for (int i = 0; i < 16; ++i) O[d][i] = 0.f;
    float m_run = 0.f, l_run = 0.f;
    bf16x8 mfrag = {0, 0, 0, 0, 0, 0, 0, 0}, onefrag = {0, 0, 0, 0, 0, 0, 0, 0}; onefrag[0] = hi ? (short)0 : (short)0x3F80;
    const int nkt = 2 * (qb + 1), nmain = 2 * qb;
    const int krow = tid >> 3, kc = (tid & 7) ^ ((krow >> 1) & 7);
    const unsigned kgo = (unsigned)(krow * PW + kc * 8) * 2u;
    const int vrow = tid >> 4, vpos = tid & 15, vc = ((((vpos >> 1) ^ (2 * (vrow & 3)))) << 1) | (vpos & 1);
    const unsigned vgo = (unsigned)(vrow * PW + vc * 8) * 2u;
    const bf16* kg = QKV + kcol; const bf16* vg = QKV + vcol;
    const unsigned wl = (unsigned)(tid >> 6) * 1024u;
    const size_t tstep = (size_t)KT * PW;
#define DMA16(g, vo, l) glds16((g), (vo), (unsigned)__builtin_amdgcn_readfirstlane((int)(unsigned)(size_t)(l)))
#define DMA_K(t, slot) do { const bf16* g_ = kg + (size_t)(t) * tstep; DMA16(g_, kgo, lds + (slot) + wl); DMA16(g_ + (size_t)64 * PW, kgo, lds + (slot) + 8192 + wl); } while (0)
#define DMA_VH(t, b, h) do { const bf16* g_ = vg + (size_t)(t) * tstep + (size_t)(64 * (h)) * PW; LAS unsigned char* l_ = lds + DA_V + (b) * 32768 + 16384 * (h) + wl; \
        DMA16(g_, vgo, l_); DMA16(g_ + (size_t)32 * PW, vgo, l_ + 8192); } while (0)
#define DMA_V(t, b) do { DMA_VH(t, b, 0); DMA_VH(t, b, 1); } while (0)
    const unsigned ka = r32 * 128;
    const int kx = (r32 >> 1) & 7;
    const int q4 = (lane & 15) >> 2, p4 = lane & 3, blk = (lane >> 4) & 1;
    const int vr0 = 4 * hi + q4;
    const unsigned va = DA_V + vr0 * 256 + 8 * p4;
    const int vx = 2 * q4;
    DMA_K(0, 0); DMA_K(1, 16384); DMA_V(0, 0);
    asm volatile("s_waitcnt vmcnt(0) lgkmcnt(0)\n\ts_barrier" ::: "memory");
    f32x16 S0, S1;
#pragma unroll
    for (int i = 0; i < 16; ++i) S0[i] = 0.f;
#pragma unroll
    for (int ks = 0; ks < 4; ++ks) S0 = MFMA32(*(LAS const bf16x8*)(lds + ka + (((2 * ks + hi) ^ kx) << 4)), qf[ks], S0);
    int kb0 = 0, kb1 = 16384, kb2 = 32768;
    for (int kt = 0; kt < nkt; ++kt) {
        const int buf = kt & 1;
        const bool more = kt + 1 < nkt;
        if (kt + 2 < nkt) DMA_K(kt + 2, kb2);
        LAS const unsigned char* Kc = lds + kb0; LAS const unsigned char* Vb = lds + buf * 32768;
        if (kt < nmain) {
            flash_half<false>(O, S0, S1, m_run, l_run, mfrag, onefrag, qf, Kc + 4096, Vb, ka, kx, va, vx, blk, hi, kt * KT, qrow, qmin);
            if (more) DMA_VH(kt + 1, buf ^ 1, 0);
            flash_half<false>(O, S1, S0, m_run, l_run, mfrag, onefrag, qf, Kc + 8192, Vb + 8192, ka, kx, va, vx, blk, hi, kt * KT + 32, qrow, qmin);
            if (more) DMA_VH(kt + 1, buf ^ 1, 1);
            flash_half<false>(O, S0, S1, m_run, l_run, mfrag, onefrag, qf, Kc + 12288, Vb + 16384, ka, kx, va, vx, blk, hi, kt * KT + 64, qrow, qmin);
            flash_half<false>(O, S1, S0, m_run, l_run, mfrag, onefrag, qf, lds + kb1, Vb + 24576, ka, kx, va, vx, blk, hi, kt * KT + 96, qrow, qmin);
        } else {
            if (more) DMA_V(kt + 1, buf ^ 1);
            flash_half<true>(O, S0, S1, m_run, l_run, mfrag, onefrag, qf, Kc + 4096, Vb, ka, kx, va, vx, blk, hi, kt * KT, qrow, qmin);
            flash_half<true>(O, S1, S0, m_run, l_run, mfrag, onefrag, qf, Kc + 8192, Vb + 8192, ka, kx, va, vx, blk, hi, kt * KT + 32, qrow, qmin);
            flash_half<true>(O, S0, S1, m_run, l_run, mfrag, onefrag, qf, Kc + 12288, Vb + 16384, ka, kx, va, vx, blk, hi, kt * KT + 64, qrow, qmin);
            flash_half<true>(O, S1, S0, m_run, l_run, mfrag, onefrag, qf, lds + kb1, Vb + 24576, ka, kx, va, vx, blk, hi, kt * KT + 96, qrow, qmin);
        }
        asm volatile("s_waitcnt vmcnt(0) lgkmcnt(0)\n\ts_barrier" ::: "memory");
        const int t0 = kb0; kb0 = kb1; kb1 = kb2; kb2 = t0;
    }
#undef DMA16
#undef DMA_K
#undef DMA_V
#undef DMA_VH
    const float l = sum_x32(l_run), inv = 1.f / l;
#pragma unroll
    for (int d = 0; d < 4; ++d)
#pragma unroll
        for (int i = 0; i < 16; ++i) O[d][i] *= inv;
}

__device__ __forceinline__ void headnorm_store(const f32x16 (&O)[4], const float* g, float post, bf16* MIX, int qrow, int col0, int hi) {
    float ss = 0.f;
#pragma unroll
    for (int d = 0; d < 4; ++d)
#pragma unroll
        for (int i = 0; i < 16; ++i) ss += O[d][i] * O[d][i];
    ss = sum_x32(ss);
    const float rs = __builtin_amdgcn_rsqf(ss * (1.f / 128.f) + EPS) * post;
    f32x4 gvv[4][4];
#pragma unroll
    for (int d = 0; d < 4; ++d)
#pragma unroll
        for (int gq = 0; gq < 4; ++gq) gvv[d][gq] = *(const f32x4*)(g + 32 * d + 8 * gq + 4 * hi);
    asm volatile("" ::: "memory");
#pragma unroll
    for (int d = 0; d < 4; ++d)
#pragma unroll
        for (int gq = 0; gq < 4; ++gq) {
            const int dv = 32 * d + 8 * gq + 4 * hi;
            const f32x4 gv = gvv[d][gq];
            v2u w; w.x = cvtpk_s(O[d][4 * gq] * rs * gv[0], O[d][4 * gq + 1] * rs * gv[1]); w.y = cvtpk_s(O[d][4 * gq + 2] * rs * gv[2], O[d][4 * gq + 3] * rs * gv[3]);
            *(v2u*)(MIX + (size_t)qrow * DM + col0 + dv) = w;
        }
}

__device__ __forceinline__ void diff_unit(LAS unsigned char* lds, const bf16* QKV, bf16* MIX, float* o1s, const float* gd, float lam, int head, int qb, int w, int lane, int tid) {
    f32x16 O[4];
#pragma unroll 1
    for (int j = 0; j < 2; ++j) {
        flash_map(O, lds, QKV, COL_DQ + head * 128 + 64 * j, COL_DK + head * 128 + 64 * j, COL_DV + head * 128, qb, w, lane, tid);
        if (j == 0) {
            f32x4* sc = (f32x4*)(o1s + ((size_t)(blockIdx.x * NWAVES + w) * 64 + opaque(lane)) * 64);
#pragma unroll
            for (int d = 0; d < 4; ++d)
#pragma unroll
                for (int i = 0; i < 4; ++i) sc[d * 4 + i] = (f32x4){O[d][4 * i], O[d][4 * i + 1], O[d][4 * i + 2], O[d][4 * i + 3]};
        }
    }
    lane = opaque(lane);
    const f32x4* sc = (const f32x4*)(o1s + ((size_t)(blockIdx.x * NWAVES + w) * 64 + lane) * 64);
#pragma unroll
    for (int d = 0; d < 4; ++d)
#pragma unroll
        for (int i = 0; i < 4; ++i) { const f32x4 t = sc[d * 4 + i];
#pragma unroll
            for (int e = 0; e < 4; ++e) O[d][4 * i + e] = t[e] - lam * O[d][4 * i + e]; }
    headnorm_store(O, gd, 1.f - LAM_INIT, MIX, qb * 256 + w * 32 + (lane & 31), head * 128, lane >> 5);
}

constexpr float SB_STOP = -44.f * 1.4426950408889634f;
__device__ __forceinline__ void sb_unit(LAS unsigned char* vl, const bf16* QKV, bf16* MIX, const float* gs, int head, int qg, int lane) {
    const int r32 = lane & 31, hi = lane >> 5;
    const int qrow = qg * 32 + r32;
    bf16x8 qf[8];
#pragma unroll
    for (int ks = 0; ks < 8; ++ks) qf[ks] = *(const bf16x8*)(QKV + (size_t)qrow * PW + COL_SQ + head * 128 + 16 * ks + 8 * hi);
    f32x16 O[4];
#pragma unroll
    for (int d = 0; d < 4; ++d)
#pragma unroll
        for (int i = 0; i < 16; ++i) O[d][i] = 0.f;
    float R = 0.f;
    const int q4 = (lane & 15) >> 2, p4 = lane & 3, blk = (lane >> 4) & 1;
    const int vr0 = 4 * hi + q4, vx = vr0 & 7;
    const unsigned va = vr0 * 256 + 8 * p4;
    const bf16* kgp = QKV + (size_t)r32 * PW + COL_SK + head * 128 + 8 * hi;
    const bf16* vgp = QKV + (size_t)(lane >> 4) * PW + COL_SV + head * 128 + (lane & 15) * 8;
    bf16x8 kf[8]; v4u vreg[8];
#pragma unroll
    for (int ks = 0; ks < 8; ++ks) kf[ks] = *(const bf16x8*)(kgp + (size_t)(qg * 32) * PW + 16 * ks);
#pragma unroll
    for (int i = 0; i < 8; ++i) vreg[i] = *(const v4u*)(vgp + (size_t)(qg * 32 + 4 * i) * PW);
    for (int kt = qg; kt >= 0; --kt) {
        const int k0 = kt * 32;
        f32x16 S;
#pragma unroll
        for (int i = 0; i < 16; ++i) S[i] = 0.f;
#pragma unroll
        for (int ks = 0; ks < 8; ++ks) S = MFMA32(kf[ks], qf[ks], S);
        LDS_WAIT();
#pragma unroll
        for (int i = 0; i < 8; ++i) { const int row = 4 * i + (lane >> 4), c = lane & 15; *(LAS v4u*)(vl + row * 256 + (((c >> 1) ^ (row & 7)) << 5) + ((c & 1) << 4)) = vreg[i]; }
        if (kt > 0) {
#pragma unroll
            for (int ks = 0; ks < 8; ++ks) kf[ks] = *(const bf16x8*)(kgp + (size_t)(k0 - 32) * PW + 16 * ks);
#pragma unroll
            for (int i = 0; i < 8; ++i) vreg[i] = *(const v4u*)(vgp + (size_t)(k0 - 32 + 4 * i) * PW);
        }
        float lb[16], lom[16];
#pragma unroll
        for (int i = 0; i < 16; ++i) {
            const int key = k0 + crow(i, hi); const float z = S[i];
            const float sp = __builtin_amdgcn_logf(1.f + __builtin_amdgcn_exp2f(-fabsf(z)));
            lb[i] = fminf(z, 0.f) - sp;
            lom[i] = (key < qrow) ? lb[i] - z : 0.f;
        }
        float gsum[4], pgs[4], after[4];
#pragma unroll
        for (int g = 0; g < 4; ++g) { gsum[g] = (lom[4 * g] + lom[4 * g + 1]) + (lom[4 * g + 2] + lom[4 * g + 3]); pgs[g] = partner_x32(gsum[g], hi); }
        float run = 0.f;
#pragma unroll
        for (int g = 3; g >= 0; --g) { after[g] = run + (hi == 0 ? pgs[g] : 0.f); run += gsum[g] + pgs[g]; }
#pragma unroll
        for (int g = 0; g < 4; ++g) {
            float suf = R + after[g];
#pragma unroll
            for (int e = 3; e >= 0; --e) {
                const int i = 4 * g + e; const int key = k0 + crow(i, hi);
                S[i] = (key < qrow) ? __builtin_amdgcn_exp2f(lb[i] + suf) : 0.f;
                suf += lom[i];
            }
        }
        R += run;
        LDS_WAIT();
#pragma unroll
        for (int kk = 0; kk < 2; ++kk) {
            const bf16x8 pb = pack8(S, kk);
#pragma unroll
            for (int d = 0; d < 4; ++d) {
                LAS const unsigned char* p = vl + va + kk * 4096 + (((2 * d + blk) ^ vx) << 5);
                const s16x4 lo = vtr(p), hi4 = vtr(p + 2048);
                const bf16x8 a = __builtin_shufflevector(lo, hi4, 0, 1, 2, 3, 4, 5, 6, 7);
                O[d] = MFMA32(a, pb, O[d]);
            }
        }
        if (__all(R < SB_STOP)) break;
    }
    LDS_WAIT();
    headnorm_store(O, gs, 1.f, MIX, qrow, 1024 + head * 128, hi);
}
__device__ __forceinline__ void transpose_item(const float* W, int K, int N, bf16* WT, const float* g, LAS float* scr, int item, int lane) {
    const int nblk = N / 32, kb = item / nblk, nb = item % nblk, k0 = 64 * kb, n0 = 32 * nb;
    const int r8 = lane >> 3, c4 = (lane & 7) * 4;
    f32x4 v[8];
#pragma unroll
    for (int i = 0; i < 8; ++i) v[i] = __builtin_nontemporal_load((const f32x4*)(W + (size_t)(k0 + r8 + 8 * i) * N + n0 + c4));
#pragma unroll
    for (int i = 0; i < 8; ++i) { const int kk = r8 + 8 * i; const float gs = g ? g[k0 + kk] : 1.f;
#pragma unroll
        for (int e = 0; e < 4; ++e) scr[kk * 33 + c4 + e] = v[i][e] * gs; }
    LDS_WAIT();
    const int c = lane & 7;
#pragma unroll
    for (int j = 0; j < 4; ++j) { const int n = (lane >> 3) + 8 * j; const LAS float* sp = scr + (8 * c) * 33 + n;
        v4u o; o.x = pk2(sp[0 * 33], sp[1 * 33]); o.y = pk2(sp[2 * 33], sp[3 * 33]); o.z = pk2(sp[4 * 33], sp[5 * 33]); o.w = pk2(sp[6 * 33], sp[7 * 33]);
        *(v4u*)(WT + (size_t)(n0 + n) * K + k0 + 8 * c) = o; }
    LDS_WAIT();
}

__device__ __forceinline__ void transpose_item_fp8(const float* W, int K, int N, unsigned char* WT8, float scale, LAS float* scr, int item, int lane) {
    const int nblk = N / 32, kb = item / nblk, nb = item % nblk, k0 = 64 * kb, n0 = 32 * nb;
    const int r8 = lane >> 3, c4 = (lane & 7) * 4;
    f32x4 v[8];
#pragma unroll
    for (int i = 0; i < 8; ++i) v[i] = __builtin_nontemporal_load((const f32x4*)(W + (size_t)(k0 + r8 + 8 * i) * N + n0 + c4));
#pragma unroll
    for (int i = 0; i < 8; ++i) { const int kk = r8 + 8 * i;
#pragma unroll
        for (int e = 0; e < 4; ++e) scr[kk * 33 + c4 + e] = v[i][e] * scale; }
    LDS_WAIT();
    const int c = lane & 7;
#pragma unroll
    for (int j = 0; j < 4; ++j) { const int n = (lane >> 3) + 8 * j; const LAS float* sp = scr + (8 * c) * 33 + n;
        int w0 = __builtin_amdgcn_cvt_pk_fp8_f32(sp[0 * 33], sp[1 * 33], 0, false); w0 = __builtin_amdgcn_cvt_pk_fp8_f32(sp[2 * 33], sp[3 * 33], w0, true);
        int w1 = __builtin_amdgcn_cvt_pk_fp8_f32(sp[4 * 33], sp[5 * 33], 0, false); w1 = __builtin_amdgcn_cvt_pk_fp8_f32(sp[6 * 33], sp[7 * 33], w1, true);
        *(v2u*)(WT8 + (size_t)(n0 + n) * K + k0 + 8 * c) = (v2u){(unsigned)w0, (unsigned)w1}; }
    LDS_WAIT();
}

#define XB_TMO      128
#define XB_XCNT(j)  (256  + 64 * (j))
#define XB_XSUB(j)  (1280 + 64 * (j))
#define XB_XGEN(j)  (2304 + 64 * (j))
#define XB_TOP      3328
#define XB_TOPGEN   3392
#define XCD_BAR_WORDS 3456
#define XB_SPIN_CAP (1u << 18)
__device__ __forceinline__ unsigned xb_ld(unsigned* p)              { return __hip_atomic_load(p, __ATOMIC_RELAXED, __HIP_MEMORY_SCOPE_AGENT); }
__device__ __forceinline__ unsigned xb_add(unsigned* p, unsigned v) { return __hip_atomic_fetch_add(p, v, __ATOMIC_RELAXED, __HIP_MEMORY_SCOPE_AGENT); }
__device__ __forceinline__ unsigned xb_xcc_id() { return (unsigned)__builtin_amdgcn_s_getreg((3 << 11) | 20) & 0xFu; }
#define XB_SPIN(cond, bar) do { unsigned _sp = 0; while (cond) { __builtin_amdgcn_s_sleep(1); \
    if ((++_sp & 255u) == 0u) { if (xb_ld(&(bar)[XB_TMO])) break; if (_sp > XB_SPIN_CAP) { atomicAdd(&(bar)[XB_TMO], 1u); break; } } } } while (0)

struct XcdBarrier {
    unsigned* bar; unsigned x;
    volatile LAS unsigned* st;
};

__device__ __forceinline__ XcdBarrier xcd_barrier_post(unsigned* bar, volatile LAS unsigned* st, bool t0) {
    XcdBarrier b; b.bar = bar; b.x = xb_xcc_id(); b.st = st;
    if (t0) (void)xb_add(&bar[XB_XCNT(b.x)], 1u);
    return b;
}
__device__ __forceinline__ void xcd_barrier_complete(unsigned* bar, unsigned x, unsigned& nloc, unsigned& nx) {
    const unsigned G = gridDim.x * gridDim.y * gridDim.z;
    unsigned sum, cnt, mine, sp = 0u;
    for (;;) {
        sum = 0u; cnt = 0u; mine = 0u;
#pragma unroll
        for (unsigned j = 0; j < 16; ++j) { const unsigned c = xb_ld(&bar[XB_XCNT(j)]); sum += c; cnt += (c > 0u) ? 1u : 0u; mine = (j == x) ? c : mine; }
        if (sum == G) break;
        __builtin_amdgcn_s_sleep(1);
        if ((++sp & 255u) == 0u) { if (xb_ld(&bar[XB_TMO])) break; if (sp > XB_SPIN_CAP) { atomicAdd(&bar[XB_TMO], 1u); break; } }
    }
    nloc = mine > 0u ? mine : 1u; nx = cnt > 0u ? cnt : 1u;
}

__device__ __forceinline__ void xcd_barrier(const XcdBarrier& b, bool t0) {
    asm volatile("s_waitcnt vmcnt(0)" ::: "memory");
    __syncthreads();
    if (t0) {
        unsigned* bar = b.bar;
        __builtin_amdgcn_s_waitcnt(0);
        unsigned nloc = b.st[0], nx = b.st[1];
        if (nloc == 0u) { xcd_barrier_complete(bar, b.x, nloc, nx); b.st[0] = nloc; b.st[1] = nx; }
        const unsigned old = xb_add(&bar[XB_XSUB(b.x)], 1u);
        const unsigned gen = old / nloc;
        if (old + 1u == (gen + 1u) * nloc) {
            __builtin_amdgcn_fence(__ATOMIC_RELEASE, "agent");
            asm volatile("s_waitcnt vmcnt(0)" ::: "memory");
            const unsigned og = xb_add(&bar[XB_TOP], 1u);
            const unsigned tg = og / nx;
            if (og + 1u == (tg + 1u) * nx) xb_add(&bar[XB_TOPGEN], 1u);
            else XB_SPIN(xb_ld(&bar[XB_TOPGEN]) == tg, bar);
            __builtin_amdgcn_fence(__ATOMIC_ACQUIRE, "agent");
            xb_add(&bar[XB_XGEN(b.x)], 1u);
            asm volatile("s_waitcnt vmcnt(0)" ::: "memory");
        } else {
            XB_SPIN(xb_ld(&bar[XB_XGEN(b.x)]) == gen, bar);
            __builtin_amdgcn_fence(__ATOMIC_ACQUIRE, "agent");
            asm volatile("s_waitcnt vmcnt(0)" ::: "memory");
        }
    }
    __syncthreads();
}

struct Args { const float* in[14]; float* out; unsigned char* ws; float inv_freq[8]; int ph_lo, ph_hi; };

__global__ void __launch_bounds__(NTHR, 2) hybrid_fwd(Args args) {
    extern __shared__ __attribute__((aligned(16))) unsigned char lds_raw[];
    LAS unsigned char* lds = (LAS unsigned char*)lds_raw;
    cg::grid_group grid = cg::this_grid();
    const int wave = __builtin_amdgcn_readfirstlane((int)threadIdx.x >> 6);
    const int G = gridDim.x, bx = blockIdx.x;
    const int gw = bx * NWAVES + wave, NGW = G * NWAVES;
#define FRESH_IDS const int lane = opaque((int)__builtin_amdgcn_mbcnt_hi(~0u, __builtin_amdgcn_mbcnt_lo(~0u, 0u))), tid = wave * 64 + lane
    unsigned char* ws = args.ws;
    const float* x = args.in[0]; const float* ln1 = args.in[1]; const float* w_in = args.in[2];
    const float* lq1 = args.in[3]; const float* lk1 = args.in[4]; const float* lq2 = args.in[5]; const float* lk2 = args.in[6];
    const float* g_diff = args.in[7]; const float* g_sb = args.in[8]; const float* w_out = args.in[9]; const float* ln2 = args.in[10];
    const float* w1 = args.in[11]; const float* w2 = args.in[12]; const float* ln_f = args.in[13];
    float* out = args.out;
    bf16* Win_t = (bf16*)(ws + WS_WIN); bf16* Wout_t = (bf16*)(ws + WS_WOUT); bf16* W1_t = (bf16*)(ws + WS_W1); unsigned char* W2_8t = ws + WS_W2;
    float* cs = (float*)(ws + WS_CS); float* ss1 = (float*)(ws + WS_SS1); float* ss2 = (float*)(ws + WS_SS2);
    bf16* Hb = (bf16*)(ws + WS_H); bf16* QKV = (bf16*)(ws + WS_QKV); bf16* MIX = (bf16*)(ws + WS_MIX); unsigned char* U8 = ws + WS_U;
    const int lo = args.ph_lo, hi_ph = args.ph_hi;
#define IN(k) (lo <= (k) && (k) < hi_ph)
    unsigned* ctl = (unsigned*)(ws + WS_CTL);
    const bool t0 = (wave == 0) && (__builtin_amdgcn_mbcnt_hi(~0u, __builtin_amdgcn_mbcnt_lo(~0u, 0u)) == 0);
    if (args.ph_lo < 0) grid.sync();
    volatile LAS unsigned* bst = (volatile LAS unsigned*)(lds + RING_BYTES);
    if (t0) { bst[0] = 0u; bst[1] = 0u; }
    __syncthreads();
    XcdBarrier xbar = xcd_barrier_post(ctl + 1024, bst, t0);
#define SEAM(k) do { if (IN(k) && IN((k) + 1)) xcd_barrier(xbar, t0); } while (0)
    if (IN(0)) {
        FRESH_IDS;
        LAS float* scr = (LAS float*)(lds + wave * 16384);
        constexpr int I_IN = (DM / 64) * (PW / 32), I_OUT = (DM / 64) * (DM / 32), I_1 = (DM / 64) * (FF / 32), I_2 = (FF / 64) * (DM / 32);
        constexpr int NITEMS = I_IN + I_OUT + I_1 + I_2;
        for (int it = gw; it < NITEMS; it += NGW) {
            int r = it;
            if (r < I_IN) { transpose_item(w_in, DM, PW, Win_t, nullptr, scr, r, lane); continue; } r -= I_IN;
            if (r < I_OUT) { transpose_item(w_out, DM, DM, Wout_t, nullptr, scr, r, lane); continue; } r -= I_OUT;
            if (r < I_1) { transpose_item(w1, DM, FF, W1_t, ln2, scr, r, lane); continue; } r -= I_1;
            transpose_item_fp8(w2, FF, DM, W2_8t, W2_SCALE, scr, r, lane);
        }
        for (int m = gw; m < M; m += NGW) {
            const f32x4* xr = (const f32x4*)(x + (size_t)m * DM) + lane; const f32x4* gr = (const f32x4*)ln1 + lane;
            f32x4 v[8], gv[8]; float s = 0.f;
#pragma unroll
            for (int j = 0; j < 8; ++j) { v[j] = __builtin_nontemporal_load(xr + 64 * j); gv[j] = gr[64 * j]; }
#pragma unroll
            for (int j = 0; j < 8; ++j) s += (v[j][0] * v[j][0] + v[j][1] * v[j][1]) + (v[j][2] * v[j][2] + v[j][3] * v[j][3]);
            const float rstd = 1.f / sqrtf(wave_sum(s) * (1.f / DM) + EPS);
            v2u* o8 = (v2u*)(Hb + (size_t)m * DM) + lane;
#pragma unroll
            for (int j = 0; j < 8; ++j) { const f32x4 gq = gv[j]; v2u w; w.x = pk2(v[j][0] * rstd * gq[0], v[j][1] * rstd * gq[1]); w.y = pk2(v[j][2] * rstd * gq[2], v[j][3] * rstd * gq[3]); o8[64 * j] = w; }
        }
        for (int e = bx * NTHR + tid; e < SEQ * 8; e += G * NTHR) {
            const int pos = e >> 3, i = e & 7;
            const float ang = (float)pos * args.inv_freq[i];
            const double rev = (double)ang * 0.15915494309189533577; const float fr = (float)(rev - rint(rev));
            cs[pos * 16 + i] = __builtin_amdgcn_cosf(fr); cs[pos * 16 + 8 + i] = __builtin_amdgcn_sinf(fr);
        }
        for (int e = bx * NTHR + tid; e < SEQ; e += G * NTHR) { ss1[e] = 0.f; ss2[e] = 0.f; }
    }
    SEAM(0);
    if (IN(1)) {
        pg8::Gemm g{Hb, Win_t, M, PW, DM}; pg8::StaticOrder S; S.init(M, PW, G, bx);
        EpiQKV E{QKV, cs};
        pg8::gemm_phase<EpiQKV, pg8::StaticOrder, true, true>(lds, g, S, E, wave);
    }
    SEAM(1);
    if (IN(2)) {
        FRESH_IDS;
        const float a = lq1[lane] * lk1[lane], b = lq2[lane] * lk2[lane];
        const float lam = __builtin_bit_cast(float, __builtin_amdgcn_readfirstlane(__builtin_bit_cast(int, __expf(wave_sum(a)) - __expf(wave_sum(b)) + LAM_INIT)));
        float* o1s = (float*)(ws + WS_H);
        for (int u = bx; u < 256; u += G) {
            const int head = u & 7, p = u >> 3;
#pragma unroll 1
            for (int t = 0; t < 2; ++t) diff_unit(lds, QKV, MIX, o1s, g_diff, lam, head, t ? 63 - p : p, wave, lane, tid);
        }
        __syncthreads();
        const int lane_sb = opaque(lane);
        for (int wu = gw; wu < 8 * 512; wu += NGW) sb_unit(lds + wave * 8192, QKV, MIX, g_sb, wu & 7, 511 - (wu >> 3), lane_sb);
        __syncthreads();
    }
    SEAM(2);
    if (IN(3)) {
        pg8::Gemm g{MIX, Wout_t, M, DM, DM}; pg8::StaticOrder S; S.init(M, DM, G, bx);
        EpiRes<false> E{x, nullptr, nullptr, Hb, ss1, 1.f};
        pg8::gemm_phase<EpiRes<false>, pg8::StaticOrder, false, true>(lds, g, S, E, wave);
    }
    SEAM(3);
    if (IN(4)) {
        pg8::Gemm g{Hb, W1_t, M, FF, DM}; pg8::StaticOrder S; S.init(M, FF, G, bx);
        EpiMlpIn E{U8, ss1};
        pg8::gemm_phase<EpiMlpIn, pg8::StaticOrder, true, true>(lds, g, S, E, wave);
    }
    SEAM(4);
    if (IN(5)) {
        pg8::Gemm g{(const pg8::bf16_t*)U8, (const pg8::bf16_t*)W2_8t, M, DM, FF / 2}; pg8::StaticOrder S; S.init(M, DM, G, bx);
        EpiRes<true> E{nullptr, Hb, nullptr, Hb, ss2, 1.f / W2_SCALE};
        pg8::gemm_phase<EpiRes<true>, pg8::StaticOrder, false, true, true>(lds, g, S, E, wave);
    }
    SEAM(5);
    if (IN(6)) {
        FRESH_IDS;
        for (int m = gw; m < M; m += NGW) {
            const v4u* xr = (const v4u*)(Hb + (size_t)m * DM) + lane; const f32x4* gr = (const f32x4*)ln_f + 2 * lane; f32x4* orow = (f32x4*)(out + (size_t)m * DM) + 2 * lane;
            v4u v[4]; f32x4 g0[4], g1[4];
#pragma unroll
            for (int j = 0; j < 4; ++j) { v[j] = xr[64 * j]; g0[j] = gr[128 * j]; g1[j] = gr[128 * j + 1]; }
            const float rstd = 1.f / sqrtf(__hip_atomic_load(ss2 + m, __ATOMIC_RELAXED, __HIP_MEMORY_SCOPE_AGENT) * (1.f / DM) + EPS);
            asm volatile("" ::: "memory");
#pragma unroll
            for (int j = 0; j < 4; ++j) {
                const f32x4 a = {__builtin_bit_cast(float, v[j].x << 16), __builtin_bit_cast(float, v[j].x & 0xffff0000u), __builtin_bit_cast(float, v[j].y << 16), __builtin_bit_cast(float, v[j].y & 0xffff0000u)};
                const f32x4 c = {__builtin_bit_cast(float, v[j].z << 16), __builtin_bit_cast(float, v[j].z & 0xffff0000u), __builtin_bit_cast(float, v[j].w << 16), __builtin_bit_cast(float, v[j].w & 0xffff0000u)};
                __builtin_nontemporal_store(a * rstd * g0[j], orow + 128 * j); __builtin_nontemporal_store(c * rstd * g1[j], orow + 128 * j + 1);
            }
        }
    }
#undef IN
#undef SEAM
}

extern "C" void kernel_launch(void* const* d_in, const int* in_sizes, int n_in, void* d_out, int out_size, void* d_ws, size_t ws_size, hipStream_t stream) {
    static int grid = 0;
    if (grid == 0) {
        if (n_in != 14 || in_sizes[0] != M * DM || out_size != M * DM || ws_size < WS_END) { fprintf(stderr, "kernel_launch: unexpected shapes (n_in %d, in0 %d, out %d, ws %zu)\n", n_in, n_in > 0 ? in_sizes[0] : -1, out_size, ws_size); grid = -1; return; }
        int dev = 0, cus = 0, per_cu = 0;
        (void)hipGetDevice(&dev); (void)hipDeviceGetAttribute(&cus, hipDeviceAttributeMultiprocessorCount, dev);
        if (hipFuncSetAttribute((const void*)hybrid_fwd, hipFuncAttributeMaxDynamicSharedMemorySize, LDS_BYTES) != hipSuccess) { fprintf(stderr, "kernel_launch: hipFuncSetAttribute failed\n"); grid = -1; return; }
        if (hipOccupancyMaxActiveBlocksPerMultiprocessor(&per_cu, (const void*)hybrid_fwd, NTHR, LDS_BYTES) != hipSuccess || per_cu < 1) { fprintf(stderr, "kernel_launch: occupancy query gave %d\n", per_cu); per_cu = 1; }
        (void)hipGetLastError();
        grid = cus * per_cu;
    }
    if (grid < 0) return;
    if (hipMemsetAsync((char*)d_ws + WS_CTL, 0, 32768, stream) != hipSuccess) { fprintf(stderr, "kernel_launch: memset failed\n"); return; }
    Args a{};
    for (int i = 0; i < 14; ++i) a.in[i] = (const float*)d_in[i];
    a.out = (float*)d_out; a.ws = (unsigned char*)d_ws;
    for (int i = 0; i < 8; ++i) a.inv_freq[i] = (float)pow(500000.0, -(double)i / 8.0);
    a.ph_lo = 0; a.ph_hi = 7;
    void* kargs[] = {&a};
    hipError_t e = hipLaunchCooperativeKernel((const void*)hybrid_fwd, dim3(grid), dim3(NTHR), kargs, LDS_BYTES, stream);
    if (e != hipSuccess) fprintf(stderr, "kernel_launch: cooperative launch failed: %s (grid %d)\n", hipGetErrorString(e), grid);
}
```

```cpp
#include <hip/hip_runtime.h>
#include <hip/hip_cooperative_groups.h>
#include <cstdio>
#include <cstdint>
#include <cmath>
namespace cg = cooperative_groups;
namespace pg8 {
#define PG8_LAS __attribute__((address_space(3)))
typedef unsigned short bf16_t;
typedef short bf16x8 __attribute__((ext_vector_type(8)));
typedef float f32x4 __attribute__((ext_vector_type(4)));
typedef unsigned u32x4 __attribute__((ext_vector_type(4)));
typedef int v8i32 __attribute__((ext_vector_type(8)));
typedef int i32x4 __attribute__((ext_vector_type(4)));
constexpr int BM = 256, BK = 64, HALF = 128, HTB = HALF * BK * 2  , STAGE_BYTES = 8 * HTB, NXCD = 8, WGM = 8;

__host__ __device__ __forceinline__ int lds_byte(int r, int c) { const int st = (r >> 4) * 2 + (c >> 5), rr = r & 15, cc = c & 31, ob = rr * 64 + cc * 2; return st * 1024 + (ob ^ (((ob >> 9) & 1) << 5)); }
__host__ __device__ __forceinline__ void stage_rc(int b, int& R, int& C) { const int st = b / 1024, sb = b % 1024, swz = sb ^ (((sb >> 9) & 1) << 5); R = (st >> 1) * 16 + swz / 64; C = (st & 1) * 32 + (swz % 64) / 2; }
__host__ __device__ __forceinline__ int perm32(int rho) { const int n = rho >> 4, i = rho & 15; return 8 * (i >> 2) + 4 * n + (i & 3); }

struct Unit { int pm, pn; };
struct Gemm { const bf16_t* A; const bf16_t* Bt; int M, N, K; };

struct StaticOrder {
    int nM, nN, nwg, G, c;
    __host__ __device__ void init(int M, int N, int G_, int c_) { nM = M / BM; nN = N / BM; nwg = nM * nN; G = G_; c = c_; }
    __host__ __device__ bool next(int i, Unit& u) const {
        const long L = (long)i * G + c; if (L >= nwg) return false;
        int wgid = (int)L; { const int q = nwg / NXCD, r = nwg % NXCD, xcd = wgid % NXCD, off = wgid / NXCD; wgid = (xcd < r ? xcd * (q + 1) : r * (q + 1) + (xcd - r) * q) + off; }
        const int nig = WGM * nN, gid = wgid / nig, fm = gid * WGM, gsz = (nM - fm) < WGM ? (nM - fm) : WGM;
        u.pm = fm + ((wgid % nig) % gsz); u.pn = (wgid % nig) / gsz; return true;
    }
    __device__ __forceinline__ void a_ready(const Unit&) const {}
    __device__ __forceinline__ void done(const Unit&) const {}
};

__device__ __forceinline__ unsigned cvt_pk_bf16(float lo, float hi) { unsigned r; asm volatile("v_cvt_pk_bf16_f32 %0, %1, %2" : "=v"(r) : "v"(lo), "v"(hi)); return r; }
template <class Epi, class Sched, bool ALIGN_EPI = false, bool SP2 = false, bool FP8 = false>
__device__ __forceinline__ void gemm_phase(PG8_LAS unsigned char* lds, const Gemm g, const Sched& S, const Epi& E, int wave_id) {
    int tid_ = wave_id * 64 + (int)__builtin_amdgcn_mbcnt_hi(~0u, __builtin_amdgcn_mbcnt_lo(~0u, 0u)); asm volatile("" : "+v"(tid_));
    const int tid = tid_, wid = __builtin_amdgcn_readfirstlane(tid >> 6), lane = tid & 63, wr = wid >> 2, wc = wid & 3, fr = lane & 15, fq = lane >> 4;
    const int K = g.K, nt = K / BK;
    unsigned voffA[2], voffB[2];
#pragma unroll
    for (int i = 0; i < 2; ++i) { int R, C; stage_rc(tid * 16 + i * 8192, R, C); const int Rb = Epi::PERM ? ((R & ~31) + perm32(R & 31)) : R;
        voffA[i] = (unsigned)(R * K + C) * 2u; voffB[i] = (unsigned)(Rb * K + C) * 2u; }
    const size_t kstep = (size_t)(BK * 2);
    const size_t hstep = (size_t)HALF * K * 2;
    const size_t tstep = 2 * hstep;
    const unsigned ldsw = (unsigned)wid * 1024u;
    const int aoff = lds_byte(wr * 64 + fr, fq * 8), boff = lds_byte(wc * 32 + fr, fq * 8);
#define PG8_SA(b, h) (((b) * 2 + (h)) * HTB)
#define PG8_SB(b, h) ((4 + (b) * 2 + (h)) * HTB)
#define PG8_STAGE(bufoff, gbase, voff) do { _Pragma("unroll") for (int _i = 0; _i < 2; ++_i) \
        __builtin_amdgcn_global_load_lds((const unsigned*)((const char*)(gbase) + (voff)[_i]), (PG8_LAS unsigned*)(lds + (bufoff) + ldsw + _i * 8192), 16, 0, 0); } while (0)
#define PG8_LD32(p) __builtin_shufflevector(*(const PG8_LAS i32x4*)(p), *(const PG8_LAS i32x4*)((p) + 1024), 0, 1, 2, 3, 4, 5, 6, 7)
#define PG8_LDA(dst, b, h) do { _Pragma("unroll") for (int m = 0; m < 4; ++m) { if constexpr (FP8) dst##8[m] = PG8_LD32(lds + PG8_SA(b, h) + aoff + m * 2048); else { _Pragma("unroll") for (int k = 0; k < 2; ++k) dst[m][k] = *(const PG8_LAS bf16x8*)(lds + PG8_SA(b, h) + aoff + m * 2048 + k * 1024); } } } while (0)
#define PG8_LDB(dst, b, h) do { _Pragma("unroll") for (int n = 0; n < 2; ++n) { if constexpr (FP8) dst##8[n] = PG8_LD32(lds + PG8_SB(b, h) + boff + n * 2048); else { _Pragma("unroll") for (int k = 0; k < 2; ++k) dst[n][k] = *(const PG8_LAS bf16x8*)(lds + PG8_SB(b, h) + boff + n * 2048 + k * 1024); } } } while (0)
#define PG8_MMA(ai, bj, At, Bt) do { __builtin_amdgcn_s_setprio(1); _Pragma("unroll") for (int m = 0; m < 4; ++m) _Pragma("unroll") for (int n = 0; n < 2; ++n) { \
        if constexpr (FP8) asm volatile("v_mfma_f32_16x16x128_f8f6f4 %0, %1, %2, %0" : "+v"(acc[ai][bj][m][n]) : "v"(Bt##8[n]), "v"(At##8[m]));   \
        else { _Pragma("unroll") for (int k = 0; k < 2; ++k) acc[ai][bj][m][n] = __builtin_amdgcn_mfma_f32_16x16x32_bf16(Bt[n][k], At[m][k], acc[ai][bj][m][n], 0, 0, 0); } } \
        __builtin_amdgcn_s_setprio(0); } while (0)
#define PG8_WAIT_V(n) asm volatile("s_waitcnt vmcnt(" #n ")" ::: "memory")
#define PG8_WAIT_L(n) asm volatile("s_waitcnt lgkmcnt(" #n ")" ::: "memory")
#define PG8_BAR __builtin_amdgcn_s_barrier()
#define PG8_SCHED __builtin_amdgcn_sched_barrier(0)
    Unit cur, nxt; int ui = 0;
    if (!S.next(0, cur)) return;
    f32x4 acc[2][2][4][2];
#pragma unroll
    for (int a = 0; a < 2; ++a)
#pragma unroll
        for (int b = 0; b < 2; ++b)
#pragma unroll
            for (int m = 0; m < 4; ++m)
#pragma unroll
                for (int n = 0; n < 2; ++n) acc[a][b][m][n] = (f32x4){0.f, 0.f, 0.f, 0.f};
    bf16x8 At[4][2], B0[2][2], B1[2][2];
    v8i32 At8[4], B08[2], B18[2];
    const char* cA = (const char*)g.A + (size_t)cur.pm * tstep; const char* cB = (const char*)g.Bt + (size_t)cur.pn * tstep;
    S.a_ready(cur);
    if constexpr (SP2) {
        PG8_STAGE(PG8_SB(0, 0), cB, voffB); PG8_STAGE(PG8_SB(0, 1), cB + hstep, voffB); PG8_STAGE(PG8_SA(0, 0), cA, voffA); PG8_STAGE(PG8_SA(0, 1), cA + hstep, voffA);
        if (wr == 1) PG8_BAR;
        PG8_WAIT_V(2); PG8_BAR;
        PG8_STAGE(PG8_SB(1, 0), cB + kstep, voffB); PG8_STAGE(PG8_SA(1, 0), cA + kstep, voffA); PG8_STAGE(PG8_SB(1, 1), cB + hstep + kstep, voffB);
        PG8_WAIT_V(6); PG8_BAR;
    } else {
        PG8_STAGE(PG8_SB(0, 0), cB, voffB); PG8_STAGE(PG8_SA(0, 0), cA, voffA); PG8_STAGE(PG8_SB(0, 1), cB + hstep, voffB); PG8_STAGE(PG8_SA(0, 1), cA + hstep, voffA);
        if (wr == 1) PG8_BAR;
        PG8_WAIT_V(4); PG8_BAR;
        PG8_STAGE(PG8_SB(1, 0), cB + kstep, voffB); PG8_STAGE(PG8_SA(1, 0), cA + kstep, voffA); PG8_STAGE(PG8_SB(1, 1), cB + hstep + kstep, voffB);
        PG8_WAIT_V(6); PG8_BAR;
    }
    for (;;) {
        const bool has_next = S.next(ui + 1, nxt);
        const char* nA = has_next ? (const char*)g.A + (size_t)nxt.pm * tstep : cA; const char* nB = has_next ? (const char*)g.Bt + (size_t)nxt.pn * tstep : cB;
        for (int t = 0; t < nt; t += 2) {
            const bool last = (t == nt - 2);
            const char* a1 = cA + (size_t)(t + 1) * kstep;
            const char* a2 = last ? nA : cA + (size_t)(t + 2) * kstep; const char* b2 = last ? nB : cB + (size_t)(t + 2) * kstep;
            const char* a3 = a2 + kstep; const char* b3 = b2 + kstep;
            if (last && has_next) S.a_ready(nxt);
            if constexpr (SP2) {
            PG8_LDB(B0, 0, 0); PG8_LDB(B1, 0, 1); PG8_SCHED; PG8_LDA(At, 0, 0); PG8_STAGE(PG8_SA(1, 1), a1 + hstep, voffA);
            PG8_WAIT_V(8); PG8_WAIT_L(0); PG8_BAR; PG8_MMA(0, 0, At, B0); PG8_MMA(0, 1, At, B1); PG8_BAR; PG8_SCHED;
            PG8_LDA(At, 0, 1); PG8_STAGE(PG8_SB(0, 0), b2, voffB); PG8_STAGE(PG8_SB(0, 1), b2 + hstep, voffB); PG8_STAGE(PG8_SA(0, 0), a2, voffA);
            PG8_WAIT_V(8); PG8_WAIT_L(0); PG8_BAR; PG8_MMA(1, 0, At, B0); PG8_MMA(1, 1, At, B1); PG8_BAR; PG8_SCHED;
            PG8_LDB(B0, 1, 0); PG8_LDB(B1, 1, 1); PG8_SCHED; PG8_LDA(At, 1, 0); PG8_STAGE(PG8_SA(0, 1), a2 + hstep, voffA);
            PG8_WAIT_V(8); PG8_WAIT_L(0); PG8_BAR; PG8_MMA(0, 0, At, B0); PG8_MMA(0, 1, At, B1); PG8_BAR; PG8_SCHED;
            PG8_LDA(At, 1, 1); PG8_STAGE(PG8_SB(1, 0), b3, voffB); PG8_STAGE(PG8_SB(1, 1), b3 + hstep, voffB); PG8_STAGE(PG8_SA(1, 0), a3, voffA);
            PG8_WAIT_V(8); PG8_WAIT_L(0); PG8_BAR; PG8_MMA(1, 0, At, B0); PG8_MMA(1, 1, At, B1); PG8_BAR; PG8_SCHED;
            } else {
            PG8_LDB(B0, 0, 0); PG8_SCHED; PG8_LDA(At, 0, 0); PG8_STAGE(PG8_SA(1, 1), a1 + hstep, voffA);
            PG8_WAIT_L(8); PG8_BAR; PG8_WAIT_L(0); PG8_MMA(0, 0, At, B0); PG8_BAR; PG8_SCHED;
            PG8_LDB(B1, 0, 1); PG8_STAGE(PG8_SB(0, 0), b2, voffB);
            PG8_BAR; PG8_WAIT_L(0); PG8_MMA(0, 1, At, B1); PG8_BAR;
            PG8_LDA(At, 0, 1); PG8_STAGE(PG8_SA(0, 0), a2, voffA);
            PG8_BAR; PG8_WAIT_L(0); PG8_MMA(1, 0, At, B0); PG8_BAR; PG8_SCHED;
            PG8_STAGE(PG8_SB(0, 1), b2 + hstep, voffB);
            PG8_WAIT_V(6); PG8_BAR; PG8_MMA(1, 1, At, B1); PG8_BAR;
            PG8_LDB(B0, 1, 0); PG8_SCHED; PG8_LDA(At, 1, 0); PG8_STAGE(PG8_SA(0, 1), a2 + hstep, voffA);
            PG8_WAIT_L(8); PG8_BAR; PG8_WAIT_L(0); PG8_MMA(0, 0, At, B0); PG8_BAR; PG8_SCHED;
            PG8_LDB(B1, 1, 1); PG8_STAGE(PG8_SB(1, 0), b3, voffB);
            PG8_BAR; PG8_WAIT_L(0); PG8_MMA(0, 1, At, B1); PG8_BAR;
            PG8_LDA(At, 1, 1); PG8_STAGE(PG8_SA(1, 0), a3, voffA);
            PG8_BAR; PG8_WAIT_L(0); PG8_MMA(1, 0, At, B0); PG8_BAR; PG8_SCHED;
            PG8_STAGE(PG8_SB(1, 1), b3 + hstep, voffB);
            PG8_WAIT_V(6); PG8_BAR; PG8_MMA(1, 1, At, B1); PG8_BAR;
            }
        }
        if constexpr (FP8) asm volatile("s_nop 15\n\ts_nop 15" ::: "memory");
        if constexpr (ALIGN_EPI) { if (wr == 0) PG8_BAR; }
        if constexpr (!Epi::AFTER_DRAIN) { E(acc, cur, wr, wc, fr, fq); S.done(cur); }
        if (!has_next) break;
#pragma unroll
        for (int a = 0; a < 2; ++a)
#pragma unroll
            for (int b = 0; b < 2; ++b)
#pragma unroll
                for (int m = 0; m < 4; ++m)
#pragma unroll
                    for (int n = 0; n < 2; ++n) acc[a][b][m][n] = (f32x4){0.f, 0.f, 0.f, 0.f};
        cur = nxt; cA = nA; cB = nB; ++ui;
        if constexpr (ALIGN_EPI) { if (wr == 1) PG8_BAR; }
    }
    PG8_WAIT_V(0);
    if constexpr (!ALIGN_EPI) { if (wr == 0) PG8_BAR; }
    PG8_BAR;
    if constexpr (Epi::AFTER_DRAIN) { E.fused(acc, cur, wr, wc, fr, fq, lds, wid, lane); S.done(cur); }
#undef PG8_SA
#undef PG8_SB
#undef PG8_STAGE
#undef PG8_LDA
#undef PG8_LDB
#undef PG8_MMA
#undef PG8_LD32
#undef PG8_WAIT_V
#undef PG8_WAIT_L
#undef PG8_BAR
#undef PG8_SCHED
}
}
#define GAS __attribute__((address_space(1)))
#define LAS __attribute__((address_space(3)))
typedef unsigned short bf16;
typedef unsigned v4u __attribute__((ext_vector_type(4)));
typedef unsigned v2u __attribute__((ext_vector_type(2)));
typedef float f32x4 __attribute__((ext_vector_type(4)));
typedef float f32x16 __attribute__((ext_vector_type(16)));
typedef short bf16x8 __attribute__((ext_vector_type(8)));
typedef short s16x4 __attribute__((ext_vector_type(4)));
using pg8::Unit; using pg8::cvt_pk_bf16; using pg8::BM; using pg8::HALF;

constexpr int SEQ = 16384, DM = 2048, PW = 6144, FF = 8192, M = SEQ;
constexpr int NWAVES = 8, NTHR = 512;
constexpr float EPS = 1e-6f;
constexpr float C2 = 0.125f * 1.4426950408889634f;
constexpr float SBSCALE = 0.08838834764831845f * 1.4426950408889634f;
constexpr float LAM_INIT = 0.2f;
constexpr float W2_SCALE = 512.f;
constexpr int COL_DQ = 0, COL_DK = 1024, COL_DV = 2048, COL_SQ = 3072, COL_SK = 4096, COL_SV = 5120;

constexpr size_t MiB = 1u << 20;
constexpr size_t WS_WIN = 0;
constexpr size_t WS_WOUT = 24 * MiB;
constexpr size_t WS_W1 = 32 * MiB;
constexpr size_t WS_W2 = 64 * MiB;
constexpr size_t WS_CS = 96 * MiB;
constexpr size_t WS_SS1 = 97 * MiB;
constexpr size_t WS_SS2 = 97 * MiB + 65536;
constexpr size_t WS_H = 98 * MiB;
constexpr size_t WS_QKV = 162 * MiB;
constexpr size_t WS_MIX = 354 * MiB;
constexpr size_t WS_U = 162 * MiB;
constexpr size_t WS_CTL = 418 * MiB;
constexpr size_t WS_END = 419 * MiB;

constexpr int RING_BYTES = 131072, LDS_BYTES = 131072 + 1024;

__device__ __forceinline__ unsigned f2bf(float f) { unsigned u = __builtin_bit_cast(unsigned, f); return (u + 0x7fffu + ((u >> 16) & 1u)) >> 16; }
__device__ __forceinline__ unsigned pk2(float lo, float hi) { return f2bf(lo) | (f2bf(hi) << 16); }
__device__ __forceinline__ float wave_sum(float v) {
#pragma unroll
    for (int o = 1; o < 64; o <<= 1) v += __shfl_xor(v, o);
    return v;
}
typedef unsigned u32x2_t __attribute__((ext_vector_type(2)));
__device__ __forceinline__ void swap_x32(float& a, float& b) { asm volatile("s_nop 1\n\tv_permlane32_swap_b32 %0, %1" : "+v"(a), "+v"(b)); }
__device__ __forceinline__ float max_x32(float x) { float a = x, b = x; swap_x32(a, b); return fmaxf(a, b); }
__device__ __forceinline__ float sum_x32(float x) { float a = x, b = x; swap_x32(a, b); return a + b; }
__device__ __forceinline__ float partner_x32(float x, int hi) { float a = x, b = x; swap_x32(a, b); return hi ? a : b; }
#define LDS_WAIT() asm volatile("s_waitcnt lgkmcnt(0)" ::: "memory")
__device__ __forceinline__ int opaque(int v) { asm volatile("" : "+v"(v)); return v; }

struct EpiQKV {
    static constexpr bool PERM = true, AFTER_DRAIN = false;
    bf16* O; const float* cs;
    __device__ __forceinline__ void operator()(const f32x4 (&acc)[2][2][4][2], const Unit& u, int wr, int wc, int fr, int fq) const {
        const int row0 = u.pm * BM + wr * 64 + fr, col0 = u.pn * BM + wc * 32 + 8 * fq;
        float sc = 1.f; if (u.pn < 4) sc = C2; else if (u.pn >= 12 && u.pn < 16) sc = SBSCALE;
        const bool rot = (u.pn < 8) && ((wc & 1) == 0);
        if (rot) {
#pragma unroll
            for (int ai = 0; ai < 2; ++ai) {
                f32x4 cv[4][4];
#pragma unroll
                for (int m = 0; m < 4; ++m) { const f32x4* p = (const f32x4*)(cs + (size_t)(row0 + ai * HALF + m * 16) * 16); cv[m][0] = p[0]; cv[m][1] = p[1]; cv[m][2] = p[2]; cv[m][3] = p[3]; }
#pragma unroll
                for (int m = 0; m < 4; ++m) {
                    const int row = row0 + ai * HALF + m * 16;
                    const f32x4 c0 = cv[m][0], c1 = cv[m][1]; f32x4 s0 = cv[m][2], s1 = cv[m][3]; if (fq == 0) { s0 = -s0; s1 = -s1; }
#pragma unroll
                    for (int bj = 0; bj < 2; ++bj) {
                        f32x4 v0 = acc[ai][bj][m][0] * sc, v1 = acc[ai][bj][m][1] * sc, p0, p1;
#pragma unroll
                        for (int e = 0; e < 4; ++e) { p0[e] = __shfl_xor(v0[e], 16); p1[e] = __shfl_xor(v1[e], 16); }
                        if (fq < 2) { v0 = v0 * c0 + p0 * s0; v1 = v1 * c1 + p1 * s1; }
                        v4u w; w.x = cvt_pk_bf16(v0[0], v0[1]); w.y = cvt_pk_bf16(v0[2], v0[3]); w.z = cvt_pk_bf16(v1[0], v1[1]); w.w = cvt_pk_bf16(v1[2], v1[3]);
                        *(v4u*)(O + (size_t)row * PW + col0 + bj * HALF) = w;
                    }
                }
            }
        } else {
#pragma unroll
            for (int ai = 0; ai < 2; ++ai)
#pragma unroll
                for (int m = 0; m < 4; ++m) {
                    const int row = row0 + ai * HALF + m * 16;
#pragma unroll
                    for (int bj = 0; bj < 2; ++bj) {
                        const f32x4 v0 = acc[ai][bj][m][0] * sc, v1 = acc[ai][bj][m][1] * sc;
                        v4u w; w.x = cvt_pk_bf16(v0[0], v0[1]); w.y = cvt_pk_bf16(v0[2], v0[3]); w.z = cvt_pk_bf16(v1[0], v1[1]); w.w = cvt_pk_bf16(v1[2], v1[3]);
                        *(v4u*)(O + (size_t)row * PW + col0 + bj * HALF) = w;
                    }
                }
        }
    }
};
template <bool RES_BF16>
struct EpiRes {
    static constexpr bool PERM = true, AFTER_DRAIN = false;
    const float* R; const bf16* Rb; float* Y; bf16* Yb; float* ss; float ascale;
    __device__ __forceinline__ void operator()(const f32x4 (&acc)[2][2][4][2], const Unit& u, int wr, int wc, int fr, int fq) const {
        const int row0 = u.pm * BM + wr * 64 + fr, col0 = u.pn * BM + wc * 32 + 8 * fq;
#pragma unroll
        for (int ai = 0; ai < 2; ++ai) {
            f32x4 rv[4][2][2];
#pragma unroll
            for (int m = 0; m < 4; ++m)
#pragma unroll
                for (int bj = 0; bj < 2; ++bj) {
                    const size_t off = (size_t)(row0 + ai * HALF + m * 16) * DM + col0 + bj * HALF;
                    if (RES_BF16) {
                        const v4u t = *(const v4u*)(Rb + off);
                        rv[m][bj][0] = (f32x4){__builtin_bit_cast(float, t.x << 16), __builtin_bit_cast(float, t.x & 0xffff0000u), __builtin_bit_cast(float, t.y << 16), __builtin_bit_cast(float, t.y & 0xffff0000u)};
                        rv[m][bj][1] = (f32x4){__builtin_bit_cast(float, t.z << 16), __builtin_bit_cast(float, t.z & 0xffff0000u), __builtin_bit_cast(float, t.w << 16), __builtin_bit_cast(float, t.w & 0xffff0000u)};
                    } else { rv[m][bj][0] = *(const f32x4*)(R + off); rv[m][bj][1] = *(const f32x4*)(R + off + 4); }
                }
            asm volatile("" ::: "memory");
#pragma unroll
            for (int m = 0; m < 4; ++m) {
                const int row = row0 + ai * HALF + m * 16; float s = 0.f;
#pragma unroll
                for (int bj = 0; bj < 2; ++bj) {
                    const size_t off = (size_t)row * DM + col0 + bj * HALF;
                    const f32x4 v0 = acc[ai][bj][m][0] * ascale + rv[m][bj][0], v1 = acc[ai][bj][m][1] * ascale + rv[m][bj][1];
                    { v4u w; w.x = cvt_pk_bf16(v0[0], v0[1]); w.y = cvt_pk_bf16(v0[2], v0[3]); w.z = cvt_pk_bf16(v1[0], v1[1]); w.w = cvt_pk_bf16(v1[2], v1[3]); *(v4u*)(Yb + off) = w; }
                    s += (v0[0] * v0[0] + v0[1] * v0[1]) + (v0[2] * v0[2] + v0[3] * v0[3]) + (v1[0] * v1[0] + v1[1] * v1[1]) + (v1[2] * v1[2] + v1[3] * v1[3]);
                }
                s += __shfl_xor(s, 16); s += __shfl_xor(s, 32);
                if (fq == 0) atomicAdd(ss + row, s);
            }
        }
    }
};
struct EpiMlpIn {
    static constexpr bool PERM = true, AFTER_DRAIN = false;
    unsigned char* O; const float* ss;
    __device__ __forceinline__ void operator()(const f32x4 (&acc)[2][2][4][2], const Unit& u, int wr, int wc, int fr, int fq) const {
        const int row0 = u.pm * BM + wr * 64 + fr, col0 = u.pn * BM + wc * 32 + 8 * fq;
        float rs[2][4];
#pragma unroll
        for (int ai = 0; ai < 2; ++ai)
#pragma unroll
            for (int m = 0; m < 4; ++m) rs[ai][m] = __hip_atomic_load(ss + row0 + ai * HALF + m * 16, __ATOMIC_RELAXED, __HIP_MEMORY_SCOPE_AGENT);
        asm volatile("" ::: "memory");
#pragma unroll
        for (int ai = 0; ai < 2; ++ai)
#pragma unroll
            for (int m = 0; m < 4; ++m) {
                const int row = row0 + ai * HALF + m * 16;
                const float rstd = __builtin_amdgcn_rsqf(rs[ai][m] * (1.f / DM) + EPS);
#pragma unroll
                for (int bj = 0; bj < 2; ++bj) {
                    f32x4 v0 = acc[ai][bj][m][0] * rstd, v1 = acc[ai][bj][m][1] * rstd;
#pragma unroll
                    for (int e = 0; e < 4; ++e) { const float a = fmaxf(v0[e], 0.f), b = fmaxf(v1[e], 0.f); v0[e] = fminf(a * a, 448.f); v1[e] = fminf(b * b, 448.f); }
                    int w0 = __builtin_amdgcn_cvt_pk_fp8_f32(v0[0], v0[1], 0, false); w0 = __builtin_amdgcn_cvt_pk_fp8_f32(v0[2], v0[3], w0, true);
                    int w1 = __builtin_amdgcn_cvt_pk_fp8_f32(v1[0], v1[1], 0, false); w1 = __builtin_amdgcn_cvt_pk_fp8_f32(v1[2], v1[3], w1, true);
                    *(v2u*)(O + (size_t)row * FF + col0 + bj * HALF) = (v2u){(unsigned)w0, (unsigned)w1};
                }
            }
    }
};
#define MFMA32(a, b, c) __builtin_amdgcn_mfma_f32_32x32x16_bf16((a), (b), (c), 0, 0, 0)
__device__ __forceinline__ int crow(int r, int hi) { return (r & 3) + 8 * (r >> 2) + 4 * hi; }
typedef short v4i16_t __attribute__((ext_vector_type(4)));
__device__ __forceinline__ s16x4 vtr(LAS const unsigned char* p) { return __builtin_bit_cast(s16x4, __builtin_amdgcn_ds_read_tr16_b64_v4i16((LAS v4i16_t*)p)); }
typedef float f32x2_t __attribute__((ext_vector_type(2)));
typedef __bf16 bf16x2_t __attribute__((ext_vector_type(2)));
__device__ __forceinline__ unsigned cvtpk_s(float lo, float hi) { f32x2_t v = {lo, hi}; bf16x2_t b = __builtin_convertvector(v, bf16x2_t); return __builtin_bit_cast(unsigned, b); }
__device__ __forceinline__ bf16x8 pack8(const f32x16& x, int s) {
    v4u p; p.x = cvtpk_s(x[8 * s], x[8 * s + 1]); p.y = cvtpk_s(x[8 * s + 2], x[8 * s + 3]); p.z = cvtpk_s(x[8 * s + 4], x[8 * s + 5]); p.w = cvtpk_s(x[8 * s + 6], x[8 * s + 7]);
    return __builtin_bit_cast(bf16x8, p);
}

__device__ __forceinline__ void glds16(const void* sbase, unsigned voff, unsigned lds_dst) { unsigned keep;
    asm volatile("s_mov_b32 %0, m0\n\ts_mov_b32 m0, %3\n\ts_nop 0\n\tglobal_load_lds_dwordx4 %1, %2\n\ts_mov_b32 m0, %0" : "=&s"(keep) : "v"(voff), "s"(sbase), "s"(lds_dst) : "memory"); }
template <bool TAIL>
__device__ __forceinline__ void flash_half(f32x16 (&O)[4], f32x16& Sc, f32x16& Sn, float& m_run, float& l_run, bf16x8& mfrag, const bf16x8& onefrag, const bf16x8 (&qf)[4],
                                           LAS const unsigned char* Kn, LAS const unsigned char* Vc, unsigned ka, int kx, unsigned va, int vx, int blk, int hi, int key0, int qrow, int qmin) {
    if (TAIL) {
        const int kb = key0 + 4 * hi;
#pragma unroll
        for (int i = 0; i < 16; ++i) { const int key = kb + (i & 3) + 8 * (i >> 2); if (key > qrow) Sc[i] = -1e30f; }
    }
    float mloc = fmaxf(Sc[0], Sc[1]);
#pragma unroll
    for (int i = 2; i < 16; ++i) mloc = fmaxf(mloc, Sc[i]);
    mloc = max_x32(mloc);
    const bool first = (key0 == 0);
    if (__any(mloc > 8.f) || first) {
        const float m_new = (mloc > 8.f || first) ? __builtin_bit_cast(float, f2bf(m_run + mloc) << 16) : m_run;
        const float delta = m_new - m_run, alpha = __builtin_amdgcn_exp2f(-delta);
        l_run *= alpha;
#pragma unroll
        for (int d = 0; d < 4; ++d)
#pragma unroll
            for (int i = 0; i < 16; ++i) O[d][i] *= alpha;
#pragma unroll
        for (int i = 0; i < 16; ++i) Sc[i] -= delta;
        m_run = m_new;
        mfrag[0] = hi ? (short)0 : (short)(f2bf(-m_new));
    }
#pragma unroll
    for (int i = 0; i < 16; ++i) Sn[i] = 0.f;
    Sn = MFMA32(onefrag, mfrag, Sn);
#pragma unroll
    for (int ks = 0; ks < 4; ++ks) {
        const bf16x8 a0 = *(LAS const bf16x8*)(Kn + ka + (((2 * ks + hi) ^ kx) << 4));
        Sn = MFMA32(a0, qf[ks], Sn);
    }
    float ls = 0.f;
#pragma unroll
    for (int i = 0; i < 16; ++i) { Sc[i] = __builtin_amdgcn_exp2f(Sc[i]); ls += Sc[i]; }
    l_run += ls;
#pragma unroll
    for (int kk = 0; kk < 2; ++kk) {
        if (kk == 1) __builtin_amdgcn_sched_barrier(0);
        const bf16x8 pb = pack8(Sc, kk);
#pragma unroll
        for (int d = 0; d < 4; ++d) {
            LAS const unsigned char* p = Vc + va + kk * 4096 + (((2 * d + blk) ^ vx) << 5);
            const s16x4 lo = vtr(p), hi4 = vtr(p + 2048);
            const bf16x8 a = __builtin_shufflevector(lo, hi4, 0, 1, 2, 3, 4, 5, 6, 7);
            O[d] = MFMA32(a, pb, O[d]);
        }
    }
}

constexpr int DA_V = 49152, KT = 128;
__device__ __forceinline__ void flash_map(f32x16 (&O)[4], LAS unsigned char* lds, const bf16* QKV, int qcol, int kcol, int vcol, int qb, int w, int lane, int tid) {
    const int r32 = lane & 31, hi = lane >> 5;
    const int qmin = qb * 256 + w * 32, qrow = qmin + r32;
    bf16x8 qf[4];
    { const int lq = opaque(lane);
      const bf16* qp = QKV + (size_t)(qmin + (lq & 31)) * PW + qcol + 8 * (lq >> 5);
#pragma unroll
      for (int ks = 0; ks < 4; ++ks) qf[ks] = *(const bf16x8*)(qp + 16 * ks); }
#pragma unroll
    for (int d = 0; d < 4; ++d)
#pragma unroll
        for (int i = 0; i < 16; ++i) O[d][i] = 0.f;
    float m_run = 0.f, l_run = 0.f;
    bf16x8 mfrag = {0, 0, 0, 0, 0, 0, 0, 0}, onefrag = {0, 0, 0, 0, 0, 0, 0, 0}; onefrag[0] = hi ? (short)0 : (short)0x3F80;
    const int nkt = 2 * (qb + 1), nmain = 2 * qb;
    const int krow = tid >> 3, kc = (tid & 7) ^ ((krow >> 1) & 7);
    const unsigned kgo = (unsigned)(krow * PW + kc * 8) * 2u;
    const int vrow = tid >> 4, vpos = tid & 15, vc = ((((vpos >> 1) ^ (2 * (vrow & 3)))) << 1) | (vpos & 1);
    const unsigned vgo = (unsigned)(vrow * PW + vc * 8) * 2u;
    const bf16* kg = QKV + kcol; const bf16* vg = QKV + vcol;
    const unsigned wl = (unsigned)(tid >> 6) * 1024u;
    const size_t tstep = (size_t)KT * PW;
#define DMA16(g, vo, l) glds16((g), (vo), (unsigned)__builtin_amdgcn_readfirstlane((int)(unsigned)(size_t)(l)))
#define DMA_K(t, slot) do { const bf16* g_ = kg + (size_t)(t) * tstep; DMA16(g_, kgo, lds + (slot) + wl); DMA16(g_ + (size_t)64 * PW, kgo, lds + (slot) + 8192 + wl); } while (0)
#define DMA_VH(t, b, h) do { const bf16* g_ = vg + (size_t)(t) * tstep + (size_t)(64 * (h)) * PW; LAS unsigned char* l_ = lds + DA_V + (b) * 32768 + 16384 * (h) + wl; \
        DMA16(g_, vgo, l_); DMA16(g_ + (size_t)32 * PW, vgo, l_ + 8192); } while (0)
#define DMA_V(t, b) do { DMA_VH(t, b, 0); DMA_VH(t, b, 1); } while (0)
    const unsigned ka = r32 * 128;
    const int kx = (r32 >> 1) & 7;
    const int q4 = (lane & 15) >> 2, p4 = lane & 3, blk = (lane >> 4) & 1;
    const int vr0 = 4 * hi + q4;
    const unsigned va = DA_V + vr0 * 256 + 8 * p4;
    const int vx = 2 * q4;
    DMA_K(0, 0); DMA_K(1, 16384); DMA_V(0, 0);
    asm volatile("s_waitcnt vmcnt(0) lgkmcnt(0)\n\ts_barrier" ::: "memory");
    f32x16 S0, S1;
#pragma unroll
    for (int i = 0; i < 16; ++i) S0[i] = 0.f;
#pragma unroll
    for (int ks = 0; ks < 4; ++ks) S0 = MFMA32(*(LAS const bf16x8*)(lds + ka + (((2 * ks + hi) ^ kx) << 4)), qf[ks], S0);
    int kb0 = 0, kb1 = 16384, kb2 = 32768;
    for (int kt = 0; kt < nkt; ++kt) {
        const int buf = kt & 1;
        const bool more = kt + 1 < nkt;
        if (kt + 2 < nkt) DMA_K(kt + 2, kb2);
        LAS const unsigned char* Kc = lds + kb0; LAS const unsigned char* Vb = lds + buf * 32768;
        if (kt < nmain) {
            flash_half<false>(O, S0, S1, m_run, l_run, mfrag, onefrag, qf, Kc + 4096, Vb, ka, kx, va, vx, blk, hi, kt * KT, qrow, qmin);
            if (more) DMA_VH(kt + 1, buf ^ 1, 0);
            flash_half<false>(O, S1, S0, m_run, l_run, mfrag, onefrag, qf, Kc + 8192, Vb + 8192, ka, kx, va, vx, blk, hi, kt * KT + 32, qrow, qmin);
            if (more) DMA_VH(kt + 1, buf ^ 1, 1);
            flash_half<false>(O, S0, S1, m_run, l_run, mfrag, onefrag, qf, Kc + 12288, Vb + 16384, ka, kx, va, vx, blk, hi, kt * KT + 64, qrow, qmin);
            flash_half<false>(O, S1, S0, m_run, l_run, mfrag, onefrag, qf, lds + kb1, Vb + 24576, ka, kx, va, vx, blk, hi, kt * KT + 96, qrow, qmin);
        } else {
            if (more) DMA_V(kt + 1, buf ^ 1);
            flash_half<true>(O, S0, S1, m_run, l_run, mfrag, onefrag, qf, Kc + 4096, Vb, ka, kx, va, vx, blk, hi, kt * KT, qrow, qmin);
            flash_half<true>(O, S1, S0, m_run, l_run, mfrag, onefrag, qf, Kc + 8192, Vb + 8192, ka, kx, va, vx, blk, hi, kt * KT + 32, qrow, qmin);
            flash_half<true>(O, S0, S1, m_run, l_run, mfrag, onefrag, qf, Kc + 12288, Vb + 16384, ka, kx, va, vx, blk, hi, kt * KT + 64, qrow, qmin);
            flash_half<true>(O, S1, S0, m_run, l_run, mfrag, onefrag, qf, lds + kb1, Vb + 24576, ka, kx, va, vx, blk, hi, kt * KT + 96, qrow, qmin);
        }
        asm volatile("s_waitcnt vmcnt(0) lgkmcnt(0)\n\ts_barrier" ::: "memory");
        const int t0 = kb0; kb0 = kb1; kb1 = kb2; kb2 = t0;
    }
#undef DMA16
#undef DMA_K
#undef DMA_V
#undef DMA_VH
    const float l = sum_x32(l_run), inv = 1.f / l;
#pragma unroll
    for (int d = 0; d < 4; ++d)
#pragma unroll
        for (int i = 0; i < 16; ++i) O[d][i] *= inv;
}

__device__ __forceinline__ void headnorm_store(const f32x16 (&O)[4], const float* g, float post, bf16* MIX, int qrow, int col0, int hi) {
    float ss = 0.f;
#pragma unroll
    for (int d = 0; d < 4; ++d)
#pragma unroll
        for (int i = 0; i < 16; ++i) ss += O[d][i] * O[d][i];
    ss = sum_x32(ss);
    const float rs = __builtin_amdgcn_rsqf(ss * (1.f / 128.f) + EPS) * post;
    f32x4 gvv[4][4];
#pragma unroll
    for (int d = 0; d < 4; ++d)
#pragma unroll
        for (int gq = 0; gq < 4; ++gq) gvv[d][gq] = *(const f32x4*)(g + 32 * d + 8 * gq + 4 * hi);
    asm volatile("" ::: "memory");
#pragma unroll
    for (int d = 0; d < 4; ++d)
#pragma unroll
        for (int gq = 0; gq < 4; ++gq) {
            const int dv = 32 * d + 8 * gq + 4 * hi;
            const f32x4 gv = gvv[d][gq];
            v2u w; w.x = cvtpk_s(O[d][4 * gq] * rs * gv[0], O[d][4 * gq + 1] * rs * gv[1]); w.y = cvtpk_s(O[d][4 * gq + 2] * rs * gv[2], O[d][4 * gq + 3] * rs * gv[3]);
            *(v2u*)(MIX + (size_t)qrow * DM + col0 + dv) = w;
        }
}

__device__ __forceinline__ void diff_unit(LAS unsigned char* lds, const bf16* QKV, bf16* MIX, float* o1s, const float* gd, float lam, int head, int qb, int w, int lane, int tid) {
    f32x16 O[4];
#pragma unroll 1
    for (int j = 0; j < 2; ++j) {
        flash_map(O, lds, QKV, COL_DQ + head * 128 + 64 * j, COL_DK + head * 128 + 64 * j, COL_DV + head * 128, qb, w, lane, tid);
        if (j == 0) {
            f32x4* sc = (f32x4*)(o1s + ((size_t)(blockIdx.x * NWAVES + w) * 64 + opaque(lane)) * 64);
#pragma unroll
            for (int d = 0; d < 4; ++d)
#pragma unroll
                for (int i = 0; i < 4; ++i) sc[d * 4 + i] = (f32x4){O[d][4 * i], O[d][4 * i + 1], O[d][4 * i + 2], O[d][4 * i + 3]};
        }
    }
    lane = opaque(lane);
    const f32x4* sc = (const f32x4*)(o1s + ((size_t)(blockIdx.x * NWAVES + w) * 64 + lane) * 64);
#pragma unroll
    for (int d = 0; d < 4; ++d)
#pragma unroll
        for (int i = 0; i < 4; ++i) { const f32x4 t = sc[d * 4 + i];
#pragma unroll
            for (int e = 0; e < 4; ++e) O[d][4 * i + e] = t[e] - lam * O[d][4 * i + e]; }
    headnorm_store(O, gd, 1.f - LAM_INIT, MIX, qb * 256 + w * 32 + (lane & 31), head * 128, lane >> 5);
}

constexpr float SB_STOP = -44.f * 1.4426950408889634f;
__device__ __forceinline__ void sb_unit(LAS unsigned char* vl, const bf16* QKV, bf16* MIX, const float* gs, int head, int qg, int lane) {
    const int r32 = lane & 31, hi = lane >> 5;
    const int qrow = qg * 32 + r32;
    bf16x8 qf[8];
#pragma unroll
    for (int ks = 0; ks < 8; ++ks) qf[ks] = *(const bf16x8*)(QKV + (size_t)qrow * PW + COL_SQ + head * 128 + 16 * ks + 8 * hi);
    f32x16 O[4];
#pragma unroll
    for (int d = 0; d < 4; ++d)
#pragma unroll
        for (int i = 0; i < 16; ++i) O[d][i] = 0.f;
    float R = 0.f;
    const int q4 = (lane & 15) >> 2, p4 = lane & 3, blk = (lane >> 4) & 1;
    const int vr0 = 4 * hi + q4, vx = vr0 & 7;
    const unsigned va = vr0 * 256 + 8 * p4;
    const bf16* kgp = QKV + (size_t)r32 * PW + COL_SK + head * 128 + 8 * hi;
    const bf16* vgp = QKV + (size_t)(lane >> 4) * PW + COL_SV + head * 128 + (lane & 15) * 8;
    bf16x8 kf[8]; v4u vreg[8];
#pragma unroll
    for (int ks = 0; ks < 8; ++ks) kf[ks] = *(const bf16x8*)(kgp + (size_t)(qg * 32) * PW + 16 * ks);
#pragma unroll
    for (int i = 0; i < 8; ++i) vreg[i] = *(const v4u*)(vgp + (size_t)(qg * 32 + 4 * i) * PW);
    for (int kt = qg; kt >= 0; --kt) {
        const int k0 = kt * 32;
        f32x16 S;
#pragma unroll
        for (int i = 0; i < 16; ++i) S[i] = 0.f;
#pragma unroll
        for (int ks = 0; ks < 8; ++ks) S = MFMA32(kf[ks], qf[ks], S);
        LDS_WAIT();
#pragma unroll
        for (int i = 0; i < 8; ++i) { const int row = 4 * i + (lane >> 4), c = lane & 15; *(LAS v4u*)(vl + row * 256 + (((c >> 1) ^ (row & 7)) << 5) + ((c & 1) << 4)) = vreg[i]; }
        if (kt > 0) {
#pragma unroll
            for (int ks = 0; ks < 8; ++ks) kf[ks] = *(const bf16x8*)(kgp + (size_t)(k0 - 32) * PW + 16 * ks);
#pragma unroll
            for (int i = 0; i < 8; ++i) vreg[i] = *(const v4u*)(vgp + (size_t)(k0 - 32 + 4 * i) * PW);
        }
        float lb[16], lom[16];
#pragma unroll
        for (int i = 0; i < 16; ++i) {
            const int key = k0 + crow(i, hi); const float z = S[i];
            const float sp = __builtin_amdgcn_logf(1.f + __builtin_amdgcn_exp2f(-fabsf(z)));
            lb[i] = fminf(z, 0.f) - sp;
            lom[i] = (key < qrow) ? lb[i] - z : 0.f;
        }
        float gsum[4], pgs[4], after[4];
#pragma unroll
        for (int g = 0; g < 4; ++g) { gsum[g] = (lom[4 * g] + lom[4 * g + 1]) + (lom[4 * g + 2] + lom[4 * g + 3]); pgs[g] = partner_x32(gsum[g], hi); }
        float run = 0.f;
#pragma unroll
        for (int g = 3; g >= 0; --g) { after[g] = run + (hi == 0 ? pgs[g] : 0.f); run += gsum[g] + pgs[g]; }
#pragma unroll
        for (int g = 0; g < 4; ++g) {
            float suf = R + after[g];
#pragma unroll
            for (int e = 3; e >= 0; --e) {
                const int i = 4 * g + e; const int key = k0 + crow(i, hi);
                S[i] = (key < qrow) ? __builtin_amdgcn_exp2f(lb[i] + suf) : 0.f;
                suf += lom[i];
            }
        }
        R += run;
        LDS_WAIT();
#pragma unroll
        for (int kk = 0; kk < 2; ++kk) {
            const bf16x8 pb = pack8(S, kk);
#pragma unroll
            for (int d = 0; d < 4; ++d) {
                LAS const unsigned char* p = vl + va + kk * 4096 + (((2 * d + blk) ^ vx) << 5);
                const s16x4 lo = vtr(p), hi4 = vtr(p + 2048);
                const bf16x8 a = __builtin_shufflevector(lo, hi4, 0, 1, 2, 3, 4, 5, 6, 7);
                O[d] = MFMA32(a, pb, O[d]);
            }
        }
        if (__all(R < SB_STOP)) break;
    }
    LDS_WAIT();
    headnorm_store(O, gs, 1.f, MIX, qrow, 1024 + head * 128, hi);
}
__device__ __forceinline__ void transpose_item(const float* W, int K, int N, bf16* WT, const float* g, LAS float* scr, int item, int lane) {
    const int nblk = N / 32, kb = item / nblk, nb = item % nblk, k0 = 64 * kb, n0 = 32 * nb;
    const int r8 = lane >> 3, c4 = (lane & 7) * 4;
    f32x4 v[8];
#pragma unroll
    for (int i = 0; i < 8; ++i) v[i] = __builtin_nontemporal_load((const f32x4*)(W + (size_t)(k0 + r8 + 8 * i) * N + n0 + c4));
#pragma unroll
    for (int i = 0; i < 8; ++i) { const int kk = r8 + 8 * i; const float gs = g ? g[k0 + kk] : 1.f;
#pragma unroll
        for (int e = 0; e < 4; ++e) scr[kk * 33 + c4 + e] = v[i][e] * gs; }
    LDS_WAIT();
    const int c = lane & 7;
#pragma unroll
    for (int j = 0; j < 4; ++j) { const int n = (lane >> 3) + 8 * j; const LAS float* sp = scr + (8 * c) * 33 + n;
        v4u o; o.x = pk2(sp[0 * 33], sp[1 * 33]); o.y = pk2(sp[2 * 33], sp[3 * 33]); o.z = pk2(sp[4 * 33], sp[5 * 33]); o.w = pk2(sp[6 * 33], sp[7 * 33]);
        *(v4u*)(WT + (size_t)(n0 + n) * K + k0 + 8 * c) = o; }
    LDS_WAIT();
}

__device__ __forceinline__ void transpose_item_fp8(const float* W, int K, int N, unsigned char* WT8, float scale, LAS float* scr, int item, int lane) {
    const int nblk = N / 32, kb = item / nblk, nb = item % nblk, k0 = 64 * kb, n0 = 32 * nb;
    const int r8 = lane >> 3, c4 = (lane & 7) * 4;
    f32x4 v[8];
#pragma unroll
    for (int i = 0; i < 8; ++i) v[i] = __builtin_nontemporal_load((const f32x4*)(W + (size_t)(k0 + r8 + 8 * i) * N + n0 + c4));
#pragma unroll
    for (int i = 0; i < 8; ++i) { const int kk = r8 + 8 * i;
#pragma unroll
        for (int e = 0; e < 4; ++e) scr[kk * 33 + c4 + e] = v[i][e] * scale; }
    LDS_WAIT();
    const int c = lane & 7;
#pragma unroll
    for (int j = 0; j < 4; ++j) { const int n = (lane >> 3) + 8 * j; const LAS float* sp = scr + (8 * c) * 33 + n;
        int w0 = __builtin_amdgcn_cvt_pk_fp8_f32(sp[0 * 33], sp[1 * 33], 0, false); w0 = __builtin_amdgcn_cvt_pk_fp8_f32(sp[2 * 33], sp[3 * 33], w0, true);
        int w1 = __builtin_amdgcn_cvt_pk_fp8_f32(sp[4 * 33], sp[5 * 33], 0, false); w1 = __builtin_amdgcn_cvt_pk_fp8_f32(sp[6 * 33], sp[7 * 33], w1, true);
        *(v2u*)(WT8 + (size_t)(n0 + n) * K + k0 + 8 * c) = (v2u){(unsigned)w0, (unsigned)w1}; }
    LDS_WAIT();
}

#define XB_TMO      128
#define XB_XCNT(j)  (256  + 64 * (j))
#define XB_XSUB(j)  (1280 + 64 * (j))
#define XB_XGEN(j)  (2304 + 64 * (j))
#define XB_TOP      3328
#define XB_TOPGEN   3392
#define XCD_BAR_WORDS 3456
#define XB_SPIN_CAP (1u << 18)
__device__ __forceinline__ unsigned xb_ld(unsigned* p)              { return __hip_atomic_load(p, __ATOMIC_RELAXED, __HIP_MEMORY_SCOPE_AGENT); }
__device__ __forceinline__ unsigned xb_add(unsigned* p, unsigned v) { return __hip_atomic_fetch_add(p, v, __ATOMIC_RELAXED, __HIP_MEMORY_SCOPE_AGENT); }
__device__ __forceinline__ unsigned xb_xcc_id() { return (unsigned)__builtin_amdgcn_s_getreg((3 << 11) | 20) & 0xFu; }
#define XB_SPIN(cond, bar) do { unsigned _sp = 0; while (cond) { __builtin_amdgcn_s_sleep(1); \
    if ((++_sp & 255u) == 0u) { if (xb_ld(&(bar)[XB_TMO])) break; if (_sp > XB_SPIN_CAP) { atomicAdd(&(bar)[XB_TMO], 1u); break; } } } } while (0)

struct XcdBarrier {
    unsigned* bar; unsigned x;
    volatile LAS unsigned* st;
};

__device__ __forceinline__ XcdBarrier xcd_barrier_post(unsigned* bar, volatile LAS unsigned* st, bool t0) {
    XcdBarrier b; b.bar = bar; b.x = xb_xcc_id(); b.st = st;
    if (t0) (void)xb_add(&bar[XB_XCNT(b.x)], 1u);
    return b;
}
__device__ __forceinline__ void xcd_barrier_complete(unsigned* bar, unsigned x, unsigned& nloc, unsigned& nx) {
    const unsigned G = gridDim.x * gridDim.y * gridDim.z;
    unsigned sum, cnt, mine, sp = 0u;
    for (;;) {
        sum = 0u; cnt = 0u; mine = 0u;
#pragma unroll
        for (unsigned j = 0; j < 16; ++j) { const unsigned c = xb_ld(&bar[XB_XCNT(j)]); sum += c; cnt += (c > 0u) ? 1u : 0u; mine = (j == x) ? c : mine; }
        if (sum == G) break;
        __builtin_amdgcn_s_sleep(1);
        if ((++sp & 255u) == 0u) { if (xb_ld(&bar[XB_TMO])) break; if (sp > XB_SPIN_CAP) { atomicAdd(&bar[XB_TMO], 1u); break; } }
    }
    nloc = mine > 0u ? mine : 1u; nx = cnt > 0u ? cnt : 1u;
}

__device__ __forceinline__ void xcd_barrier(const XcdBarrier& b, bool t0) {
    asm volatile("s_waitcnt vmcnt(0)" ::: "memory");
    __syncthreads();
    if (t0) {
        unsigned* bar = b.bar;
        __builtin_amdgcn_s_waitcnt(0);
        unsigned nloc = b.st[0], nx = b.st[1];
        if (nloc == 0u) { xcd_barrier_complete(bar, b.x, nloc, nx); b.st[0] = nloc; b.st[1] = nx; }
        const unsigned old = xb_add(&bar[XB_XSUB(b.x)], 1u);
        const unsigned gen = old / nloc;
        if (old + 1u == (gen + 1u) * nloc) {
            __builtin_amdgcn_fence(__ATOMIC_RELEASE, "agent");
            asm volatile("s_waitcnt vmcnt(0)" ::: "memory");
            const unsigned og = xb_add(&bar[XB_TOP], 1u);
            const unsigned tg = og / nx;
            if (og + 1u == (tg + 1u) * nx) xb_add(&bar[XB_TOPGEN], 1u);
            else XB_SPIN(xb_ld(&bar[XB_TOPGEN]) == tg, bar);
            __builtin_amdgcn_fence(__ATOMIC_ACQUIRE, "agent");
            xb_add(&bar[XB_XGEN(b.x)], 1u);
            asm volatile("s_waitcnt vmcnt(0)" ::: "memory");
        } else {
            XB_SPIN(xb_ld(&bar[XB_XGEN(b.x)]) == gen, bar);
            __builtin_amdgcn_fence(__ATOMIC_ACQUIRE, "agent");
            asm volatile("s_waitcnt vmcnt(0)" ::: "memory");
        }
    }
    __syncthreads();
}

struct Args { const float* in[14]; float* out; unsigned char* ws; float inv_freq[8]; int ph_lo, ph_hi; };

__global__ void __launch_bounds__(NTHR, 2) hybrid_fwd(Args args) {
    extern __shared__ __attribute__((aligned(16))) unsigned char lds_raw[];
    LAS unsigned char* lds = (LAS unsigned char*)lds_raw;
    cg::grid_group grid = cg::this_grid();
    const int wave = __builtin_amdgcn_readfirstlane((int)threadIdx.x >> 6);
    const int G = gridDim.x, bx = blockIdx.x;
    const int gw = bx * NWAVES + wave, NGW = G * NWAVES;
#define FRESH_IDS const int lane = opaque((int)__builtin_amdgcn_mbcnt_hi(~0u, __builtin_amdgcn_mbcnt_lo(~0u, 0u))), tid = wave * 64 + lane
    unsigned char* ws = args.ws;
    const float* x = args.in[0]; const float* ln1 = args.in[1]; const float* w_in = args.in[2];
    const float* lq1 = args.in[3]; const float* lk1 = args.in[4]; const float* lq2 = args.in[5]; const float* lk2 = args.in[6];
    const float* g_diff = args.in[7]; const float* g_sb = args.in[8]; const float* w_out = args.in[9]; const float* ln2 = args.in[10];
    const float* w1 = args.in[11]; const float* w2 = args.in[12]; const float* ln_f = args.in[13];
    float* out = args.out;
    bf16* Win_t = (bf16*)(ws + WS_WIN); bf16* Wout_t = (bf16*)(ws + WS_WOUT); bf16* W1_t = (bf16*)(ws + WS_W1); unsigned char* W2_8t = ws + WS_W2;
    float* cs = (float*)(ws + WS_CS); float* ss1 = (float*)(ws + WS_SS1); float* ss2 = (float*)(ws + WS_SS2);
    bf16* Hb = (bf16*)(ws + WS_H); bf16* QKV = (bf16*)(ws + WS_QKV); bf16* MIX = (bf16*)(ws + WS_MIX); unsigned char* U8 = ws + WS_U;
    const int lo = args.ph_lo, hi_ph = args.ph_hi;
#define IN(k) (lo <= (k) && (k) < hi_ph)
    unsigned* ctl = (unsigned*)(ws + WS_CTL);
    const bool t0 = (wave == 0) && (__builtin_amdgcn_mbcnt_hi(~0u, __builtin_amdgcn_mbcnt_lo(~0u, 0u)) == 0);
    if (args.ph_lo < 0) grid.sync();
    volatile LAS unsigned* bst = (volatile LAS unsigned*)(lds + RING_BYTES);
    if (t0) { bst[0] = 0u; bst[1] = 0u; }
    __syncthreads();
    XcdBarrier xbar = xcd_barrier_post(ctl + 1024, bst, t0);
#define SEAM(k) do { if (IN(k) && IN((k) + 1)) xcd_barrier(xbar, t0); } while (0)
    if (IN(0)) {
        FRESH_IDS;
        LAS float* scr = (LAS float*)(lds + wave * 16384);
        constexpr int I_IN = (DM / 64) * (PW / 32), I_OUT = (DM / 64) * (DM / 32), I_1 = (DM / 64) * (FF / 32), I_2 = (FF / 64) * (DM / 32);
        constexpr int NITEMS = I_IN + I_OUT + I_1 + I_2;
        for (int it = gw; it < NITEMS; it += NGW) {
            int r = it;
            if (r < I_IN) { transpose_item(w_in, DM, PW, Win_t, nullptr, scr, r, lane); continue; } r -= I_IN;
            if (r < I_OUT) { transpose_item(w_out, DM, DM, Wout_t, nullptr, scr, r, lane); continue; } r -= I_OUT;
            if (r < I_1) { transpose_item(w1, DM, FF, W1_t, ln2, scr, r, lane); continue; } r -= I_1;
            transpose_item_fp8(w2, FF, DM, W2_8t, W2_SCALE, scr, r, lane);
        }
        for (int m = gw; m < M; m += NGW) {
            const f32x4* xr = (const f32x4*)(x + (size_t)m * DM) + lane; const f32x4* gr = (const f32x4*)ln1 + lane;
            f32x4 v[8], gv[8]; float s = 0.f;
#pragma unroll
            for (int j = 0; j < 8; ++j) { v[j] = __builtin_nontemporal_load(xr + 64 * j); gv[j] = gr[64 * j]; }
#pragma unroll
            for (int j = 0; j < 8; ++j) s += (v[j][0] * v[j][0] + v[j][1] * v[j][1]) + (v[j][2] * v[j][2] + v[j][3] * v[j][3]);
            const float rstd = 1.f / sqrtf(wave_sum(s) * (1.f / DM) + EPS);
            v2u* o8 = (v2u*)(Hb + (size_t)m * DM) + lane;
#pragma unroll
            for (int j = 0; j < 8; ++j) { const f32x4 gq = gv[j]; v2u w; w.x = pk2(v[j][0] * rstd * gq[0], v[j][1] * rstd * gq[1]); w.y = pk2(v[j][2] * rstd * gq[2], v[j][3] * rstd * gq[3]); o8[64 * j] = w; }
        }
        for (int e = bx * NTHR + tid; e < SEQ * 8; e += G * NTHR) {
            const int pos = e >> 3, i = e & 7;
            const float ang = (float)pos * args.inv_freq[i];
            const double rev = (double)ang * 0.15915494309189533577; const float fr = (float)(rev - rint(rev));
            cs[pos * 16 + i] = __builtin_amdgcn_cosf(fr); cs[pos * 16 + 8 + i] = __builtin_amdgcn_sinf(fr);
        }
        for (int e = bx * NTHR + tid; e < SEQ; e += G * NTHR) { ss1[e] = 0.f; ss2[e] = 0.f; }
    }
    SEAM(0);
    if (IN(1)) {
        pg8::Gemm g{Hb, Win_t, M, PW, DM}; pg8::StaticOrder S; S.init(M, PW, G, bx);
        EpiQKV E{QKV, cs};
        pg8::gemm_phase<EpiQKV, pg8::StaticOrder, true, true>(lds, g, S, E, wave);
    }
    SEAM(1);
    if (IN(2)) {
        FRESH_IDS;
        const float a = lq1[lane] * lk1[lane], b = lq2[lane] * lk2[lane];
        const float lam = __builtin_bit_cast(float, __builtin_amdgcn_readfirstlane(__builtin_bit_cast(int, __expf(wave_sum(a)) - __expf(wave_sum(b)) + LAM_INIT)));
        float* o1s = (float*)(ws + WS_H);
        for (int u = bx; u < 256; u += G) {
            const int head = u & 7, p = u >> 3;
#pragma unroll 1
            for (int t = 0; t < 2; ++t) diff_unit(lds, QKV, MIX, o1s, g_diff, lam, head, t ? 63 - p : p, wave, lane, tid);
        }
        __syncthreads();
        const int lane_sb = opaque(lane);
        for (int wu = gw; wu < 8 * 512; wu += NGW) sb_unit(lds + wave * 8192, QKV, MIX, g_sb, wu & 7, 511 - (wu >> 3), lane_sb);
        __syncthreads();
    }
    SEAM(2);
    if (IN(3)) {
        pg8::Gemm g{MIX, Wout_t, M, DM, DM}; pg8::StaticOrder S; S.init(M, DM, G, bx);
        EpiRes<false> E{x, nullptr, nullptr, Hb, ss1, 1.f};
        pg8::gemm_phase<EpiRes<false>, pg8::StaticOrder, false, true>(lds, g, S, E, wave);
    }
    SEAM(3);
    if (IN(4)) {
        pg8::Gemm g{Hb, W1_t, M, FF, DM}; pg8::StaticOrder S; S.init(M, FF, G, bx);
        EpiMlpIn E{U8, ss1};
        pg8::gemm_phase<EpiMlpIn, pg8::StaticOrder, true, true>(lds, g, S, E, wave);
    }
    SEAM(4);
    if (IN(5)) {
        pg8::Gemm g{(const pg8::bf16_t*)U8, (const pg8::bf16_t*)W2_8t, M, DM, FF / 2}; pg8::StaticOrder S; S.init(M, DM, G, bx);
        EpiRes<true> E{nullptr, Hb, nullptr, Hb, ss2, 1.f / W2_SCALE};
        pg8::gemm_phase<EpiRes<true>, pg8::StaticOrder, false, true, true>(lds, g, S, E, wave);
    }
    SEAM(5);
    if (IN(6)) {
        FRESH_IDS;
        for (int m = gw; m < M; m += NGW) {
            const v4u* xr = (const v4u*)(Hb + (size_t)m * DM) + lane; const f32x4* gr = (const f32x4*)ln_f + 2 * lane; f32x4* orow = (f32x4*)(out + (size_t)m * DM) + 2 * lane;
            v4u v[4]; f32x4 g0[4], g1[4];
#pragma unroll
            for (int j = 0; j < 4; ++j) { v[j] = xr[64 * j]; g0[j] = gr[128 * j]; g1[j] = gr[128 * j + 1]; }
            const float rstd = 1.f / sqrtf(__hip_atomic_load(ss2 + m, __ATOMIC_RELAXED, __HIP_MEMORY_SCOPE_AGENT) * (1.f / DM) + EPS);
            asm volatile("" ::: "memory");
#pragma unroll
            for (int j = 0; j < 4; ++j) {
                const f32x4 a = {__builtin_bit_cast(float, v[j].x << 16), __builtin_bit_cast(float, v[j].x & 0xffff0000u), __builtin_bit_cast(float, v[j].y << 16), __builtin_bit_cast(float, v[j].y & 0xffff0000u)};
                const f32x4 c = {__builtin_bit_cast(float, v[j].z << 16), __builtin_bit_cast(float, v[j].z & 0xffff0000u), __builtin_bit_cast(float, v[j].w << 16), __builtin_bit_cast(float, v[j].w & 0xffff0000u)};
                __builtin_nontemporal_store(a * rstd * g0[j], orow + 128 * j); __builtin_nontemporal_store(c * rstd * g1[j], orow + 128 * j + 1);
            }
        }
    }
#undef IN
#undef SEAM
}

extern "C" void kernel_launch(void* const* d_in, const int* in_sizes, int n_in, void* d_out, int out_size, void* d_ws, size_t ws_size, hipStream_t stream) {
    static int grid = 0;
    if (grid == 0) {
        if (n_in != 14 || in_sizes[0] != M * DM || out_size != M * DM || ws_size < WS_END) { fprintf(stderr, "kernel_launch: unexpected shapes (n_in %d, in0 %d, out %d, ws %zu)\n", n_in, n_in > 0 ? in_sizes[0] : -1, out_size, ws_size); grid = -1; return; }
        int dev = 0, cus = 0, per_cu = 0;
        (void)hipGetDevice(&dev); (void)hipDeviceGetAttribute(&cus, hipDeviceAttributeMultiprocessorCount, dev);
        if (hipFuncSetAttribute((const void*)hybrid_fwd, hipFuncAttributeMaxDynamicSharedMemorySize, LDS_BYTES) != hipSuccess) { fprintf(stderr, "kernel_launch: hipFuncSetAttribute failed\n"); grid = -1; return; }
        if (hipOccupancyMaxActiveBlocksPerMultiprocessor(&per_cu, (const void*)hybrid_fwd, NTHR, LDS_BYTES) != hipSuccess || per_cu < 1) { fprintf(stderr, "kernel_launch: occupancy query gave %d\n", per_cu); per_cu = 1; }
        (void)hipGetLastError();
        grid = cus * per_cu;
    }
    if (grid < 0) return;
    if (hipMemsetAsync((char*)d_ws + WS_CTL, 0, 32768, stream) != hipSuccess) { fprintf(stderr, "kernel_launch: memset failed\n"); return; }
    Args a{};
    for (int i = 0; i < 14; ++i) a.in[i] = (const float*)d_in[i];
    a.out = (float*)d_out; a.ws = (unsigned char*)d_ws;
    for (int i = 0; i < 8; ++i) a.inv_freq[i] = (float)pow(500000.0, -(double)i / 8.0);
    a.ph_lo = 0; a.ph_hi = 7;
    void* kargs[] = {&a};
    hipError_t e = hipLaunchCooperativeKernel((const void*)hybrid_fwd, dim3(grid), dim3(NTHR), kargs, LDS_BYTES, stream);
    if (e != hipSuccess) fprintf(stderr, "kernel_launch: cooperative launch failed: %s (grid %d)\n", hipGetErrorString(e), grid);
}
```

```cpp
#include <hip/hip_runtime.h>
#include <hip/hip_cooperative_groups.h>
#include <cstdio>
#include <cstdint>
#include <cmath>
namespace cg = cooperative_groups;
namespace pg8 {
#define PG8_LAS __attribute__((address_space(3)))
typedef unsigned short bf16_t;
typedef short bf16x8 __attribute__((ext_vector_type(8)));
typedef float f32x4 __attribute__((ext_vector_type(4)));
typedef unsigned u32x4 __attribute__((ext_vector_type(4)));
typedef int v8i32 __attribute__((ext_vector_type(8)));
typedef int i32x4 __attribute__((ext_vector_type(4)));
constexpr int BM = 256, BK = 64, HALF = 128, HTB = HALF * BK * 2  , STAGE_BYTES = 8 * HTB, NXCD = 8, WGM = 8;

__host__ __device__ __forceinline__ int lds_byte(int r, int c) { const int st = (r >> 4) * 2 + (c >> 5), rr = r & 15, cc = c & 31, ob = rr * 64 + cc * 2; return st * 1024 + (ob ^ (((ob >> 9) & 1) << 5)); }
__host__ __device__ __forceinline__ void stage_rc(int b, int& R, int& C) { const int st = b / 1024, sb = b % 1024, swz = sb ^ (((sb >> 9) & 1) << 5); R = (st >> 1) * 16 + swz / 64; C = (st & 1) * 32 + (swz % 64) / 2; }
__host__ __device__ __forceinline__ int perm32(int rho) { const int n = rho >> 4, i = rho & 15; return 8 * (i >> 2) + 4 * n + (i & 3); }

struct Unit { int pm, pn; };
struct Gemm { const bf16_t* A; const bf16_t* Bt; int M, N, K; };

struct StaticOrder {
    int nM, nN, nwg, G, c;
    __host__ __device__ void init(int M, int N, int G_, int c_) { nM = M / BM; nN = N / BM; nwg = nM * nN; G = G_; c = c_; }
    __host__ __device__ bool next(int i, Unit& u) const {
        const long L = (long)i * G + c; if (L >= nwg) return false;
        int wgid = (int)L; { const int q = nwg / NXCD, r = nwg % NXCD, xcd = wgid % NXCD, off = wgid / NXCD; wgid = (xcd < r ? xcd * (q + 1) : r * (q + 1) + (xcd - r) * q) + off; }
        const int nig = WGM * nN, gid = wgid / nig, fm = gid * WGM, gsz = (nM - fm) < WGM ? (nM - fm) : WGM;
        u.pm = fm + ((wgid % nig) % gsz); u.pn = (wgid % nig) / gsz; return true;
    }
    __device__ __forceinline__ void a_ready(const Unit&) const {}
    __device__ __forceinline__ void done(const Unit&) const {}
};

__device__ __forceinline__ unsigned cvt_pk_bf16(float lo, float hi) { unsigned r; asm volatile("v_cvt_pk_bf16_f32 %0, %1, %2" : "=v"(r) : "v"(lo), "v"(hi)); return r; }
template <class Epi, class Sched, bool ALIGN_EPI = false, bool SP2 = false, bool FP8 = false>
__device__ __forceinline__ void gemm_phase(PG8_LAS unsigned char* lds, const Gemm g, const Sched& S, const Epi& E, int wave_id) {
    int tid_ = wave_id * 64 + (int)__builtin_amdgcn_mbcnt_hi(~0u, __builtin_amdgcn_mbcnt_lo(~0u, 0u)); asm volatile("" : "+v"(tid_));
    const int tid = tid_, wid = __builtin_amdgcn_readfirstlane(tid >> 6), lane = tid & 63, wr = wid >> 2, wc = wid & 3, fr = lane & 15, fq = lane >> 4;
    const int K = g.K, nt = K / BK;
    unsigned voffA[2], voffB[2];
#pragma unroll
    for (int i = 0; i < 2; ++i) { int R, C; stage_rc(tid * 16 + i * 8192, R, C); const int Rb = Epi::PERM ? ((R & ~31) + perm32(R & 31)) : R;
        voffA[i] = (unsigned)(R * K + C) * 2u; voffB[i] = (unsigned)(Rb * K + C) * 2u; }
    const size_t kstep = (size_t)(BK * 2);
    const size_t hstep = (size_t)HALF * K * 2;
    const size_t tstep = 2 * hstep;
    const unsigned ldsw = (unsigned)wid * 1024u;
    const int aoff = lds_byte(wr * 64 + fr, fq * 8), boff = lds_byte(wc * 32 + fr, fq * 8);
#define PG8_SA(b, h) (((b) * 2 + (h)) * HTB)
#define PG8_SB(b, h) ((4 + (b) * 2 + (h)) * HTB)
#define PG8_STAGE(bufoff, gbase, voff) do { _Pragma("unroll") for (int _i = 0; _i < 2; ++_i) \
        __builtin_amdgcn_global_load_lds((const unsigned*)((const char*)(gbase) + (voff)[_i]), (PG8_LAS unsigned*)(lds + (bufoff) + ldsw + _i * 8192), 16, 0, 0); } while (0)
#define PG8_LD32(p) __builtin_shufflevector(*(const PG8_LAS i32x4*)(p), *(const PG8_LAS i32x4*)((p) + 1024), 0, 1, 2, 3, 4, 5, 6, 7)
#define PG8_LDA(dst, b, h) do { _Pragma("unroll") for (int m = 0; m < 4; ++m) { if constexpr (FP8) dst##8[m] = PG8_LD32(lds + PG8_SA(b, h) + aoff + m * 2048); else { _Pragma("unroll") for (int k = 0; k < 2; ++k) dst[m][k] = *(const PG8_LAS bf16x8*)(lds + PG8_SA(b, h) + aoff + m * 2048 + k * 1024); } } } while (0)
#define PG8_LDB(dst, b, h) do { _Pragma("unroll") for (int n = 0; n < 2; ++n) { if constexpr (FP8) dst##8[n] = PG8_LD32(lds + PG8_SB(b, h) + boff + n * 2048); else { _Pragma("unroll") for (int k = 0; k < 2; ++k) dst[n][k] = *(const PG8_LAS bf16x8*)(lds + PG8_SB(b, h) + boff + n * 2048 + k * 1024); } } } while (0)
#define PG8_MMA(ai, bj, At, Bt) do { __builtin_amdgcn_s_setprio(1); _Pragma("unroll") for (int m = 0; m < 4; ++m) _Pragma("unroll") for (int n = 0; n < 2; ++n) { \
        if constexpr (FP8) asm volatile("v_mfma_f32_16x16x128_f8f6f4 %0, %1, %2, %0" : "+v"(acc[ai][bj][m][n]) : "v"(Bt##8[n]), "v"(At##8[m]));   \
        else { _Pragma("unroll") for (int k = 0; k < 2; ++k) acc[ai][bj][m][n] = __builtin_amdgcn_mfma_f32_16x16x32_bf16(Bt[n][k], At[m][k], acc[ai][bj][m][n], 0, 0, 0); } } \
        __builtin_amdgcn_s_setprio(0); } while (0)
#define PG8_WAIT_V(n) asm volatile("s_waitcnt vmcnt(" #n ")" ::: "memory")
#define PG8_WAIT_L(n) asm volatile("s_waitcnt lgkmcnt(" #n ")" ::: "memory")
#define PG8_BAR __builtin_amdgcn_s_barrier()
#define PG8_SCHED __builtin_amdgcn_sched_barrier(0)
    Unit cur, nxt; int ui = 0;
    if (!S.next(0, cur)) return;
    f32x4 acc[2][2][4][2];
#pragma unroll
    for (int a = 0; a < 2; ++a)
#pragma unroll
        for (int b = 0; b < 2; ++b)
#pragma unroll
            for (int m = 0; m < 4; ++m)
#pragma unroll
                for (int n = 0; n < 2; ++n) acc[a][b][m][n] = (f32x4){0.f, 0.f, 0.f, 0.f};
    bf16x8 At[4][2], B0[2][2], B1[2][2];
    v8i32 At8[4], B08[2], B18[2];
    const char* cA = (const char*)g.A + (size_t)cur.pm * tstep; const char* cB = (const char*)g.Bt + (size_t)cur.pn * tstep;
    S.a_ready(cur);
    if constexpr (SP2) {
        PG8_STAGE(PG8_SB(0, 0), cB, voffB); PG8_STAGE(PG8_SB(0, 1), cB + hstep, voffB); PG8_STAGE(PG8_SA(0, 0), cA, voffA); PG8_STAGE(PG8_SA(0, 1), cA + hstep, voffA);
        if (wr == 1) PG8_BAR;
        PG8_WAIT_V(2); PG8_BAR;
        PG8_STAGE(PG8_SB(1, 0), cB + kstep, voffB); PG8_STAGE(PG8_SA(1, 0), cA + kstep, voffA); PG8_STAGE(PG8_SB(1, 1), cB + hstep + kstep, voffB);
        PG8_WAIT_V(6); PG8_BAR;
    } else {
        PG8_STAGE(PG8_SB(0, 0), cB, voffB); PG8_STAGE(PG8_SA(0, 0), cA, voffA); PG8_STAGE(PG8_SB(0, 1), cB + hstep, voffB); PG8_STAGE(PG8_SA(0, 1), cA + hstep, voffA);
        if (wr == 1) PG8_BAR;
        PG8_WAIT_V(4); PG8_BAR;
        PG8_STAGE(PG8_SB(1, 0), cB + kstep, voffB); PG8_STAGE(PG8_SA(1, 0), cA + kstep, voffA); PG8_STAGE(PG8_SB(1, 1), cB + hstep + kstep, voffB);
        PG8_WAIT_V(6); PG8_BAR;
    }
    for (;;) {
        const bool has_next = S.next(ui + 1, nxt);
        const char* nA = has_next ? (const char*)g.A + (size_t)nxt.pm * tstep : cA; const char* nB = has_next ? (const char*)g.Bt + (size_t)nxt.pn * tstep : cB;
        for (int t = 0; t < nt; t += 2) {
            const bool last = (t == nt - 2);
            const char* a1 = cA + (size_t)(t + 1) * kstep;
            const char* a2 = last ? nA : cA + (size_t)(t + 2) * kstep; const char* b2 = last ? nB : cB + (size_t)(t + 2) * kstep;
            const char* a3 = a2 + kstep; const char* b3 = b2 + kstep;
            if (last && has_next) S.a_ready(nxt);
            if constexpr (SP2) {
            PG8_LDB(B0, 0, 0); PG8_LDB(B1, 0, 1); PG8_SCHED; PG8_LDA(At, 0, 0); PG8_STAGE(PG8_SA(1, 1), a1 + hstep, voffA);
            PG8_WAIT_V(8); PG8_WAIT_L(0); PG8_BAR; PG8_MMA(0, 0, At, B0); PG8_MMA(0, 1, At, B1); PG8_BAR; PG8_SCHED;
            PG8_LDA(At, 0, 1); PG8_STAGE(PG8_SB(0, 0), b2, voffB); PG8_STAGE(PG8_SB(0, 1), b2 + hstep, voffB); PG8_STAGE(PG8_SA(0, 0), a2, voffA);
            PG8_WAIT_V(8); PG8_WAIT_L(0); PG8_BAR; PG8_MMA(1, 0, At, B0); PG8_MMA(1, 1, At, B1); PG8_BAR; PG8_SCHED;
            PG8_LDB(B0, 1, 0); PG8_LDB(B1, 1, 1); PG8_SCHED; PG8_LDA(At, 1, 0); PG8_STAGE(PG8_SA(0, 1), a2 + hstep, voffA);
            PG8_WAIT_V(8); PG8_WAIT_L(0); PG8_BAR; PG8_MMA(0, 0, At, B0); PG8_MMA(0, 1, At, B1); PG8_BAR; PG8_SCHED;
            PG8_LDA(At, 1, 1); PG8_STAGE(PG8_SB(1, 0), b3, voffB); PG8_STAGE(PG8_SB(1, 1), b3 + hstep, voffB); PG8_STAGE(PG8_SA(1, 0), a3, voffA);
            PG8_WAIT_V(8); PG8_WAIT_L(0); PG8_BAR; PG8_MMA(1, 0, At, B0); PG8_MMA(1, 1, At, B1); PG8_BAR; PG8_SCHED;
            } else {
            PG8_LDB(B0, 0, 0); PG8_SCHED; PG8_LDA(At, 0, 0); PG8_STAGE(PG8_SA(1, 1), a1 + hstep, voffA);
            PG8_WAIT_L(8); PG8_BAR; PG8_WAIT_L(0); PG8_MMA(0, 0, At, B0); PG8_BAR; PG8_SCHED;
            PG8_LDB(B1, 0, 1); PG8_STAGE(PG8_SB(0, 0), b2, voffB);
            PG8_BAR; PG8_WAIT_L(0); PG8_MMA(0, 1, At, B1); PG8_BAR;
            PG8_LDA(At, 0, 1); PG8_STAGE(PG8_SA(0, 0), a2, voffA);
            PG8_BAR; PG8_WAIT_L(0); PG8_MMA(1, 0, At, B0); PG8_BAR; PG8_SCHED;
            PG8_STAGE(PG8_SB(0, 1), b2 + hstep, voffB);
            PG8_WAIT_V(6); PG8_BAR; PG8_MMA(1, 1, At, B1); PG8_BAR;
            PG8_LDB(B0, 1, 0); PG8_SCHED; PG8_LDA(At, 1, 0); PG8_STAGE(PG8_SA(0, 1), a2 + hstep, voffA);
            PG8_WAIT_L(8); PG8_BAR; PG8_WAIT_L(0); PG8_MMA(0, 0, At, B0); PG8_BAR; PG8_SCHED;
            PG8_LDB(B1, 1, 1); PG8_STAGE(PG8_SB(1, 0), b3, voffB);
            PG8_BAR; PG8_WAIT_L(0); PG8_MMA(0, 1, At, B1); PG8_BAR;
            PG8_LDA(At, 1, 1); PG8_STAGE(PG8_SA(1, 0), a3, voffA);
            PG8_BAR; PG8_WAIT_L(0); PG8_MMA(1, 0, At, B0); PG8_BAR; PG8_SCHED;
            PG8_STAGE(PG8_SB(1, 1), b3 + hstep, voffB);
            PG8_WAIT_V(6); PG8_BAR; PG8_MMA(1, 1, At, B1); PG8_BAR;
            }
        }
        if constexpr (FP8) asm volatile("s_nop 15\n\ts_nop 15" ::: "memory");
        if constexpr (ALIGN_EPI) { if (wr == 0) PG8_BAR; }
        if constexpr (!Epi::AFTER_DRAIN) { E(acc, cur, wr, wc, fr, fq); S.done(cur); }
        if (!has_next) break;
#pragma unroll
        for (int a = 0; a < 2; ++a)
#pragma unroll
            for (int b = 0; b < 2; ++b)
#pragma unroll
                for (int m = 0; m < 4; ++m)
#pragma unroll
                    for (int n = 0; n < 2; ++n) acc[a][b][m][n] = (f32x4){0.f, 0.f, 0.f, 0.f};
        cur = nxt; cA = nA; cB = nB; ++ui;
        if constexpr (ALIGN_EPI) { if (wr == 1) PG8_BAR; }
    }
    PG8_WAIT_V(0);
    if constexpr (!ALIGN_EPI) { if (wr == 0) PG8_BAR; }
    PG8_BAR;
    if constexpr (Epi::AFTER_DRAIN) { E.fused(acc, cur, wr, wc, fr, fq, lds, wid, lane); S.done(cur); }
#undef PG8_SA
#undef PG8_SB
#undef PG8_STAGE
#undef PG8_LDA
#undef PG8_LDB
#undef PG8_MMA
#undef PG8_LD32
#undef PG8_WAIT_V
#undef PG8_WAIT_L
#undef PG8_BAR
#undef PG8_SCHED
}
}
#define GAS __attribute__((address_space(1)))
#define LAS __attribute__((address_space(3)))
typedef unsigned short bf16;
typedef unsigned v4u __attribute__((ext_vector_type(4)));
typedef unsigned v2u __attribute__((ext_vector_type(2)));
typedef float f32x4 __attribute__((ext_vector_type(4)));
typedef float f32x16 __attribute__((ext_vector_type(16)));
typedef short bf16x8 __attribute__((ext_vector_type(8)));
typedef short s16x4 __attribute__((ext_vector_type(4)));
using pg8::Unit; using pg8::cvt_pk_bf16; using pg8::BM; using pg8::HALF;

constexpr int SEQ = 16384, DM = 2048, PW = 6144, FF = 8192, M = SEQ;
constexpr int NWAVES = 8, NTHR = 512;
constexpr float EPS = 1e-6f;
constexpr float C2 = 0.125f * 1.4426950408889634f;
constexpr float SBSCALE = 0.08838834764831845f * 1.4426950408889634f;
constexpr float LAM_INIT = 0.2f;
constexpr float W1_SCALE = 32.f;
constexpr float W2_SCALE = 512.f;
constexpr int COL_DQ = 0, COL_DK = 1024, COL_DV = 2048, COL_SQ = 3072, COL_SK = 4096, COL_SV = 5120;

constexpr size_t MiB = 1u << 20;
constexpr size_t WS_WIN = 0;
constexpr size_t WS_WOUT = 24 * MiB;
constexpr size_t WS_W1 = 32 * MiB;
constexpr size_t WS_W2 = 64 * MiB;
constexpr size_t WS_CS = 96 * MiB;
constexpr size_t WS_SS1 = 97 * MiB;
constexpr size_t WS_SS2 = 97 * MiB + 65536;
constexpr size_t WS_H = 98 * MiB;
constexpr size_t WS_QKV = 162 * MiB;
constexpr size_t WS_MIX = 354 * MiB;
constexpr size_t WS_U = 162 * MiB;
constexpr size_t WS_CTL = 418 * MiB;
constexpr size_t WS_H8 = 420 * MiB;
constexpr size_t WS_END = 452 * MiB;

constexpr int RING_BYTES = 131072, LDS_BYTES = 131072 + 1024;

__device__ __forceinline__ unsigned f2bf(float f) { unsigned u = __builtin_bit_cast(unsigned, f); return (u + 0x7fffu + ((u >> 16) & 1u)) >> 16; }
__device__ __forceinline__ unsigned pk2(float lo, float hi) { return f2bf(lo) | (f2bf(hi) << 16); }
__device__ __forceinline__ float wave_sum(float v) {
#pragma unroll
    for (int o = 1; o < 64; o <<= 1) v += __shfl_xor(v, o);
    return v;
}
typedef unsigned u32x2_t __attribute__((ext_vector_type(2)));
__device__ __forceinline__ void swap_x32(float& a, float& b) { asm volatile("s_nop 1\n\tv_permlane32_swap_b32 %0, %1" : "+v"(a), "+v"(b)); }
__device__ __forceinline__ float max_x32(float x) { float a = x, b = x; swap_x32(a, b); return fmaxf(a, b); }
__device__ __forceinline__ float sum_x32(float x) { float a = x, b = x; swap_x32(a, b); return a + b; }
__device__ __forceinline__ float partner_x32(float x, int hi) { float a = x, b = x; swap_x32(a, b); return hi ? a : b; }
#define LDS_WAIT() asm volatile("s_waitcnt lgkmcnt(0)" ::: "memory")
__device__ __forceinline__ int opaque(int v) { asm volatile("" : "+v"(v)); return v; }

struct EpiQKV {
    static constexpr bool PERM = true, AFTER_DRAIN = false;
    bf16* O; const float* cs;
    __device__ __forceinline__ void operator()(const f32x4 (&acc)[2][2][4][2], const Unit& u, int wr, int wc, int fr, int fq) const {
        const int row0 = u.pm * BM + wr * 64 + fr, col0 = u.pn * BM + wc * 32 + 8 * fq;
        float sc = 1.f; if (u.pn < 4) sc = C2; else if (u.pn >= 12 && u.pn < 16) sc = SBSCALE;
        const bool rot = (u.pn < 8) && ((wc & 1) == 0);
        if (rot) {
#pragma unroll
            for (int ai = 0; ai < 2; ++ai) {
                f32x4 cv[4][4];
#pragma unroll
                for (int m = 0; m < 4; ++m) { const f32x4* p = (const f32x4*)(cs + (size_t)(row0 + ai * HALF + m * 16) * 16); cv[m][0] = p[0]; cv[m][1] = p[1]; cv[m][2] = p[2]; cv[m][3] = p[3]; }
#pragma unroll
                for (int m = 0; m < 4; ++m) {
                    const int row = row0 + ai * HALF + m * 16;
                    const f32x4 c0 = cv[m][0], c1 = cv[m][1]; f32x4 s0 = cv[m][2], s1 = cv[m][3]; if (fq == 0) { s0 = -s0; s1 = -s1; }
#pragma unroll
                    for (int bj = 0; bj < 2; ++bj) {
                        f32x4 v0 = acc[ai][bj][m][0] * sc, v1 = acc[ai][bj][m][1] * sc, p0, p1;
#pragma unroll
                        for (int e = 0; e < 4; ++e) { p0[e] = __shfl_xor(v0[e], 16); p1[e] = __shfl_xor(v1[e], 16); }
                        if (fq < 2) { v0 = v0 * c0 + p0 * s0; v1 = v1 * c1 + p1 * s1; }
                        v4u w; w.x = cvt_pk_bf16(v0[0], v0[1]); w.y = cvt_pk_bf16(v0[2], v0[3]); w.z = cvt_pk_bf16(v1[0], v1[1]); w.w = cvt_pk_bf16(v1[2], v1[3]);
                        *(v4u*)(O + (size_t)row * PW + col0 + bj * HALF) = w;
                    }
                }
            }
        } else {
#pragma unroll
            for (int ai = 0; ai < 2; ++ai)
#pragma unroll
                for (int m = 0; m < 4; ++m) {
                    const int row = row0 + ai * HALF + m * 16;
#pragma unroll
                    for (int bj = 0; bj < 2; ++bj) {
                        const f32x4 v0 = acc[ai][bj][m][0] * sc, v1 = acc[ai][bj][m][1] * sc;
                        v4u w; w.x = cvt_pk_bf16(v0[0], v0[1]); w.y = cvt_pk_bf16(v0[2], v0[3]); w.z = cvt_pk_bf16(v1[0], v1[1]); w.w = cvt_pk_bf16(v1[2], v1[3]);
                        *(v4u*)(O + (size_t)row * PW + col0 + bj * HALF) = w;
                    }
                }
        }
    }
};
template <bool RES_BF16>
struct EpiRes {
    static constexpr bool PERM = true, AFTER_DRAIN = false;
    const float* R; bf16* Yb; unsigned char* Y8; float* ss; float ascale;
    __device__ __forceinline__ void operator()(const f32x4 (&acc)[2][2][4][2], const Unit& u, int wr, int wc, int fr, int fq) const {
        const int row0 = u.pm * BM + wr * 64 + fr, col0 = u.pn * BM + wc * 32 + 8 * fq;
#pragma unroll
        for (int ai = 0; ai < 2; ++ai) {
            f32x4 rv[4][2][2];
#pragma unroll
            for (int m = 0; m < 4; ++m)
#pragma unroll
                for (int bj = 0; bj < 2; ++bj) {
                    const size_t off = (size_t)(row0 + ai * HALF + m * 16) * DM + col0 + bj * HALF;
                    if (RES_BF16) {
                        const v4u t = *(const v4u*)(Yb + off);
                        rv[m][bj][0] = (f32x4){__builtin_bit_cast(float, t.x << 16), __builtin_bit_cast(float, t.x & 0xffff0000u), __builtin_bit_cast(float, t.y << 16), __builtin_bit_cast(float, t.y & 0xffff0000u)};
                        rv[m][bj][1] = (f32x4){__builtin_bit_cast(float, t.z << 16), __builtin_bit_cast(float, t.z & 0xffff0000u), __builtin_bit_cast(float, t.w << 16), __builtin_bit_cast(float, t.w & 0xffff0000u)};
                    } else { rv[m][bj][0] = *(const f32x4*)(R + off); rv[m][bj][1] = *(const f32x4*)(R + off + 4); }
                }
            asm volatile("" ::: "memory");
#pragma unroll
            for (int m = 0; m < 4; ++m) {
                const int row = row0 + ai * HALF + m * 16; float s = 0.f;
#pragma unroll
                for (int bj = 0; bj < 2; ++bj) {
                    const size_t off = (size_t)row * DM + col0 + bj * HALF;
                    const f32x4 v0 = acc[ai][bj][m][0] * ascale + rv[m][bj][0], v1 = acc[ai][bj][m][1] * ascale + rv[m][bj][1];
                    { v4u w; w.x = cvt_pk_bf16(v0[0], v0[1]); w.y = cvt_pk_bf16(v0[2], v0[3]); w.z = cvt_pk_bf16(v1[0], v1[1]); w.w = cvt_pk_bf16(v1[2], v1[3]); *(v4u*)(Yb + off) = w; }
                    if (!RES_BF16) { int w0 = __builtin_amdgcn_cvt_pk_fp8_f32(v0[0], v0[1], 0, false); w0 = __builtin_amdgcn_cvt_pk_fp8_f32(v0[2], v0[3], w0, true);
                        int w1 = __builtin_amdgcn_cvt_pk_fp8_f32(v1[0], v1[1], 0, false); w1 = __builtin_amdgcn_cvt_pk_fp8_f32(v1[2], v1[3], w1, true);
                        *(v2u*)(Y8 + off) = (v2u){(unsigned)w0, (unsigned)w1}; }
                    s += (v0[0] * v0[0] + v0[1] * v0[1]) + (v0[2] * v0[2] + v0[3] * v0[3]) + (v1[0] * v1[0] + v1[1] * v1[1]) + (v1[2] * v1[2] + v1[3] * v1[3]);
                }
                s += __shfl_xor(s, 16); s += __shfl_xor(s, 32);
                if (fq == 0) atomicAdd(ss + row, s);
            }
        }
    }
};
struct EpiMlpIn {
    static constexpr bool PERM = true, AFTER_DRAIN = false;
    unsigned char* O; const float* ss;
    __device__ __forceinline__ void operator()(const f32x4 (&acc)[2][2][4][2], const Unit& u, int wr, int wc, int fr, int fq) const {
        const int row0 = u.pm * BM + wr * 64 + fr, col0 = u.pn * BM + wc * 32 + 8 * fq;
        float rs[2][4];
#pragma unroll
        for (int ai = 0; ai < 2; ++ai)
#pragma unroll
            for (int m = 0; m < 4; ++m) rs[ai][m] = __hip_atomic_load(ss + row0 + ai * HALF + m * 16, __ATOMIC_RELAXED, __HIP_MEMORY_SCOPE_AGENT);
        asm volatile("" ::: "memory");
#pragma unroll
        for (int ai = 0; ai < 2; ++ai)
#pragma unroll
            for (int m = 0; m < 4; ++m) {
                const int row = row0 + ai * HALF + m * 16;
                const float rstd = __builtin_amdgcn_rsqf(rs[ai][m] * (1.f / DM) + EPS) * (1.f / W1_SCALE);
#pragma unroll
                for (int bj = 0; bj < 2; ++bj) {
                    f32x4 v0 = acc[ai][bj][m][0] * rstd, v1 = acc[ai][bj][m][1] * rstd;
#pragma unroll
                    for (int e = 0; e < 4; ++e) { const float a = fmaxf(v0[e], 0.f), b = fmaxf(v1[e], 0.f); v0[e] = fminf(a * a, 448.f); v1[e] = fminf(b * b, 448.f); }
                    int w0 = __builtin_amdgcn_cvt_pk_fp8_f32(v0[0], v0[1], 0, false); w0 = __builtin_amdgcn_cvt_pk_fp8_f32(v0[2], v0[3], w0, true);
                    int w1 = __builtin_amdgcn_cvt_pk_fp8_f32(v1[0], v1[1], 0, false); w1 = __builtin_amdgcn_cvt_pk_fp8_f32(v1[2], v1[3], w1, true);
                    *(v2u*)(O + (size_t)row * FF + col0 + bj * HALF) = (v2u){(unsigned)w0, (unsigned)w1};
                }
            }
    }
};
#define MFMA32(a, b, c) __builtin_amdgcn_mfma_f32_32x32x16_bf16((a), (b), (c), 0, 0, 0)
__device__ __forceinline__ int crow(int r, int hi) { return (r & 3) + 8 * (r >> 2) + 4 * hi; }
typedef short v4i16_t __attribute__((ext_vector_type(4)));
__device__ __forceinline__ s16x4 vtr(LAS const unsigned char* p) { return __builtin_bit_cast(s16x4, __builtin_amdgcn_ds_read_tr16_b64_v4i16((LAS v4i16_t*)p)); }
typedef float f32x2_t __attribute__((ext_vector_type(2)));
typedef __bf16 bf16x2_t __attribute__((ext_vector_type(2)));
__device__ __forceinline__ unsigned cvtpk_s(float lo, float hi) { f32x2_t v = {lo, hi}; bf16x2_t b = __builtin_convertvector(v, bf16x2_t); return __builtin_bit_cast(unsigned, b); }
__device__ __forceinline__ bf16x8 pack8(const f32x16& x, int s) {
    v4u p; p.x = cvtpk_s(x[8 * s], x[8 * s + 1]); p.y = cvtpk_s(x[8 * s + 2], x[8 * s + 3]); p.z = cvtpk_s(x[8 * s + 4], x[8 * s + 5]); p.w = cvtpk_s(x[8 * s + 6], x[8 * s + 7]);
    return __builtin_bit_cast(bf16x8, p);
}

__device__ __forceinline__ void glds16(const void* sbase, unsigned voff, unsigned lds_dst) { unsigned keep;
    asm volatile("s_mov_b32 %0, m0\n\ts_mov_b32 m0, %3\n\ts_nop 0\n\tglobal_load_lds_dwordx4 %1, %2\n\ts_mov_b32 m0, %0" : "=&s"(keep) : "v"(voff), "s"(sbase), "s"(lds_dst) : "memory"); }
template <bool TAIL>
__device__ __forceinline__ void flash_half(f32x16 (&O)[4], f32x16& Sc, f32x16& Sn, float& m_run, float& l_run, bf16x8& mfrag, const bf16x8& onefrag, const bf16x8 (&qf)[4],
                                           LAS const unsigned char* Kn, LAS const unsigned char* Vc, unsigned ka, int kx, unsigned va, int vx, int blk, int hi, int key0, int qrow, int qmin) {
    if (TAIL) {
        const int kb = key0 + 4 * hi;
#pragma unroll
        for (int i = 0; i < 16; ++i) { const int key = kb + (i & 3) + 8 * (i >> 2); if (key > qrow) Sc[i] = -1e30f; }
    }
    float mloc = fmaxf(Sc[0], Sc[1]);
#pragma unroll
    for (int i = 2; i < 16; ++i) mloc = fmaxf(mloc, Sc[i]);
    mloc = max_x32(mloc);
    const bool first = (key0 == 0);
    if (__any(mloc > 8.f) || first) {
        const float m_new = (mloc > 8.f || first) ? __builtin_bit_cast(float, f2bf(m_run + mloc) << 16) : m_run;
        const float delta = m_new - m_run, alpha = __builtin_amdgcn_exp2f(-delta);
        l_run *= alpha;
#pragma unroll
        for (int d = 0; d < 4; ++d)
#pragma unroll
            for (int i = 0; i < 16; ++i) O[d][i] *= alpha;
#pragma unroll
        for (int i = 0; i < 16; ++i) Sc[i] -= delta;
        m_run = m_new;
        mfrag[0] = hi ? (short)0 : (short)(f2bf(-m_new));
    }
#pragma unroll
    for (int i = 0; i < 16; ++i) Sn[i] = 0.f;
    Sn = MFMA32(onefrag, mfrag, Sn);
#pragma unroll
    for (int ks = 0; ks < 4; ++ks) {
        const bf16x8 a0 = *(LAS const bf16x8*)(Kn + ka + (((2 * ks + hi) ^ kx) << 4));
        Sn = MFMA32(a0, qf[ks], Sn);
    }
    float ls = 0.f;
#pragma unroll
    for (int i = 0; i < 16; ++i) { Sc[i] = __builtin_amdgcn_exp2f(Sc[i]); ls += Sc[i]; }
    l_run += ls;
#pragma unroll
    for (int kk = 0; kk < 2; ++kk) {
        if (kk == 1) __builtin_amdgcn_sched_barrier(0);
        const bf16x8 pb = pack8(Sc, kk);
#pragma unroll
        for (int d = 0; d < 4; ++d) {
            LAS const unsigned char* p = Vc + va + kk * 4096 + (((2 * d + blk) ^ vx) << 5);
            const s16x4 lo = vtr(p), hi4 = vtr(p + 2048);
            const bf16x8 a = __builtin_shufflevector(lo, hi4, 0, 1, 2, 3, 4, 5, 6, 7);
            O[d] = MFMA32(a, pb, O[d]);
        }
    }
}

constexpr int DA_V = 49152, KT = 128;
__device__ __forceinline__ void flash_map(f32x16 (&O)[4], LAS unsigned char* lds, const bf16* QKV, int qcol, int kcol, int vcol, int qb, int w, int lane, int tid) {
    const int r32 = lane & 31, hi = lane >> 5;
    const int qmin = qb * 256 + w * 32, qrow = qmin + r32;
    bf16x8 qf[4];
    { const int lq = opaque(lane);
      const bf16* qp = QKV + (size_t)(qmin + (lq & 31)) * PW + qcol + 8 * (lq >> 5);
#pragma unroll
      for (int ks = 0; ks < 4; ++ks) qf[ks] = *(const bf16x8*)(qp + 16 * ks); }
#pragma unroll
    for (int d = 0; d < 4; ++d)
#pragma unroll
        for (int i = 0; i < 16; ++i) O[d][i] = 0.f;
    float m_run = 0.f, l_run = 0.f;
    bf16x8 mfrag = {0, 0, 0, 0, 0, 0, 0, 0}, onefrag = {0, 0, 0, 0, 0, 0, 0, 0}; onefrag[0] = hi ? (short)0 : (short)0x3F80;
    const int nkt = 2 * (qb + 1), nmain = 2 * qb;
    const int krow = tid >> 3, kc = (tid & 7) ^ ((krow >> 1) & 7);
    const unsigned kgo = (unsigned)(krow * PW + kc * 8) * 2u;
    const int vrow = tid >> 4, vpos = tid & 15, vc = ((((vpos >> 1) ^ (2 * (vrow & 3)))) << 1) | (vpos & 1);
    const unsigned vgo = (unsigned)(vrow * PW + vc * 8) * 2u;
    const bf16* kg = QKV + kcol; const bf16* vg = QKV + vcol;
    const unsigned wl = (unsigned)(tid >> 6) * 1024u;
    const size_t tstep = (size_t)KT * PW;
#define DMA16(g, vo, l) glds16((g), (vo), (unsigned)__builtin_amdgcn_readfirstlane((int)(unsigned)(size_t)(l)))
#define DMA_K(t, slot) do { const bf16* g_ = kg + (size_t)(t) * tstep; DMA16(g_, kgo, lds + (slot) + wl); DMA16(g_ + (size_t)64 * PW, kgo, lds + (slot) + 8192 + wl); } while (0)
#define DMA_VH(t, b, h) do { const bf16* g_ = vg + (size_t)(t) * tstep + (size_t)(64 * (h)) * PW; LAS unsigned char* l_ = lds + DA_V + (b) * 32768 + 16384 * (h) + wl; \
        DMA16(g_, vgo, l_); DMA16(g_ + (size_t)32 * PW, vgo, l_ + 8192); } while (0)
#define DMA_V(t, b) do { DMA_VH(t, b, 0); DMA_VH(t, b, 1); } while (0)
    const unsigned ka = r32 * 128;
    const int kx = (r32 >> 1) & 7;
    const int q4 = (lane & 15) >> 2, p4 = lane & 3, blk = (lane >> 4) & 1;
    const int vr0 = 4 * hi + q4;
    const unsigned va = DA_V + vr0 * 256 + 8 * p4;
    const int vx = 2 * q4;
    DMA_K(0, 0); DMA_K(1, 16384); DMA_V(0, 0);
    asm volatile("s_waitcnt vmcnt(0) lgkmcnt(0)\n\ts_barrier" ::: "memory");
    f32x16 S0, S1;
#pragma unroll
    for (int i = 0; i < 16; ++i) S0[i] = 0.f;
#pragma unroll
    for (int ks = 0; ks < 4; ++ks) S0 = MFMA32(*(LAS const bf16x8*)(lds + ka + (((2 * ks + hi) ^ kx) << 4)), qf[ks], S0);
    int kb0 = 0, kb1 = 16384, kb2 = 32768;
    for (int kt = 0; kt < nkt; ++kt) {
        const int buf = kt & 1;
        const bool more = kt + 1 < nkt;
        if (kt + 2 < nkt) DMA_K(kt + 2, kb2);
        LAS const unsigned char* Kc = lds + kb0; LAS const unsigned char* Vb = lds + buf * 32768;
        if (kt < nmain) {
            flash_half<false>(O, S0, S1, m_run, l_run, mfrag, onefrag, qf, Kc + 4096, Vb, ka, kx, va, vx, blk, hi, kt * KT, qrow, qmin);
            if (more) DMA_VH(kt + 1, buf ^ 1, 0);
            flash_half<false>(O, S1, S0, m_run, l_run, mfrag, onefrag, qf, Kc + 8192, Vb + 8192, ka, kx, va, vx, blk, hi, kt * KT + 32, qrow, qmin);
            if (more) DMA_VH(kt + 1, buf ^ 1, 1);
            flash_half<false>(O, S0, S1, m_run, l_run, mfrag, onefrag, qf, Kc + 12288, Vb + 16384, ka, kx, va, vx, blk, hi, kt * KT + 64, qrow, qmin);
            flash_half<false>(O, S1, S0, m_run, l_run, mfrag, onefrag, qf, lds + kb1, Vb + 24576, ka, kx, va, vx, blk, hi, kt * KT + 96, qrow, qmin);
        } else {
            if (more) DMA_V(kt + 1, buf ^ 1);
            flash_half<true>(O, S0, S1, m_run, l_run, mfrag, onefrag, qf, Kc + 4096, Vb, ka, kx, va, vx, blk, hi, kt * KT, qrow, qmin);
            flash_half<true>(O, S1, S0, m_run, l_run, mfrag, onefrag, qf, Kc + 8192, Vb + 8192, ka, kx, va, vx, blk, hi, kt * KT + 32, qrow, qmin);
            flash_half<true>(O, S0, S1, m_run, l_run, mfrag, onefrag, qf, Kc + 12288, Vb + 16384, ka, kx, va, vx, blk, hi, kt * KT + 64, qrow, qmin);
            flash_half<true>(O, S1, S0, m_run, l_run, mfrag, onefrag, qf, lds + kb1, Vb + 24576, ka, kx, va, vx, blk, hi, kt * KT + 96, qrow, qmin);
        }
        asm volatile("s_waitcnt vmcnt(0) lgkmcnt(0)\n\ts_barrier" ::: "memory");
        const int t0 = kb0; kb0 = kb1; kb1 = kb2; kb2 = t0;
    }
#undef DMA16
#undef DMA_K
#undef DMA_V
#undef DMA_VH
    const float l = sum_x32(l_run), inv = 1.f / l;
#pragma unroll
    for (int d = 0; d < 4; ++d)
#pragma unroll
        for (int i = 0; i < 16; ++i) O[d][i] *= inv;
}

__device__ __forceinline__ void headnorm_store(const f32x16 (&O)[4], const float* g, float post, bf16* MIX, int qrow, int col0, int hi) {
    float ss = 0.f;
#pragma unroll
    for (int d = 0; d < 4; ++d)
#pragma unroll
        for (int i = 0; i < 16; ++i) ss += O[d][i] * O[d][i];
    ss = sum_x32(ss);
    const float rs = __builtin_amdgcn_rsqf(ss * (1.f / 128.f) + EPS) * post;
    f32x4 gvv[4][4];
#pragma unroll
    for (int d = 0; d < 4; ++d)
#pragma unroll
        for (int gq = 0; gq < 4; ++gq) gvv[d][gq] = *(const f32x4*)(g + 32 * d + 8 * gq + 4 * hi);
    asm volatile("" ::: "memory");
#pragma unroll
    for (int d = 0; d < 4; ++d)
#pragma unroll
        for (int gq = 0; gq < 4; ++gq) {
            const int dv = 32 * d + 8 * gq + 4 * hi;
            const f32x4 gv = gvv[d][gq];
            v2u w; w.x = cvtpk_s(O[d][4 * gq] * rs * gv[0], O[d][4 * gq + 1] * rs * gv[1]); w.y = cvtpk_s(O[d][4 * gq + 2] * rs * gv[2], O[d][4 * gq + 3] * rs * gv[3]);
            *(v2u*)(MIX + (size_t)qrow * DM + col0 + dv) = w;
        }
}

__device__ __forceinline__ void diff_unit(LAS unsigned char* lds, const bf16* QKV, bf16* MIX, float* o1s, const float* gd, float lam, int head, int qb, int w, int lane, int tid) {
    f32x16 O[4];
#pragma unroll 1
    for (int j = 0; j < 2; ++j) {
        flash_map(O, lds, QKV, COL_DQ + head * 128 + 64 * j, COL_DK + head * 128 + 64 * j, COL_DV + head * 128, qb, w, lane, tid);
        if (j == 0) {
            f32x4* sc = (f32x4*)(o1s + ((size_t)(blockIdx.x * NWAVES + w) * 64 + opaque(lane)) * 64);
#pragma unroll
            for (int d = 0; d < 4; ++d)
#pragma unroll
                for (int i = 0; i < 4; ++i) sc[d * 4 + i] = (f32x4){O[d][4 * i], O[d][4 * i + 1], O[d][4 * i + 2], O[d][4 * i + 3]};
        }
    }
    lane = opaque(lane);
    const f32x4* sc = (const f32x4*)(o1s + ((size_t)(blockIdx.x * NWAVES + w) * 64 + lane) * 64);
#pragma unroll
    for (int d = 0; d < 4; ++d)
#pragma unroll
        for (int i = 0; i < 4; ++i) { const f32x4 t = sc[d * 4 + i];
#pragma unroll
            for (int e = 0; e < 4; ++e) O[d][4 * i + e] = t[e] - lam * O[d][4 * i + e]; }
    headnorm_store(O, gd, 1.f - LAM_INIT, MIX, qb * 256 + w * 32 + (lane & 31), head * 128, lane >> 5);
}

constexpr float SB_STOP = -44.f * 1.4426950408889634f;
__device__ __forceinline__ void sb_unit(LAS unsigned char* vl, const bf16* QKV, bf16* MIX, const float* gs, int head, int qg, int lane) {
    const int r32 = lane & 31, hi = lane >> 5;
    const int qrow = qg * 32 + r32;
    bf16x8 qf[8];
#pragma unroll
    for (int ks = 0; ks < 8; ++ks) qf[ks] = *(const bf16x8*)(QKV + (size_t)qrow * PW + COL_SQ + head * 128 + 16 * ks + 8 * hi);
    f32x16 O[4];
#pragma unroll
    for (int d = 0; d < 4; ++d)
#pragma unroll
        for (int i = 0; i < 16; ++i) O[d][i] = 0.f;
    float R = 0.f;
    const int q4 = (lane & 15) >> 2, p4 = lane & 3, blk = (lane >> 4) & 1;
    const int vr0 = 4 * hi + q4, vx = vr0 & 7;
    const unsigned va = vr0 * 256 + 8 * p4;
    const bf16* kgp = QKV + (size_t)r32 * PW + COL_SK + head * 128 + 8 * hi;
    const bf16* vgp = QKV + (size_t)(lane >> 4) * PW + COL_SV + head * 128 + (lane & 15) * 8;
    bf16x8 kf[8]; v4u vreg[8];
#pragma unroll
    for (int ks = 0; ks < 8; ++ks) kf[ks] = *(const bf16x8*)(kgp + (size_t)(qg * 32) * PW + 16 * ks);
#pragma unroll
    for (int i = 0; i < 8; ++i) vreg[i] = *(const v4u*)(vgp + (size_t)(qg * 32 + 4 * i) * PW);
    for (int kt = qg; kt >= 0; --kt) {
        const int k0 = kt * 32;
        f32x16 S;
#pragma unroll
        for (int i = 0; i < 16; ++i) S[i] = 0.f;
#pragma unroll
        for (int ks = 0; ks < 8; ++ks) S = MFMA32(kf[ks], qf[ks], S);
        LDS_WAIT();
#pragma unroll
        for (int i = 0; i < 8; ++i) { const int row = 4 * i + (lane >> 4), c = lane & 15; *(LAS v4u*)(vl + row * 256 + (((c >> 1) ^ (row & 7)) << 5) + ((c & 1) << 4)) = vreg[i]; }
        if (kt > 0) {
#pragma unroll
            for (int ks = 0; ks < 8; ++ks) kf[ks] = *(const bf16x8*)(kgp + (size_t)(k0 - 32) * PW + 16 * ks);
#pragma unroll
            for (int i = 0; i < 8; ++i) vreg[i] = *(const v4u*)(vgp + (size_t)(k0 - 32 + 4 * i) * PW);
        }
        float lb[16], lom[16];
#pragma unroll
        for (int i = 0; i < 16; ++i) {
            const int key = k0 + crow(i, hi); const float z = S[i];
            const float sp = __builtin_amdgcn_logf(1.f + __builtin_amdgcn_exp2f(-fabsf(z)));
            lb[i] = fminf(z, 0.f) - sp;
            lom[i] = (key < qrow) ? lb[i] - z : 0.f;
        }
        float gsum[4], pgs[4], after[4];
#pragma unroll
        for (int g = 0; g < 4; ++g) { gsum[g] = (lom[4 * g] + lom[4 * g + 1]) + (lom[4 * g + 2] + lom[4 * g + 3]); pgs[g] = partner_x32(gsum[g], hi); }
        float run = 0.f;
#pragma unroll
        for (int g = 3; g >= 0; --g) { after[g] = run + (hi == 0 ? pgs[g] : 0.f); run += gsum[g] + pgs[g]; }
#pragma unroll
        for (int g = 0; g < 4; ++g) {
            float suf = R + after[g];
#pragma unroll
            for (int e = 3; e >= 0; --e) {
                const int i = 4 * g + e; const int key = k0 + crow(i, hi);
                S[i] = (key < qrow) ? __builtin_amdgcn_exp2f(lb[i] + suf) : 0.f;
                suf += lom[i];
            }
        }
        R += run;
        LDS_WAIT();
#pragma unroll
        for (int kk = 0; kk < 2; ++kk) {
            const bf16x8 pb = pack8(S, kk);
#pragma unroll
            for (int d = 0; d < 4; ++d) {
                LAS const unsigned char* p = vl + va + kk * 4096 + (((2 * d + blk) ^ vx) << 5);
                const s16x4 lo = vtr(p), hi4 = vtr(p + 2048);
                const bf16x8 a = __builtin_shufflevector(lo, hi4, 0, 1, 2, 3, 4, 5, 6, 7);
                O[d] = MFMA32(a, pb, O[d]);
            }
        }
        if (__all(R < SB_STOP)) break;
    }
    LDS_WAIT();
    headnorm_store(O, gs, 1.f, MIX, qrow, 1024 + head * 128, hi);
}
__device__ __forceinline__ void transpose_item(const float* W, int K, int N, bf16* WT, const float* g, LAS float* scr, int item, int lane) {
    const int nblk = N / 32, kb = item / nblk, nb = item % nblk, k0 = 64 * kb, n0 = 32 * nb;
    const int r8 = lane >> 3, c4 = (lane & 7) * 4;
    f32x4 v[8];
#pragma unroll
    for (int i = 0; i < 8; ++i) v[i] = __builtin_nontemporal_load((const f32x4*)(W + (size_t)(k0 + r8 + 8 * i) * N + n0 + c4));
#pragma unroll
    for (int i = 0; i < 8; ++i) { const int kk = r8 + 8 * i; const float gs = g ? g[k0 + kk] : 1.f;
#pragma unroll
        for (int e = 0; e < 4; ++e) scr[kk * 33 + c4 + e] = v[i][e] * gs; }
    LDS_WAIT();
    const int c = lane & 7;
#pragma unroll
    for (int j = 0; j < 4; ++j) { const int n = (lane >> 3) + 8 * j; const LAS float* sp = scr + (8 * c) * 33 + n;
        v4u o; o.x = pk2(sp[0 * 33], sp[1 * 33]); o.y = pk2(sp[2 * 33], sp[3 * 33]); o.z = pk2(sp[4 * 33], sp[5 * 33]); o.w = pk2(sp[6 * 33], sp[7 * 33]);
        *(v4u*)(WT + (size_t)(n0 + n) * K + k0 + 8 * c) = o; }
    LDS_WAIT();
}

__device__ __forceinline__ void transpose_item_fp8(const float* W, int K, int N, unsigned char* WT8, const float* g, float scale, LAS float* scr, int item, int lane) {
    const int nblk = N / 32, kb = item / nblk, nb = item % nblk, k0 = 64 * kb, n0 = 32 * nb;
    const int r8 = lane >> 3, c4 = (lane & 7) * 4;
    f32x4 v[8];
#pragma unroll
    for (int i = 0; i < 8; ++i) v[i] = __builtin_nontemporal_load((const f32x4*)(W + (size_t)(k0 + r8 + 8 * i) * N + n0 + c4));
#pragma unroll
    for (int i = 0; i < 8; ++i) { const int kk = r8 + 8 * i; const float gs = g ? g[k0 + kk] * scale : scale;
#pragma unroll
        for (int e = 0; e < 4; ++e) scr[kk * 33 + c4 + e] = v[i][e] * gs; }
    LDS_WAIT();
    const int c = lane & 7;
#pragma unroll
    for (int j = 0; j < 4; ++j) { const int n = (lane >> 3) + 8 * j; const LAS float* sp = scr + (8 * c) * 33 + n;
        int w0 = __builtin_amdgcn_cvt_pk_fp8_f32(sp[0 * 33], sp[1 * 33], 0, false); w0 = __builtin_amdgcn_cvt_pk_fp8_f32(sp[2 * 33], sp[3 * 33], w0, true);
        int w1 = __builtin_amdgcn_cvt_pk_fp8_f32(sp[4 * 33], sp[5 * 33], 0, false); w1 = __builtin_amdgcn_cvt_pk_fp8_f32(sp[6 * 33], sp[7 * 33], w1, true);
        *(v2u*)(WT8 + (size_t)(n0 + n) * K + k0 + 8 * c) = (v2u){(unsigned)w0, (unsigned)w1}; }
    LDS_WAIT();
}

#define XB_TMO      128
#define XB_XCNT(j)  (256  + 64 * (j))
#define XB_XSUB(j)  (1280 + 64 * (j))
#define XB_XGEN(j)  (2304 + 64 * (j))
#define XB_TOP      3328
#define XB_TOPGEN   3392
#define XCD_BAR_WORDS 3456
#define XB_SPIN_CAP (1u << 18)
__device__ __forceinline__ unsigned xb_ld(unsigned* p)              { return __hip_atomic_load(p, __ATOMIC_RELAXED, __HIP_MEMORY_SCOPE_AGENT); }
__device__ __forceinline__ unsigned xb_add(unsigned* p, unsigned v) { return __hip_atomic_fetch_add(p, v, __ATOMIC_RELAXED, __HIP_MEMORY_SCOPE_AGENT); }
__device__ __forceinline__ unsigned xb_xcc_id() { return (unsigned)__builtin_amdgcn_s_getreg((3 << 11) | 20) & 0xFu; }
#define XB_SPIN(cond, bar) do { unsigned _sp = 0; while (cond) { __builtin_amdgcn_s_sleep(1); \
    if ((++_sp & 255u) == 0u) { if (xb_ld(&(bar)[XB_TMO])) break; if (_sp > XB_SPIN_CAP) { atomicAdd(&(bar)[XB_TMO], 1u); break; } } } } while (0)

struct XcdBarrier {
    unsigned* bar; unsigned x;
    volatile LAS unsigned* st;
};

__device__ __forceinline__ XcdBarrier xcd_barrier_post(unsigned* bar, volatile LAS unsigned* st, bool t0) {
    XcdBarrier b; b.bar = bar; b.x = xb_xcc_id(); b.st = st;
    if (t0) (void)xb_add(&bar[XB_XCNT(b.x)], 1u);
    return b;
}
__device__ __forceinline__ void xcd_barrier_complete(unsigned* bar, unsigned x, unsigned& nloc, unsigned& nx) {
    const unsigned G = gridDim.x * gridDim.y * gridDim.z;
    unsigned sum, cnt, mine, sp = 0u;
    for (;;) {
        sum = 0u; cnt = 0u; mine = 0u;
#pragma unroll
        for (unsigned j = 0; j < 16; ++j) { const unsigned c = xb_ld(&bar[XB_XCNT(j)]); sum += c; cnt += (c > 0u) ? 1u : 0u; mine = (j == x) ? c : mine; }
        if (sum == G) break;
        __builtin_amdgcn_s_sleep(1);
        if ((++sp & 255u) == 0u) { if (xb_ld(&bar[XB_TMO])) break; if (sp > XB_SPIN_CAP) { atomicAdd(&bar[XB_TMO], 1u); break; } }
    }
    nloc = mine > 0u ? mine : 1u; nx = cnt > 0u ? cnt : 1u;
}

__device__ __forceinline__ void xcd_barrier(const XcdBarrier& b, bool t0) {
    asm volatile("s_waitcnt vmcnt(0)" ::: "memory");
    __syncthreads();
    if (t0) {
        unsigned* bar = b.bar;
        __builtin_amdgcn_s_waitcnt(0);
        unsigned nloc = b.st[0], nx = b.st[1];
        if (nloc == 0u) { xcd_barrier_complete(bar, b.x, nloc, nx); b.st[0] = nloc; b.st[1] = nx; }
        const unsigned old = xb_add(&bar[XB_XSUB(b.x)], 1u);
        const unsigned gen = old / nloc;
        if (old + 1u == (gen + 1u) * nloc) {
            __builtin_amdgcn_fence(__ATOMIC_RELEASE, "agent");
            asm volatile("s_waitcnt vmcnt(0)" ::: "memory");
            const unsigned og = xb_add(&bar[XB_TOP], 1u);
            const unsigned tg = og / nx;
            if (og + 1u == (tg + 1u) * nx) xb_add(&bar[XB_TOPGEN], 1u);
            else XB_SPIN(xb_ld(&bar[XB_TOPGEN]) == tg, bar);
            __builtin_amdgcn_fence(__ATOMIC_ACQUIRE, "agent");
            xb_add(&bar[XB_XGEN(b.x)], 1u);
            asm volatile("s_waitcnt vmcnt(0)" ::: "memory");
        } else {
            XB_SPIN(xb_ld(&bar[XB_XGEN(b.x)]) == gen, bar);
            __builtin_amdgcn_fence(__ATOMIC_ACQUIRE, "agent");
            asm volatile("s_waitcnt vmcnt(0)" ::: "memory");
        }
    }
    __syncthreads();
}

struct Args { const float* in[14]; float* out; unsigned char* ws; float inv_freq[8]; int ph_lo, ph_hi; };

__global__ void __launch_bounds__(NTHR, 2) hybrid_fwd(Args args) {
    extern __shared__ __attribute__((aligned(16))) unsigned char lds_raw[];
    LAS unsigned char* lds = (LAS unsigned char*)lds_raw;
    cg::grid_group grid = cg::this_grid();
    const int wave = __builtin_amdgcn_readfirstlane((int)threadIdx.x >> 6);
    const int G = gridDim.x, bx = blockIdx.x;
    const int gw = bx * NWAVES + wave, NGW = G * NWAVES;
#define FRESH_IDS const int lane = opaque((int)__builtin_amdgcn_mbcnt_hi(~0u, __builtin_amdgcn_mbcnt_lo(~0u, 0u))), tid = wave * 64 + lane
    unsigned char* ws = args.ws;
    const float* x = args.in[0]; const float* ln1 = args.in[1]; const float* w_in = args.in[2];
    const float* lq1 = args.in[3]; const float* lk1 = args.in[4]; const float* lq2 = args.in[5]; const float* lk2 = args.in[6];
    const float* g_diff = args.in[7]; const float* g_sb = args.in[8]; const float* w_out = args.in[9]; const float* ln2 = args.in[10];
    const float* w1 = args.in[11]; const float* w2 = args.in[12]; const float* ln_f = args.in[13];
    float* out = args.out;
    bf16* Win_t = (bf16*)(ws + WS_WIN); bf16* Wout_t = (bf16*)(ws + WS_WOUT); unsigned char* W1_8t = ws + WS_W1; unsigned char* W2_8t = ws + WS_W2; unsigned char* Hb8 = ws + WS_H8;
    float* cs = (float*)(ws + WS_CS); float* ss1 = (float*)(ws + WS_SS1); float* ss2 = (float*)(ws + WS_SS2);
    bf16* Hb = (bf16*)(ws + WS_H); bf16* QKV = (bf16*)(ws + WS_QKV); bf16* MIX = (bf16*)(ws + WS_MIX); unsigned char* U8 = ws + WS_U;
    const int lo = args.ph_lo, hi_ph = args.ph_hi;
#define IN(k) (lo <= (k) && (k) < hi_ph)
    unsigned* ctl = (unsigned*)(ws + WS_CTL);
    const bool t0 = (wave == 0) && (__builtin_amdgcn_mbcnt_hi(~0u, __builtin_amdgcn_mbcnt_lo(~0u, 0u)) == 0);
    if (args.ph_lo < 0) grid.sync();
    volatile LAS unsigned* bst = (volatile LAS unsigned*)(lds + RING_BYTES);
    if (t0) { bst[0] = 0u; bst[1] = 0u; }
    __syncthreads();
    XcdBarrier xbar = xcd_barrier_post(ctl + 1024, bst, t0);
#define SEAM(k) do { if (IN(k) && IN((k) + 1)) xcd_barrier(xbar, t0); } while (0)
    if (IN(0)) {
        FRESH_IDS;
        LAS float* scr = (LAS float*)(lds + wave * 16384);
        constexpr int I_IN = (DM / 64) * (PW / 32), I_OUT = (DM / 64) * (DM / 32), I_1 = (DM / 64) * (FF / 32), I_2 = (FF / 64) * (DM / 32);
        constexpr int NITEMS = I_IN + I_OUT + I_1 + I_2;
        for (int it = gw; it < NITEMS; it += NGW) {
            int r = it;
            if (r < I_IN) { transpose_item(w_in, DM, PW, Win_t, nullptr, scr, r, lane); continue; } r -= I_IN;
            if (r < I_OUT) { transpose_item(w_out, DM, DM, Wout_t, nullptr, scr, r, lane); continue; } r -= I_OUT;
            if (r < I_1) { transpose_item_fp8(w1, DM, FF, W1_8t, ln2, W1_SCALE, scr, r, lane); continue; } r -= I_1;
            transpose_item_fp8(w2, FF, DM, W2_8t, nullptr, W2_SCALE, scr, r, lane);
        }
        for (int m = gw; m < M; m += NGW) {
            const f32x4* xr = (const f32x4*)(x + (size_t)m * DM) + lane; const f32x4* gr = (const f32x4*)ln1 + lane;
            f32x4 v[8], gv[8]; float s = 0.f;
#pragma unroll
            for (int j = 0; j < 8; ++j) { v[j] = __builtin_nontemporal_load(xr + 64 * j); gv[j] = gr[64 * j]; }
#pragma unroll
            for (int j = 0; j < 8; ++j) s += (v[j][0] * v[j][0] + v[j][1] * v[j][1]) + (v[j][2] * v[j][2] + v[j][3] * v[j][3]);
            const float rstd = 1.f / sqrtf(wave_sum(s) * (1.f / DM) + EPS);
            v2u* o8 = (v2u*)(Hb + (size_t)m * DM) + lane;
#pragma unroll
            for (int j = 0; j < 8; ++j) { const f32x4 gq = gv[j]; v2u w; w.x = pk2(v[j][0] * rstd * gq[0], v[j][1] * rstd * gq[1]); w.y = pk2(v[j][2] * rstd * gq[2], v[j][3] * rstd * gq[3]); o8[64 * j] = w; }
        }
        for (int e = bx * NTHR + tid; e < SEQ * 8; e += G * NTHR) {
            const int pos = e >> 3, i = e & 7;
            const float ang = (float)pos * args.inv_freq[i];
            const double rev = (double)ang * 0.15915494309189533577; const float fr = (float)(rev - rint(rev));
            cs[pos * 16 + i] = __builtin_amdgcn_cosf(fr); cs[pos * 16 + 8 + i] = __builtin_amdgcn_sinf(fr);
        }
        for (int e = bx * NTHR + tid; e < SEQ; e += G * NTHR) { ss1[e] = 0.f; ss2[e] = 0.f; }
    }
    SEAM(0);
    if (IN(1)) {
        pg8::Gemm g{Hb, Win_t, M, PW, DM}; pg8::StaticOrder S; S.init(M, PW, G, bx);
        EpiQKV E{QKV, cs};
        pg8::gemm_phase<EpiQKV, pg8::StaticOrder, true, true>(lds, g, S, E, wave);
    }
    SEAM(1);
    if (IN(2)) {
        FRESH_IDS;
        const float a = lq1[lane] * lk1[lane], b = lq2[lane] * lk2[lane];
        const float lam = __builtin_bit_cast(float, __builtin_amdgcn_readfirstlane(__builtin_bit_cast(int, __expf(wave_sum(a)) - __expf(wave_sum(b)) + LAM_INIT)));
        float* o1s = (float*)(ws + WS_H);
        for (int u = bx; u < 256; u += G) {
            const int head = u & 7, p = u >> 3;
#pragma unroll 1
            for (int t = 0; t < 2; ++t) diff_unit(lds, QKV, MIX, o1s, g_diff, lam, head, t ? 63 - p : p, wave, lane, tid);
        }
        __syncthreads();
        const int lane_sb = opaque(lane);
        for (int wu = gw; wu < 8 * 512; wu += NGW) sb_unit(lds + wave * 8192, QKV, MIX, g_sb, wu & 7, 511 - (wu >> 3), lane_sb);
        __syncthreads();
    }
    SEAM(2);
    if (IN(3)) {
        pg8::Gemm g{MIX, Wout_t, M, DM, DM}; pg8::StaticOrder S; S.init(M, DM, G, bx);
        EpiRes<false> E{x, Hb, Hb8, ss1, 1.f};
        pg8::gemm_phase<EpiRes<false>, pg8::StaticOrder, false, true>(lds, g, S, E, wave);
    }
    SEAM(3);
    if (IN(4)) {
        pg8::Gemm g{(const pg8::bf16_t*)Hb8, (const pg8::bf16_t*)W1_8t, M, FF, DM / 2}; pg8::StaticOrder S; S.init(M, FF, G, bx);
        EpiMlpIn E{U8, ss1};
        pg8::gemm_phase<EpiMlpIn, pg8::StaticOrder, true, true, true>(lds, g, S, E, wave);
    }
    SEAM(4);
    if (IN(5)) {
        pg8::Gemm g{(const pg8::bf16_t*)U8, (const pg8::bf16_t*)W2_8t, M, DM, FF / 2}; pg8::StaticOrder S; S.init(M, DM, G, bx);
        EpiRes<true> E{nullptr, Hb, nullptr, ss2, 1.f / W2_SCALE};
        pg8::gemm_phase<EpiRes<true>, pg8::StaticOrder, false, true, true>(lds, g, S, E, wave);
    }
    SEAM(5);
    if (IN(6)) {
        FRESH_IDS;
        for (int m = gw; m < M; m += NGW) {
            const v4u* xr = (const v4u*)(Hb + (size_t)m * DM) + lane; const f32x4* gr = (const f32x4*)ln_f + 2 * lane; f32x4* orow = (f32x4*)(out + (size_t)m * DM) + 2 * lane;
            v4u v[4]; f32x4 g0[4], g1[4];
#pragma unroll
            for (int j = 0; j < 4; ++j) { v[j] = xr[64 * j]; g0[j] = gr[128 * j]; g1[j] = gr[128 * j + 1]; }
            const float rstd = 1.f / sqrtf(__hip_atomic_load(ss2 + m, __ATOMIC_RELAXED, __HIP_MEMORY_SCOPE_AGENT) * (1.f / DM) + EPS);
            asm volatile("" ::: "memory");
#pragma unroll
            for (int j = 0; j < 4; ++j) {
                const f32x4 a = {__builtin_bit_cast(float, v[j].x << 16), __builtin_bit_cast(float, v[j].x & 0xffff0000u), __builtin_bit_cast(float, v[j].y << 16), __builtin_bit_cast(float, v[j].y & 0xffff0000u)};
                const f32x4 c = {__builtin_bit_cast(float, v[j].z << 16), __builtin_bit_cast(float, v[j].z & 0xffff0000u), __builtin_bit_cast(float, v[j].w << 16), __builtin_bit_cast(float, v[j].w & 0xffff0000u)};
                __builtin_nontemporal_store(a * rstd * g0[j], orow + 128 * j); __builtin_nontemporal_store(c * rstd * g1[j], orow + 128 * j + 1);
            }
        }
    }
#undef IN
#undef SEAM
}

extern "C" void kernel_launch(void* const* d_in, const int* in_sizes, int n_in, void* d_out, int out_size, void* d_ws, size_t ws_size, hipStream_t stream) {
    static int grid = 0;
    if (grid == 0) {
        if (n_in != 14 || in_sizes[0] != M * DM || out_size != M * DM || ws_size < WS_END) { fprintf(stderr, "kernel_launch: unexpected shapes (n_in %d, in0 %d, out %d, ws %zu)\n", n_in, n_in > 0 ? in_sizes[0] : -1, out_size, ws_size); grid = -1; return; }
        int dev = 0, cus = 0, per_cu = 0;
        (void)hipGetDevice(&dev); (void)hipDeviceGetAttribute(&cus, hipDeviceAttributeMultiprocessorCount, dev);
        if (hipFuncSetAttribute((const void*)hybrid_fwd, hipFuncAttributeMaxDynamicSharedMemorySize, LDS_BYTES) != hipSuccess) { fprintf(stderr, "kernel_launch: hipFuncSetAttribute failed\n"); grid = -1; return; }
        if (hipOccupancyMaxActiveBlocksPerMultiprocessor(&per_cu, (const void*)hybrid_fwd, NTHR, LDS_BYTES) != hipSuccess || per_cu < 1) { fprintf(stderr, "kernel_launch: occupancy query gave %d\n", per_cu); per_cu = 1; }
        (void)hipGetLastError();
        grid = cus * per_cu;
    }
    if (grid < 0) return;
    if (hipMemsetAsync((char*)d_ws + WS_CTL, 0, 32768, stream) != hipSuccess) { fprintf(stderr, "kernel_launch: memset failed\n"); return; }
    Args a{};
    for (int i = 0; i < 14; ++i) a.in[i] = (const float*)d_in[i];
    a.out = (float*)d_out; a.ws = (unsigned char*)d_ws;
    for (int i = 0; i < 8; ++i) a.inv_freq[i] = (float)pow(500000.0, -(double)i / 8.0);
    a.ph_lo = 0; a.ph_hi = 7;
    void* kargs[] = {&a};
    hipError_t e = hipLaunchCooperativeKernel((const void*)hybrid_fwd, dim3(grid), dim3(NTHR), kargs, LDS_BYTES, stream);
    if (e != hipSuccess) fprintf(stderr, "kernel_launch: cooperative launch failed: %s (grid %d)\n", hipGetErrorString(e), grid);
}
```

```cpp
#include <hip/hip_runtime.h>
#include <hip/hip_cooperative_groups.h>
#include <cstdio>
#include <cstdint>
#include <cmath>
namespace cg = cooperative_groups;
namespace pg8 {
#define PG8_LAS __attribute__((address_space(3)))
typedef unsigned short bf16_t;
typedef short bf16x8 __attribute__((ext_vector_type(8)));
typedef float f32x4 __attribute__((ext_vector_type(4)));
typedef unsigned u32x4 __attribute__((ext_vector_type(4)));
typedef int v8i32 __attribute__((ext_vector_type(8)));
typedef int i32x4 __attribute__((ext_vector_type(4)));
constexpr int BM = 256, BK = 64, HALF = 128, HTB = HALF * BK * 2  , STAGE_BYTES = 8 * HTB, NXCD = 8, WGM = 8;

__host__ __device__ __forceinline__ int lds_byte(int r, int c) { const int st = (r >> 4) * 2 + (c >> 5), rr = r & 15, cc = c & 31, ob = rr * 64 + cc * 2; return st * 1024 + (ob ^ (((ob >> 9) & 1) << 5)); }
__host__ __device__ __forceinline__ void stage_rc(int b, int& R, int& C) { const int st = b / 1024, sb = b % 1024, swz = sb ^ (((sb >> 9) & 1) << 5); R = (st >> 1) * 16 + swz / 64; C = (st & 1) * 32 + (swz % 64) / 2; }
__host__ __device__ __forceinline__ int perm32(int rho) { const int n = rho >> 4, i = rho & 15; return 8 * (i >> 2) + 4 * n + (i & 3); }

struct Unit { int pm, pn; };
struct Gemm { const bf16_t* A; const bf16_t* Bt; int M, N, K; };

struct StaticOrder {
    int nM, nN, nwg, G, c;
    __host__ __device__ void init(int M, int N, int G_, int c_) { nM = M / BM; nN = N / BM; nwg = nM * nN; G = G_; c = c_; }
    __host__ __device__ bool next(int i, Unit& u) const {
        const long L = (long)i * G + c; if (L >= nwg) return false;
        int wgid = (int)L; { const int q = nwg / NXCD, r = nwg % NXCD, xcd = wgid % NXCD, off = wgid / NXCD; wgid = (xcd < r ? xcd * (q + 1) : r * (q + 1) + (xcd - r) * q) + off; }
        const int nig = WGM * nN, gid = wgid / nig, fm = gid * WGM, gsz = (nM - fm) < WGM ? (nM - fm) : WGM;
        u.pm = fm + ((wgid % nig) % gsz); u.pn = (wgid % nig) / gsz; return true;
    }
    __device__ __forceinline__ void a_ready(const Unit&) const {}
    __device__ __forceinline__ void done(const Unit&) const {}
};

__device__ __forceinline__ unsigned cvt_pk_bf16(float lo, float hi) { unsigned r; asm volatile("v_cvt_pk_bf16_f32 %0, %1, %2" : "=v"(r) : "v"(lo), "v"(hi)); return r; }
template <class Epi, class Sched, bool ALIGN_EPI = false, bool SP2 = false, bool FP8 = false>
__device__ __forceinline__ void gemm_phase(PG8_LAS unsigned char* lds, const Gemm g, const Sched& S, const Epi& E, int wave_id) {
    int tid_ = wave_id * 64 + (int)__builtin_amdgcn_mbcnt_hi(~0u, __builtin_amdgcn_mbcnt_lo(~0u, 0u)); asm volatile("" : "+v"(tid_));
    const int tid = tid_, wid = __builtin_amdgcn_readfirstlane(tid >> 6), lane = tid & 63, wr = wid >> 2, wc = wid & 3, fr = lane & 15, fq = lane >> 4;
    const int K = g.K, nt = K / BK;
    unsigned voffA[2], voffB[2];
#pragma unroll
    for (int i = 0; i < 2; ++i) { int R, C; stage_rc(tid * 16 + i * 8192, R, C); const int Rb = Epi::PERM ? ((R & ~31) + perm32(R & 31)) : R;
        voffA[i] = (unsigned)(R * K + C) * 2u; voffB[i] = (unsigned)(Rb * K + C) * 2u; }
    const size_t kstep = (size_t)(BK * 2);
    const size_t hstep = (size_t)HALF * K * 2;
    const size_t tstep = 2 * hstep;
    const unsigned ldsw = (unsigned)wid * 1024u;
    const int aoff = lds_byte(wr * 64 + fr, fq * 8), boff = lds_byte(wc * 32 + fr, fq * 8);
#define PG8_SA(b, h) (((b) * 2 + (h)) * HTB)
#define PG8_SB(b, h) ((4 + (b) * 2 + (h)) * HTB)
#define PG8_STAGE(bufoff, gbase, voff) do { _Pragma("unroll") for (int _i = 0; _i < 2; ++_i) \
        __builtin_amdgcn_global_load_lds((const unsigned*)((const char*)(gbase) + (voff)[_i]), (PG8_LAS unsigned*)(lds + (bufoff) + ldsw + _i * 8192), 16, 0, 0); } while (0)
#define PG8_LD32(p) __builtin_shufflevector(*(const PG8_LAS i32x4*)(p), *(const PG8_LAS i32x4*)((p) + 1024), 0, 1, 2, 3, 4, 5, 6, 7)
#define PG8_LDA(dst, b, h) do { _Pragma("unroll") for (int m = 0; m < 4; ++m) { if constexpr (FP8) dst##8[m] = PG8_LD32(lds + PG8_SA(b, h) + aoff + m * 2048); else { _Pragma("unroll") for (int k = 0; k < 2; ++k) dst[m][k] = *(const PG8_LAS bf16x8*)(lds + PG8_SA(b, h) + aoff + m * 2048 + k * 1024); } } } while (0)
#define PG8_LDB(dst, b, h) do { _Pragma("unroll") for (int n = 0; n < 2; ++n) { if constexpr (FP8) dst##8[n] = PG8_LD32(lds + PG8_SB(b, h) + boff + n * 2048); else { _Pragma("unroll") for (int k = 0; k < 2; ++k) dst[n][k] = *(const PG8_LAS bf16x8*)(lds + PG8_SB(b, h) + boff + n * 2048 + k * 1024); } } } while (0)
#define PG8_MMA(ai, bj, At, Bt) do { __builtin_amdgcn_s_setprio(1); _Pragma("unroll") for (int m = 0; m < 4; ++m) _Pragma("unroll") for (int n = 0; n < 2; ++n) { \
        if constexpr (FP8) asm volatile("v_mfma_f32_16x16x128_f8f6f4 %0, %1, %2, %0" : "+v"(acc[ai][bj][m][n]) : "v"(Bt##8[n]), "v"(At##8[m]));   \
        else { _Pragma("unroll") for (int k = 0; k < 2; ++k) acc[ai][bj][m][n] = __builtin_amdgcn_mfma_f32_16x16x32_bf16(Bt[n][k], At[m][k], acc[ai][bj][m][n], 0, 0, 0); } } \
        __builtin_amdgcn_s_setprio(0); } while (0)
#define PG8_WAIT_V(n) asm volatile("s_waitcnt vmcnt(" #n ")" ::: "memory")
#define PG8_WAIT_L(n) asm volatile("s_waitcnt lgkmcnt(" #n ")" ::: "memory")
#define PG8_BAR __builtin_amdgcn_s_barrier()
#define PG8_SCHED __builtin_amdgcn_sched_barrier(0)
    Unit cur, nxt; int ui = 0;
    if (!S.next(0, cur)) return;
    f32x4 acc[2][2][4][2];
#pragma unroll
    for (int a = 0; a < 2; ++a)
#pragma unroll
        for (int b = 0; b < 2; ++b)
#pragma unroll
            for (int m = 0; m < 4; ++m)
#pragma unroll
                for (int n = 0; n < 2; ++n) acc[a][b][m][n] = (f32x4){0.f, 0.f, 0.f, 0.f};
    bf16x8 At[4][2], B0[2][2], B1[2][2];
    v8i32 At8[4], B08[2], B18[2];
    const char* cA = (const char*)g.A + (size_t)cur.pm * tstep; const char* cB = (const char*)g.Bt + (size_t)cur.pn * tstep;
    S.a_ready(cur);
    if constexpr (SP2) {
        PG8_STAGE(PG8_SB(0, 0), cB, voffB); PG8_STAGE(PG8_SB(0, 1), cB + hstep, voffB); PG8_STAGE(PG8_SA(0, 0), cA, voffA); PG8_STAGE(PG8_SA(0, 1), cA + hstep, voffA);
        if (wr == 1) PG8_BAR;
        PG8_WAIT_V(2); PG8_BAR;
        PG8_STAGE(PG8_SB(1, 0), cB + kstep, voffB); PG8_STAGE(PG8_SA(1, 0), cA + kstep, voffA); PG8_STAGE(PG8_SB(1, 1), cB + hstep + kstep, voffB);
        PG8_WAIT_V(6); PG8_BAR;
    } else {
        PG8_STAGE(PG8_SB(0, 0), cB, voffB); PG8_STAGE(PG8_SA(0, 0), cA, voffA); PG8_STAGE(PG8_SB(0, 1), cB + hstep, voffB); PG8_STAGE(PG8_SA(0, 1), cA + hstep, voffA);
        if (wr == 1) PG8_BAR;
        PG8_WAIT_V(4); PG8_BAR;
        PG8_STAGE(PG8_SB(1, 0), cB + kstep, voffB); PG8_STAGE(PG8_SA(1, 0), cA + kstep, voffA); PG8_STAGE(PG8_SB(1, 1), cB + hstep + kstep, voffB);
        PG8_WAIT_V(6); PG8_BAR;
    }
    for (;;) {
        const bool has_next = S.next(ui + 1, nxt);
        const char* nA = has_next ? (const char*)g.A + (size_t)nxt.pm * tstep : cA; const char* nB = has_next ? (const char*)g.Bt + (size_t)nxt.pn * tstep : cB;
        for (int t = 0; t < nt; t += 2) {
            const bool last = (t == nt - 2);
            const char* a1 = cA + (size_t)(t + 1) * kstep;
            const char* a2 = last ? nA : cA + (size_t)(t + 2) * kstep; const char* b2 = last ? nB : cB + (size_t)(t + 2) * kstep;
            const char* a3 = a2 + kstep; const char* b3 = b2 + kstep;
            if (last && has_next) S.a_ready(nxt);
            if constexpr (SP2) {
            PG8_LDB(B0, 0, 0); PG8_LDB(B1, 0, 1); PG8_SCHED; PG8_LDA(At, 0, 0); PG8_STAGE(PG8_SA(1, 1), a1 + hstep, voffA);
            PG8_WAIT_V(8); PG8_WAIT_L(0); PG8_BAR; PG8_MMA(0, 0, At, B0); PG8_MMA(0, 1, At, B1); PG8_BAR; PG8_SCHED;
            PG8_LDA(At, 0, 1); PG8_STAGE(PG8_SB(0, 0), b2, voffB); PG8_STAGE(PG8_SB(0, 1), b2 + hstep, voffB); PG8_STAGE(PG8_SA(0, 0), a2, voffA);
            PG8_WAIT_V(8); PG8_WAIT_L(0); PG8_BAR; PG8_MMA(1, 0, At, B0); PG8_MMA(1, 1, At, B1); PG8_BAR; PG8_SCHED;
            PG8_LDB(B0, 1, 0); PG8_LDB(B1, 1, 1); PG8_SCHED; PG8_LDA(At, 1, 0); PG8_STAGE(PG8_SA(0, 1), a2 + hstep, voffA);
            PG8_WAIT_V(8); PG8_WAIT_L(0); PG8_BAR; PG8_MMA(0, 0, At, B0); PG8_MMA(0, 1, At, B1); PG8_BAR; PG8_SCHED;
            PG8_LDA(At, 1, 1); PG8_STAGE(PG8_SB(1, 0), b3, voffB); PG8_STAGE(PG8_SB(1, 1), b3 + hstep, voffB); PG8_STAGE(PG8_SA(1, 0), a3, voffA);
            PG8_WAIT_V(8); PG8_WAIT_L(0); PG8_BAR; PG8_MMA(1, 0, At, B0); PG8_MMA(1, 1, At, B1); PG8_BAR; PG8_SCHED;
            } else {
            PG8_LDB(B0, 0, 0); PG8_SCHED; PG8_LDA(At, 0, 0); PG8_STAGE(PG8_SA(1, 1), a1 + hstep, voffA);
            PG8_WAIT_L(8); PG8_BAR; PG8_WAIT_L(0); PG8_MMA(0, 0, At, B0); PG8_BAR; PG8_SCHED;
            PG8_LDB(B1, 0, 1); PG8_STAGE(PG8_SB(0, 0), b2, voffB);
            PG8_BAR; PG8_WAIT_L(0); PG8_MMA(0, 1, At, B1); PG8_BAR;
            PG8_LDA(At, 0, 1); PG8_STAGE(PG8_SA(0, 0), a2, voffA);
            PG8_BAR; PG8_WAIT_L(0); PG8_MMA(1, 0, At, B0); PG8_BAR; PG8_SCHED;
            PG8_STAGE(PG8_SB(0, 1), b2 + hstep, voffB);
            PG8_WAIT_V(6); PG8_BAR; PG8_MMA(1, 1, At, B1); PG8_BAR;
            PG8_LDB(B0, 1, 0); PG8_SCHED; PG8_LDA(At, 1, 0); PG8_STAGE(PG8_SA(0, 1), a2 + hstep, voffA);
            PG8_WAIT_L(8); PG8_BAR; PG8_WAIT_L(0); PG8_MMA(0, 0, At, B0); PG8_BAR; PG8_SCHED;
            PG8_LDB(B1, 1, 1); PG8_STAGE(PG8_SB(1, 0), b3, voffB);
            PG8_BAR; PG8_WAIT_L(0); PG8_MMA(0, 1, At, B1); PG8_BAR;
            PG8_LDA(At, 1, 1); PG8_STAGE(PG8_SA(1, 0), a3, voffA);
            PG8_BAR; PG8_WAIT_L(0); PG8_MMA(1, 0, At, B0); PG8_BAR; PG8_SCHED;
            PG8_STAGE(PG8_SB(1, 1), b3 + hstep, voffB);
            PG8_WAIT_V(6); PG8_BAR; PG8_MMA(1, 1, At, B1); PG8_BAR;
            }
        }
        if constexpr (FP8) asm volatile("s_nop 15\n\ts_nop 15" ::: "memory");
        if constexpr (ALIGN_EPI) { if (wr == 0) PG8_BAR; }
        if constexpr (!Epi::AFTER_DRAIN) { E(acc, cur, wr, wc, fr, fq); S.done(cur); }
        if (!has_next) break;
#pragma unroll
        for (int a = 0; a < 2; ++a)
#pragma unroll
            for (int b = 0; b < 2; ++b)
#pragma unroll
                for (int m = 0; m < 4; ++m)
#pragma unroll
                    for (int n = 0; n < 2; ++n) acc[a][b][m][n] = (f32x4){0.f, 0.f, 0.f, 0.f};
        cur = nxt; cA = nA; cB = nB; ++ui;
        if constexpr (ALIGN_EPI) { if (wr == 1) PG8_BAR; }
    }
    PG8_WAIT_V(0);
    if constexpr (!ALIGN_EPI) { if (wr == 0) PG8_BAR; }
    PG8_BAR;
    if constexpr (Epi::AFTER_DRAIN) { E.fused(acc, cur, wr, wc, fr, fq, lds, wid, lane); S.done(cur); }
#undef PG8_SA
#undef PG8_SB
#undef PG8_STAGE
#undef PG8_LDA
#undef PG8_LDB
#undef PG8_MMA
#undef PG8_LD32
#undef PG8_WAIT_V
#undef PG8_WAIT_L
#undef PG8_BAR
#undef PG8_SCHED
}
}
#define GAS __attribute__((address_space(1)))
#define LAS __attribute__((address_space(3)))
typedef unsigned short bf16;
typedef unsigned v4u __attribute__((ext_vector_type(4)));
typedef unsigned v2u __attribute__((ext_vector_type(2)));
typedef float f32x4 __attribute__((ext_vector_type(4)));
typedef float f32x16 __attribute__((ext_vector_type(16)));
typedef short bf16x8 __attribute__((ext_vector_type(8)));
typedef short s16x4 __attribute__((ext_vector_type(4)));
using pg8::Unit; using pg8::cvt_pk_bf16; using pg8::BM; using pg8::HALF;

constexpr int SEQ = 16384, DM = 2048, PW = 6144, FF = 8192, M = SEQ;
constexpr int NWAVES = 8, NTHR = 512;
constexpr float EPS = 1e-6f;
constexpr float C2 = 0.125f * 1.4426950408889634f;
constexpr float SBSCALE = 0.08838834764831845f * 1.4426950408889634f;
constexpr float LAM_INIT = 0.2f;
constexpr float W1_SCALE = 32.f;
constexpr float W2_SCALE = 512.f;
constexpr int COL_DQ = 0, COL_DK = 1024, COL_DV = 2048, COL_SQ = 3072, COL_SK = 4096, COL_SV = 5120;

constexpr size_t MiB = 1u << 20;
constexpr size_t WS_WIN = 0;
constexpr size_t WS_WOUT = 24 * MiB;
constexpr size_t WS_W1 = 32 * MiB;
constexpr size_t WS_W2 = 64 * MiB;
constexpr size_t WS_CS = 96 * MiB;
constexpr size_t WS_SS1 = 97 * MiB;
constexpr size_t WS_SS2 = 97 * MiB + 65536;
constexpr size_t WS_H = 98 * MiB;
constexpr size_t WS_QKV = 162 * MiB;
constexpr size_t WS_MIX = 354 * MiB;
constexpr size_t WS_U = 162 * MiB;
constexpr size_t WS_CTL = 418 * MiB;
constexpr size_t WS_H8 = 420 * MiB;
constexpr size_t WS_END = 452 * MiB;

constexpr int RING_BYTES = 131072, LDS_BYTES = 131072 + 1024;

__device__ __forceinline__ unsigned f2bf(float f) { unsigned u = __builtin_bit_cast(unsigned, f); return (u + 0x7fffu + ((u >> 16) & 1u)) >> 16; }
__device__ __forceinline__ unsigned pk2(float lo, float hi) { return f2bf(lo) | (f2bf(hi) << 16); }
__device__ __forceinline__ float wave_sum(float v) {
#pragma unroll
    for (int o = 1; o < 64; o <<= 1) v += __shfl_xor(v, o);
    return v;
}
typedef unsigned u32x2_t __attribute__((ext_vector_type(2)));
__device__ __forceinline__ void swap_x32(float& a, float& b) { asm volatile("s_nop 1\n\tv_permlane32_swap_b32 %0, %1" : "+v"(a), "+v"(b)); }
__device__ __forceinline__ float max_x32(float x) { float a = x, b = x; swap_x32(a, b); return fmaxf(a, b); }
__device__ __forceinline__ float sum_x32(float x) { float a = x, b = x; swap_x32(a, b); return a + b; }
__device__ __forceinline__ float partner_x32(float x, int hi) { float a = x, b = x; swap_x32(a, b); return hi ? a : b; }
#define LDS_WAIT() asm volatile("s_waitcnt lgkmcnt(0)" ::: "memory")
__device__ __forceinline__ int opaque(int v) { asm volatile("" : "+v"(v)); return v; }

struct EpiQKV {
    static constexpr bool PERM = true, AFTER_DRAIN = false;
    bf16* O; const float* cs;
    __device__ __forceinline__ void operator()(const f32x4 (&acc)[2][2][4][2], const Unit& u, int wr, int wc, int fr, int fq) const {
        const int row0 = u.pm * BM + wr * 64 + fr, col0 = u.pn * BM + wc * 32 + 8 * fq;
        float sc = 1.f; if (u.pn < 4) sc = C2; else if (u.pn >= 12 && u.pn < 16) sc = SBSCALE;
        const bool rot = (u.pn < 8) && ((wc & 1) == 0);
        if (rot) {
#pragma unroll
            for (int ai = 0; ai < 2; ++ai) {
                f32x4 cv[4][4];
#pragma unroll
                for (int m = 0; m < 4; ++m) { const f32x4* p = (const f32x4*)(cs + (size_t)(row0 + ai * HALF + m * 16) * 16); cv[m][0] = p[0]; cv[m][1] = p[1]; cv[m][2] = p[2]; cv[m][3] = p[3]; }
#pragma unroll
                for (int m = 0; m < 4; ++m) {
                    const int row = row0 + ai * HALF + m * 16;
                    const f32x4 c0 = cv[m][0], c1 = cv[m][1]; f32x4 s0 = cv[m][2], s1 = cv[m][3]; if (fq == 0) { s0 = -s0; s1 = -s1; }
#pragma unroll
                    for (int bj = 0; bj < 2; ++bj) {
                        f32x4 v0 = acc[ai][bj][m][0] * sc, v1 = acc[ai][bj][m][1] * sc, p0, p1;
#pragma unroll
                        for (int e = 0; e < 4; ++e) { p0[e] = __shfl_xor(v0[e], 16); p1[e] = __shfl_xor(v1[e], 16); }
                        if (fq < 2) { v0 = v0 * c0 + p0 * s0; v1 = v1 * c1 + p1 * s1; }
                        v4u w; w.x = cvt_pk_bf16(v0[0], v0[1]); w.y = cvt_pk_bf16(v0[2], v0[3]); w.z = cvt_pk_bf16(v1[0], v1[1]); w.w = cvt_pk_bf16(v1[2], v1[3]);
                        *(v4u*)(O + (size_t)row * PW + col0 + bj * HALF) = w;
                    }
                }
            }
        } else {
#pragma unroll
            for (int ai = 0; ai < 2; ++ai)
#pragma unroll
                for (int m = 0; m < 4; ++m) {
                    const int row = row0 + ai * HALF + m * 16;
#pragma unroll
                    for (int bj = 0; bj < 2; ++bj) {
                        const f32x4 v0 = acc[ai][bj][m][0] * sc, v1 = acc[ai][bj][m][1] * sc;
                        v4u w; w.x = cvt_pk_bf16(v0[0], v0[1]); w.y = cvt_pk_bf16(v0[2], v0[3]); w.z = cvt_pk_bf16(v1[0], v1[1]); w.w = cvt_pk_bf16(v1[2], v1[3]);
                        *(v4u*)(O + (size_t)row * PW + col0 + bj * HALF) = w;
                    }
                }
        }
    }
};
template <bool RES_BF16>
struct EpiRes {
    static constexpr bool PERM = true, AFTER_DRAIN = false;
    const float* R; bf16* Yb; unsigned char* Y8; float* ss; float ascale;
    __device__ __forceinline__ void operator()(const f32x4 (&acc)[2][2][4][2], const Unit& u, int wr, int wc, int fr, int fq) const {
        const int row0 = u.pm * BM + wr * 64 + fr, col0 = u.pn * BM + wc * 32 + 8 * fq;
#pragma unroll
        for (int ai = 0; ai < 2; ++ai) {
            f32x4 rv[4][2][2];
#pragma unroll
            for (int m = 0; m < 4; ++m)
#pragma unroll
                for (int bj = 0; bj < 2; ++bj) {
                    const size_t off = (size_t)(row0 + ai * HALF + m * 16) * DM + col0 + bj * HALF;
                    if (RES_BF16) {
                        const v4u t = *(const v4u*)(Yb + off);
                        rv[m][bj][0] = (f32x4){__builtin_bit_cast(float, t.x << 16), __builtin_bit_cast(float, t.x & 0xffff0000u), __builtin_bit_cast(float, t.y << 16), __builtin_bit_cast(float, t.y & 0xffff0000u)};
                        rv[m][bj][1] = (f32x4){__builtin_bit_cast(float, t.z << 16), __builtin_bit_cast(float, t.z & 0xffff0000u), __builtin_bit_cast(float, t.w << 16), __builtin_bit_cast(float, t.w & 0xffff0000u)};
                    } else { rv[m][bj][0] = *(const f32x4*)(R + off); rv[m][bj][1] = *(const f32x4*)(R + off + 4); }
                }
            asm volatile("" ::: "memory");
#pragma unroll
            for (int m = 0; m < 4; ++m) {
                const int row = row0 + ai * HALF + m * 16; float s = 0.f;
#pragma unroll
                for (int bj = 0; bj < 2; ++bj) {
                    const size_t off = (size_t)row * DM + col0 + bj * HALF;
                    const f32x4 v0 = acc[ai][bj][m][0] * ascale + rv[m][bj][0], v1 = acc[ai][bj][m][1] * ascale + rv[m][bj][1];
                    { v4u w; w.x = cvt_pk_bf16(v0[0], v0[1]); w.y = cvt_pk_bf16(v0[2], v0[3]); w.z = cvt_pk_bf16(v1[0], v1[1]); w.w = cvt_pk_bf16(v1[2], v1[3]); *(v4u*)(Yb + off) = w; }
                    if (!RES_BF16) { int w0 = __builtin_amdgcn_cvt_pk_fp8_f32(v0[0], v0[1], 0, false); w0 = __builtin_amdgcn_cvt_pk_fp8_f32(v0[2], v0[3], w0, true);
                        int w1 = __builtin_amdgcn_cvt_pk_fp8_f32(v1[0], v1[1], 0, false); w1 = __builtin_amdgcn_cvt_pk_fp8_f32(v1[2], v1[3], w1, true);
                        *(v2u*)(Y8 + off) = (v2u){(unsigned)w0, (unsigned)w1}; }
                    s += (v0[0] * v0[0] + v0[1] * v0[1]) + (v0[2] * v0[2] + v0[3] * v0[3]) + (v1[0] * v1[0] + v1[1] * v1[1]) + (v1[2] * v1[2] + v1[3] * v1[3]);
                }
                s += __shfl_xor(s, 16); s += __shfl_xor(s, 32);
                if (fq == 0) atomicAdd(ss + row, s);
            }
        }
    }
};
struct EpiMlpIn {
    static constexpr bool PERM = true, AFTER_DRAIN = false;
    unsigned char* O; const float* ss;
    __device__ __forceinline__ void operator()(const f32x4 (&acc)[2][2][4][2], const Unit& u, int wr, int wc, int fr, int fq) const {
        const int row0 = u.pm * BM + wr * 64 + fr, col0 = u.pn * BM + wc * 32 + 8 * fq;
        float rs[2][4];
#pragma unroll
        for (int ai = 0; ai < 2; ++ai)
#pragma unroll
            for (int m = 0; m < 4; ++m) rs[ai][m] = __hip_atomic_load(ss + row0 + ai * HALF + m * 16, __ATOMIC_RELAXED, __HIP_MEMORY_SCOPE_AGENT);
        asm volatile("" ::: "memory");
#pragma unroll
        for (int ai = 0; ai < 2; ++ai)
#pragma unroll
            for (int m = 0; m < 4; ++m) {
                const int row = row0 + ai * HALF + m * 16;
                const float rstd = __builtin_amdgcn_rsqf(rs[ai][m] * (1.f / DM) + EPS) * (1.f / W1_SCALE);
#pragma unroll
                for (int bj = 0; bj < 2; ++bj) {
                    f32x4 v0 = acc[ai][bj][m][0] * rstd, v1 = acc[ai][bj][m][1] * rstd;
#pragma unroll
                    for (int e = 0; e < 4; ++e) { const float a = fmaxf(v0[e], 0.f), b = fmaxf(v1[e], 0.f); v0[e] = fminf(a * a, 448.f); v1[e] = fminf(b * b, 448.f); }
                    int w0 = __builtin_amdgcn_cvt_pk_fp8_f32(v0[0], v0[1], 0, false); w0 = __builtin_amdgcn_cvt_pk_fp8_f32(v0[2], v0[3], w0, true);
                    int w1 = __builtin_amdgcn_cvt_pk_fp8_f32(v1[0], v1[1], 0, false); w1 = __builtin_amdgcn_cvt_pk_fp8_f32(v1[2], v1[3], w1, true);
                    *(v2u*)(O + (size_t)row * FF + col0 + bj * HALF) = (v2u){(unsigned)w0, (unsigned)w1};
                }
            }
    }
};
#define MFMA32(a, b, c) __builtin_amdgcn_mfma_f32_32x32x16_bf16((a), (b), (c), 0, 0, 0)
__device__ __forceinline__ int crow(int r, int hi) { return (r & 3) + 8 * (r >> 2) + 4 * hi; }
typedef short v4i16_t __attribute__((ext_vector_type(4)));
__device__ __forceinline__ s16x4 vtr(LAS const unsigned char* p) { return __builtin_bit_cast(s16x4, __builtin_amdgcn_ds_read_tr16_b64_v4i16((LAS v4i16_t*)p)); }
typedef float f32x2_t __attribute__((ext_vector_type(2)));
typedef __bf16 bf16x2_t __attribute__((ext_vector_type(2)));
__device__ __forceinline__ unsigned cvtpk_s(float lo, float hi) { f32x2_t v = {lo, hi}; bf16x2_t b = __builtin_convertvector(v, bf16x2_t); return __builtin_bit_cast(unsigned, b); }
__device__ __forceinline__ bf16x8 pack8(const f32x16& x, int s) {
    v4u p; p.x = cvtpk_s(x[8 * s], x[8 * s + 1]); p.y = cvtpk_s(x[8 * s + 2], x[8 * s + 3]); p.z = cvtpk_s(x[8 * s + 4], x[8 * s + 5]); p.w = cvtpk_s(x[8 * s + 6], x[8 * s + 7]);
    return __builtin_bit_cast(bf16x8, p);
}

__device__ __forceinline__ void glds16(const void* sbase, unsigned voff, unsigned lds_dst) { unsigned keep;
    asm volatile("s_mov_b32 %0, m0\n\ts_mov_b32 m0, %3\n\ts_nop 0\n\tglobal_load_lds_dwordx4 %1, %2\n\ts_mov_b32 m0, %0" : "=&s"(keep) : "v"(voff), "s"(sbase), "s"(lds_dst) : "memory"); }
template <bool TAIL>
__device__ __forceinline__ void flash_half(f32x16 (&O)[4], f32x16& Sc, f32x16& Sn, float& m_run, float& l_run, bf16x8& mfrag, const bf16x8& onefrag, const bf16x8 (&qf)[4],
                                           LAS const unsigned char* Kn, LAS const unsigned char* Vc, unsigned ka, int kx, unsigned va, int vx, int blk, int hi, int key0, int qrow, int qmin) {
    if (TAIL) {
        const int kb = key0 + 4 * hi;
#pragma unroll
        for (int i = 0; i < 16; ++i) { const int key = kb + (i & 3) + 8 * (i >> 2); if (key > qrow) Sc[i] = -1e30f; }
    }
    float mloc = fmaxf(Sc[0], Sc[1]);
#pragma unroll
    for (int i = 2; i < 16; ++i) mloc = fmaxf(mloc, Sc[i]);
    mloc = max_x32(mloc);
    const bool first = (key0 == 0);
    if (__any(mloc > 8.f) || first) {
        const float m_new = (mloc > 8.f || first) ? __builtin_bit_cast(float, f2bf(m_run + mloc) << 16) : m_run;
        const float delta = m_new - m_run, alpha = __builtin_amdgcn_exp2f(-delta);
        l_run *= alpha;
#pragma unroll
        for (int d = 0; d < 4; ++d)
#pragma unroll
            for (int i = 0; i < 16; ++i) O[d][i] *= alpha;
#pragma unroll
        for (int i = 0; i < 16; ++i) Sc[i] -= delta;
        m_run = m_new;
        mfrag[0] = hi ? (short)0 : (short)(f2bf(-m_new));
    }
#pragma unroll
    for (int i = 0; i < 16; ++i) Sn[i] = 0.f;
    Sn = MFMA32(onefrag, mfrag, Sn);
#pragma unroll
    for (int ks = 0; ks < 4; ++ks) {
        const bf16x8 a0 = *(LAS const bf16x8*)(Kn + ka + (((2 * ks + hi) ^ kx) << 4));
        Sn = MFMA32(a0, qf[ks], Sn);
    }
    float ls = 0.f;
#pragma unroll
    for (int i = 0; i < 16; ++i) { Sc[i] = __builtin_amdgcn_exp2f(Sc[i]); ls += Sc[i]; }
    l_run += ls;
#pragma unroll
    for (int kk = 0; kk < 2; ++kk) {
        if (kk == 1) __builtin_amdgcn_sched_barrier(0);
        const bf16x8 pb = pack8(Sc, kk);
#pragma unroll
        for (int d = 0; d < 4; ++d) {
            LAS const unsigned char* p = Vc + va + kk * 4096 + (((2 * d + blk) ^ vx) << 5);
            const s16x4 lo = vtr(p), hi4 = vtr(p + 2048);
            const bf16x8 a = __builtin_shufflevector(lo, hi4, 0, 1, 2, 3, 4, 5, 6, 7);
            O[d] = MFMA32(a, pb, O[d]);
        }
    }
}

constexpr int DA_V = 49152, KT = 128;
__device__ __forceinline__ void flash_map(f32x16 (&O)[4], LAS unsigned char* lds, const bf16* QKV, int qcol, int kcol, int vcol, int qb, int w, int lane, int tid) {
    const int r32 = lane & 31, hi = lane >> 5;
    const int qmin = qb * 256 + w * 32, qrow = qmin + r32;
    bf16x8 qf[4];
    { const int lq = opaque(lane);
      const bf16* qp = QKV + (size_t)(qmin + (lq & 31)) * PW + qcol + 8 * (lq >> 5);
#pragma unroll
      for (int ks = 0; ks < 4; ++ks) qf[ks] = *(const bf16x8*)(qp + 16 * ks); }
#pragma unroll
    for (int d = 0; d < 4; ++d)
#pragma unroll
        for (int i = 0; i < 16; ++i) O[d][i] = 0.f;
    float m_run = 0.f, l_run = 0.f;
    bf16x8 mfrag = {0, 0, 0, 0, 0, 0, 0, 0}, onefrag = {0, 0, 0, 0, 0, 0, 0, 0}; onefrag[0] = hi ? (short)0 : (short)0x3F80;
    const int nkt = 2 * (qb + 1), nmain = 2 * qb;
    const int krow = tid >> 3, kc = (tid & 7) ^ ((krow >> 1) & 7);
    const unsigned kgo = (unsigned)(krow * PW + kc * 8) * 2u;
    const int vrow = tid >> 4, vpos = tid & 15, vc = ((((vpos >> 1) ^ (2 * (vrow & 3)))) << 1) | (vpos & 1);
    const unsigned vgo = (unsigned)(vrow * PW + vc * 8) * 2u;
    const bf16* kg = QKV + kcol; const bf16* vg = QKV + vcol;
    const unsigned wl = (unsigned)(tid >> 6) * 1024u;
    const size_t tstep = (size_t)KT * PW;
#define DMA16(g, vo, l) glds16((g), (vo), (unsigned)__builtin_amdgcn_readfirstlane((int)(unsigned)(size_t)(l)))
#define DMA_K(t, slot) do { const bf16* g_ = kg + (size_t)(t) * tstep; DMA16(g_, kgo, lds + (slot) + wl); DMA16(g_ + (size_t)64 * PW, kgo, lds + (slot) + 8192 + wl); } while (0)
#define DMA_VH(t, b, h) do { const bf16* g_ = vg + (size_t)(t) * tstep + (size_t)(64 * (h)) * PW; LAS unsigned char* l_ = lds + DA_V + (b) * 32768 + 16384 * (h) + wl; \
        DMA16(g_, vgo, l_); DMA16(g_ + (size_t)32 * PW, vgo, l_ + 8192); } while (0)
#define DMA_V(t, b) do { DMA_VH(t, b, 0); DMA_VH(t, b, 1); } while (0)
    const unsigned ka = r32 * 128;
    const int kx = (r32 >> 1) & 7;
    const int q4 = (lane & 15) >> 2, p4 = lane & 3, blk = (lane >> 4) & 1;
    const int vr0 = 4 * hi + q4;
    const unsigned va = DA_V + vr0 * 256 + 8 * p4;
    const int vx = 2 * q4;
    DMA_K(0, 0); DMA_K(1, 16384); DMA_V(0, 0);
    asm volatile("s_waitcnt vmcnt(0) lgkmcnt(0)\n\ts_barrier" ::: "memory");
    f32x16 S0, S1;
#pragma unroll
    for (int i = 0; i < 16; ++i) S0[i] = 0.f;
#pragma unroll
    for (int ks = 0; ks < 4; ++ks) S0 = MFMA32(*(LAS const bf16x8*)(lds + ka + (((2 * ks + hi) ^ kx) << 4)), qf[ks], S0);
    int kb0 = 0, kb1 = 16384, kb2 = 32768;
    for (int kt = 0; kt < nkt; ++kt) {
        const int buf = kt & 1;
        const bool more = kt + 1 < nkt;
        if (kt + 2 < nkt) DMA_K(kt + 2, kb2);
        LAS const unsigned char* Kc = lds + kb0; LAS const unsigned char* Vb = lds + buf * 32768;
        if (kt < nmain) {
            flash_half<false>(O, S0, S1, m_run, l_run, mfrag, onefrag, qf, Kc + 4096, Vb, ka, kx, va, vx, blk, hi, kt * KT, qrow, qmin);
            if (more) DMA_VH(kt + 1, buf ^ 1, 0);
            flash_half<false>(O, S1, S0, m_run, l_run, mfrag, onefrag, qf, Kc + 8192, Vb + 8192, ka, kx, va, vx, blk, hi, kt * KT + 32, qrow, qmin);
            if (more) DMA_VH(kt + 1, buf ^ 1, 1);
            flash_half<false>(O, S0, S1, m_run, l_run, mfrag, onefrag, qf, Kc + 12288, Vb + 16384, ka, kx, va, vx, blk, hi, kt * KT + 64, qrow, qmin);
            flash_half<false>(O, S1, S0, m_run, l_run, mfrag, onefrag, qf, lds + kb1, Vb + 24576, ka, kx, va, vx, blk, hi, kt * KT + 96, qrow, qmin);
        } else {
            if (more) DMA_V(kt + 1, buf ^ 1);
            flash_half<true>(O, S0, S1, m_run, l_run, mfrag, onefrag, qf, Kc + 4096, Vb, ka, kx, va, vx, blk, hi, kt * KT, qrow, qmin);
            flash_half<true>(O, S1, S0, m_run, l_run, mfrag, onefrag, qf, Kc + 8192, Vb + 8192, ka, kx, va, vx, blk, hi, kt * KT + 32, qrow, qmin);
            flash_half<true>(O, S0, S1, m_run, l_run, mfrag, onefrag, qf, Kc + 12288, Vb + 16384, ka, kx, va, vx, blk, hi, kt * KT + 64, qrow, qmin);
            flash_half<true>(O, S1, S0, m_run, l_run, mfrag, onefrag, qf, lds + kb1, Vb + 24576, ka, kx, va, vx, blk, hi, kt * KT + 96, qrow, qmin);
        }
        asm volatile("s_waitcnt vmcnt(0) lgkmcnt(0)\n\ts_barrier" ::: "memory");
        const int t0 = kb0; kb0 = kb1; kb1 = kb2; kb2 = t0;
    }
#undef DMA16
#undef DMA_K
#undef DMA_V
#undef DMA_VH
    const float l = sum_x32(l_run), inv = 1.f / l;
#pragma unroll
    for (int d = 0; d < 4; ++d)
#pragma unroll
        for (int i = 0; i < 16; ++i) O[d][i] *= inv;
}

__device__ __forceinline__ void headnorm_store(const f32x16 (&O)[4], const float* g, float post, bf16* MIX, int qrow, int col0, int hi) {
    float ss = 0.f;
#pragma unroll
    for (int d = 0; d < 4; ++d)
#pragma unroll
        for (int i = 0; i < 16; ++i) ss += O[d][i] * O[d][i];
    ss = sum_x32(ss);
    const float rs = __builtin_amdgcn_rsqf(ss * (1.f / 128.f) + EPS) * post;
    f32x4 gvv[4][4];
#pragma unroll
    for (int d = 0; d < 4; ++d)
#pragma unroll
        for (int gq = 0; gq < 4; ++gq) gvv[d][gq] = *(const f32x4*)(g + 32 * d + 8 * gq + 4 * hi);
    asm volatile("" ::: "memory");
#pragma unroll
    for (int d = 0; d < 4; ++d)
#pragma unroll
        for (int gq = 0; gq < 4; ++gq) {
            const int dv = 32 * d + 8 * gq + 4 * hi;
            const f32x4 gv = gvv[d][gq];
            v2u w; w.x = cvtpk_s(O[d][4 * gq] * rs * gv[0], O[d][4 * gq + 1] * rs * gv[1]); w.y = cvtpk_s(O[d][4 * gq + 2] * rs * gv[2], O[d][4 * gq + 3] * rs * gv[3]);
            *(v2u*)(MIX + (size_t)qrow * DM + col0 + dv) = w;
        }
}

__device__ __forceinline__ void diff_unit(LAS unsigned char* lds, const bf16* QKV, bf16* MIX, float* o1s, const float* gd, float lam, int head, int qb, int w, int lane, int tid) {
    f32x16 O[4];
#pragma unroll 1
    for (int j = 0; j < 2; ++j) {
        flash_map(O, lds, QKV, COL_DQ + head * 128 + 64 * j, COL_DK + head * 128 + 64 * j, COL_DV + head * 128, qb, w, lane, tid);
        if (j == 0) {
            f32x4* sc = (f32x4*)(o1s + ((size_t)(blockIdx.x * NWAVES + w) * 64 + opaque(lane)) * 64);
#pragma unroll
            for (int d = 0; d < 4; ++d)
#pragma unroll
                for (int i = 0; i < 4; ++i) sc[d * 4 + i] = (f32x4){O[d][4 * i], O[d][4 * i + 1], O[d][4 * i + 2], O[d][4 * i + 3]};
        }
    }
    lane = opaque(lane);
    const f32x4* sc = (const f32x4*)(o1s + ((size_t)(blockIdx.x * NWAVES + w) * 64 + lane) * 64);
#pragma unroll
    for (int d = 0; d < 4; ++d)
#pragma unroll
        for (int i = 0; i < 4; ++i) { const f32x4 t = sc[d * 4 + i];
#pragma unroll
            for (int e = 0; e < 4; ++e) O[d][4 * i + e] = t[e] - lam * O[d][4 * i + e]; }
    headnorm_store(O, gd, 1.f - LAM_INIT, MIX, qb * 256 + w * 32 + (lane & 31), head * 128, lane >> 5);
}

constexpr float SB_STOP = -44.f * 1.4426950408889634f;
__device__ __forceinline__ void sb_unit(LAS unsigned char* vl, const bf16* QKV, bf16* MIX, const float* gs, int head, int qg, int lane) {
    const int r32 = lane & 31, hi = lane >> 5;
    const int qrow = qg * 32 + r32;
    bf16x8 qf[8];
#pragma unroll
    for (int ks = 0; ks < 8; ++ks) qf[ks] = *(const bf16x8*)(QKV + (size_t)qrow * PW + COL_SQ + head * 128 + 16 * ks + 8 * hi);
    f32x16 O[4];
#pragma unroll
    for (int d = 0; d < 4; ++d)
#pragma unroll
        for (int i = 0; i < 16; ++i) O[d][i] = 0.f;
    float R = 0.f;
    const int q4 = (lane & 15) >> 2, p4 = lane & 3, blk = (lane >> 4) & 1;
    const int vr0 = 4 * hi + q4, vx = vr0 & 7;
    const unsigned va = vr0 * 256 + 8 * p4;
    const bf16* kgp = QKV + (size_t)r32 * PW + COL_SK + head * 128 + 8 * hi;
    const bf16* vgp = QKV + (size_t)(lane >> 4) * PW + COL_SV + head * 128 + (lane & 15) * 8;
    bf16x8 kf[8]; v4u vreg[8];
#pragma unroll
    for (int ks = 0; ks < 8; ++ks) kf[ks] = *(const bf16x8*)(kgp + (size_t)(qg * 32) * PW + 16 * ks);
#pragma unroll
    for (int i = 0; i < 8; ++i) vreg[i] = *(const v4u*)(vgp + (size_t)(qg * 32 + 4 * i) * PW);
    for (int kt = qg; kt >= 0; --kt) {
        const int k0 = kt * 32;
        f32x16 S;
#pragma unroll
        for (int i = 0; i < 16; ++i) S[i] = 0.f;
#pragma unroll
        for (int ks = 0; ks < 8; ++ks) S = MFMA32(kf[ks], qf[ks], S);
        LDS_WAIT();
#pragma unroll
        for (int i = 0; i < 8; ++i) { const int row = 4 * i + (lane >> 4), c = lane & 15; *(LAS v4u*)(vl + row * 256 + (((c >> 1) ^ (row & 7)) << 5) + ((c & 1) << 4)) = vreg[i]; }
        if (kt > 0) {
#pragma unroll
            for (int ks = 0; ks < 8; ++ks) kf[ks] = *(const bf16x8*)(kgp + (size_t)(k0 - 32) * PW + 16 * ks);
#pragma unroll
            for (int i = 0; i < 8; ++i) vreg[i] = *(const v4u*)(vgp + (size_t)(k0 - 32 + 4 * i) * PW);
        }
        float lb[16], lom[16];
#pragma unroll
        for (int i = 0; i < 16; ++i) {
            const int key = k0 + crow(i, hi); const float z = S[i];
            const float sp = __builtin_amdgcn_logf(1.f + __builtin_amdgcn_exp2f(-fabsf(z)));
            lb[i] = fminf(z, 0.f) - sp;
            lom[i] = (key < qrow) ? lb[i] - z : 0.f;
        }
        float gsum[4], pgs[4], after[4];
#pragma unroll
        for (int g = 0; g < 4; ++g) { gsum[g] = (lom[4 * g] + lom[4 * g + 1]) + (lom[4 * g + 2] + lom[4 * g + 3]); pgs[g] = partner_x32(gsum[g], hi); }
        float run = 0.f;
#pragma unroll
        for (int g = 3; g >= 0; --g) { after[g] = run + (hi == 0 ? pgs[g] : 0.f); run += gsum[g] + pgs[g]; }
#pragma unroll
        for (int g = 0; g < 4; ++g) {
            float suf = R + after[g];
#pragma unroll
            for (int e = 3; e >= 0; --e) {
                const int i = 4 * g + e; const int key = k0 + crow(i, hi);
                S[i] = (key < qrow) ? __builtin_amdgcn_exp2f(lb[i] + suf) : 0.f;
                suf += lom[i];
            }
        }
        R += run;
        LDS_WAIT();
#pragma unroll
        for (int kk = 0; kk < 2; ++kk) {
            const bf16x8 pb = pack8(S, kk);
#pragma unroll
            for (int d = 0; d < 4; ++d) {
                LAS const unsigned char* p = vl + va + kk * 4096 + (((2 * d + blk) ^ vx) << 5);
                const s16x4 lo = vtr(p), hi4 = vtr(p + 2048);
                const bf16x8 a = __builtin_shufflevector(lo, hi4, 0, 1, 2, 3, 4, 5, 6, 7);
                O[d] = MFMA32(a, pb, O[d]);
            }
        }
        if (__all(R < SB_STOP)) break;
    }
    LDS_WAIT();
    headnorm_store(O, gs, 1.f, MIX, qrow, 1024 + head * 128, hi);
}
__device__ __forceinline__ void transpose_item(const float* W, int K, int N, bf16* WT, const float* g, LAS float* scr, int item, int lane) {
    const int nblk = N / 32, kb = item / nblk, nb = item % nblk, k0 = 64 * kb, n0 = 32 * nb;
    const int r8 = lane >> 3, c4 = (lane & 7) * 4;
    f32x4 v[8];
#pragma unroll
    for (int i = 0; i < 8; ++i) v[i] = __builtin_nontemporal_load((const f32x4*)(W + (size_t)(k0 + r8 + 8 * i) * N + n0 + c4));
#pragma unroll
    for (int i = 0; i < 8; ++i) { const int kk = r8 + 8 * i; const float gs = g ? g[k0 + kk] : 1.f;
#pragma unroll
        for (int e = 0; e < 4; ++e) scr[kk * 33 + c4 + e] = v[i][e] * gs; }
    LDS_WAIT();
    const int c = lane & 7;
#pragma unroll
    for (int j = 0; j < 4; ++j) { const int n = (lane >> 3) + 8 * j; const LAS float* sp = scr + (8 * c) * 33 + n;
        v4u o; o.x = pk2(sp[0 * 33], sp[1 * 33]); o.y = pk2(sp[2 * 33], sp[3 * 33]); o.z = pk2(sp[4 * 33], sp[5 * 33]); o.w = pk2(sp[6 * 33], sp[7 * 33]);
        *(v4u*)(WT + (size_t)(n0 + n) * K + k0 + 8 * c) = o; }
    LDS_WAIT();
}

__device__ __forceinline__ void transpose_item_fp8(const float* W, int K, int N, unsigned char* WT8, const float* g, float scale, LAS float* scr, int item, int lane) {
    const int nblk = N / 32, kb = item / nblk, nb = item % nblk, k0 = 64 * kb, n0 = 32 * nb;
    const int r8 = lane >> 3, c4 = (lane & 7) * 4;
    f32x4 v[8];
#pragma unroll
    for (int i = 0; i < 8; ++i) v[i] = __builtin_nontemporal_load((const f32x4*)(W + (size_t)(k0 + r8 + 8 * i) * N + n0 + c4));
#pragma unroll
    for (int i = 0; i < 8; ++i) { const int kk = r8 + 8 * i; const float gs = g ? g[k0 + kk] * scale : scale;
#pragma unroll
        for (int e = 0; e < 4; ++e) scr[kk * 33 + c4 + e] = v[i][e] * gs; }
    LDS_WAIT();
    const int c = lane & 7;
#pragma unroll
    for (int j = 0; j < 4; ++j) { const int n = (lane >> 3) + 8 * j; const LAS float* sp = scr + (8 * c) * 33 + n;
        int w0 = __builtin_amdgcn_cvt_pk_fp8_f32(sp[0 * 33], sp[1 * 33], 0, false); w0 = __builtin_amdgcn_cvt_pk_fp8_f32(sp[2 * 33], sp[3 * 33], w0, true);
        int w1 = __builtin_amdgcn_cvt_pk_fp8_f32(sp[4 * 33], sp[5 * 33], 0, false); w1 = __builtin_amdgcn_cvt_pk_fp8_f32(sp[6 * 33], sp[7 * 33], w1, true);
        *(v2u*)(WT8 + (size_t)(n0 + n) * K + k0 + 8 * c) = (v2u){(unsigned)w0, (unsigned)w1}; }
    LDS_WAIT();
}

#define XB_TMO      128
#define XB_XCNT(j)  (256  + 64 * (j))
#define XB_XSUB(j)  (1280 + 64 * (j))
#define XB_XGEN(j)  (2304 + 64 * (j))
#define XB_TOP      3328
#define XB_TOPGEN   3392
#define XCD_BAR_WORDS 3456
#define XB_SPIN_CAP (1u << 18)
__device__ __forceinline__ unsigned xb_ld(unsigned* p)              { return __hip_atomic_load(p, __ATOMIC_RELAXED, __HIP_MEMORY_SCOPE_AGENT); }
__device__ __forceinline__ unsigned xb_add(unsigned* p, unsigned v) { return __hip_atomic_fetch_add(p, v, __ATOMIC_RELAXED, __HIP_MEMORY_SCOPE_AGENT); }
__device__ __forceinline__ unsigned xb_xcc_id() { return (unsigned)__builtin_amdgcn_s_getreg((3 << 11) | 20) & 0xFu; }
#define XB_SPIN(cond, bar) do { unsigned _sp = 0; while (cond) { __builtin_amdgcn_s_sleep(1); \
    if ((++_sp & 255u) == 0u) { if (xb_ld(&(bar)[XB_TMO])) break; if (_sp > XB_SPIN_CAP) { atomicAdd(&(bar)[XB_TMO], 1u); break; } } } } while (0)

struct XcdBarrier {
    unsigned* bar; unsigned x;
    volatile LAS unsigned* st;
};

__device__ __forceinline__ XcdBarrier xcd_barrier_post(unsigned* bar, volatile LAS unsigned* st, bool t0) {
    XcdBarrier b; b.bar = bar; b.x = xb_xcc_id(); b.st = st;
    if (t0) (void)xb_add(&bar[XB_XCNT(b.x)], 1u);
    return b;
}
__device__ __forceinline__ void xcd_barrier_complete(unsigned* bar, unsigned x, unsigned& nloc, unsigned& nx) {
    const unsigned G = gridDim.x * gridDim.y * gridDim.z;
    unsigned sum, cnt, mine, sp = 0u;
    for (;;) {
        sum = 0u; cnt = 0u; mine = 0u;
#pragma unroll
        for (unsigned j = 0; j < 16; ++j) { const unsigned c = xb_ld(&bar[XB_XCNT(j)]); sum += c; cnt += (c > 0u) ? 1u : 0u; mine = (j == x) ? c : mine; }
        if (sum == G) break;
        __builtin_amdgcn_s_sleep(1);
        if ((++sp & 255u) == 0u) { if (xb_ld(&bar[XB_TMO])) break; if (sp > XB_SPIN_CAP) { atomicAdd(&bar[XB_TMO], 1u); break; } }
    }
    nloc = mine > 0u ? mine : 1u; nx = cnt > 0u ? cnt : 1u;
}

__device__ __forceinline__ void xcd_barrier(const XcdBarrier& b, bool t0) {
    asm volatile("s_waitcnt vmcnt(0)" ::: "memory");
    __syncthreads();
    if (t0) {
        unsigned* bar = b.bar;
        __builtin_amdgcn_s_waitcnt(0);
        unsigned nloc = b.st[0], nx = b.st[1];
        if (nloc == 0u) { xcd_barrier_complete(bar, b.x, nloc, nx); b.st[0] = nloc; b.st[1] = nx; }
        const unsigned old = xb_add(&bar[XB_XSUB(b.x)], 1u);
        const unsigned gen = old / nloc;
        if (old + 1u == (gen + 1u) * nloc) {
            __builtin_amdgcn_fence(__ATOMIC_RELEASE, "agent");
            asm volatile("s_waitcnt vmcnt(0)" ::: "memory");
            const unsigned og = xb_add(&bar[XB_TOP], 1u);
            const unsigned tg = og / nx;
            if (og + 1u == (tg + 1u) * nx) xb_add(&bar[XB_TOPGEN], 1u);
            else XB_SPIN(xb_ld(&bar[XB_TOPGEN]) == tg, bar);
            __builtin_amdgcn_fence(__ATOMIC_ACQUIRE, "agent");
            xb_add(&bar[XB_XGEN(b.x)], 1u);
            asm volatile("s_waitcnt vmcnt(0)" ::: "memory");
        } else {
            XB_SPIN(xb_ld(&bar[XB_XGEN(b.x)]) == gen, bar);
            __builtin_amdgcn_fence(__ATOMIC_ACQUIRE, "agent");
            asm volatile("s_waitcnt vmcnt(0)" ::: "memory");
        }
    }
    __syncthreads();
}

struct Args { const float* in[14]; float* out; unsigned char* ws; float inv_freq[8]; int ph_lo, ph_hi; };

__global__ void __launch_bounds__(NTHR, 2) hybrid_fwd(Args args) {
    extern __shared__ __attribute__((aligned(16))) unsigned char lds_raw[];
    LAS unsigned char* lds = (LAS unsigned char*)lds_raw;
    cg::grid_group grid = cg::this_grid();
    const int wave = __builtin_amdgcn_readfirstlane((int)threadIdx.x >> 6);
    const int G = gridDim.x, bx = blockIdx.x;
    const int gw = bx * NWAVES + wave, NGW = G * NWAVES;
#define FRESH_IDS const int lane = opaque((int)__builtin_amdgcn_mbcnt_hi(~0u, __builtin_amdgcn_mbcnt_lo(~0u, 0u))), tid = wave * 64 + lane
    unsigned char* ws = args.ws;
    const float* x = args.in[0]; const float* ln1 = args.in[1]; const float* w_in = args.in[2];
    const float* lq1 = args.in[3]; const float* lk1 = args.in[4]; const float* lq2 = args.in[5]; const float* lk2 = args.in[6];
    const float* g_diff = args.in[7]; const float* g_sb = args.in[8]; const float* w_out = args.in[9]; const float* ln2 = args.in[10];
    const float* w1 = args.in[11]; const float* w2 = args.in[12]; const float* ln_f = args.in[13];
    float* out = args.out;
    bf16* Win_t = (bf16*)(ws + WS_WIN); bf16* Wout_t = (bf16*)(ws + WS_WOUT); unsigned char* W1_8t = ws + WS_W1; unsigned char* W2_8t = ws + WS_W2; unsigned char* Hb8 = ws + WS_H8;
    float* cs = (float*)(ws + WS_CS); float* ss1 = (float*)(ws + WS_SS1); float* ss2 = (float*)(ws + WS_SS2);
    bf16* Hb = (bf16*)(ws + WS_H); bf16* QKV = (bf16*)(ws + WS_QKV); bf16* MIX = (bf16*)(ws + WS_MIX); unsigned char* U8 = ws + WS_U;
    const int lo = args.ph_lo, hi_ph = args.ph_hi;
#define IN(k) (lo <= (k) && (k) < hi_ph)
    unsigned* ctl = (unsigned*)(ws + WS_CTL);
    const bool t0 = (wave == 0) && (__builtin_amdgcn_mbcnt_hi(~0u, __builtin_amdgcn_mbcnt_lo(~0u, 0u)) == 0);
    if (args.ph_lo < 0) grid.sync();
    volatile LAS unsigned* bst = (volatile LAS unsigned*)(lds + RING_BYTES);
    if (t0) { bst[0] = 0u; bst[1] = 0u; }
    __syncthreads();
    XcdBarrier xbar = xcd_barrier_post(ctl + 1024, bst, t0);
#define SEAM(k) do { if (IN(k) && IN((k) + 1)) xcd_barrier(xbar, t0); } while (0)
    if (IN(0)) {
        FRESH_IDS;
        LAS float* scr = (LAS float*)(lds + wave * 16384);
        constexpr int I_IN = (DM / 64) * (PW / 32), I_OUT = (DM / 64) * (DM / 32), I_1 = (DM / 64) * (FF / 32), I_2 = (FF / 64) * (DM / 32);
        constexpr int NITEMS = I_IN + I_OUT + I_1 + I_2;
        for (int it = gw; it < NITEMS; it += NGW) {
            int r = it;
            if (r < I_IN) { transpose_item(w_in, DM, PW, Win_t, nullptr, scr, r, lane); continue; } r -= I_IN;
            if (r < I_OUT) { transpose_item(w_out, DM, DM, Wout_t, nullptr, scr, r, lane); continue; } r -= I_OUT;
            if (r < I_1) { transpose_item_fp8(w1, DM, FF, W1_8t, ln2, W1_SCALE, scr, r, lane); continue; } r -= I_1;
            transpose_item_fp8(w2, FF, DM, W2_8t, nullptr, W2_SCALE, scr, r, lane);
        }
        for (int m = gw; m < M; m += NGW) {
            const f32x4* xr = (const f32x4*)(x + (size_t)m * DM) + lane; const f32x4* gr = (const f32x4*)ln1 + lane;
            f32x4 v[8], gv[8]; float s = 0.f;
#pragma unroll
            for (int j = 0; j < 8; ++j) { v[j] = __builtin_nontemporal_load(xr + 64 * j); gv[j] = gr[64 * j]; }
#pragma unroll
            for (int j = 0; j < 8; ++j) s += (v[j][0] * v[j][0] + v[j][1] * v[j][1]) + (v[j][2] * v[j][2] + v[j][3] * v[j][3]);
            const float rstd = 1.f / sqrtf(wave_sum(s) * (1.f / DM) + EPS);
            v2u* o8 = (v2u*)(Hb + (size_t)m * DM) + lane;
#pragma unroll
            for (int j = 0; j < 8; ++j) { const f32x4 gq = gv[j]; v2u w; w.x = pk2(v[j][0] * rstd * gq[0], v[j][1] * rstd * gq[1]); w.y = pk2(v[j][2] * rstd * gq[2], v[j][3] * rstd * gq[3]); o8[64 * j] = w; }
        }
        for (int e = bx * NTHR + tid; e < SEQ * 8; e += G * NTHR) {
            const int pos = e >> 3, i = e & 7;
            const float ang = (float)pos * args.inv_freq[i];
            const double rev = (double)ang * 0.15915494309189533577; const float fr = (float)(rev - rint(rev));
            cs[pos * 16 + i] = __builtin_amdgcn_cosf(fr); cs[pos * 16 + 8 + i] = __builtin_amdgcn_sinf(fr);
        }
        for (int e = bx * NTHR + tid; e < SEQ; e += G * NTHR) { ss1[e] = 0.f; ss2[e] = 0.f; }
    }
    SEAM(0);
    if (IN(1)) {
        pg8::Gemm g{Hb, Win_t, M, PW, DM}; pg8::StaticOrder S; S.init(M, PW, G, bx);
        EpiQKV E{QKV, cs};
        pg8::gemm_phase<EpiQKV, pg8::StaticOrder, true, true>(lds, g, S, E, wave);
    }
    SEAM(1);
    if (IN(2)) {
        FRESH_IDS;
        const float a = lq1[lane] * lk1[lane], b = lq2[lane] * lk2[lane];
        const float lam = __builtin_bit_cast(float, __builtin_amdgcn_readfirstlane(__builtin_bit_cast(int, __expf(wave_sum(a)) - __expf(wave_sum(b)) + LAM_INIT)));
        float* o1s = (float*)(ws + WS_H);
        for (int u = bx; u < 256; u += G) {
            const int head = u & 7, p = u >> 3;
#pragma unroll 1
            for (int t = 0; t < 2; ++t) diff_unit(lds, QKV, MIX, o1s, g_diff, lam, head, t ? 63 - p : p, wave, lane, tid);
        }
        __syncthreads();
        const int lane_sb = opaque(lane);
        for (int wu = gw; wu < 8 * 512; wu += NGW) sb_unit(lds + wave * 8192, QKV, MIX, g_sb, wu & 7, 511 - (wu >> 3), lane_sb);
        __syncthreads();
    }
    SEAM(2);
    if (IN(3)) {
        pg8::Gemm g{MIX, Wout_t, M, DM, DM}; pg8::StaticOrder S; S.init(M, DM, G, bx);
        EpiRes<false> E{x, Hb, Hb8, ss1, 1.f};
        pg8::gemm_phase<EpiRes<false>, pg8::StaticOrder, false, true>(lds, g, S, E, wave);
    }
    SEAM(3);
    if (IN(4)) {
        pg8::Gemm g{(const pg8::bf16_t*)Hb8, (const pg8::bf16_t*)W1_8t, M, FF, DM / 2}; pg8::StaticOrder S; S.init(M, FF, G, bx);
        EpiMlpIn E{U8, ss1};
        pg8::gemm_phase<EpiMlpIn, pg8::StaticOrder, false, true, true>(lds, g, S, E, wave);
    }
    SEAM(4);
    if (IN(5)) {
        pg8::Gemm g{(const pg8::bf16_t*)U8, (const pg8::bf16_t*)W2_8t, M, DM, FF / 2}; pg8::StaticOrder S; S.init(M, DM, G, bx);
        EpiRes<true> E{nullptr, Hb, nullptr, ss2, 1.f / W2_SCALE};
        pg8::gemm_phase<EpiRes<true>, pg8::StaticOrder, false, true, true>(lds, g, S, E, wave);
    }
    SEAM(5);
    if (IN(6)) {
        FRESH_IDS;
        for (int m = gw; m < M; m += NGW) {
            const v4u* xr = (const v4u*)(Hb + (size_t)m * DM) + lane; const f32x4* gr = (const f32x4*)ln_f + 2 * lane; f32x4* orow = (f32x4*)(out + (size_t)m * DM) + 2 * lane;
            v4u v[4]; f32x4 g0[4], g1[4];
#pragma unroll
            for (int j = 0; j < 4; ++j) { v[j] = xr[64 * j]; g0[j] = gr[128 * j]; g1[j] = gr[128 * j + 1]; }
            const float rstd = 1.f / sqrtf(__hip_atomic_load(ss2 + m, __ATOMIC_RELAXED, __HIP_MEMORY_SCOPE_AGENT) * (1.f / DM) + EPS);
            asm volatile("" ::: "memory");
#pragma unroll
            for (int j = 0; j < 4; ++j) {
                const f32x4 a = {__builtin_bit_cast(float, v[j].x << 16), __builtin_bit_cast(float, v[j].x & 0xffff0000u), __builtin_bit_cast(float, v[j].y << 16), __builtin_bit_cast(float, v[j].y & 0xffff0000u)};
                const f32x4 c = {__builtin_bit_cast(float, v[j].z << 16), __builtin_bit_cast(float, v[j].z & 0xffff0000u), __builtin_bit_cast(float, v[j].w << 16), __builtin_bit_cast(float, v[j].w & 0xffff0000u)};
                __builtin_nontemporal_store(a * rstd * g0[j], orow + 128 * j); __builtin_nontemporal_store(c * rstd * g1[j], orow + 128 * j + 1);
            }
        }
    }
#undef IN
#undef SEAM
}

extern "C" void kernel_launch(void* const* d_in, const int* in_sizes, int n_in, void* d_out, int out_size, void* d_ws, size_t ws_size, hipStream_t stream) {
    static int grid = 0;
    if (grid == 0) {
        if (n_in != 14 || in_sizes[0] != M * DM || out_size != M * DM || ws_size < WS_END) { fprintf(stderr, "kernel_launch: unexpected shapes (n_in %d, in0 %d, out %d, ws %zu)\n", n_in, n_in > 0 ? in_sizes[0] : -1, out_size, ws_size); grid = -1; return; }
        int dev = 0, cus = 0, per_cu = 0;
        (void)hipGetDevice(&dev); (void)hipDeviceGetAttribute(&cus, hipDeviceAttributeMultiprocessorCount, dev);
        if (hipFuncSetAttribute((const void*)hybrid_fwd, hipFuncAttributeMaxDynamicSharedMemorySize, LDS_BYTES) != hipSuccess) { fprintf(stderr, "kernel_launch: hipFuncSetAttribute failed\n"); grid = -1; return; }
        if (hipOccupancyMaxActiveBlocksPerMultiprocessor(&per_cu, (const void*)hybrid_fwd, NTHR, LDS_BYTES) != hipSuccess || per_cu < 1) { fprintf(stderr, "kernel_launch: occupancy query gave %d\n", per_cu); per_cu = 1; }
        (void)hipGetLastError();
        grid = cus * per_cu;
    }
    if (grid < 0) return;
    if (hipMemsetAsync((char*)d_ws + WS_CTL, 0, 32768, stream) != hipSuccess) { fprintf(stderr, "kernel_launch: memset failed\n"); return; }
    Args a{};
    for (int i = 0; i < 14; ++i) a.in[i] = (const float*)d_in[i];
    a.out = (float*)d_out; a.ws = (unsigned char*)d_ws;
    for (int i = 0; i < 8; ++i) a.inv_freq[i] = (float)pow(500000.0, -(double)i / 8.0);
    a.ph_lo = 0; a.ph_hi = 7;
    void* kargs[] = {&a};
    hipError_t e = hipLaunchCooperativeKernel((const void*)hybrid_fwd, dim3(grid), dim3(NTHR), kargs, LDS_BYTES, stream);
    if (e != hipSuccess) fprintf(stderr, "kernel_launch: cooperative launch failed: %s (grid %d)\n", hipGetErrorString(e), grid);
}
```
